# Optimizing an MI355X kernel written in HIP

```python
import jax, jax.numpy as jnp
from jax import lax
import numpy as np

D_MODEL = 2048
BATCH = 4
SEQ = 4096
DEPTH = 2

GRID_W = 64
CTX_LEN = 256
EPS = 1e-6

MLA_HEADS = 8
MLA_NOPE = 128
MLA_ROPE = 64
MLA_V = 128
MLA_Q_RANK = 512
MLA_KV_RANK = 512
MLA_SCALE = (MLA_NOPE + MLA_ROPE) ** -0.5
ROPE_BASE = 10000.0

NA_HEADS = 4
NA_HEAD_DIM = 128
NA_KH = 8
NA_KW = 16
NA_SCALE = NA_HEAD_DIM ** -0.5

FN_GROUPS = 4
FN_CH = 128

MLA_WIDTH = MLA_HEADS * MLA_V
NA_WIDTH = NA_HEADS * NA_HEAD_DIM
FN_WIDTH = FN_GROUPS * FN_CH
MIX_WIDTH = MLA_WIDTH + NA_WIDTH + FN_WIDTH
IN_SPLITS = (MLA_Q_RANK, MLA_KV_RANK, MLA_ROPE, NA_WIDTH, NA_WIDTH, NA_WIDTH, FN_WIDTH)
IN_COLS = sum(IN_SPLITS)

D_FF = 5632
CONV_W = 3
Q_BLOCK = 128

kernel_name = 'hybrid_mla_natten_fnet_convffn_prefix'


def rmsnorm(x, g):
    xf = x.astype(jnp.float32)
    y = xf * lax.rsqrt(jnp.mean(xf * xf, axis=-1, keepdims=True) + EPS)
    return (y * g.astype(jnp.float32)).astype(x.dtype)


def split_columns(u):
    offs = np.cumsum(IN_SPLITS)[:-1].tolist()
    return jnp.split(u, offs, axis=-1)


def axial_angles(rows, cols):
    n = MLA_ROPE // 4
    freqs = ROPE_BASE ** (-jnp.arange(n, dtype=jnp.float32) / n)
    ang_r = rows.astype(jnp.float32)[:, None, None] * freqs
    ang_c = cols.astype(jnp.float32)[:, None, None] * freqs
    return ang_r, ang_c


def rotate(x, ang):
    n = x.shape[-1] // 2
    x1, x2 = x[..., :n], x[..., n:]
    cos, sin = jnp.cos(ang).astype(x.dtype), jnp.sin(ang).astype(x.dtype)
    return jnp.concatenate([x1 * cos - x2 * sin, x2 * cos + x1 * sin], axis=-1)


def axial_rope(x, ang_r, ang_c):
    h = x.shape[-1] // 2
    return jnp.concatenate([rotate(x[..., :h], ang_r), rotate(x[..., h:], ang_c)], axis=-1)


def mla_qkv(c_q, c_kv, k_r, g_q, w_uq, g_kv, w_ukv, angles):
    B, L, _ = c_q.shape
    q = (rmsnorm(c_q, g_q) @ w_uq).reshape(B, L, MLA_HEADS, MLA_NOPE + MLA_ROPE)
    kv = (rmsnorm(c_kv, g_kv) @ w_ukv).reshape(B, L, MLA_HEADS, MLA_NOPE + MLA_V)
    q_nope, q_rope = q[..., :MLA_NOPE], q[..., MLA_NOPE:]
    k_nope, v = kv[..., :MLA_NOPE], kv[..., MLA_NOPE:]
    k_rope = k_r[:, :, None, :]
    if angles is not None:
        q_rope = axial_rope(q_rope, *angles)
        k_rope = axial_rope(k_rope, *angles)
    q = jnp.concatenate([q_nope, q_rope], axis=-1)
    k = jnp.concatenate([k_nope, jnp.broadcast_to(k_rope, (B, L, MLA_HEADS, MLA_ROPE))], axis=-1)
    return q, k, v


def blocked_attention(q, k, v, scale):
    B, L, H, dq = q.shape
    dv = v.shape[-1]
    nb = L // Q_BLOCK
    qb = q.reshape(B, nb, Q_BLOCK, H, dq).transpose(1, 0, 2, 3, 4)

    def one_block(qi):
        s = jnp.einsum('bqhd,bkhd->bhqk', qi, k, preferred_element_type=jnp.float32) * scale
        p = jax.nn.softmax(s, axis=-1).astype(v.dtype)
        return jnp.einsum('bhqk,bkhd->bqhd', p, v)

    o = lax.map(one_block, qb)
    return o.transpose(1, 0, 2, 3, 4).reshape(B, L, H * dv)


def neighborhood_attention(q, k, v, k_ctx, v_ctx, rpb):
    B, S, H, d = q.shape
    rows = S // GRID_W
    kh = min(NA_KH, rows)
    qg = q.reshape(B, rows, GRID_W, H, d)
    kg = k.reshape(B, rows, GRID_W, H, d)
    vg = v.reshape(B, rows, GRID_W, H, d)
    w_idx = jnp.arange(GRID_W)
    col_start = jnp.clip(w_idx - NA_KW // 2, 0, GRID_W - NA_KW)
    col_idx = col_start[:, None] + jnp.arange(NA_KW)
    rel_col = col_idx - w_idx[:, None] + (NA_KW - 1)
    nwin = kh * NA_KW

    def one_row(r):
        rs = jnp.clip(r - kh // 2, 0, rows - kh)
        q_r = lax.dynamic_index_in_dim(qg, r, axis=1, keepdims=False)
        k_rows = lax.dynamic_slice_in_dim(kg, rs, kh, axis=1)
        v_rows = lax.dynamic_slice_in_dim(vg, rs, kh, axis=1)
        k_win = k_rows[:, :, col_idx]
        v_win = v_rows[:, :, col_idx]
        rel_row = rs + jnp.arange(kh) - r + (NA_KH - 1)
        bias = rpb[:, rel_row[None, :, None], rel_col[:, None, :]]
        s_win = jnp.einsum('bwhd,bawjhd->bhwaj', q_r, k_win, preferred_element_type=jnp.float32) * NA_SCALE
        s_win = s_win + bias.astype(jnp.float32)
        s_ctx = jnp.einsum('bwhd,bchd->bhwc', q_r, k_ctx, preferred_element_type=jnp.float32) * NA_SCALE
        s = jnp.concatenate([s_win.reshape(B, H, GRID_W, nwin), s_ctx], axis=-1)
        p = jax.nn.softmax(s, axis=-1).astype(v.dtype)
        p_win = p[..., :nwin].reshape(B, H, GRID_W, kh, NA_KW)
        p_ctx = p[..., nwin:]
        return (jnp.einsum('bhwaj,bawjhd->bwhd', p_win, v_win)
                + jnp.einsum('bhwc,bchd->bwhd', p_ctx, v_ctx))

    o = lax.map(one_row, jnp.arange(rows))
    return o.transpose(1, 0, 2, 3, 4).reshape(B, S, H * d)


def fourier_mix(f, w_fnet):
    B, L, _ = f.shape
    fg = f.reshape(B, L, FN_GROUPS, FN_CH).astype(jnp.float32)
    spec = jnp.fft.fft2(fg, axes=(1, 3), norm='ortho').real.astype(f.dtype)
    return jnp.einsum('blgc,gcd->blgd', spec, w_fnet).reshape(B, L, FN_WIDTH)


def conv_ffn(h, w_up, conv_w, conv_b, w_down):
    L = h.shape[1]
    u = h @ w_up
    up = jnp.pad(u, ((0, 0), (CONV_W // 2, CONV_W // 2), (0, 0)))
    u = sum(up[:, j:j + L] * conv_w[j] for j in range(CONV_W)) + conv_b
    gate, val = jnp.split(u, 2, axis=-1)
    return (jax.nn.silu(gate) * val) @ w_down


def heads(t, n_heads):
    B, L, _ = t.shape
    return t.reshape(B, L, n_heads, -1)


def setup_inputs(seed: int = 0) -> dict:
    key = jax.random.key(seed)
    ks = jax.random.split(key, 24)
    D = D_MODEL

    def nrm(k, shape, scale):
        return jax.random.normal(k, shape, jnp.float32) * scale

    return {
        'x': nrm(ks[0], (BATCH, SEQ, D), 1.0),
        'c': nrm(ks[1], (BATCH, D), 1.0),
        'ctx': nrm(ks[2], (BATCH, CTX_LEN, D), 1.0),
        'c_ctx': nrm(ks[3], (D,), 1.0),
        'w_mod': nrm(ks[4], (DEPTH, D, 6 * D), D ** -0.5),
        'b_mod': nrm(ks[5], (DEPTH, 6 * D), 0.02),
        'g_attn': 1.0 + nrm(ks[6], (DEPTH, D), 0.02),
        'g_ffn': 1.0 + nrm(ks[7], (DEPTH, D), 0.02),
        'w_in': nrm(ks[8], (DEPTH, D, IN_COLS), D ** -0.5),
        'g_q': 1.0 + nrm(ks[9], (DEPTH, MLA_Q_RANK), 0.02),
        'w_uq': nrm(ks[10], (DEPTH, MLA_Q_RANK, MLA_HEADS * (MLA_NOPE + MLA_ROPE)), MLA_Q_RANK ** -0.5),
        'g_kv': 1.0 + nrm(ks[11], (DEPTH, MLA_KV_RANK), 0.02),
        'w_ukv': nrm(ks[12], (DEPTH, MLA_KV_RANK, MLA_HEADS * (MLA_NOPE + MLA_V)), MLA_KV_RANK ** -0.5),
        'na_rpb': nrm(ks[13], (DEPTH, NA_HEADS, 2 * NA_KH - 1, 2 * NA_KW - 1), 0.1),
        'w_fnet': nrm(ks[14], (DEPTH, FN_GROUPS, FN_CH, FN_CH), FN_CH ** -0.5),
        'w_out': nrm(ks[15], (DEPTH, MIX_WIDTH, D), MIX_WIDTH ** -0.5),
        'w_up': nrm(ks[16], (DEPTH, D, 2 * D_FF), D ** -0.5),
        'conv_w': nrm(ks[17], (DEPTH, CONV_W, 2 * D_FF), CONV_W ** -0.5),
        'conv_b': nrm(ks[18], (DEPTH, 2 * D_FF), 0.02),
        'w_down': nrm(ks[19], (DEPTH, D_FF, D), D_FF ** -0.5),
        'g_final': 1.0 + nrm(ks[20], (D,), 0.02),
    }


def reference(x, c, ctx, c_ctx, w_mod, b_mod, g_attn, g_ffn, w_in, g_q, w_uq, g_kv, w_ukv,
              na_rpb, w_fnet, w_out, w_up, conv_w, conv_b, w_down, g_final):
    S = x.shape[1]
    pos = jnp.arange(S)
    angles = axial_angles(pos // GRID_W, pos % GRID_W)
    xc = ctx
    mod_in = jax.nn.silu(c)
    modc_in = jax.nn.silu(c_ctx)

    for l in range(DEPTH):
        ctx_out = l < DEPTH - 1
        sh1, sc1, gt1, sh2, sc2, gt2 = jnp.split((mod_in @ w_mod[l] + b_mod[l])[:, None, :], 6, axis=-1)
        csh1, csc1, cgt1, csh2, csc2, cgt2 = jnp.split(modc_in @ w_mod[l] + b_mod[l], 6, axis=-1)

        h = rmsnorm(x, g_attn[l]) * (1 + sc1) + sh1
        hc = rmsnorm(xc, g_attn[l]) * (1 + csc1) + csh1
        cq, ckv, kr, qn, kn, vn, f = split_columns(h @ w_in[l])
        cq_c, ckv_c, kr_c, qn_c, kn_c, vn_c, f_c = split_columns(hc @ w_in[l])

        q_m, k_m, v_m = mla_qkv(cq, ckv, kr, g_q[l], w_uq[l], g_kv[l], w_ukv[l], angles)
        q_mc, k_mc, v_mc = mla_qkv(cq_c, ckv_c, kr_c, g_q[l], w_uq[l], g_kv[l], w_ukv[l], None)
        o_mla = blocked_attention(q_m, jnp.concatenate([k_m, k_mc], axis=1),
                                  jnp.concatenate([v_m, v_mc], axis=1), MLA_SCALE)
        kn_c, vn_c = heads(kn_c, NA_HEADS), heads(vn_c, NA_HEADS)
        o_na = neighborhood_attention(heads(qn, NA_HEADS), heads(kn, NA_HEADS), heads(vn, NA_HEADS),
                                      kn_c, vn_c, na_rpb[l])
        o_fn = fourier_mix(f, w_fnet[l])
        x = x + gt1 * (jnp.concatenate([o_mla, o_na, o_fn], axis=-1) @ w_out[l])

        if ctx_out:
            o_mla_c = blocked_attention(q_mc, k_mc, v_mc, MLA_SCALE)
            o_na_c = blocked_attention(heads(qn_c, NA_HEADS), kn_c, vn_c, NA_SCALE)
            o_fn_c = fourier_mix(f_c, w_fnet[l])
            xc = xc + cgt1 * (jnp.concatenate([o_mla_c, o_na_c, o_fn_c], axis=-1) @ w_out[l])

        h2 = rmsnorm(x, g_ffn[l]) * (1 + sc2) + sh2
        x = x + gt2 * conv_ffn(h2, w_up[l], conv_w[l], conv_b[l], w_down[l])
        if ctx_out:
            h2c = rmsnorm(xc, g_ffn[l]) * (1 + csc2) + csh2
            xc = xc + cgt2 * conv_ffn(h2c, w_up[l], conv_w[l], conv_b[l], w_down[l])

    return rmsnorm(x, g_final)
```

```cpp
#include <hip/hip_runtime.h>
#include <hip/hip_cooperative_groups.h>
#include <cstdio>
namespace cg = cooperative_groups;

#define LAS __attribute__((address_space(3)))
#define DI __device__ __forceinline__
typedef unsigned short bf16_t;
typedef short bf16x8 __attribute__((ext_vector_type(8)));
typedef short s16x4 __attribute__((ext_vector_type(4)));
typedef float f32x4 __attribute__((ext_vector_type(4)));
typedef float f32x2 __attribute__((ext_vector_type(2)));
typedef float f32x16 __attribute__((ext_vector_type(16)));
typedef unsigned u32x4 __attribute__((ext_vector_type(4)));
typedef unsigned u32x2 __attribute__((ext_vector_type(2)));
typedef __bf16 bfv2 __attribute__((ext_vector_type(2)));

constexpr int D = 2048, NB = 4, SEQ = 4096, CTXL = 256, ML = NB * SEQ, MC = NB * CTXL, MT = ML + MC;
constexpr int INC = 3136, UC = 3328;
constexpr int U_CQ = 0, U_CKV = 512, U_QN = 1024, U_KN = 1536, U_VN = 2048, U_F = 2560, U_KR = 3072;
constexpr int DFF = 5632, KEYS = SEQ + CTXL;
constexpr float EPS = 1e-6f, LOG2E = 1.4426950408889634f;
constexpr int NT = 512;
constexpr int LDS_BYTES = 136 * 1024;

constexpr size_t al(size_t x) { return (x + 255) & ~(size_t)255; }
constexpr size_t WS_WIN = 0;
constexpr size_t WS_WUQ = WS_WIN + al((size_t)2 * UC * D * 2);
constexpr size_t WS_WUKV = WS_WUQ + al((size_t)2 * 1536 * 512 * 2);
constexpr size_t WS_WOUT = WS_WUKV + al((size_t)2 * 4096 * 512 * 2);
constexpr size_t WS_WUP = WS_WOUT + al((size_t)2 * D * D * 2);
constexpr size_t WS_WDN = WS_WUP + al((size_t)2 * 2 * DFF * D * 2);
constexpr size_t WS_WC = WS_WDN + al((size_t)2 * D * DFF * 2);
constexpr size_t WS_DFTC = WS_WC + al((size_t)2 * 1024 * 512 * 2);
constexpr size_t WS_TRIG = WS_DFTC + al((size_t)256 * 512 * 2);
constexpr size_t WS_ROPE = WS_TRIG + al(4096 * 8);
constexpr size_t WS_MOD = WS_ROPE + al(64 * 16 * 8);
constexpr size_t WS_CTR = WS_MOD + al((size_t)2 * 5 * 12288 * 4);
constexpr size_t WS_X = WS_CTR + 256;
constexpr size_t WS_H = WS_X + al((size_t)MT * D * 4);
constexpr size_t H_ROWS = 1 + MT + 256;
constexpr size_t WS_CAT = WS_H + al(H_ROWS * D * 2);
constexpr size_t WS_YTC = WS_CAT + al((size_t)MT * D * 2);
constexpr size_t WS_U = WS_YTC + al((size_t)2048 * 512 * 2);
constexpr size_t WS_SSQ = WS_U + al((size_t)MT * UC * 2);
constexpr size_t WS_Q = WS_SSQ + al((size_t)MT * 16 * 4);
constexpr size_t WS_KN = WS_Q + al((size_t)MT * 1536 * 2);
constexpr size_t WS_VT = WS_KN + al((size_t)MT * 1024 * 2);
constexpr size_t WS_VNT = WS_VT + al((size_t)32 * 128 * KEYS * 2);
constexpr size_t WS_YT = WS_VNT + al((size_t)16 * 128 * KEYS * 2);
constexpr size_t WS_END = WS_YT + al((size_t)2048 * 8192 * 2);
constexpr size_t WS_ACT = WS_U;
static_assert(WS_ACT + (size_t)MT * DFF * 2 <= WS_END, "ACT alias");
static_assert((size_t)4096 * 8192 * 2 <= H_ROWS * D * 2, "DFT alias");
static_assert(WS_END <= (size_t)805306368, "workspace");

struct Params { const float* in[21]; float* out; unsigned char* ws; };

DI unsigned pk2(float a, float b) { f32x2 v = {a, b}; bfv2 r = __builtin_convertvector(v, bfv2); return __builtin_bit_cast(unsigned, r); }
DI bf16_t f2bf(float a) { return (bf16_t)(pk2(a, 0.f) & 0xffffu); }
DI float shx(float v, int m, int lane) { return __builtin_bit_cast(float, __builtin_amdgcn_ds_bpermute((lane ^ m) << 2, __builtin_bit_cast(int, v))); }
DI float sq4(f32x4 v) { return (v[0] * v[0] + v[1] * v[1]) + (v[2] * v[2] + v[3] * v[3]); }
DI u32x4 pk8(f32x4 a, f32x4 b) { u32x4 w; w.x = pk2(a[0], a[1]); w.y = pk2(a[2], a[3]); w.z = pk2(b[0], b[1]); w.w = pk2(b[2], b[3]); return w; }

namespace pg8 {
constexpr int BM = 256, BK = 64, HALF = 128, HTB = HALF * BK * 2, STAGE_BYTES = 8 * HTB;
DI int lds_byte(int r, int c) { const int st = (r >> 4) * 2 + (c >> 5), rr = r & 15, cc = c & 31, ob = rr * 64 + cc * 2; return st * 1024 + (ob ^ (((ob >> 9) & 1) << 5)); }
DI void stage_rc(int b, int& R, int& C) { const int st = b / 1024, sb = b % 1024, swz = sb ^ (((sb >> 9) & 1) << 5); R = (st >> 1) * 16 + swz / 64; C = (st & 1) * 32 + (swz % 64) / 2; }
DI int perm32(int rho) { const int n = rho >> 4, i = rho & 15; return 8 * (i >> 2) + 4 * n + (i & 3); }
struct Unit { int pm, pn; };
struct Gemm { const bf16_t* A; const bf16_t* Bt; int lda, ldb, K; int conv; };

struct Sched {
    int nM, nN, cnt, G, c, i0, start;
    DI void init(int nM_, int nN_, int G_, int c_, int start_) { nM = nM_; nN = nN_; cnt = nM * nN; G = G_; c = c_; start = start_;
        i0 = (start_ > c_) ? (start_ - c_ + G_ - 1) / G_ : 0; }
    DI bool next(int i, Unit& u) const {
        const long L = (long)(i0 + i) * G + c - start; if (L >= cnt) return false;
        const int w = (int)L, nig = 8 * nN, gid = w / nig, fm = gid * 8, gsz = (nM - fm) < 8 ? (nM - fm) : 8;
        u.pm = fm + ((w % nig) % gsz); u.pn = (w % nig) / gsz; return true;
    }
};
struct OneUnit { Unit u; bool has; DI bool next(int i, Unit& o) const { o = u; return has && i == 0; } };

template <class Epi, class SchedT>
DI void gemm_phase(LAS unsigned char* lds, const Gemm g, const SchedT& S, const Epi& E) {
    int tid = threadIdx.x; asm volatile("" : "+v"(tid));
    const int wid = __builtin_amdgcn_readfirstlane(tid >> 6), lane = tid & 63, wr = wid >> 2, wc = wid & 3, fr = lane & 15, fq = lane >> 4;
    const int K = g.K, nt = K / BK;
    unsigned voffA[2], voffB[2];
    auto mk_voff = [&]() { int t2 = threadIdx.x; asm volatile("" : "+v"(t2));
#pragma unroll
        for (int i = 0; i < 2; ++i) { int R, C; stage_rc(t2 * 16 + i * 8192, R, C); const int Rb = Epi::PERM ? ((R & ~31) + perm32(R & 31)) : R;
            const int Ra = g.conv ? ((R >> 6) * 62 + (R & 63)) : R;
            voffA[i] = (unsigned)(Ra * g.lda + C) * 2u; voffB[i] = (unsigned)(Rb * g.ldb + C) * 2u; } };
    mk_voff();
    const size_t kstep = (size_t)(BK * 2);
    const size_t hstepA = (size_t)(g.conv ? 124 : HALF) * g.lda * 2, hstepB = (size_t)HALF * g.ldb * 2;
    const size_t tstepA = 2 * hstepA, tstepB = 2 * hstepB;
    const unsigned ldsw = (unsigned)wid * 1024u;
    const int aoff = lds_byte(wr * 64 + fr, fq * 8), boff = lds_byte(wc * 32 + fr, fq * 8);
#define PG8_SA(b, h) (((b) * 2 + (h)) * HTB)
#define PG8_SB(b, h) ((4 + (b) * 2 + (h)) * HTB)
#define PG8_STAGE(bufoff, gbase, voff) do { _Pragma("unroll") for (int _i = 0; _i < 2; ++_i) \
        __builtin_amdgcn_global_load_lds((const unsigned*)((const char*)(gbase) + (voff)[_i]), (LAS unsigned*)(lds + (bufoff) + ldsw + _i * 8192), 16, 0, 0); } while (0)
#define PG8_LDA(dst, b, h) do { _Pragma("unroll") for (int m = 0; m < 4; ++m) _Pragma("unroll") for (int k = 0; k < 2; ++k) dst[m][k] = *(const LAS bf16x8*)(lds + PG8_SA(b, h) + aoff + m * 2048 + k * 1024); } while (0)
#define PG8_LDB(dst, b, h) do { _Pragma("unroll") for (int n = 0; n < 2; ++n) _Pragma("unroll") for (int k = 0; k < 2; ++k) dst[n][k] = *(const LAS bf16x8*)(lds + PG8_SB(b, h) + boff + n * 2048 + k * 1024); } while (0)
#define PG8_MMA(ai, bj, At, Bt) do { __builtin_amdgcn_s_setprio(1); _Pragma("unroll") for (int m = 0; m < 4; ++m) _Pragma("unroll") for (int n = 0; n < 2; ++n) _Pragma("unroll") for (int k = 0; k < 2; ++k) \
        acc[ai][bj][m][n] = __builtin_amdgcn_mfma_f32_16x16x32_bf16(Bt[n][k], At[m][k], acc[ai][bj][m][n], 0, 0, 0); __builtin_amdgcn_s_setprio(0); } while (0)
#define PG8_WAIT_V(n) asm volatile("s_waitcnt vmcnt(" #n ")" ::: "memory")
#define PG8_WAIT_L(n) asm volatile("s_waitcnt lgkmcnt(" #n ")" ::: "memory")
#define PG8_BAR __builtin_amdgcn_s_barrier()
#define PG8_SCHED __builtin_amdgcn_sched_barrier(0)
    Unit cur, nxt; int ui = 0;
    if (!S.next(0, cur)) return;
    f32x4 acc[2][2][4][2];
#pragma unroll
    for (int a = 0; a < 2; ++a)
#pragma unroll
        for (int b = 0; b < 2; ++b)
#pragma unroll
            for (int m = 0; m < 4; ++m)
#pragma unroll
                for (int n = 0; n < 2; ++n) acc[a][b][m][n] = (f32x4){0.f, 0.f, 0.f, 0.f};
    bf16x8 At[4][2], B0[2][2], B1[2][2];
    const char* cA = (const char*)g.A + (size_t)cur.pm * tstepA; const char* cB = (const char*)g.Bt + (size_t)cur.pn * tstepB;
    PG8_STAGE(PG8_SB(0, 0), cB, voffB); PG8_STAGE(PG8_SA(0, 0), cA, voffA); PG8_STAGE(PG8_SB(0, 1), cB + hstepB, voffB); PG8_STAGE(PG8_SA(0, 1), cA + hstepA, voffA);
    if (wr == 1) PG8_BAR;
    PG8_WAIT_V(4); PG8_BAR;
    PG8_STAGE(PG8_SB(1, 0), cB + kstep, voffB); PG8_STAGE(PG8_SA(1, 0), cA + kstep, voffA); PG8_STAGE(PG8_SB(1, 1), cB + hstepB + kstep, voffB);
    PG8_WAIT_V(6); PG8_BAR;
    for (;;) {
        const bool has_next = S.next(ui + 1, nxt);
        const char* nA = has_next ? (const char*)g.A + (size_t)nxt.pm * tstepA : cA; const char* nB = has_next ? (const char*)g.Bt + (size_t)nxt.pn * tstepB : cB;
        for (int t = 0; t < nt; t += 2) {
            const bool last = (t == nt - 2);
            const char* a1 = cA + (size_t)(t + 1) * kstep;
            const char* a2 = last ? nA : cA + (size_t)(t + 2) * kstep; const char* b2 = last ? nB : cB + (size_t)(t + 2) * kstep;
            const char* a3 = a2 + kstep; const char* b3 = b2 + kstep;
            PG8_LDB(B0, 0, 0); PG8_SCHED; PG8_LDA(At, 0, 0); PG8_STAGE(PG8_SA(1, 1), a1 + hstepA, voffA);
            PG8_WAIT_L(8); PG8_BAR; PG8_WAIT_L(0); PG8_MMA(0, 0, At, B0); PG8_BAR; PG8_SCHED;
            PG8_LDB(B1, 0, 1); PG8_STAGE(PG8_SB(0, 0), b2, voffB);
            PG8_BAR; PG8_WAIT_L(0); PG8_MMA(0, 1, At, B1); PG8_BAR;
            PG8_LDA(At, 0, 1); PG8_STAGE(PG8_SA(0, 0), a2, voffA);
            PG8_BAR; PG8_WAIT_L(0); PG8_MMA(1, 0, At, B0); PG8_BAR; PG8_SCHED;
            PG8_STAGE(PG8_SB(0, 1), b2 + hstepB, voffB);
            PG8_WAIT_V(6); PG8_BAR; PG8_MMA(1, 1, At, B1); PG8_BAR;
            PG8_LDB(B0, 1, 0); PG8_SCHED; PG8_LDA(At, 1, 0); PG8_STAGE(PG8_SA(0, 1), a2 + hstepA, voffA);
            PG8_WAIT_L(8); PG8_BAR; PG8_WAIT_L(0); PG8_MMA(0, 0, At, B0); PG8_BAR; PG8_SCHED;
            PG8_LDB(B1, 1, 1); PG8_STAGE(PG8_SB(1, 0), b3, voffB);
            PG8_BAR; PG8_WAIT_L(0); PG8_MMA(0, 1, At, B1); PG8_BAR;
            PG8_LDA(At, 1, 1); PG8_STAGE(PG8_SA(1, 0), a3, voffA);
            PG8_BAR; PG8_WAIT_L(0); PG8_MMA(1, 0, At, B0); PG8_BAR; PG8_SCHED;
            PG8_STAGE(PG8_SB(1, 1), b3 + hstepB, voffB);
            PG8_WAIT_V(6); PG8_BAR; PG8_MMA(1, 1, At, B1); PG8_BAR;
        }
        { int fr2 = fr, fq2 = fq, wr2 = wr, wc2 = wc; asm volatile("" : "+v"(fr2), "+v"(fq2), "+s"(wr2), "+s"(wc2));
          E(acc, cur, wr2, wc2, fr2, fq2); }
        if (has_next) mk_voff();
        if (!has_next) break;
#pragma unroll
        for (int a = 0; a < 2; ++a)
#pragma unroll
            for (int b = 0; b < 2; ++b)
#pragma unroll
                for (int m = 0; m < 4; ++m)
#pragma unroll
                    for (int n = 0; n < 2; ++n) acc[a][b][m][n] = (f32x4){0.f, 0.f, 0.f, 0.f};
        cur = nxt; cA = nA; cB = nB; ++ui;
    }
    PG8_WAIT_V(0);
    if (wr == 0) PG8_BAR;
    PG8_BAR;
#undef PG8_SA
#undef PG8_SB
#undef PG8_STAGE
#undef PG8_LDA
#undef PG8_LDB
#undef PG8_MMA
#undef PG8_WAIT_V
#undef PG8_WAIT_L
#undef PG8_BAR
#undef PG8_SCHED
}
}
using pg8::Unit;
typedef const f32x4 (&AccRef)[2][2][4][2];

DI void row_bk(int row, int& b, int& key) { if (row < ML) { b = row >> 12; key = row & 4095; } else { const int rc = row - ML; b = rc >> 8; key = SEQ + (rc & 255); } }
DI void rope8(f32x4& v0, f32x4& v1, int row, int axis, int fq, int lane, const f32x2* rope) {
    const int l = row & 4095, pos = axis ? (l & 63) : (l >> 6);
    const f32x2* t = rope + pos * 16 + 8 * (fq & 1);
    const float sgn = (fq < 2) ? -1.f : 1.f;
#pragma unroll
    for (int j = 0; j < 4; ++j) {
        const float p0 = shx(v0[j], 32, lane), p1 = shx(v1[j], 32, lane);
        const f32x2 c0 = t[j], c1 = t[4 + j];
        v0[j] = v0[j] * c0.x + sgn * p0 * c0.y; v1[j] = v1[j] * c1.x + sgn * p1 * c1.y;
    }
}

struct EpiU {
    static constexpr bool PERM = true;
    bf16_t* U; float* ssq; bf16_t* VnT; const f32x2* rope; float qscale;
    DI void operator()(AccRef acc, const Unit& u, int wr, int wc, int fr, int fq) const {
        const int pn = u.pn, rowb = u.pm * 256 + wr * 64 + fr;
        if (pn == 8 || pn == 9) {
#pragma unroll
            for (int ai = 0; ai < 2; ++ai)
#pragma unroll
                for (int m = 0; m < 4; ++m) { int b, key; row_bk(rowb + ai * 128 + m * 16, b, key);
#pragma unroll
                    for (int bj = 0; bj < 2; ++bj) { const int hn = 2 * (pn - 8) + bj;
#pragma unroll
                        for (int n = 0; n < 2; ++n) { bf16_t* dst = VnT + ((size_t)((b * 4 + hn) * 128 + 32 * wc + 8 * fq + 4 * n)) * KEYS + key;
#pragma unroll
                            for (int j = 0; j < 4; ++j) dst[(size_t)j * KEYS] = f2bf(acc[ai][bj][m][n][j]); } } }
            return;
        }
        const float sc = (pn == 4 || pn == 5) ? qscale : 1.f;
#pragma unroll
        for (int ai = 0; ai < 2; ++ai)
#pragma unroll
            for (int m = 0; m < 4; ++m) { const int row = rowb + ai * 128 + m * 16; float ss = 0.f;
#pragma unroll
                for (int bj = 0; bj < 2; ++bj) { f32x4 v0 = acc[ai][bj][m][0] * sc, v1 = acc[ai][bj][m][1] * sc;
                    if (pn == 12 && bj == 0 && wc < 2 && row < ML) rope8(v0, v1, row, wc & 1, fq, fq * 16 + fr, rope);
                    ss += sq4(v0) + sq4(v1);
                    *(u32x4*)(U + (size_t)row * UC + 256 * pn + 128 * bj + 32 * wc + 8 * fq) = pk8(v0, v1); }
                if (pn < 4) { ss += shx(ss, 16, fq * 16 + fr); ss += shx(ss, 32, fq * 16 + fr); if (fq == 0) ssq[(size_t)row * 16 + pn * 4 + wc] = ss; } }
    }
};
DI float row_rstd(const float* ssq, int row, int which) { const f32x4 a = *(const f32x4*)(ssq + (size_t)row * 16 + which * 8), b = *(const f32x4*)(ssq + (size_t)row * 16 + which * 8 + 4);
    const float s = ((a[0] + a[1]) + (a[2] + a[3])) + ((b[0] + b[1]) + (b[2] + b[3])); return __builtin_amdgcn_rsqf(s * (1.f / 512.f) + EPS); }
struct EpiQ {
    static constexpr bool PERM = true;
    bf16_t* Q; const float* ssq; const f32x2* rope; float scale;
    DI void operator()(AccRef acc, const Unit& u, int wr, int wc, int fr, int fq) const {
        const int rowb = u.pm * 256 + wr * 64 + fr;
#pragma unroll
        for (int ai = 0; ai < 2; ++ai)
#pragma unroll
            for (int m = 0; m < 4; ++m) { const int row = rowb + ai * 128 + m * 16; const float rs = row_rstd(ssq, row, 0) * scale;
#pragma unroll
                for (int bj = 0; bj < 2; ++bj) { const int c32 = 256 * u.pn + 128 * bj + 32 * wc; f32x4 v0 = acc[ai][bj][m][0] * rs, v1 = acc[ai][bj][m][1] * rs;
                    if (((c32 >> 6) % 3) == 2 && row < ML) rope8(v0, v1, row, (c32 >> 5) & 1, fq, fq * 16 + fr, rope);
                    *(u32x4*)(Q + (size_t)row * 1536 + c32 + 8 * fq) = pk8(v0, v1); } }
    }
};
struct EpiKV {
    static constexpr bool PERM = true;
    bf16_t* KN; bf16_t* VT; const float* ssq;
    DI void operator()(AccRef acc, const Unit& u, int wr, int wc, int fr, int fq) const {
        const int pn = u.pn, rowb = u.pm * 256 + wr * 64 + fr;
#pragma unroll
        for (int ai = 0; ai < 2; ++ai)
#pragma unroll
            for (int m = 0; m < 4; ++m) { const int row = rowb + ai * 128 + m * 16; const float rs = row_rstd(ssq, row, 1); int b, key; row_bk(row, b, key);
#pragma unroll
                for (int bj = 0; bj < 2; ++bj) {
                    if (pn < 4) { *(u32x4*)(KN + (size_t)row * 1024 + 256 * pn + 128 * bj + 32 * wc + 8 * fq) = pk8(acc[ai][bj][m][0] * rs, acc[ai][bj][m][1] * rs); }
                    else { const int h = 2 * (pn - 4) + bj;
#pragma unroll
                        for (int n = 0; n < 2; ++n) { bf16_t* dst = VT + ((size_t)((b * 8 + h) * 128 + 32 * wc + 8 * fq + 4 * n)) * KEYS + key;
#pragma unroll
                            for (int j = 0; j < 4; ++j) dst[(size_t)j * KEYS] = f2bf(acc[ai][bj][m][n][j] * rs); } } } }
    }
};
struct EpiY {
    static constexpr bool PERM = true;
    bf16_t* YT; bf16_t* YTc;
    DI void operator()(AccRef acc, const Unit& u, int wr, int wc, int fr, int fq) const {
        const int g = u.pm;
#pragma unroll
        for (int ai = 0; ai < 2; ++ai)
#pragma unroll
            for (int m = 0; m < 4; ++m) { const int d = 64 * wr + 16 * m + fr;
#pragma unroll
                for (int bj = 0; bj < 2; ++bj) { const int tok = 256 * u.pn + 128 * bj + 32 * wc + 8 * fq; const u32x4 w = pk8(acc[ai][bj][m][0], acc[ai][bj][m][1]);
                    if (tok < ML) { const int b = tok >> 12, l = tok & 4095; *(u32x4*)(YT + ((size_t)((b * 4 + g) * 128 + d)) * 8192 + ai * 4096 + l) = w; }
                    else { const int tc = tok - ML, b = tc >> 8, l = tc & 255; *(u32x4*)(YTc + ((size_t)((b * 4 + g) * 128 + d)) * 512 + ai * 256 + l) = w; } } }
    }
};
struct EpiF {
    static constexpr bool PERM = true;
    bf16_t* CAT; int ctx;
    DI void operator()(AccRef acc, const Unit& u, int wr, int wc, int fr, int fq) const {
        const int b = u.pn >> 1;
#pragma unroll
        for (int ai = 0; ai < 2; ++ai)
#pragma unroll
            for (int m = 0; m < 4; ++m) { const int lp = u.pm * 256 + 128 * ai + 64 * wr + 16 * m + fr; const int row = ctx ? (ML + b * 256 + lp) : (b * 4096 + lp);
#pragma unroll
                for (int bj = 0; bj < 2; ++bj) { const int g = 2 * (u.pn & 1) + bj;
                    *(u32x4*)(CAT + (size_t)row * D + 1536 + g * 128 + 32 * wc + 8 * fq) = pk8(acc[ai][bj][m][0], acc[ai][bj][m][1]); } }
    }
};
struct EpiRes {
    static constexpr bool PERM = false;
    const float* xl; const float* xc; float* out; const float* gate;
    DI void operator()(AccRef acc, const Unit& u, int wr, int wc, int fr, int fq) const {
        const int row0 = u.pm * 256; const int midx = row0 < ML ? (row0 >> 12) : 4;
        const float* src = row0 < ML ? xl : (xc - (size_t)ML * D);
        const float* gp = gate + (size_t)midx * 12288;
        const int col0 = u.pn * 256 + wc * 32 + 4 * fq;
        f32x4 gv[2][2];
#pragma unroll
        for (int bj = 0; bj < 2; ++bj)
#pragma unroll
            for (int n = 0; n < 2; ++n) gv[bj][n] = *(const f32x4*)(gp + col0 + bj * 128 + n * 16);
#pragma unroll
        for (int ai = 0; ai < 2; ++ai)
#pragma unroll
            for (int m = 0; m < 4; ++m) { const size_t off = (size_t)(row0 + wr * 64 + fr + ai * 128 + m * 16) * D + col0;
#pragma unroll
                for (int bj = 0; bj < 2; ++bj)
#pragma unroll
                    for (int n = 0; n < 2; ++n) { const f32x4 xv = *(const f32x4*)(src + off + bj * 128 + n * 16);
                        *(f32x4*)(out + off + bj * 128 + n * 16) = xv + gv[bj][n] * acc[ai][bj][m][n]; }
                asm volatile("" ::: "memory"); }
    }
};
DI float dpp_ror1(float v) { return __builtin_bit_cast(float, __builtin_amdgcn_update_dpp(0, __builtin_bit_cast(int, v), 0x121, 0xf, 0xf, false)); }
DI float dpp_ror15(float v) { return __builtin_bit_cast(float, __builtin_amdgcn_update_dpp(0, __builtin_bit_cast(int, v), 0x12f, 0xf, 0xf, false)); }
struct EpiConv {
    static constexpr bool PERM = true;
    bf16_t* ACT; const float* cw; const float* cb; int Mq;
    DI void operator()(AccRef acc, const Unit& u, int wr, int wc, int fr, int fq) const {
#pragma unroll
        for (int n = 0; n < 2; ++n) {
            const int cg_ = 128 * u.pn + 32 * wc + 8 * fq + 4 * n;
#pragma unroll
            for (int ai = 0; ai < 2; ++ai) {
                const int tok0 = 248 * u.pm - 1 + 62 * (2 * ai + wr);
                f32x4 o[4];
#pragma unroll
                for (int bj = 0; bj < 2; ++bj) {
                    f32x4 w[2][4];
#pragma unroll
                    for (int t = 0; t < 3; ++t) w[bj][t] = *(const f32x4*)(cw + (size_t)t * 2 * DFF + bj * DFF + cg_);
                    w[bj][3] = *(const f32x4*)(cb + bj * DFF + cg_);
#pragma unroll
                    for (int m = 0; m < 4; ++m) {
                        const int tok = tok0 + 16 * m + fr; const int msk = tok < ML ? 4095 : 255;
                        const bool hu = (tok & msk) != 0, hd = ((tok + 1) & msk) != 0;
                        f32x4 r = acc[ai][bj][m][n] * w[bj][1] + w[bj][3];
#pragma unroll
                        for (int j = 0; j < 4; ++j) {
                            const float su = (m > 0 && fr == 15) ? acc[ai][bj][(m + 3) & 3][n][j] : acc[ai][bj][m][n][j];
                            const float sd = (m < 3 && fr == 0) ? acc[ai][bj][(m + 1) & 3][n][j] : acc[ai][bj][m][n][j];
                            const float uu = dpp_ror1(su), dd = dpp_ror15(sd);
                            r[j] += hu ? uu * w[bj][0][j] : 0.f; r[j] += hd ? dd * w[bj][2][j] : 0.f; }
                        if (bj == 0) {
#pragma unroll
                            for (int j = 0; j < 4; ++j) o[m][j] = r[j] * __builtin_amdgcn_rcpf(1.f + __builtin_amdgcn_exp2f(-LOG2E * r[j]));
                        } else o[m] = o[m] * r;
                    }
                }
#pragma unroll
                for (int m = 0; m < 4; ++m) { const int li = 16 * m + fr, tok = tok0 + li;
                    if (li >= 1 && li <= 62 && tok < Mq) { u32x2 v; v.x = pk2(o[m][0], o[m][1]); v.y = pk2(o[m][2], o[m][3]);
                        *(u32x2*)(ACT + (size_t)tok * DFF + cg_) = v; } }
            }
        }
    }
};

struct Frame {
    LAS unsigned char* lds; unsigned char* ldsg; int tid, lane, wave, G, vcu;
    const Params& P; unsigned char* ws;
    DI const float* inp(int i) const { return P.in[i]; }
    DI int nrep(int d) const { int n = 1 + d; asm volatile("" : "+s"(n)); return n; }
    DI void refresh() { int t = threadIdx.x; asm volatile("" : "+v"(t)); tid = t; lane = t & 63; wave = __builtin_amdgcn_readfirstlane(t >> 6);
        unsigned char* w = P.ws; asm volatile("" : "+s"(w)); ws = w;
        int g = gridDim.x, bx = blockIdx.x; asm volatile("" : "+s"(g), "+s"(bx)); G = g; vcu = (g % 8 == 0) ? (bx % 8) * (g / 8) + bx / 8 : bx; }
};

DI void p_mod(const Frame& F) {
    float* sv = (float*)F.ldsg; float* red = sv + 5 * 2048;
    const float* c = F.inp(1); const float* cc = F.inp(3);
    for (int i = F.tid; i < 5 * 2048; i += NT) { const int r = i >> 11, k = i & 2047; const float v = r < 4 ? c[r * 2048 + k] : cc[k]; sv[i] = v / (1.f + __expf(-v)); }
    __syncthreads();
    float* mod = (float*)(F.ws + WS_MOD);
    for (int tile = F.vcu; tile < 384; tile += F.G) {
        const int l = tile / 192, colb = (tile % 192) * 64, cl = F.tid & 63, kg = F.tid >> 6;
        const float* w = F.inp(4) + (size_t)l * 2048 * 12288 + colb + cl;
        float a0 = 0.f, a1 = 0.f, a2 = 0.f, a3 = 0.f, a4 = 0.f;
#pragma unroll 8
        for (int k = kg * 256; k < kg * 256 + 256; ++k) { const float wv = w[(size_t)k * 12288]; a0 += sv[k] * wv; a1 += sv[2048 + k] * wv; a2 += sv[4096 + k] * wv; a3 += sv[6144 + k] * wv; a4 += sv[8192 + k] * wv; }
        float* rp = red + (kg * 64 + cl) * 5; rp[0] = a0; rp[1] = a1; rp[2] = a2; rp[3] = a3; rp[4] = a4;
        __syncthreads();
        if (F.tid < 320) { const int r = F.tid >> 6; float s = 0.f;
#pragma unroll
            for (int q = 0; q < 8; ++q) s += red[(q * 64 + cl) * 5 + r];
            mod[(size_t)(l * 5 + r) * 12288 + colb + cl] = s + F.inp(5)[l * 12288 + colb + cl]; }
        __syncthreads();
    }
}
template <class MapF>
DI void convT(const Frame& F, const float* src, int K, int Nsrc, bf16_t* dst, int Ndst, const float* kscale, MapF map) {
    float* ts = (float*)F.ldsg;
    const int ntn = Ndst / 64, ntiles = ntn * (K / 64);
    for (int t = F.vcu; t < ntiles; t += F.G) {
        const int n0 = (t % ntn) * 64, k0 = (t / ntn) * 64, sc = map(n0);
#pragma unroll
        for (int p = 0; p < 8; ++p) { const int kk = p * 8 + (F.tid >> 6), cc = F.tid & 63;
            float v = sc >= 0 ? src[(size_t)(k0 + kk) * Nsrc + sc + cc] : 0.f; if (kscale) v *= kscale[k0 + kk];
            ts[kk * 65 + cc] = v; }
        __syncthreads();
        { const int n = F.tid >> 3, kc = F.tid & 7; f32x4 a, b;
#pragma unroll
            for (int j = 0; j < 4; ++j) { a[j] = ts[(kc * 8 + j) * 65 + n]; b[j] = ts[(kc * 8 + 4 + j) * 65 + n]; }
            *(u32x4*)(dst + (size_t)(n0 + n) * K + k0 + kc * 8) = pk8(a, b); }
        __syncthreads();
    }
}
DI void p_tables(const Frame& F) {
    const int gt = F.vcu * NT + F.tid, gn = F.G * NT;
    f32x2* trig = (f32x2*)(F.ws + WS_TRIG); f32x2* rope = (f32x2*)(F.ws + WS_ROPE);
    for (int i = gt; i < 4096; i += gn) { f32x2 v; v.x = cospif((float)i / 2048.f); v.y = sinpif((float)i / 2048.f); trig[i] = v; }
    for (int i = gt; i < 1024; i += gn) { const int pos = i >> 4, k = i & 15; const float fr = powf(10000.f, -(float)k / 16.f); const float a = (float)pos * fr; f32x2 v; v.x = cosf(a); v.y = sinf(a); rope[i] = v; }
    bf16_t* dc = (bf16_t*)F.P.out + (size_t)4096 * 8192;
    for (int i = gt; i < 256 * 512; i += gn) { const int lp = i >> 9, c = i & 511, part = c >> 8, l = c & 255; const int idx = (lp * l) & 255;
        const float v = part ? -sinpif((float)idx / 128.f) : cospif((float)idx / 128.f); dc[i] = f2bf(v * (1.f / 16.f)); }
    if (gt < 32) ((unsigned*)(F.ws + WS_CTR))[gt] = 0u;
    if (F.tid == 0) *(float**)(F.ws + WS_CTR + 128) = F.P.out;
    bf16_t* wc = (bf16_t*)(F.ws + WS_WC); const float* wf = F.inp(14);
    for (int i = gt; i < 2 * 4 * 2 * 128 * 128; i += gn) {
        const int d = i & 127, c = (i >> 7) & 127, part = (i >> 14) & 1, g = (i >> 15) & 3, l = i >> 17;
        const float* wp = wf + ((size_t)(l * 4 + g) * 128) * 128 + d; float s = 0.f;
        for (int c2 = 0; c2 < 128; ++c2) { const int idx = (c * c2) & 127; const float tv = part ? sinpif((float)idx / 64.f) : cospif((float)idx / 64.f); s += tv * wp[(size_t)c2 * 128]; }
        s *= 0.08838834764831845f;
        bf16_t* row = wc + ((size_t)l * 1024 + (g * 2 + part) * 128 + d) * 512;
#pragma unroll
        for (int g2 = 0; g2 < 4; ++g2) row[g2 * 128 + c] = (g2 == g) ? f2bf(s) : (bf16_t)0;
    }
}
DI void p_convert(const Frame& F) {
#pragma unroll
    for (int l = 0; l < 2; ++l) {
        convT(F, F.inp(8) + (size_t)l * D * INC, D, INC, (bf16_t*)(F.ws + WS_WIN) + (size_t)l * UC * D, UC, nullptr,
              [](int n) { return n < 1024 ? n : (n < 3072 ? n + 64 : (n < 3136 ? n - 2048 : -1)); });
        convT(F, F.inp(10) + (size_t)l * 512 * 1536, 512, 1536, (bf16_t*)(F.ws + WS_WUQ) + (size_t)l * 1536 * 512, 1536, F.inp(9) + l * 512, [](int n) { return n; });
        convT(F, F.inp(12) + (size_t)l * 512 * 2048, 512, 2048, (bf16_t*)(F.ws + WS_WUKV) + (size_t)l * 2048 * 512, 2048, F.inp(11) + l * 512,
              [](int n) { const int which = n >> 10, h = (n >> 7) & 7, j = n & 127; return h * 256 + which * 128 + j; });
        convT(F, F.inp(15) + (size_t)l * D * D, D, D, (bf16_t*)(F.ws + WS_WOUT) + (size_t)l * D * D, D, nullptr, [](int n) { return n; });
        convT(F, F.inp(16) + (size_t)l * D * 2 * DFF, D, 2 * DFF, (bf16_t*)(F.ws + WS_WUP) + (size_t)l * 2 * DFF * D, 2 * DFF, nullptr,
              [](int n) { const int pn = n >> 8, bj = (n >> 7) & 1, q = n & 127; return bj * DFF + pn * 128 + q; });
        convT(F, F.inp(19) + (size_t)l * DFF * D, DFF, D, (bf16_t*)(F.ws + WS_WDN) + (size_t)l * D * DFF, D, nullptr, [](int n) { return n; });
    }
}
DI void p_dft(const Frame& F) {
    const f32x2* trig = (const f32x2*)(F.ws + WS_TRIG); bf16_t* dft = (bf16_t*)F.P.out;
    const int gt = F.vcu * NT + F.tid, gn = F.G * NT;
    for (int ch = gt; ch < 4096 * 1024; ch += gn) { const int lp = ch >> 10, c8 = ch & 1023, part = c8 >> 9, l0 = (c8 & 511) * 8; f32x4 a, b;
#pragma unroll
        for (int j = 0; j < 4; ++j) { const f32x2 t0 = trig[(lp * (l0 + j)) & 4095], t1 = trig[(lp * (l0 + 4 + j)) & 4095];
            a[j] = (part ? -t0.y : t0.x) * (1.f / 64.f); b[j] = (part ? -t1.y : t1.x) * (1.f / 64.f); }
        *(u32x4*)(dft + (size_t)lp * 8192 + part * 4096 + l0) = pk8(a, b); }
}

DI void norm_phase(const Frame& F, const float* xl, const float* xc, int M, const float* g, const float* modl, int sh_off, int sc_off, bf16_t* H, float* outf) {
    const int gw = F.vcu * 8 + F.wave, nw = F.G * 8;
    for (int row = gw; row < M; row += nw) {
        const float* xr = row < ML ? xl + (size_t)row * D : xc + (size_t)(row - ML) * D;
        f32x4 v[8]; float ss = 0.f;
#pragma unroll
        for (int i = 0; i < 4; ++i) { v[2 * i] = *(const f32x4*)(xr + i * 512 + F.lane * 8); v[2 * i + 1] = *(const f32x4*)(xr + i * 512 + F.lane * 8 + 4); ss += sq4(v[2 * i]) + sq4(v[2 * i + 1]); }
#pragma unroll
        for (int o = 32; o >= 1; o >>= 1) ss += shx(ss, o, F.lane);
        const float rs = __builtin_amdgcn_rsqf(ss * (1.f / 2048.f) + EPS);
        const int midx = row < ML ? (row >> 12) : 4;
#pragma unroll
        for (int i = 0; i < 4; ++i) { const int col = i * 512 + F.lane * 8;
            const f32x4 g0 = *(const f32x4*)(g + col), g1 = *(const f32x4*)(g + col + 4);
            if (outf) { *(f32x4*)(outf + (size_t)row * D + col) = v[2 * i] * rs * g0; *(f32x4*)(outf + (size_t)row * D + col + 4) = v[2 * i + 1] * rs * g1; }
            else { const float* mp = modl + (size_t)midx * 12288 + col;
                const f32x4 s0 = *(const f32x4*)(mp + sc_off), s1 = *(const f32x4*)(mp + sc_off + 4), h0 = *(const f32x4*)(mp + sh_off), h1 = *(const f32x4*)(mp + sh_off + 4);
                *(u32x4*)(H + (size_t)row * D + col) = pk8(v[2 * i] * rs * g0 * (1.f + s0) + h0, v[2 * i + 1] * rs * g1 * (1.f + s1) + h1); } }
    }
}

struct AttnItem {
    const bf16_t* q; const bf16_t* kn; const bf16_t* kr; const bf16_t* vt; bf16_t* o;
    int ldq, ldk, ldo, lat_row0, ctx_row0, t0, ntl, nctx, mode, r0, hn;
};
template <int DQ>
DI void attn_item(const Frame& F, const AttnItem& it, const float* rpb_lds) {
    constexpr int KP = DQ + 8, VP = 72, KS = DQ / 16;
    constexpr int KBYTES = 64 * KP * 2, VBYTES = 128 * VP * 2, BUF = KBYTES + VBYTES;
    LAS unsigned char* base = F.lds;
    int tid = threadIdx.x; asm volatile("" : "+v"(tid));
    const int lane = tid & 63, w = __builtin_amdgcn_readfirstlane(tid >> 6), qq = lane & 31, hh = lane >> 5;
    const int ntile = it.ntl + it.nctx;
    u32x4 rk[2], rr, rv[2];
    auto gload = [&](int ti) {
        int rowb, vcol;
        if (ti < it.ntl) { const int kt = it.t0 + ti; rowb = it.lat_row0 + kt * 64; vcol = kt * 64; } else { const int j = ti - it.ntl; rowb = it.ctx_row0 + j * 64; vcol = SEQ + j * 64; }
#pragma unroll
        for (int i = 0; i < 2; ++i) { const int id = tid + i * NT; rk[i] = *(const u32x4*)(it.kn + (size_t)(rowb + (id >> 4)) * it.ldk + (id & 15) * 8);
            rv[i] = *(const u32x4*)(it.vt + (size_t)(id >> 3) * KEYS + vcol + (id & 7) * 8); }
        if (DQ == 192) rr = *(const u32x4*)(it.kr + (size_t)(rowb + (tid >> 3)) * UC + (tid & 7) * 8);
    };
    auto lstore = [&](int buf) {
        LAS unsigned char* kb = base + buf * BUF; LAS unsigned char* vb = kb + KBYTES;
#pragma unroll
        for (int i = 0; i < 2; ++i) { const int id = tid + i * NT; *(LAS u32x4*)(kb + ((id >> 4) * KP + (id & 15) * 8) * 2) = rk[i];
            *(LAS u32x4*)(vb + ((id >> 3) * VP + (id & 7) * 8) * 2) = rv[i]; }
        if (DQ == 192) *(LAS u32x4*)(kb + ((tid >> 3) * KP + 128 + (tid & 7) * 8) * 2) = rr;
    };
    bf16x8 qf[KS];
    { const bf16_t* qp = it.q + (size_t)(32 * w + qq) * it.ldq + 8 * hh;
#pragma unroll
        for (int ks = 0; ks < KS; ++ks) qf[ks] = *(const bf16x8*)(qp + 16 * ks); }
    f32x16 o[4];
#pragma unroll
    for (int db = 0; db < 4; ++db)
#pragma unroll
        for (int i = 0; i < 16; ++i) o[db][i] = 0.f;
    float mrun = -INFINITY, lrun = 0.f;
    const int r = it.r0 + (w >> 1), wq = 32 * (w & 1) + qq;
    const int rs = min(max(r - 4, 0), 56), cs = min(max(wq - 8, 0), 48);

    __syncthreads();
    gload(0); lstore(0);
    if (ntile > 1) gload(1);
    __syncthreads();
    for (int ti = 0; ti < ntile; ++ti) {
        const int buf = ti & 1;
        const bool lat = ti < it.ntl; const int krow = it.t0 + ti;
        const bool active = !(it.mode == 1 && lat && (krow < rs || krow > rs + 7));
        if (active) {
            LAS unsigned char* kb = base + buf * BUF; LAS unsigned char* vb = kb + KBYTES;
            f32x16 s[2];
#pragma unroll
            for (int blk = 0; blk < 2; ++blk) {
#pragma unroll
                for (int i = 0; i < 16; ++i) s[blk][i] = 0.f;
#pragma unroll
                for (int ks = 0; ks < KS; ++ks) { const bf16x8 a = *(const LAS bf16x8*)(kb + ((32 * blk + qq) * KP + 16 * ks + 8 * hh) * 2);
                    s[blk] = __builtin_amdgcn_mfma_f32_32x32x16_bf16(a, qf[ks], s[blk], 0, 0, 0); }
            }
            if (it.mode == 1 && lat) {
                const float* bp = rpb_lds + it.hn * 465 + (krow - r + 7) * 31 - wq + 15;
#pragma unroll
                for (int blk = 0; blk < 2; ++blk)
#pragma unroll
                    for (int i = 0; i < 16; ++i) { const int kc = 32 * blk + (i & 3) + 8 * (i >> 2) + 4 * hh; const bool ok = kc >= cs && kc < cs + 16;
                        const int kcc = ok ? kc : cs; s[blk][i] = ok ? s[blk][i] + bp[kcc] : -INFINITY; }
            }
            float mx = s[0][0];
#pragma unroll
            for (int blk = 0; blk < 2; ++blk)
#pragma unroll
                for (int i = 0; i < 16; ++i) mx = fmaxf(mx, s[blk][i]);
            mx = fmaxf(mx, shx(mx, 32, lane));
            const float mnew = fmaxf(mrun, mx), alpha = __builtin_amdgcn_exp2f(mrun - mnew);
            mrun = mnew;
            float ps = 0.f;
#pragma unroll
            for (int blk = 0; blk < 2; ++blk)
#pragma unroll
                for (int i = 0; i < 16; ++i) { const float p = __builtin_amdgcn_exp2f(s[blk][i] - mnew); s[blk][i] = p; ps += p; }
            lrun = lrun * alpha + ps;
            if (__builtin_amdgcn_ballot_w64(alpha != 1.f) != 0ull) {
#pragma unroll
                for (int db = 0; db < 4; ++db)
#pragma unroll
                    for (int i = 0; i < 16; ++i) o[db][i] *= alpha;
            }
#pragma unroll
            for (int blk = 0; blk < 2; ++blk)
#pragma unroll
                for (int s2 = 0; s2 < 2; ++s2) {
                    u32x4 pw; pw.x = pk2(s[blk][8 * s2], s[blk][8 * s2 + 1]); pw.y = pk2(s[blk][8 * s2 + 2], s[blk][8 * s2 + 3]);
                    pw.z = pk2(s[blk][8 * s2 + 4], s[blk][8 * s2 + 5]); pw.w = pk2(s[blk][8 * s2 + 6], s[blk][8 * s2 + 7]);
                    const bf16x8 pf = __builtin_bit_cast(bf16x8, pw);
#pragma unroll
                    for (int db = 0; db < 4; ++db) { LAS unsigned char* vp = vb + ((32 * db + qq) * VP + 32 * blk + 16 * s2 + 4 * hh) * 2;
                        const u32x2 v0 = *(const LAS u32x2*)vp, v1 = *(const LAS u32x2*)(vp + 16);
                        u32x4 vv; vv.x = v0.x; vv.y = v0.y; vv.z = v1.x; vv.w = v1.y;
                        o[db] = __builtin_amdgcn_mfma_f32_32x32x16_bf16(__builtin_bit_cast(bf16x8, vv), pf, o[db], 0, 0, 0); }
                }
        }
        if (ti + 1 < ntile) lstore(buf ^ 1);
        if (ti + 2 < ntile) gload(ti + 2);
        __syncthreads();
    }
    const float lt = lrun + shx(lrun, 32, lane), inv = 1.f / lt;
    bf16_t* op = it.o + (size_t)(32 * w + qq) * it.ldo + 4 * hh;
#pragma unroll
    for (int db = 0; db < 4; ++db)
#pragma unroll
        for (int ig = 0; ig < 4; ++ig) { u32x2 v; v.x = pk2(o[db][4 * ig] * inv, o[db][4 * ig + 1] * inv); v.y = pk2(o[db][4 * ig + 2] * inv, o[db][4 * ig + 3] * inv);
            *(u32x2*)(op + 32 * db + 8 * ig) = v; }
}

DI void mixer_attention(const Frame& F, int layer, int cidx) {
    const int nitems = layer == 0 ? 816 : 768;
    bf16_t* U = (bf16_t*)(F.ws + WS_U); bf16_t* Q = (bf16_t*)(F.ws + WS_Q); bf16_t* KN = (bf16_t*)(F.ws + WS_KN);
    bf16_t* VT = (bf16_t*)(F.ws + WS_VT); bf16_t* VNT = (bf16_t*)(F.ws + WS_VNT); bf16_t* CAT = (bf16_t*)(F.ws + WS_CAT);
    unsigned* ctr = (unsigned*)(F.ws + WS_CTR) + cidx;
    float* rpb = (float*)(F.ldsg + 100 * 1024);
    volatile int* slot = (volatile int*)(F.ldsg + 100 * 1024 + 8192);
    __syncthreads();
    for (int i = F.tid; i < 4 * 465; i += NT) rpb[i] = F.inp(13)[layer * 4 * 465 + i] * LOG2E;
    for (;;) {
        __syncthreads();
        if (F.tid == 0) *slot = (int)atomicAdd(ctr, 1u);
        __syncthreads();
        const int idx = *slot;
        if (idx >= nitems) break;
        AttnItem it; it.kr = nullptr; it.mode = 0; it.r0 = 0; it.hn = 0; it.nctx = 4;
        if (idx < 512 || (idx >= 768 && idx < 800)) {
            int b, h, row0;
            if (idx < 512) { b = idx >> 7; h = (idx >> 4) & 7; row0 = b * 4096 + (idx & 15) * 256; it.t0 = 0; it.ntl = 64; }
            else { const int j = idx - 768; b = j >> 3; h = j & 7; row0 = ML + b * 256; it.t0 = 0; it.ntl = 0; }
            it.q = Q + (size_t)row0 * 1536 + h * 192; it.ldq = 1536;
            it.kn = KN + h * 128; it.ldk = 1024; it.kr = U + U_KR;
            it.vt = VT + (size_t)(b * 8 + h) * 128 * KEYS;
            it.o = CAT + (size_t)row0 * D + h * 128; it.ldo = D;
            it.lat_row0 = b * 4096; it.ctx_row0 = ML + b * 256;
            attn_item<192>(F, it, rpb);
        } else {
            int b, hn, row0;
            if (idx < 768) { const int j = idx - 512; b = j >> 6; hn = (j >> 4) & 3; const int R = j & 15; row0 = b * 4096 + R * 256;
                const int rlo = max(4 * R - 4, 0), rhi = min(max(4 * R - 1, 0), 56) + 7; it.t0 = rlo; it.ntl = rhi - rlo + 1; it.mode = 1; it.r0 = 4 * R; it.hn = hn; }
            else { const int j = idx - 800; b = j >> 2; hn = j & 3; row0 = ML + b * 256; it.t0 = 0; it.ntl = 0; }
            it.q = U + (size_t)row0 * UC + U_QN + hn * 128; it.ldq = UC;
            it.kn = U + U_KN + hn * 128; it.ldk = UC;
            it.vt = VNT + (size_t)(b * 4 + hn) * 128 * KEYS;
            it.o = CAT + (size_t)row0 * D + 1024 + hn * 128; it.ldo = D;
            it.lat_row0 = b * 4096; it.ctx_row0 = ML + b * 256;
            attn_item<128>(F, it, rpb);
        }
    }
}

#ifndef PHMASK
#define PHMASK 0x7ff
#endif
#define PH(k) (((PHMASK) >> (k)) & 1)
#ifndef DUPMASK
#define DUPMASK 0x000
#endif
#define REP(k) for (int rep_ = 0, nrep_ = F.nrep((DUPMASK >> (k)) & 1); rep_ < nrep_; ++rep_)
#define Hbuf ((bf16_t*)(F.ws + WS_H))
#define H (Hbuf + D)
#define X ((float*)(F.ws + WS_X))
#define U ((bf16_t*)(F.ws + WS_U))
#define SSQ ((float*)(F.ws + WS_SSQ))
#define CAT ((bf16_t*)(F.ws + WS_CAT))
#define mod ((const float*)(F.ws + WS_MOD))
#define rope ((const f32x2*)(F.ws + WS_ROPE))
#define GSYNC() do { grid.sync(); F.refresh(); } while (0)
DI void layer_body(Frame& F, cg::grid_group& grid, const int l) {
        const int Mq = l == 0 ? MT : ML;
#define modl (mod + (size_t)l * 5 * 12288)
#define xl (l == 0 ? F.inp(0) : (const float*)X)
#define xc (l == 0 ? F.inp(2) : (const float*)(X + (size_t)ML * D))
        REP(1) {
        if (PH(1)) norm_phase(F, xl, xc, MT, F.inp(6) + l * D, modl, 0, 2048, H, nullptr);
        GSYNC(); }
        REP(2) {
        { pg8::Gemm g{H, (const bf16_t*)(F.ws + WS_WIN) + (size_t)l * UC * D, D, D, D, 0};
          pg8::Sched S; S.init(MT / 256, UC / 256, F.G, F.vcu, 0);
          EpiU E{U, SSQ, (bf16_t*)(F.ws + WS_VNT), rope, 0.08838834764831845f * LOG2E};
          if (PH(2)) pg8::gemm_phase(F.lds, g, S, E); }
        GSYNC(); }
        REP(3) {
        { int start = 0;
          { pg8::Gemm g{U + U_CQ, (const bf16_t*)(F.ws + WS_WUQ) + (size_t)l * 1536 * 512, UC, 512, 512, 0};
            pg8::Sched S; S.init(Mq / 256, 6, F.G, F.vcu, start); start += (Mq / 256) * 6;
            EpiQ E{(bf16_t*)(F.ws + WS_Q), SSQ, rope, 0.07216878364870323f * LOG2E};
            if (PH(3)) pg8::gemm_phase(F.lds, g, S, E); }
          { pg8::Gemm g{U + U_CKV, (const bf16_t*)(F.ws + WS_WUKV) + (size_t)l * 2048 * 512, UC, 512, 512, 0};
            pg8::Sched S; S.init(MT / 256, 8, F.G, F.vcu, start); start += (MT / 256) * 8;
            EpiKV E{(bf16_t*)(F.ws + WS_KN), (bf16_t*)(F.ws + WS_VT), SSQ};
            if (PH(4)) pg8::gemm_phase(F.lds, g, S, E); }
          { pg8::Gemm g{(const bf16_t*)(F.ws + WS_WC) + (size_t)l * 1024 * 512, U + U_F, 512, UC, 512, 0};
            pg8::Sched S; S.init(4, Mq / 256, F.G, F.vcu, start);
            EpiY E{(bf16_t*)(F.ws + WS_YT), (bf16_t*)(F.ws + WS_YTC)};
            if (PH(5)) pg8::gemm_phase(F.lds, g, S, E); } }
        GSYNC(); }
        REP(7) {
        if (F.vcu < 128 || (l == 0 && F.vcu < 136)) {
            const bool cx = F.vcu >= 128; const int ld = cx ? 512 : 8192;
            const bf16_t* dftp = *(const bf16_t* const*)(F.ws + WS_CTR + 128);
            pg8::Gemm g{dftp + (cx ? (size_t)4096 * 8192 : (size_t)0), (const bf16_t*)(F.ws + (cx ? WS_YTC : WS_YT)), ld, ld, ld, 0};
            pg8::OneUnit S; S.u.pm = cx ? 0 : (F.vcu & 15); S.u.pn = cx ? (F.vcu - 128) : (F.vcu >> 4); S.has = true;
            EpiF E{CAT, cx ? 1 : 0}; if (PH(6)) pg8::gemm_phase(F.lds, g, S, E); }
        if (PH(7)) mixer_attention(F, l, l + 2 * rep_);
        GSYNC(); }
        REP(8) {
        { pg8::Gemm g{CAT, (const bf16_t*)(F.ws + WS_WOUT) + (size_t)l * D * D, D, D, D, 0};
          pg8::Sched S; S.init(Mq / 256, 8, F.G, F.vcu, 0);
          EpiRes E{xl, xc, X, modl + 4096};
          if (PH(8)) pg8::gemm_phase(F.lds, g, S, E); }
        GSYNC(); }
        REP(4) {
        if (PH(1)) norm_phase(F, X, X + (size_t)ML * D, Mq, F.inp(7) + l * D, modl, 6144, 8192, H, nullptr);
        GSYNC(); }
        REP(10) {
        { pg8::Gemm g{Hbuf, (const bf16_t*)(F.ws + WS_WUP) + (size_t)l * 2 * DFF * D, D, D, D, 1};
          pg8::Sched S; S.init((Mq + 247) / 248, 44, F.G, F.vcu, 0);
          EpiConv E{(bf16_t*)(F.ws + WS_ACT), F.inp(17) + (size_t)l * 3 * 2 * DFF, F.inp(18) + (size_t)l * 2 * DFF, Mq};
          if (PH(10)) pg8::gemm_phase(F.lds, g, S, E); }
        GSYNC(); }
        { pg8::Gemm g{(const bf16_t*)(F.ws + WS_ACT), (const bf16_t*)(F.ws + WS_WDN) + (size_t)l * D * DFF, DFF, DFF, DFF, 0};
          pg8::Sched S; S.init(Mq / 256, 8, F.G, F.vcu, 0);
          EpiRes E{X, X + (size_t)ML * D, X, modl + 10240};
          if (PH(9)) pg8::gemm_phase(F.lds, g, S, E); }
        GSYNC();

}

__global__ void __launch_bounds__(NT) fwd_megakernel(Params p) {
    extern __shared__ __attribute__((aligned(16))) unsigned char lds_raw[];
    cg::grid_group grid = cg::this_grid();
    const int tid_ = threadIdx.x, G_ = gridDim.x, bx_ = blockIdx.x;
    Frame F{(LAS unsigned char*)lds_raw, lds_raw, tid_, tid_ & 63, __builtin_amdgcn_readfirstlane(tid_ >> 6), G_, (G_ % 8 == 0) ? (bx_ % 8) * (G_ / 8) + bx_ / 8 : bx_, p, p.ws};
    REP(0) { if (PH(0)) { p_mod(F);
    p_tables(F);
    p_convert(F); }
    GSYNC(); }
    if (PH(0)) p_dft(F);

    for (int l = 0; l < 2; ++l) layer_body(F, grid, l);
    if (PH(1)) norm_phase(F, X, X, ML, F.inp(20), nullptr, 0, 0, nullptr, p.out);
}
#undef Hbuf
#undef H
#undef X
#undef U
#undef SSQ
#undef CAT
#undef mod
#undef rope
#undef modl
#undef xl
#undef xc


extern "C" void kernel_launch(void* const* d_in, const int* in_sizes, int n_in, void* d_out, int out_size, void* d_ws, size_t ws_size, hipStream_t stream) {
    static int grid_blocks = 0;
    if (!grid_blocks) {
        int dev = 0, cus = 0, per_cu = 0;
        hipGetDevice(&dev);
        hipDeviceGetAttribute(&cus, hipDeviceAttributeMultiprocessorCount, dev);
        hipFuncSetAttribute((const void*)fwd_megakernel, hipFuncAttributeMaxDynamicSharedMemorySize, LDS_BYTES);
        hipOccupancyMaxActiveBlocksPerMultiprocessor(&per_cu, (const void*)fwd_megakernel, NT, LDS_BYTES);
        if (per_cu < 1) { fprintf(stderr, "occupancy query says %d blocks/CU\n", per_cu); per_cu = 1; }
        grid_blocks = cus;
        if (ws_size < WS_END) fprintf(stderr, "workspace too small: %zu < %zu\n", ws_size, (size_t)WS_END);
    }
    Params p{};
    for (int i = 0; i < 21; ++i) p.in[i] = (const float*)d_in[i];
    p.out = (float*)d_out; p.ws = (unsigned char*)d_ws;
    void* args[] = {&p};
    hipError_t e = hipLaunchCooperativeKernel((const void*)fwd_megakernel, dim3(grid_blocks), dim3(NT), args, LDS_BYTES, stream);
    if (e != hipSuccess) fprintf(stderr, "cooperative launch failed: %s (grid %d)\n", hipGetErrorString(e), grid_blocks);
}
```

```cpp
#include <hip/hip_runtime.h>
#include <hip/hip_cooperative_groups.h>
#include <cstdio>
namespace cg = cooperative_groups;

#define LAS __attribute__((address_space(3)))
#define DI __device__ __forceinline__
typedef unsigned short bf16_t;
typedef short bf16x8 __attribute__((ext_vector_type(8)));
typedef short s16x4 __attribute__((ext_vector_type(4)));
typedef float f32x4 __attribute__((ext_vector_type(4)));
typedef float f32x2 __attribute__((ext_vector_type(2)));
typedef float f32x16 __attribute__((ext_vector_type(16)));
typedef unsigned u32x4 __attribute__((ext_vector_type(4)));
typedef unsigned u32x2 __attribute__((ext_vector_type(2)));
typedef __bf16 bfv2 __attribute__((ext_vector_type(2)));

constexpr int D = 2048, NB = 4, SEQ = 4096, CTXL = 256, ML = NB * SEQ, MC = NB * CTXL, MT = ML + MC;
constexpr int INC = 3136, UC = 3328;
constexpr int U_CQ = 0, U_CKV = 512, U_QN = 1024, U_KN = 1536, U_VN = 2048, U_F = 2560, U_KR = 3072;
constexpr int DFF = 5632, KEYS = SEQ + CTXL;
constexpr float EPS = 1e-6f, LOG2E = 1.4426950408889634f;
constexpr int NT = 512;
constexpr int LDS_BYTES = 136 * 1024;

constexpr size_t al(size_t x) { return (x + 255) & ~(size_t)255; }
constexpr size_t WS_WIN = 0;
constexpr size_t WS_WUQ = WS_WIN + al((size_t)2 * UC * D * 2);
constexpr size_t WS_WUKV = WS_WUQ + al((size_t)2 * 1536 * 512 * 2);
constexpr size_t WS_WOUT = WS_WUKV + al((size_t)2 * 4096 * 512 * 2);
constexpr size_t WS_WUP = WS_WOUT + al((size_t)2 * D * D * 2);
constexpr size_t WS_WDN = WS_WUP + al((size_t)2 * 2 * DFF * D * 2);
constexpr size_t WS_WC = WS_WDN + al((size_t)2 * D * DFF * 2);
constexpr size_t WS_DFTC = WS_WC + al((size_t)2 * 1024 * 512 * 2);
constexpr size_t WS_TRIG = WS_DFTC + al((size_t)256 * 512 * 2);
constexpr size_t WS_ROPE = WS_TRIG + al(4096 * 8);
constexpr size_t WS_MOD = WS_ROPE + al(64 * 16 * 8);
constexpr size_t WS_CTR = WS_MOD + al((size_t)2 * 5 * 12288 * 4);
constexpr size_t WS_X = WS_CTR + 256;
constexpr size_t WS_H = WS_X + al((size_t)MT * D * 4);
constexpr size_t H_ROWS = 1 + MT + 256;
constexpr size_t WS_CAT = WS_H + al(H_ROWS * D * 2);
constexpr size_t WS_YTC = WS_CAT + al((size_t)MT * D * 2);
constexpr size_t WS_U = WS_YTC + al((size_t)2048 * 512 * 2);
constexpr size_t WS_SSQ = WS_U + al((size_t)MT * UC * 2);
constexpr size_t WS_Q = WS_SSQ + al((size_t)MT * 16 * 4);
constexpr size_t WS_KN = WS_Q + al((size_t)MT * 1536 * 2);
constexpr size_t WS_VT = WS_KN + al((size_t)MT * 1024 * 2);
constexpr size_t WS_VNT = WS_VT + al((size_t)32 * 128 * KEYS * 2);
constexpr size_t WS_YT = WS_VNT + al((size_t)16 * 128 * KEYS * 2);
constexpr size_t WS_END = WS_YT + al((size_t)2048 * 8192 * 2);
constexpr size_t WS_ACT = WS_U;
static_assert(WS_ACT + (size_t)MT * DFF * 2 <= WS_END, "ACT alias");
static_assert((size_t)4096 * 8192 * 2 <= H_ROWS * D * 2, "DFT alias");
static_assert(WS_END <= (size_t)805306368, "workspace");

struct Params { const float* in[21]; float* out; unsigned char* ws; };

DI unsigned pk2(float a, float b) { f32x2 v = {a, b}; bfv2 r = __builtin_convertvector(v, bfv2); return __builtin_bit_cast(unsigned, r); }
DI bf16_t f2bf(float a) { return (bf16_t)(pk2(a, 0.f) & 0xffffu); }
DI float shx(float v, int m, int lane) { return __builtin_bit_cast(float, __builtin_amdgcn_ds_bpermute((lane ^ m) << 2, __builtin_bit_cast(int, v))); }
DI float sq4(f32x4 v) { return (v[0] * v[0] + v[1] * v[1]) + (v[2] * v[2] + v[3] * v[3]); }
DI u32x4 pk8(f32x4 a, f32x4 b) { u32x4 w; w.x = pk2(a[0], a[1]); w.y = pk2(a[2], a[3]); w.z = pk2(b[0], b[1]); w.w = pk2(b[2], b[3]); return w; }

namespace pg8 {
constexpr int BM = 256, BK = 64, HALF = 128, HTB = HALF * BK * 2, STAGE_BYTES = 8 * HTB;
DI int lds_byte(int r, int c) { const int st = (r >> 4) * 2 + (c >> 5), rr = r & 15, cc = c & 31, ob = rr * 64 + cc * 2; return st * 1024 + (ob ^ (((ob >> 9) & 1) << 5)); }
DI void stage_rc(int b, int& R, int& C) { const int st = b / 1024, sb = b % 1024, swz = sb ^ (((sb >> 9) & 1) << 5); R = (st >> 1) * 16 + swz / 64; C = (st & 1) * 32 + (swz % 64) / 2; }
DI int perm32(int rho) { const int n = rho >> 4, i = rho & 15; return 8 * (i >> 2) + 4 * n + (i & 3); }
struct Unit { int pm, pn; };
struct Gemm { const bf16_t* A; const bf16_t* Bt; int lda, ldb, K; int conv; };

struct Sched {
    int nM, nN, cnt, G, c, i0, start;
    DI void init(int nM_, int nN_, int G_, int c_, int start_) { nM = nM_; nN = nN_; cnt = nM * nN; G = G_; c = c_; start = start_;
        i0 = (start_ > c_) ? (start_ - c_ + G_ - 1) / G_ : 0; }
    DI bool next(int i, Unit& u) const {
        const long L = (long)(i0 + i) * G + c - start; if (L >= cnt) return false;
        const int w = (int)L, nig = 8 * nN, gid = w / nig, fm = gid * 8, gsz = (nM - fm) < 8 ? (nM - fm) : 8;
        u.pm = fm + ((w % nig) % gsz); u.pn = (w % nig) / gsz; return true;
    }
};
struct OneUnit { Unit u; bool has; DI bool next(int i, Unit& o) const { o = u; return has && i == 0; } };

template <class Epi, class SchedT>
DI void gemm_phase(LAS unsigned char* lds, const Gemm g, const SchedT& S, const Epi& E) {
    int tid = threadIdx.x; asm volatile("" : "+v"(tid));
    const int wid = __builtin_amdgcn_readfirstlane(tid >> 6), lane = tid & 63, wr = wid >> 2, wc = wid & 3, fr = lane & 15, fq = lane >> 4;
    const int K = g.K, nt = K / BK;
    unsigned voffA[2], voffB[2];
    auto mk_voff = [&]() { int t2 = threadIdx.x; asm volatile("" : "+v"(t2));
#pragma unroll
        for (int i = 0; i < 2; ++i) { int R, C; stage_rc(t2 * 16 + i * 8192, R, C); const int Rb = Epi::PERM ? ((R & ~31) + perm32(R & 31)) : R;
            const int Ra = g.conv ? ((R >> 6) * 62 + (R & 63)) : R;
            voffA[i] = (unsigned)(Ra * g.lda + C) * 2u; voffB[i] = (unsigned)(Rb * g.ldb + C) * 2u; } };
    mk_voff();
    const size_t kstep = (size_t)(BK * 2);
    const size_t hstepA = (size_t)(g.conv ? 124 : HALF) * g.lda * 2, hstepB = (size_t)HALF * g.ldb * 2;
    const size_t tstepA = 2 * hstepA, tstepB = 2 * hstepB;
    const unsigned ldsw = (unsigned)wid * 1024u;
    const int aoff = lds_byte(wr * 64 + fr, fq * 8), boff = lds_byte(wc * 32 + fr, fq * 8);
#define PG8_SA(b, h) (((b) * 2 + (h)) * HTB)
#define PG8_SB(b, h) ((4 + (b) * 2 + (h)) * HTB)
#define PG8_STAGE(bufoff, gbase, voff) do { _Pragma("unroll") for (int _i = 0; _i < 2; ++_i) \
        __builtin_amdgcn_global_load_lds((const unsigned*)((const char*)(gbase) + (voff)[_i]), (LAS unsigned*)(lds + (bufoff) + ldsw + _i * 8192), 16, 0, 0); } while (0)
#define PG8_LDA(dst, b, h) do { _Pragma("unroll") for (int m = 0; m < 4; ++m) _Pragma("unroll") for (int k = 0; k < 2; ++k) dst[m][k] = *(const LAS bf16x8*)(lds + PG8_SA(b, h) + aoff + m * 2048 + k * 1024); } while (0)
#define PG8_LDB(dst, b, h) do { _Pragma("unroll") for (int n = 0; n < 2; ++n) _Pragma("unroll") for (int k = 0; k < 2; ++k) dst[n][k] = *(const LAS bf16x8*)(lds + PG8_SB(b, h) + boff + n * 2048 + k * 1024); } while (0)
#define PG8_MMA(ai, bj, At, Bt) do { __builtin_amdgcn_s_setprio(1); _Pragma("unroll") for (int m = 0; m < 4; ++m) _Pragma("unroll") for (int n = 0; n < 2; ++n) _Pragma("unroll") for (int k = 0; k < 2; ++k) \
        acc[ai][bj][m][n] = __builtin_amdgcn_mfma_f32_16x16x32_bf16(Bt[n][k], At[m][k], acc[ai][bj][m][n], 0, 0, 0); __builtin_amdgcn_s_setprio(0); } while (0)
#define PG8_WAIT_V(n) asm volatile("s_waitcnt vmcnt(" #n ")" ::: "memory")
#define PG8_WAIT_L(n) asm volatile("s_waitcnt lgkmcnt(" #n ")" ::: "memory")
#define PG8_BAR __builtin_amdgcn_s_barrier()
#define PG8_SCHED __builtin_amdgcn_sched_barrier(0)
    Unit cur, nxt; int ui = 0;
    if (!S.next(0, cur)) return;
    f32x4 acc[2][2][4][2];
#pragma unroll
    for (int a = 0; a < 2; ++a)
#pragma unroll
        for (int b = 0; b < 2; ++b)
#pragma unroll
            for (int m = 0; m < 4; ++m)
#pragma unroll
                for (int n = 0; n < 2; ++n) acc[a][b][m][n] = (f32x4){0.f, 0.f, 0.f, 0.f};
    bf16x8 At[4][2], B0[2][2], B1[2][2];
    const char* cA = (const char*)g.A + (size_t)cur.pm * tstepA; const char* cB = (const char*)g.Bt + (size_t)cur.pn * tstepB;
    PG8_STAGE(PG8_SB(0, 0), cB, voffB); PG8_STAGE(PG8_SA(0, 0), cA, voffA); PG8_STAGE(PG8_SB(0, 1), cB + hstepB, voffB); PG8_STAGE(PG8_SA(0, 1), cA + hstepA, voffA);
    if (wr == 1) PG8_BAR;
    PG8_WAIT_V(4); PG8_BAR;
    PG8_STAGE(PG8_SB(1, 0), cB + kstep, voffB); PG8_STAGE(PG8_SA(1, 0), cA + kstep, voffA); PG8_STAGE(PG8_SB(1, 1), cB + hstepB + kstep, voffB);
    PG8_WAIT_V(6); PG8_BAR;
    for (;;) {
        const bool has_next = S.next(ui + 1, nxt);
        const char* nA = has_next ? (const char*)g.A + (size_t)nxt.pm * tstepA : cA; const char* nB = has_next ? (const char*)g.Bt + (size_t)nxt.pn * tstepB : cB;
        for (int t = 0; t < nt; t += 2) {
            const bool last = (t == nt - 2);
            const char* a1 = cA + (size_t)(t + 1) * kstep;
            const char* a2 = last ? nA : cA + (size_t)(t + 2) * kstep; const char* b2 = last ? nB : cB + (size_t)(t + 2) * kstep;
            const char* a3 = a2 + kstep; const char* b3 = b2 + kstep;
            PG8_LDB(B0, 0, 0); PG8_SCHED; PG8_LDA(At, 0, 0); PG8_STAGE(PG8_SA(1, 1), a1 + hstepA, voffA);
            PG8_WAIT_L(8); PG8_BAR; PG8_WAIT_L(0); PG8_MMA(0, 0, At, B0); PG8_BAR; PG8_SCHED;
            PG8_LDB(B1, 0, 1); PG8_STAGE(PG8_SB(0, 0), b2, voffB);
            PG8_BAR; PG8_WAIT_L(0); PG8_MMA(0, 1, At, B1); PG8_BAR;
            PG8_LDA(At, 0, 1); PG8_STAGE(PG8_SA(0, 0), a2, voffA);
            PG8_BAR; PG8_WAIT_L(0); PG8_MMA(1, 0, At, B0); PG8_BAR; PG8_SCHED;
            PG8_STAGE(PG8_SB(0, 1), b2 + hstepB, voffB);
            PG8_WAIT_V(6); PG8_BAR; PG8_MMA(1, 1, At, B1); PG8_BAR;
            PG8_LDB(B0, 1, 0); PG8_SCHED; PG8_LDA(At, 1, 0); PG8_STAGE(PG8_SA(0, 1), a2 + hstepA, voffA);
            PG8_WAIT_L(8); PG8_BAR; PG8_WAIT_L(0); PG8_MMA(0, 0, At, B0); PG8_BAR; PG8_SCHED;
            PG8_LDB(B1, 1, 1); PG8_STAGE(PG8_SB(1, 0), b3, voffB);
            PG8_BAR; PG8_WAIT_L(0); PG8_MMA(0, 1, At, B1); PG8_BAR;
            PG8_LDA(At, 1, 1); PG8_STAGE(PG8_SA(1, 0), a3, voffA);
            PG8_BAR; PG8_WAIT_L(0); PG8_MMA(1, 0, At, B0); PG8_BAR; PG8_SCHED;
            PG8_STAGE(PG8_SB(1, 1), b3 + hstepB, voffB);
            PG8_WAIT_V(6); PG8_BAR; PG8_MMA(1, 1, At, B1); PG8_BAR;
        }
        { int fr2 = fr, fq2 = fq, wr2 = wr, wc2 = wc; asm volatile("" : "+v"(fr2), "+v"(fq2), "+s"(wr2), "+s"(wc2));
          E(acc, cur, wr2, wc2, fr2, fq2); }
        if (has_next) mk_voff();
        if (!has_next) break;
#pragma unroll
        for (int a = 0; a < 2; ++a)
#pragma unroll
            for (int b = 0; b < 2; ++b)
#pragma unroll
                for (int m = 0; m < 4; ++m)
#pragma unroll
                    for (int n = 0; n < 2; ++n) acc[a][b][m][n] = (f32x4){0.f, 0.f, 0.f, 0.f};
        cur = nxt; cA = nA; cB = nB; ++ui;
    }
    PG8_WAIT_V(0);
    if (wr == 0) PG8_BAR;
    PG8_BAR;
#undef PG8_SA
#undef PG8_SB
#undef PG8_STAGE
#undef PG8_LDA
#undef PG8_LDB
#undef PG8_MMA
#undef PG8_WAIT_V
#undef PG8_WAIT_L
#undef PG8_BAR
#undef PG8_SCHED
}
}
using pg8::Unit;
typedef const f32x4 (&AccRef)[2][2][4][2];

DI void row_bk(int row, int& b, int& key) { if (row < ML) { b = row >> 12; key = row & 4095; } else { const int rc = row - ML; b = rc >> 8; key = SEQ + (rc & 255); } }
DI void rope8(f32x4& v0, f32x4& v1, int row, int axis, int fq, int lane, const f32x2* rope) {
    const int l = row & 4095, pos = axis ? (l & 63) : (l >> 6);
    const f32x2* t = rope + pos * 16 + 8 * (fq & 1);
    const float sgn = (fq < 2) ? -1.f : 1.f;
#pragma unroll
    for (int j = 0; j < 4; ++j) {
        const float p0 = shx(v0[j], 32, lane), p1 = shx(v1[j], 32, lane);
        const f32x2 c0 = t[j], c1 = t[4 + j];
        v0[j] = v0[j] * c0.x + sgn * p0 * c0.y; v1[j] = v1[j] * c1.x + sgn * p1 * c1.y;
    }
}

struct EpiU {
    static constexpr bool PERM = true;
    bf16_t* U; float* ssq; bf16_t* VnT; const f32x2* rope; float qscale;
    DI void operator()(AccRef acc, const Unit& u, int wr, int wc, int fr, int fq) const {
        const int pn = u.pn, rowb = u.pm * 256 + wr * 64 + fr;
        if (pn == 8 || pn == 9) {
#pragma unroll
            for (int ai = 0; ai < 2; ++ai)
#pragma unroll
                for (int m = 0; m < 4; ++m) { int b, key; row_bk(rowb + ai * 128 + m * 16, b, key);
#pragma unroll
                    for (int bj = 0; bj < 2; ++bj) { const int hn = 2 * (pn - 8) + bj;
#pragma unroll
                        for (int n = 0; n < 2; ++n) { bf16_t* dst = VnT + ((size_t)((b * 4 + hn) * 128 + 32 * wc + 8 * fq + 4 * n)) * KEYS + key;
#pragma unroll
                            for (int j = 0; j < 4; ++j) dst[(size_t)j * KEYS] = f2bf(acc[ai][bj][m][n][j]); } } }
            return;
        }
        const float sc = (pn == 4 || pn == 5) ? qscale : 1.f;
#pragma unroll
        for (int ai = 0; ai < 2; ++ai)
#pragma unroll
            for (int m = 0; m < 4; ++m) { const int row = rowb + ai * 128 + m * 16; float ss = 0.f;
#pragma unroll
                for (int bj = 0; bj < 2; ++bj) { f32x4 v0 = acc[ai][bj][m][0] * sc, v1 = acc[ai][bj][m][1] * sc;
                    if (pn == 12 && bj == 0 && wc < 2 && row < ML) rope8(v0, v1, row, wc & 1, fq, fq * 16 + fr, rope);
                    ss += sq4(v0) + sq4(v1);
                    *(u32x4*)(U + (size_t)row * UC + 256 * pn + 128 * bj + 32 * wc + 8 * fq) = pk8(v0, v1); }
                if (pn < 4) { ss += shx(ss, 16, fq * 16 + fr); ss += shx(ss, 32, fq * 16 + fr); if (fq == 0) ssq[(size_t)row * 16 + pn * 4 + wc] = ss; } }
    }
};
DI float row_rstd(const float* ssq, int row, int which) { const f32x4 a = *(const f32x4*)(ssq + (size_t)row * 16 + which * 8), b = *(const f32x4*)(ssq + (size_t)row * 16 + which * 8 + 4);
    const float s = ((a[0] + a[1]) + (a[2] + a[3])) + ((b[0] + b[1]) + (b[2] + b[3])); return __builtin_amdgcn_rsqf(s * (1.f / 512.f) + EPS); }
struct EpiQ {
    static constexpr bool PERM = true;
    bf16_t* Q; const float* ssq; const f32x2* rope; float scale;
    DI void operator()(AccRef acc, const Unit& u, int wr, int wc, int fr, int fq) const {
        const int rowb = u.pm * 256 + wr * 64 + fr;
#pragma unroll
        for (int ai = 0; ai < 2; ++ai)
#pragma unroll
            for (int m = 0; m < 4; ++m) { const int row = rowb + ai * 128 + m * 16; const float rs = row_rstd(ssq, row, 0) * scale;
#pragma unroll
                for (int bj = 0; bj < 2; ++bj) { const int c32 = 256 * u.pn + 128 * bj + 32 * wc; f32x4 v0 = acc[ai][bj][m][0] * rs, v1 = acc[ai][bj][m][1] * rs;
                    if (((c32 >> 6) % 3) == 2 && row < ML) rope8(v0, v1, row, (c32 >> 5) & 1, fq, fq * 16 + fr, rope);
                    *(u32x4*)(Q + (size_t)row * 1536 + c32 + 8 * fq) = pk8(v0, v1); } }
    }
};
struct EpiKV {
    static constexpr bool PERM = true;
    bf16_t* KN; bf16_t* VT; const float* ssq;
    DI void operator()(AccRef acc, const Unit& u, int wr, int wc, int fr, int fq) const {
        const int pn = u.pn, rowb = u.pm * 256 + wr * 64 + fr;
#pragma unroll
        for (int ai = 0; ai < 2; ++ai)
#pragma unroll
            for (int m = 0; m < 4; ++m) { const int row = rowb + ai * 128 + m * 16; const float rs = row_rstd(ssq, row, 1); int b, key; row_bk(row, b, key);
#pragma unroll
                for (int bj = 0; bj < 2; ++bj) {
                    if (pn < 4) { *(u32x4*)(KN + (size_t)row * 1024 + 256 * pn + 128 * bj + 32 * wc + 8 * fq) = pk8(acc[ai][bj][m][0] * rs, acc[ai][bj][m][1] * rs); }
                    else { const int h = 2 * (pn - 4) + bj;
#pragma unroll
                        for (int n = 0; n < 2; ++n) { bf16_t* dst = VT + ((size_t)((b * 8 + h) * 128 + 32 * wc + 8 * fq + 4 * n)) * KEYS + key;
#pragma unroll
                            for (int j = 0; j < 4; ++j) dst[(size_t)j * KEYS] = f2bf(acc[ai][bj][m][n][j] * rs); } } } }
    }
};
struct EpiY {
    static constexpr bool PERM = true;
    bf16_t* YT; bf16_t* YTc;
    DI void operator()(AccRef acc, const Unit& u, int wr, int wc, int fr, int fq) const {
        const int g = u.pm;
#pragma unroll
        for (int ai = 0; ai < 2; ++ai)
#pragma unroll
            for (int m = 0; m < 4; ++m) { const int d = 64 * wr + 16 * m + fr;
#pragma unroll
                for (int bj = 0; bj < 2; ++bj) { const int tok = 256 * u.pn + 128 * bj + 32 * wc + 8 * fq; const u32x4 w = pk8(acc[ai][bj][m][0], acc[ai][bj][m][1]);
                    if (tok < ML) { const int b = tok >> 12, l = tok & 4095; *(u32x4*)(YT + ((size_t)((b * 4 + g) * 128 + d)) * 8192 + ai * 4096 + l) = w; }
                    else { const int tc = tok - ML, b = tc >> 8, l = tc & 255; *(u32x4*)(YTc + ((size_t)((b * 4 + g) * 128 + d)) * 512 + ai * 256 + l) = w; } } }
    }
};
struct EpiF {
    static constexpr bool PERM = true;
    bf16_t* CAT; int ctx;
    DI void operator()(AccRef acc, const Unit& u, int wr, int wc, int fr, int fq) const {
        const int b = u.pn >> 1;
#pragma unroll
        for (int ai = 0; ai < 2; ++ai)
#pragma unroll
            for (int m = 0; m < 4; ++m) { const int lp = u.pm * 256 + 128 * ai + 64 * wr + 16 * m + fr; const int row = ctx ? (ML + b * 256 + lp) : (b * 4096 + lp);
#pragma unroll
                for (int bj = 0; bj < 2; ++bj) { const int g = 2 * (u.pn & 1) + bj;
                    *(u32x4*)(CAT + (size_t)row * D + 1536 + g * 128 + 32 * wc + 8 * fq) = pk8(acc[ai][bj][m][0], acc[ai][bj][m][1]); } }
    }
};
struct EpiRes {
    static constexpr bool PERM = false;
    const float* xl; const float* xc; float* out; const float* gate;
    DI void operator()(AccRef acc, const Unit& u, int wr, int wc, int fr, int fq) const {
        const int row0 = u.pm * 256; const int midx = row0 < ML ? (row0 >> 12) : 4;
        const float* src = row0 < ML ? xl : (xc - (size_t)ML * D);
        const float* gp = gate + (size_t)midx * 12288;
        const int col0 = u.pn * 256 + wc * 32 + 4 * fq;
        f32x4 gv[2][2];
#pragma unroll
        for (int bj = 0; bj < 2; ++bj)
#pragma unroll
            for (int n = 0; n < 2; ++n) gv[bj][n] = *(const f32x4*)(gp + col0 + bj * 128 + n * 16);
#pragma unroll
        for (int ai = 0; ai < 2; ++ai)
#pragma unroll
            for (int m = 0; m < 4; ++m) { const size_t off = (size_t)(row0 + wr * 64 + fr + ai * 128 + m * 16) * D + col0;
#pragma unroll
                for (int bj = 0; bj < 2; ++bj)
#pragma unroll
                    for (int n = 0; n < 2; ++n) { const f32x4 xv = *(const f32x4*)(src + off + bj * 128 + n * 16);
                        *(f32x4*)(out + off + bj * 128 + n * 16) = xv + gv[bj][n] * acc[ai][bj][m][n]; }
                asm volatile("" ::: "memory"); }
    }
};
DI float dpp_ror1(float v) { return __builtin_bit_cast(float, __builtin_amdgcn_update_dpp(0, __builtin_bit_cast(int, v), 0x121, 0xf, 0xf, false)); }
DI float dpp_ror15(float v) { return __builtin_bit_cast(float, __builtin_amdgcn_update_dpp(0, __builtin_bit_cast(int, v), 0x12f, 0xf, 0xf, false)); }
struct EpiConv {
    static constexpr bool PERM = true;
    bf16_t* ACT; const float* cw; const float* cb; int Mq;
    DI void operator()(AccRef acc, const Unit& u, int wr, int wc, int fr, int fq) const {
#pragma unroll
        for (int n = 0; n < 2; ++n) {
            const int cg_ = 128 * u.pn + 32 * wc + 8 * fq + 4 * n;
#pragma unroll
            for (int ai = 0; ai < 2; ++ai) {
                const int tok0 = 248 * u.pm - 1 + 62 * (2 * ai + wr);
                f32x4 o[4];
#pragma unroll
                for (int bj = 0; bj < 2; ++bj) {
                    f32x4 w[2][4];
#pragma unroll
                    for (int t = 0; t < 3; ++t) w[bj][t] = *(const f32x4*)(cw + (size_t)t * 2 * DFF + bj * DFF + cg_);
                    w[bj][3] = *(const f32x4*)(cb + bj * DFF + cg_);
#pragma unroll
                    for (int m = 0; m < 4; ++m) {
                        const int tok = tok0 + 16 * m + fr; const int msk = tok < ML ? 4095 : 255;
                        const bool hu = (tok & msk) != 0, hd = ((tok + 1) & msk) != 0;
                        f32x4 r = acc[ai][bj][m][n] * w[bj][1] + w[bj][3];
#pragma unroll
                        for (int j = 0; j < 4; ++j) {
                            const float su = (m > 0 && fr == 15) ? acc[ai][bj][(m + 3) & 3][n][j] : acc[ai][bj][m][n][j];
                            const float sd = (m < 3 && fr == 0) ? acc[ai][bj][(m + 1) & 3][n][j] : acc[ai][bj][m][n][j];
                            const float uu = dpp_ror1(su), dd = dpp_ror15(sd);
                            r[j] += hu ? uu * w[bj][0][j] : 0.f; r[j] += hd ? dd * w[bj][2][j] : 0.f; }
                        if (bj == 0) {
#pragma unroll
                            for (int j = 0; j < 4; ++j) o[m][j] = r[j] * __builtin_amdgcn_rcpf(1.f + __builtin_amdgcn_exp2f(-LOG2E * r[j]));
                        } else o[m] = o[m] * r;
                    }
                }
#pragma unroll
                for (int m = 0; m < 4; ++m) { const int li = 16 * m + fr, tok = tok0 + li;
                    if (li >= 1 && li <= 62 && tok < Mq) { u32x2 v; v.x = pk2(o[m][0], o[m][1]); v.y = pk2(o[m][2], o[m][3]);
                        *(u32x2*)(ACT + (size_t)tok * DFF + cg_) = v; } }
            }
        }
    }
};

struct Frame {
    LAS unsigned char* lds; unsigned char* ldsg; int tid, lane, wave, G, vcu;
    const Params& P; unsigned char* ws;
    DI const float* inp(int i) const { return P.in[i]; }
    DI int nrep(int d) const { int n = 1 + d; asm volatile("" : "+s"(n)); return n; }
    DI void refresh() { int t = threadIdx.x; asm volatile("" : "+v"(t)); tid = t; lane = t & 63; wave = __builtin_amdgcn_readfirstlane(t >> 6);
        unsigned char* w = P.ws; asm volatile("" : "+s"(w)); ws = w;
        int g = gridDim.x, bx = blockIdx.x; asm volatile("" : "+s"(g), "+s"(bx)); G = g; vcu = (g % 8 == 0) ? (bx % 8) * (g / 8) + bx / 8 : bx; }
};

DI void p_mod(const Frame& F) {
    float* sv = (float*)F.ldsg; float* red = sv + 5 * 2048;
    const float* c = F.inp(1); const float* cc = F.inp(3);
    for (int i = F.tid; i < 5 * 2048; i += NT) { const int r = i >> 11, k = i & 2047; const float v = r < 4 ? c[r * 2048 + k] : cc[k]; sv[i] = v / (1.f + __expf(-v)); }
    __syncthreads();
    float* mod = (float*)(F.ws + WS_MOD);
    for (int tile = F.vcu; tile < 768; tile += F.G) {
        const int l = tile / 384, colb = (tile % 384) * 32, cl = F.tid & 31, kg = F.tid >> 5;
        const float* w = F.inp(4) + (size_t)l * 2048 * 12288 + colb + cl;
        float a0 = 0.f, a1 = 0.f, a2 = 0.f, a3 = 0.f, a4 = 0.f;
#pragma unroll 16
        for (int k = kg * 128; k < kg * 128 + 128; ++k) { const float wv = __builtin_nontemporal_load(w + (size_t)k * 12288); a0 += sv[k] * wv; a1 += sv[2048 + k] * wv; a2 += sv[4096 + k] * wv; a3 += sv[6144 + k] * wv; a4 += sv[8192 + k] * wv; }
        float* rp = red + (kg * 32 + cl) * 5; rp[0] = a0; rp[1] = a1; rp[2] = a2; rp[3] = a3; rp[4] = a4;
        __syncthreads();
        if (F.tid < 160) { const int r = F.tid >> 5; float s = 0.f;
#pragma unroll
            for (int q = 0; q < 16; ++q) s += red[(q * 32 + cl) * 5 + r];
            mod[(size_t)(l * 5 + r) * 12288 + colb + cl] = s + F.inp(5)[l * 12288 + colb + cl]; }
        __syncthreads();
    }
}
DI void p_tables(const Frame& F) {
    const int gt = F.vcu * NT + F.tid, gn = F.G * NT;
    f32x2* t4096 = (f32x2*)F.ldsg;
    __syncthreads();
    for (int i = F.tid; i < 4096; i += NT) { f32x2 v; v.x = cospif((float)i / 2048.f); v.y = sinpif((float)i / 2048.f); t4096[i] = v; }
    __syncthreads();
    f32x2* rope = (f32x2*)(F.ws + WS_ROPE);
    for (int i = gt; i < 1024; i += gn) { const int pos = i >> 4, k = i & 15; const float fr = powf(10000.f, -(float)k / 16.f); const float a = (float)pos * fr; f32x2 v; v.x = cosf(a); v.y = sinf(a); rope[i] = v; }
    if (gt < 32) ((unsigned*)(F.ws + WS_CTR))[gt] = 0u;
    if (F.tid == 0) *(float**)(F.ws + WS_CTR + 128) = F.P.out;
    bf16_t* dc = (bf16_t*)F.P.out + (size_t)4096 * 8192;
    for (int i = gt; i < 256 * 512; i += gn) { const int lp = i >> 9, cc = i & 511, part = cc >> 8, l = cc & 255; const f32x2 t = t4096[((lp * l) & 255) * 16];
        dc[i] = f2bf((part ? -t.y : t.x) * (1.f / 16.f)); }
    bf16_t* wc = (bf16_t*)(F.ws + WS_WC); const float* wf = F.inp(14);
    for (int i = gt; i < 2 * 4 * 2 * 128 * 128; i += gn) {
        const int d = i & 127, cch = (i >> 7) & 127, part = (i >> 14) & 1, g = (i >> 15) & 3, l = i >> 17;
        const float* wp = wf + ((size_t)(l * 4 + g) * 128) * 128 + d; float sacc = 0.f;
        for (int c2 = 0; c2 < 128; ++c2) { const f32x2 t = t4096[((cch * c2) & 127) * 32]; sacc += (part ? t.y : t.x) * wp[(size_t)c2 * 128]; }
        sacc *= 0.08838834764831845f;
        bf16_t* row = wc + ((size_t)l * 1024 + (g * 2 + part) * 128 + d) * 512;
#pragma unroll
        for (int g2 = 0; g2 < 4; ++g2) row[g2 * 128 + cch] = (g2 == g) ? f2bf(sacc) : (bf16_t)0;
    }
    bf16_t* dft = (bf16_t*)F.P.out;
    for (int ch = gt; ch < 4096 * 1024; ch += gn) { const int lp = ch >> 10, c8 = ch & 1023, part = c8 >> 9, l0 = (c8 & 511) * 8; f32x4 a, b;
#pragma unroll
        for (int j = 0; j < 4; ++j) { const f32x2 t0 = t4096[(lp * (l0 + j)) & 4095], t1 = t4096[(lp * (l0 + 4 + j)) & 4095];
            a[j] = (part ? -t0.y : t0.x) * (1.f / 64.f); b[j] = (part ? -t1.y : t1.x) * (1.f / 64.f); }
        *(u32x4*)(dft + (size_t)lp * 8192 + part * 4096 + l0) = pk8(a, b); }
    __syncthreads();
}
struct CvDesc { const float* src; const float* kscale; bf16_t* dst; int K, Nsrc, Ndst, mapid, ntiles; };
DI int cv_map(int mapid, int n) {
    if (mapid == 1) return n < 1024 ? n : (n < 3072 ? n + 64 : (n < 3136 ? n - 2048 : -1));
    if (mapid == 2) { const int which = n >> 10, h = (n >> 7) & 7, j = n & 127; return h * 256 + which * 128 + j; }
    if (mapid == 3) { const int pn = n >> 8, bj = (n >> 7) & 1, q = n & 127; return bj * DFF + pn * 128 + q; }
    return n;
}
DI CvDesc cv_desc(const Frame& F, int m) {
    const int l = m / 6, j = m % 6; CvDesc d; d.kscale = nullptr; d.mapid = 0;
    if (j == 0) { d.src = F.inp(8) + (size_t)l * D * INC; d.K = D; d.Nsrc = INC; d.dst = (bf16_t*)(F.ws + WS_WIN) + (size_t)l * UC * D; d.Ndst = UC; d.mapid = 1; }
    else if (j == 1) { d.src = F.inp(10) + (size_t)l * 512 * 1536; d.K = 512; d.Nsrc = 1536; d.dst = (bf16_t*)(F.ws + WS_WUQ) + (size_t)l * 1536 * 512; d.Ndst = 1536; d.kscale = F.inp(9) + l * 512; }
    else if (j == 2) { d.src = F.inp(12) + (size_t)l * 512 * 2048; d.K = 512; d.Nsrc = 2048; d.dst = (bf16_t*)(F.ws + WS_WUKV) + (size_t)l * 2048 * 512; d.Ndst = 2048; d.kscale = F.inp(11) + l * 512; d.mapid = 2; }
    else if (j == 3) { d.src = F.inp(15) + (size_t)l * D * D; d.K = D; d.Nsrc = D; d.dst = (bf16_t*)(F.ws + WS_WOUT) + (size_t)l * D * D; d.Ndst = D; }
    else if (j == 4) { d.src = F.inp(16) + (size_t)l * D * 2 * DFF; d.K = D; d.Nsrc = 2 * DFF; d.dst = (bf16_t*)(F.ws + WS_WUP) + (size_t)l * 2 * DFF * D; d.Ndst = 2 * DFF; d.mapid = 3; }
    else { d.src = F.inp(19) + (size_t)l * DFF * D; d.K = DFF; d.Nsrc = D; d.dst = (bf16_t*)(F.ws + WS_WDN) + (size_t)l * D * DFF; d.Ndst = D; }
    d.ntiles = (d.Ndst / 128) * (d.K / 64); return d;
}
struct CvTile { const float* src; const float* kscale; bf16_t* dst; int K, Nsrc, sc0, sc1, n0, k0; bool ok; };
DI CvTile cv_tile(const Frame& F, int t) {
    CvTile r; r.ok = false;
    for (int m = 0; m < 12; ++m) { const CvDesc d = cv_desc(F, m);
        if (t < d.ntiles) { const int ntn = d.Ndst / 128; r.n0 = (t % ntn) * 128; r.k0 = (t / ntn) * 64; r.src = d.src; r.kscale = d.kscale; r.dst = d.dst; r.K = d.K; r.Nsrc = d.Nsrc;
            r.sc0 = cv_map(d.mapid, r.n0); r.sc1 = cv_map(d.mapid, r.n0 + 64); r.ok = true; return r; }
        t -= d.ntiles; }
    return r;
}
DI void cv_load(const Frame& F, const CvTile& t, f32x4 (&r)[4]) {
#pragma unroll
    for (int h = 0; h < 2; ++h) { const int sc = h ? t.sc1 : t.sc0;
#pragma unroll
        for (int p = 0; p < 2; ++p) { const int kk = p * 32 + (F.tid >> 4);
            f32x4 v = {0.f, 0.f, 0.f, 0.f};
            if (sc >= 0) { v = __builtin_nontemporal_load((const f32x4*)(t.src + (size_t)(t.k0 + kk) * t.Nsrc + sc + (F.tid & 15) * 4)); if (t.kscale) v *= t.kscale[t.k0 + kk]; }
            r[h * 2 + p] = v; } }
}
DI void p_convert(const Frame& F) {
    float* ts = (float*)F.ldsg;
    int t = F.vcu; CvTile cur = cv_tile(F, t); f32x4 r[4]; int buf = 0;
    if (cur.ok) cv_load(F, cur, r);
    while (cur.ok) {
        float* tb = ts + buf * (2 * 64 * 65);
#pragma unroll
        for (int h = 0; h < 2; ++h)
#pragma unroll
            for (int p = 0; p < 2; ++p) { const int kk = p * 32 + (F.tid >> 4); float* q = tb + h * (64 * 65) + kk * 65 + (F.tid & 15) * 4;
                q[0] = r[h * 2 + p][0]; q[1] = r[h * 2 + p][1]; q[2] = r[h * 2 + p][2]; q[3] = r[h * 2 + p][3]; }
        __syncthreads();
        const CvTile nxt = cv_tile(F, t + F.G);
        if (nxt.ok) cv_load(F, nxt, r);
#pragma unroll
        for (int h = 0; h < 2; ++h) { const int n = F.tid >> 3, kc = F.tid & 7; const float* q = tb + h * (64 * 65) + n; f32x4 a, b;
#pragma unroll
            for (int j = 0; j < 4; ++j) { a[j] = q[(kc * 8 + j) * 65]; b[j] = q[(kc * 8 + 4 + j) * 65]; }
            *(u32x4*)(cur.dst + (size_t)(cur.n0 + h * 64 + n) * cur.K + cur.k0 + kc * 8) = pk8(a, b); }
        buf ^= 1; t += F.G; cur = nxt;
    }
    __syncthreads();
}

DI void norm_phase(const Frame& F, const float* xl, const float* xc, int M, const float* g, const float* modl, int sh_off, int sc_off, bf16_t* H, float* outf) {
    const int gw = F.vcu * 8 + F.wave, nw = F.G * 8;
    for (int row = gw; row < M; row += nw) {
        const float* xr = row < ML ? xl + (size_t)row * D : xc + (size_t)(row - ML) * D;
        f32x4 v[8]; float ss = 0.f;
#pragma unroll
        for (int i = 0; i < 4; ++i) { v[2 * i] = *(const f32x4*)(xr + i * 512 + F.lane * 8); v[2 * i + 1] = *(const f32x4*)(xr + i * 512 + F.lane * 8 + 4); ss += sq4(v[2 * i]) + sq4(v[2 * i + 1]); }
#pragma unroll
        for (int o = 32; o >= 1; o >>= 1) ss += shx(ss, o, F.lane);
        const float rs = __builtin_amdgcn_rsqf(ss * (1.f / 2048.f) + EPS);
        const int midx = row < ML ? (row >> 12) : 4;
#pragma unroll
        for (int i = 0; i < 4; ++i) { const int col = i * 512 + F.lane * 8;
            const f32x4 g0 = *(const f32x4*)(g + col), g1 = *(const f32x4*)(g + col + 4);
            if (outf) { *(f32x4*)(outf + (size_t)row * D + col) = v[2 * i] * rs * g0; *(f32x4*)(outf + (size_t)row * D + col + 4) = v[2 * i + 1] * rs * g1; }
            else { const float* mp = modl + (size_t)midx * 12288 + col;
                const f32x4 s0 = *(const f32x4*)(mp + sc_off), s1 = *(const f32x4*)(mp + sc_off + 4), h0 = *(const f32x4*)(mp + sh_off), h1 = *(const f32x4*)(mp + sh_off + 4);
                *(u32x4*)(H + (size_t)row * D + col) = pk8(v[2 * i] * rs * g0 * (1.f + s0) + h0, v[2 * i + 1] * rs * g1 * (1.f + s1) + h1); } }
    }
}

struct AttnItem {
    const bf16_t* q; const bf16_t* kn; const bf16_t* kr; const bf16_t* vt; bf16_t* o;
    int ldq, ldk, ldo, lat_row0, ctx_row0, t0, ntl, nctx, mode, r0, hn;
};
template <int DQ>
DI void attn_item(const Frame& F, const AttnItem& it, const float* rpb_lds) {
    constexpr int KP = DQ + 8, VP = 72, KS = DQ / 16;
    constexpr int KBYTES = 64 * KP * 2, VBYTES = 128 * VP * 2, BUF = KBYTES + VBYTES;
    LAS unsigned char* base = F.lds;
    int tid = threadIdx.x; asm volatile("" : "+v"(tid));
    const int lane = tid & 63, w = __builtin_amdgcn_readfirstlane(tid >> 6), qq = lane & 31, hh = lane >> 5;
    const int ntile = it.ntl + it.nctx;
    u32x4 rk[2], rr, rv[2];
    auto gload = [&](int ti) {
        int rowb, vcol;
        if (ti < it.ntl) { const int kt = it.t0 + ti; rowb = it.lat_row0 + kt * 64; vcol = kt * 64; } else { const int j = ti - it.ntl; rowb = it.ctx_row0 + j * 64; vcol = SEQ + j * 64; }
#pragma unroll
        for (int i = 0; i < 2; ++i) { const int id = tid + i * NT; rk[i] = *(const u32x4*)(it.kn + (size_t)(rowb + (id >> 4)) * it.ldk + (id & 15) * 8);
            rv[i] = *(const u32x4*)(it.vt + (size_t)(id >> 3) * KEYS + vcol + (id & 7) * 8); }
        if (DQ == 192) rr = *(const u32x4*)(it.kr + (size_t)(rowb + (tid >> 3)) * UC + (tid & 7) * 8);
    };
    auto lstore = [&](int buf) {
        LAS unsigned char* kb = base + buf * BUF; LAS unsigned char* vb = kb + KBYTES;
#pragma unroll
        for (int i = 0; i < 2; ++i) { const int id = tid + i * NT; *(LAS u32x4*)(kb + ((id >> 4) * KP + (id & 15) * 8) * 2) = rk[i];
            *(LAS u32x4*)(vb + ((id >> 3) * VP + (id & 7) * 8) * 2) = rv[i]; }
        if (DQ == 192) *(LAS u32x4*)(kb + ((tid >> 3) * KP + 128 + (tid & 7) * 8) * 2) = rr;
    };
    bf16x8 qf[KS];
    { const bf16_t* qp = it.q + (size_t)(32 * w + qq) * it.ldq + 8 * hh;
#pragma unroll
        for (int ks = 0; ks < KS; ++ks) qf[ks] = *(const bf16x8*)(qp + 16 * ks); }
    f32x16 o[4];
#pragma unroll
    for (int db = 0; db < 4; ++db)
#pragma unroll
        for (int i = 0; i < 16; ++i) o[db][i] = 0.f;
    float mrun = -INFINITY, lrun = 0.f;
    const int r = it.r0 + (w >> 1), wq = 32 * (w & 1) + qq;
    const int rs = min(max(r - 4, 0), 56), cs = min(max(wq - 8, 0), 48);

    __syncthreads();
    gload(0); lstore(0);
    if (ntile > 1) gload(1);
    __syncthreads();
    for (int ti = 0; ti < ntile; ++ti) {
        const int buf = ti & 1;
        const bool lat = ti < it.ntl; const int krow = it.t0 + ti;
        const bool active = !(it.mode == 1 && lat && (krow < rs || krow > rs + 7));
        if (active) {
            LAS unsigned char* kb = base + buf * BUF; LAS unsigned char* vb = kb + KBYTES;
            f32x16 s[2];
#pragma unroll
            for (int blk = 0; blk < 2; ++blk) {
#pragma unroll
                for (int i = 0; i < 16; ++i) s[blk][i] = 0.f;
#pragma unroll
                for (int ks = 0; ks < KS; ++ks) { const bf16x8 a = *(const LAS bf16x8*)(kb + ((32 * blk + qq) * KP + 16 * ks + 8 * hh) * 2);
                    s[blk] = __builtin_amdgcn_mfma_f32_32x32x16_bf16(a, qf[ks], s[blk], 0, 0, 0); }
            }
            if (it.mode == 1 && lat) {
                const float* bp = rpb_lds + it.hn * 465 + (krow - r + 7) * 31 - wq + 15;
#pragma unroll
                for (int blk = 0; blk < 2; ++blk)
#pragma unroll
                    for (int i = 0; i < 16; ++i) { const int kc = 32 * blk + (i & 3) + 8 * (i >> 2) + 4 * hh; const bool ok = kc >= cs && kc < cs + 16;
                        const int kcc = ok ? kc : cs; s[blk][i] = ok ? s[blk][i] + bp[kcc] : -INFINITY; }
            }
            float mx = s[0][0];
#pragma unroll
            for (int blk = 0; blk < 2; ++blk)
#pragma unroll
                for (int i = 0; i < 16; ++i) mx = fmaxf(mx, s[blk][i]);
            mx = fmaxf(mx, shx(mx, 32, lane));
            const float mnew = fmaxf(mrun, mx), alpha = __builtin_amdgcn_exp2f(mrun - mnew);
            mrun = mnew;
            float ps = 0.f;
#pragma unroll
            for (int blk = 0; blk < 2; ++blk)
#pragma unroll
                for (int i = 0; i < 16; ++i) { const float p = __builtin_amdgcn_exp2f(s[blk][i] - mnew); s[blk][i] = p; ps += p; }
            lrun = lrun * alpha + ps;
            if (__builtin_amdgcn_ballot_w64(alpha != 1.f) != 0ull) {
#pragma unroll
                for (int db = 0; db < 4; ++db)
#pragma unroll
                    for (int i = 0; i < 16; ++i) o[db][i] *= alpha;
            }
#pragma unroll
            for (int blk = 0; blk < 2; ++blk)
#pragma unroll
                for (int s2 = 0; s2 < 2; ++s2) {
                    u32x4 pw; pw.x = pk2(s[blk][8 * s2], s[blk][8 * s2 + 1]); pw.y = pk2(s[blk][8 * s2 + 2], s[blk][8 * s2 + 3]);
                    pw.z = pk2(s[blk][8 * s2 + 4], s[blk][8 * s2 + 5]); pw.w = pk2(s[blk][8 * s2 + 6], s[blk][8 * s2 + 7]);
                    const bf16x8 pf = __builtin_bit_cast(bf16x8, pw);
#pragma unroll
                    for (int db = 0; db < 4; ++db) { LAS unsigned char* vp = vb + ((32 * db + qq) * VP + 32 * blk + 16 * s2 + 4 * hh) * 2;
                        const u32x2 v0 = *(const LAS u32x2*)vp, v1 = *(const LAS u32x2*)(vp + 16);
                        u32x4 vv; vv.x = v0.x; vv.y = v0.y; vv.z = v1.x; vv.w = v1.y;
                        o[db] = __builtin_amdgcn_mfma_f32_32x32x16_bf16(__builtin_bit_cast(bf16x8, vv), pf, o[db], 0, 0, 0); }
                }
        }
        if (ti + 1 < ntile) lstore(buf ^ 1);
        if (ti + 2 < ntile) gload(ti + 2);
        __syncthreads();
    }
    const float lt = lrun + shx(lrun, 32, lane), inv = 1.f / lt;
    bf16_t* op = it.o + (size_t)(32 * w + qq) * it.ldo + 4 * hh;
#pragma unroll
    for (int db = 0; db < 4; ++db)
#pragma unroll
        for (int ig = 0; ig < 4; ++ig) { u32x2 v; v.x = pk2(o[db][4 * ig] * inv, o[db][4 * ig + 1] * inv); v.y = pk2(o[db][4 * ig + 2] * inv, o[db][4 * ig + 3] * inv);
            *(u32x2*)(op + 32 * db + 8 * ig) = v; }
}

DI void mixer_attention(const Frame& F, int layer, int cidx) {
    const int nitems = layer == 0 ? 816 : 768;
    bf16_t* U = (bf16_t*)(F.ws + WS_U); bf16_t* Q = (bf16_t*)(F.ws + WS_Q); bf16_t* KN = (bf16_t*)(F.ws + WS_KN);
    bf16_t* VT = (bf16_t*)(F.ws + WS_VT); bf16_t* VNT = (bf16_t*)(F.ws + WS_VNT); bf16_t* CAT = (bf16_t*)(F.ws + WS_CAT);
    unsigned* ctr = (unsigned*)(F.ws + WS_CTR) + cidx;
    float* rpb = (float*)(F.ldsg + 100 * 1024);
    volatile int* slot = (volatile int*)(F.ldsg + 100 * 1024 + 8192);
    __syncthreads();
    for (int i = F.tid; i < 4 * 465; i += NT) rpb[i] = F.inp(13)[layer * 4 * 465 + i] * LOG2E;
    for (;;) {
        __syncthreads();
        if (F.tid == 0) *slot = (int)atomicAdd(ctr, 1u);
        __syncthreads();
        const int idx = *slot;
        if (idx >= nitems) break;
        AttnItem it; it.kr = nullptr; it.mode = 0; it.r0 = 0; it.hn = 0; it.nctx = 4;
        if (idx < 512 || (idx >= 768 && idx < 800)) {
            int b, h, row0;
            if (idx < 512) { b = idx >> 7; h = (idx >> 4) & 7; row0 = b * 4096 + (idx & 15) * 256; it.t0 = 0; it.ntl = 64; }
            else { const int j = idx - 768; b = j >> 3; h = j & 7; row0 = ML + b * 256; it.t0 = 0; it.ntl = 0; }
            it.q = Q + (size_t)row0 * 1536 + h * 192; it.ldq = 1536;
            it.kn = KN + h * 128; it.ldk = 1024; it.kr = U + U_KR;
            it.vt = VT + (size_t)(b * 8 + h) * 128 * KEYS;
            it.o = CAT + (size_t)row0 * D + h * 128; it.ldo = D;
            it.lat_row0 = b * 4096; it.ctx_row0 = ML + b * 256;
            attn_item<192>(F, it, rpb);
        } else {
            int b, hn, row0;
            if (idx < 768) { const int j = idx - 512; b = j >> 6; hn = (j >> 4) & 3; const int R = j & 15; row0 = b * 4096 + R * 256;
                const int rlo = max(4 * R - 4, 0), rhi = min(max(4 * R - 1, 0), 56) + 7; it.t0 = rlo; it.ntl = rhi - rlo + 1; it.mode = 1; it.r0 = 4 * R; it.hn = hn; }
            else { const int j = idx - 800; b = j >> 2; hn = j & 3; row0 = ML + b * 256; it.t0 = 0; it.ntl = 0; }
            it.q = U + (size_t)row0 * UC + U_QN + hn * 128; it.ldq = UC;
            it.kn = U + U_KN + hn * 128; it.ldk = UC;
            it.vt = VNT + (size_t)(b * 4 + hn) * 128 * KEYS;
            it.o = CAT + (size_t)row0 * D + 1024 + hn * 128; it.ldo = D;
            it.lat_row0 = b * 4096; it.ctx_row0 = ML + b * 256;
            attn_item<128>(F, it, rpb);
        }
    }
}

#ifndef PHMASK
#define PHMASK 0x7ff
#endif
#define PH(k) (((PHMASK) >> (k)) & 1)
#ifndef DUPMASK
#define DUPMASK 0x000
#endif
#define REP(k) for (int rep_ = 0, nrep_ = F.nrep((DUPMASK >> (k)) & 1); rep_ < nrep_; ++rep_)
#define Hbuf ((bf16_t*)(F.ws + WS_H))
#define H (Hbuf + D)
#define X ((float*)(F.ws + WS_X))
#define U ((bf16_t*)(F.ws + WS_U))
#define SSQ ((float*)(F.ws + WS_SSQ))
#define CAT ((bf16_t*)(F.ws + WS_CAT))
#define mod ((const float*)(F.ws + WS_MOD))
#define rope ((const f32x2*)(F.ws + WS_ROPE))
#define GSYNC() do { grid.sync(); F.refresh(); } while (0)
DI void layer_body(Frame& F, cg::grid_group& grid, const int l) {
        const int Mq = l == 0 ? MT : ML;
#define modl (mod + (size_t)l * 5 * 12288)
#define xl (l == 0 ? F.inp(0) : (const float*)X)
#define xc (l == 0 ? F.inp(2) : (const float*)(X + (size_t)ML * D))
        REP(1) {
        if (PH(1)) norm_phase(F, xl, xc, MT, F.inp(6) + l * D, modl, 0, 2048, H, nullptr);
        GSYNC(); }
        REP(2) {
        { pg8::Gemm g{H, (const bf16_t*)(F.ws + WS_WIN) + (size_t)l * UC * D, D, D, D, 0};
          pg8::Sched S; S.init(MT / 256, UC / 256, F.G, F.vcu, 0);
          EpiU E{U, SSQ, (bf16_t*)(F.ws + WS_VNT), rope, 0.08838834764831845f * LOG2E};
          if (PH(2)) pg8::gemm_phase(F.lds, g, S, E); }
        GSYNC(); }
        REP(3) {
        { int start = 0;
          { pg8::Gemm g{U + U_CQ, (const bf16_t*)(F.ws + WS_WUQ) + (size_t)l * 1536 * 512, UC, 512, 512, 0};
            pg8::Sched S; S.init(Mq / 256, 6, F.G, F.vcu, start); start += (Mq / 256) * 6;
            EpiQ E{(bf16_t*)(F.ws + WS_Q), SSQ, rope, 0.07216878364870323f * LOG2E};
            if (PH(3)) pg8::gemm_phase(F.lds, g, S, E); }
          { pg8::Gemm g{U + U_CKV, (const bf16_t*)(F.ws + WS_WUKV) + (size_t)l * 2048 * 512, UC, 512, 512, 0};
            pg8::Sched S; S.init(MT / 256, 8, F.G, F.vcu, start); start += (MT / 256) * 8;
            EpiKV E{(bf16_t*)(F.ws + WS_KN), (bf16_t*)(F.ws + WS_VT), SSQ};
            if (PH(4)) pg8::gemm_phase(F.lds, g, S, E); }
          { pg8::Gemm g{(const bf16_t*)(F.ws + WS_WC) + (size_t)l * 1024 * 512, U + U_F, 512, UC, 512, 0};
            pg8::Sched S; S.init(4, Mq / 256, F.G, F.vcu, start);
            EpiY E{(bf16_t*)(F.ws + WS_YT), (bf16_t*)(F.ws + WS_YTC)};
            if (PH(5)) pg8::gemm_phase(F.lds, g, S, E); } }
        GSYNC(); }
        REP(7) {
        if (F.vcu < 128 || (l == 0 && F.vcu < 136)) {
            const bool cx = F.vcu >= 128; const int ld = cx ? 512 : 8192;
            const bf16_t* dftp = *(const bf16_t* const*)(F.ws + WS_CTR + 128);
            pg8::Gemm g{dftp + (cx ? (size_t)4096 * 8192 : (size_t)0), (const bf16_t*)(F.ws + (cx ? WS_YTC : WS_YT)), ld, ld, ld, 0};
            pg8::OneUnit S; S.u.pm = cx ? 0 : (F.vcu & 15); S.u.pn = cx ? (F.vcu - 128) : (F.vcu >> 4); S.has = true;
            EpiF E{CAT, cx ? 1 : 0}; if (PH(6)) pg8::gemm_phase(F.lds, g, S, E); }
        if (PH(7)) mixer_attention(F, l, l + 2 * rep_);
        GSYNC(); }
        REP(8) {
        { pg8::Gemm g{CAT, (const bf16_t*)(F.ws + WS_WOUT) + (size_t)l * D * D, D, D, D, 0};
          pg8::Sched S; S.init(Mq / 256, 8, F.G, F.vcu, 0);
          EpiRes E{xl, xc, X, modl + 4096};
          if (PH(8)) pg8::gemm_phase(F.lds, g, S, E); }
        GSYNC(); }
        REP(4) {
        if (PH(1)) norm_phase(F, X, X + (size_t)ML * D, Mq, F.inp(7) + l * D, modl, 6144, 8192, H, nullptr);
        GSYNC(); }
        REP(10) {
        { pg8::Gemm g{Hbuf, (const bf16_t*)(F.ws + WS_WUP) + (size_t)l * 2 * DFF * D, D, D, D, 1};
          pg8::Sched S; S.init((Mq + 247) / 248, 44, F.G, F.vcu, 0);
          EpiConv E{(bf16_t*)(F.ws + WS_ACT), F.inp(17) + (size_t)l * 3 * 2 * DFF, F.inp(18) + (size_t)l * 2 * DFF, Mq};
          if (PH(10)) pg8::gemm_phase(F.lds, g, S, E); }
        GSYNC(); }
        { pg8::Gemm g{(const bf16_t*)(F.ws + WS_ACT), (const bf16_t*)(F.ws + WS_WDN) + (size_t)l * D * DFF, DFF, DFF, DFF, 0};
          pg8::Sched S; S.init(Mq / 256, 8, F.G, F.vcu, 0);
          EpiRes E{X, X + (size_t)ML * D, X, modl + 10240};
          if (PH(9)) pg8::gemm_phase(F.lds, g, S, E); }
        GSYNC();

}

__global__ void __launch_bounds__(NT) fwd_megakernel(Params p) {
    extern __shared__ __attribute__((aligned(16))) unsigned char lds_raw[];
    cg::grid_group grid = cg::this_grid();
    const int tid_ = threadIdx.x, G_ = gridDim.x, bx_ = blockIdx.x;
    Frame F{(LAS unsigned char*)lds_raw, lds_raw, tid_, tid_ & 63, __builtin_amdgcn_readfirstlane(tid_ >> 6), G_, (G_ % 8 == 0) ? (bx_ % 8) * (G_ / 8) + bx_ / 8 : bx_, p, p.ws};
    REP(0) { if (PH(0)) { p_mod(F);
    p_tables(F);
    p_convert(F); }
    GSYNC(); }

    for (int l = 0; l < 2; ++l) layer_body(F, grid, l);
    if (PH(1)) norm_phase(F, X, X, ML, F.inp(20), nullptr, 0, 0, nullptr, p.out);
}
#undef Hbuf
#undef H
#undef X
#undef U
#undef SSQ
#undef CAT
#undef mod
#undef rope
#undef modl
#undef xl
#undef xc


extern "C" void kernel_launch(void* const* d_in, const int* in_sizes, int n_in, void* d_out, int out_size, void* d_ws, size_t ws_size, hipStream_t stream) {
    static int grid_blocks = 0;
    if (!grid_blocks) {
        int dev = 0, cus = 0, per_cu = 0;
        hipGetDevice(&dev);
        hipDeviceGetAttribute(&cus, hipDeviceAttributeMultiprocessorCount, dev);
        hipFuncSetAttribute((const void*)fwd_megakernel, hipFuncAttributeMaxDynamicSharedMemorySize, LDS_BYTES);
        hipOccupancyMaxActiveBlocksPerMultiprocessor(&per_cu, (const void*)fwd_megakernel, NT, LDS_BYTES);
        if (per_cu < 1) { fprintf(stderr, "occupancy query says %d blocks/CU\n", per_cu); per_cu = 1; }
        grid_blocks = cus;
        if (ws_size < WS_END) fprintf(stderr, "workspace too small: %zu < %zu\n", ws_size, (size_t)WS_END);
    }
    Params p{};
    for (int i = 0; i < 21; ++i) p.in[i] = (const float*)d_in[i];
    p.out = (float*)d_out; p.ws = (unsigned char*)d_ws;
    void* args[] = {&p};
    hipError_t e = hipLaunchCooperativeKernel((const void*)fwd_megakernel, dim3(grid_blocks), dim3(NT), args, LDS_BYTES, stream);
    if (e != hipSuccess) fprintf(stderr, "cooperative launch failed: %s (grid %d)\n", hipGetErrorString(e), grid_blocks);
}
```

```cpp
#include <hip/hip_runtime.h>
#include <hip/hip_cooperative_groups.h>
#include <cstdio>
namespace cg = cooperative_groups;

#define LAS __attribute__((address_space(3)))
#define GAS __attribute__((address_space(1)))
template <class T> __device__ __forceinline__ T* as_global(T* p) { return p; }
#define DI __device__ __forceinline__
typedef unsigned short bf16_t;
typedef short bf16x8 __attribute__((ext_vector_type(8)));
typedef short s16x4 __attribute__((ext_vector_type(4)));
typedef float f32x4 __attribute__((ext_vector_type(4)));
typedef float f32x2 __attribute__((ext_vector_type(2)));
typedef float f32x16 __attribute__((ext_vector_type(16)));
typedef unsigned u32x4 __attribute__((ext_vector_type(4)));
typedef unsigned u32x2 __attribute__((ext_vector_type(2)));
typedef __bf16 bfv2 __attribute__((ext_vector_type(2)));

constexpr int D = 2048, NB = 4, SEQ = 4096, CTXL = 256, ML = NB * SEQ, MC = NB * CTXL, MT = ML + MC;
constexpr int INC = 3136, UC = 3328;
constexpr int U_CQ = 0, U_CKV = 512, U_QN = 1024, U_KN = 1536, U_VN = 2048, U_F = 2560, U_KR = 3072;
constexpr int DFF = 5632, KEYS = SEQ + CTXL;
constexpr float EPS = 1e-6f, LOG2E = 1.4426950408889634f;
constexpr int NT = 512;
constexpr int LDS_BYTES = 136 * 1024;

constexpr size_t al(size_t x) { return (x + 255) & ~(size_t)255; }
constexpr size_t WS_WIN = 0;
constexpr size_t WS_WUQ = WS_WIN + al((size_t)2 * UC * D * 2);
constexpr size_t WS_WUKV = WS_WUQ + al((size_t)2 * 1536 * 512 * 2);
constexpr size_t WS_WOUT = WS_WUKV + al((size_t)2 * 4096 * 512 * 2);
constexpr size_t WS_WUP = WS_WOUT + al((size_t)2 * D * D * 2);
constexpr size_t WS_WDN = WS_WUP + al((size_t)2 * 2 * DFF * D * 2);
constexpr size_t WS_WC = WS_WDN + al((size_t)2 * D * DFF * 2);
constexpr size_t WS_DFTC = WS_WC + al((size_t)2 * 1024 * 512 * 2);
constexpr size_t WS_TRIG = WS_DFTC + al((size_t)256 * 512 * 2);
constexpr size_t WS_ROPE = WS_TRIG + al(4096 * 8);
constexpr size_t WS_MOD = WS_ROPE + al(64 * 16 * 8);
constexpr size_t WS_CTR = WS_MOD + al((size_t)2 * 5 * 12288 * 4);
constexpr size_t WS_X = WS_CTR + 256;
constexpr size_t WS_H = WS_X + al((size_t)MT * D * 4);
constexpr size_t H_ROWS = 1 + MT + 256;
constexpr size_t WS_CAT = WS_H + al(H_ROWS * D * 2);
constexpr size_t WS_YTC = WS_CAT + al((size_t)MT * D * 2);
constexpr size_t WS_U = WS_YTC + al((size_t)2048 * 512 * 2);
constexpr size_t WS_SSQ = WS_U + al((size_t)MT * UC * 2);
constexpr size_t WS_Q = WS_SSQ + al((size_t)MT * 16 * 4);
constexpr size_t WS_KN = WS_Q + al((size_t)MT * 1536 * 2);
constexpr size_t WS_VT = WS_KN + al((size_t)MT * 1024 * 2);
constexpr size_t WS_VNT = WS_VT + al((size_t)32 * 128 * KEYS * 2);
constexpr size_t WS_YT = WS_VNT + al((size_t)16 * 128 * KEYS * 2);
constexpr size_t WS_END = WS_YT + al((size_t)2048 * 8192 * 2);
constexpr size_t WS_ACT = WS_U;
static_assert(WS_ACT + (size_t)MT * DFF * 2 <= WS_END, "ACT alias");
static_assert((size_t)4096 * 8192 * 2 <= H_ROWS * D * 2, "DFT alias");
static_assert(WS_END <= (size_t)805306368, "workspace");

struct Params { const float* in[21]; float* out; unsigned char* ws; };

DI unsigned pk2(float a, float b) { f32x2 v = {a, b}; bfv2 r = __builtin_convertvector(v, bfv2); return __builtin_bit_cast(unsigned, r); }
DI bf16_t f2bf(float a) { return (bf16_t)(pk2(a, 0.f) & 0xffffu); }
DI float shx(float v, int m, int lane) { return __builtin_bit_cast(float, __builtin_amdgcn_ds_bpermute((lane ^ m) << 2, __builtin_bit_cast(int, v))); }
DI float sq4(f32x4 v) { return (v[0] * v[0] + v[1] * v[1]) + (v[2] * v[2] + v[3] * v[3]); }
DI u32x4 pk8(f32x4 a, f32x4 b) { u32x4 w; w.x = pk2(a[0], a[1]); w.y = pk2(a[2], a[3]); w.z = pk2(b[0], b[1]); w.w = pk2(b[2], b[3]); return w; }

namespace pg8 {
constexpr int BM = 256, BK = 64, HALF = 128, HTB = HALF * BK * 2, STAGE_BYTES = 8 * HTB;
DI int lds_byte(int r, int c) { const int st = (r >> 4) * 2 + (c >> 5), rr = r & 15, cc = c & 31, ob = rr * 64 + cc * 2; return st * 1024 + (ob ^ (((ob >> 9) & 1) << 5)); }
DI void stage_rc(int b, int& R, int& C) { const int st = b / 1024, sb = b % 1024, swz = sb ^ (((sb >> 9) & 1) << 5); R = (st >> 1) * 16 + swz / 64; C = (st & 1) * 32 + (swz % 64) / 2; }
DI int perm32(int rho) { const int n = rho >> 4, i = rho & 15; return 8 * (i >> 2) + 4 * n + (i & 3); }
struct Unit { int pm, pn; };
struct Gemm { const bf16_t* A; const bf16_t* Bt; int lda, ldb, K; int conv; };

struct Sched {
    int nM, nN, cnt, G, c, i0, start;
    DI void init(int nM_, int nN_, int G_, int c_, int start_) { nM = nM_; nN = nN_; cnt = nM * nN; G = G_; c = c_; start = start_;
        i0 = (start_ > c_) ? (start_ - c_ + G_ - 1) / G_ : 0; }
    DI bool next(int i, Unit& u) const {
        const long L = (long)(i0 + i) * G + c - start; if (L >= cnt) return false;
        const int w = (int)L, nig = 8 * nN, gid = w / nig, fm = gid * 8, gsz = (nM - fm) < 8 ? (nM - fm) : 8;
        u.pm = fm + ((w % nig) % gsz); u.pn = (w % nig) / gsz; return true;
    }
};
struct OneUnit { Unit u; bool has; DI bool next(int i, Unit& o) const { o = u; return has && i == 0; } };

template <class Epi, class SchedT>
DI void gemm_phase(LAS unsigned char* lds, const Gemm g, const SchedT& S, const Epi& E) {
    int tid = threadIdx.x; asm volatile("" : "+v"(tid));
    const int wid = __builtin_amdgcn_readfirstlane(tid >> 6), lane = tid & 63, wr = wid >> 2, wc = wid & 3, fr = lane & 15, fq = lane >> 4;
    const int K = g.K, nt = K / BK;
    unsigned voffA[2], voffB[2];
    auto mk_voff = [&]() { int t2 = threadIdx.x; asm volatile("" : "+v"(t2));
#pragma unroll
        for (int i = 0; i < 2; ++i) { int R, C; stage_rc(t2 * 16 + i * 8192, R, C); const int Rb = Epi::PERM ? ((R & ~31) + perm32(R & 31)) : R;
            const int Ra = g.conv ? ((R >> 6) * 62 + (R & 63)) : R;
            voffA[i] = (unsigned)(Ra * g.lda + C) * 2u; voffB[i] = (unsigned)(Rb * g.ldb + C) * 2u; } };
    mk_voff();
    const size_t kstep = (size_t)(BK * 2);
    const size_t hstepA = (size_t)(g.conv ? 124 : HALF) * g.lda * 2, hstepB = (size_t)HALF * g.ldb * 2;
    const size_t tstepA = 2 * hstepA, tstepB = 2 * hstepB;
    const unsigned ldsw = (unsigned)wid * 1024u;
    const int aoff = lds_byte(wr * 64 + fr, fq * 8), boff = lds_byte(wc * 32 + fr, fq * 8);
#define PG8_SA(b, h) (((b) * 2 + (h)) * HTB)
#define PG8_SB(b, h) ((4 + (b) * 2 + (h)) * HTB)
#define PG8_STAGE(bufoff, gbase, voff) do { _Pragma("unroll") for (int _i = 0; _i < 2; ++_i) \
        __builtin_amdgcn_global_load_lds((const unsigned*)((const char*)(gbase) + (voff)[_i]), (LAS unsigned*)(lds + (bufoff) + ldsw + _i * 8192), 16, 0, 0); } while (0)
#define PG8_LDA(dst, b, h) do { _Pragma("unroll") for (int m = 0; m < 4; ++m) _Pragma("unroll") for (int k = 0; k < 2; ++k) dst[m][k] = *(const LAS bf16x8*)(lds + PG8_SA(b, h) + aoff + m * 2048 + k * 1024); } while (0)
#define PG8_LDB(dst, b, h) do { _Pragma("unroll") for (int n = 0; n < 2; ++n) _Pragma("unroll") for (int k = 0; k < 2; ++k) dst[n][k] = *(const LAS bf16x8*)(lds + PG8_SB(b, h) + boff + n * 2048 + k * 1024); } while (0)
#define PG8_MMA(ai, bj, At, Bt) do { __builtin_amdgcn_s_setprio(1); _Pragma("unroll") for (int m = 0; m < 4; ++m) _Pragma("unroll") for (int n = 0; n < 2; ++n) _Pragma("unroll") for (int k = 0; k < 2; ++k) \
        acc[ai][bj][m][n] = __builtin_amdgcn_mfma_f32_16x16x32_bf16(Bt[n][k], At[m][k], acc[ai][bj][m][n], 0, 0, 0); __builtin_amdgcn_s_setprio(0); } while (0)
#define PG8_WAIT_V(n) asm volatile("s_waitcnt vmcnt(" #n ")" ::: "memory")
#define PG8_WAIT_L(n) asm volatile("s_waitcnt lgkmcnt(" #n ")" ::: "memory")
#define PG8_BAR __builtin_amdgcn_s_barrier()
#define PG8_SCHED __builtin_amdgcn_sched_barrier(0)
    Unit cur, nxt; int ui = 0;
    if (!S.next(0, cur)) return;
    f32x4 acc[2][2][4][2];
#pragma unroll
    for (int a = 0; a < 2; ++a)
#pragma unroll
        for (int b = 0; b < 2; ++b)
#pragma unroll
            for (int m = 0; m < 4; ++m)
#pragma unroll
                for (int n = 0; n < 2; ++n) acc[a][b][m][n] = (f32x4){0.f, 0.f, 0.f, 0.f};
    bf16x8 At[4][2], B0[2][2], B1[2][2];
    const char* cA = (const char*)g.A + (size_t)cur.pm * tstepA; const char* cB = (const char*)g.Bt + (size_t)cur.pn * tstepB;
    PG8_STAGE(PG8_SB(0, 0), cB, voffB); PG8_STAGE(PG8_SA(0, 0), cA, voffA); PG8_STAGE(PG8_SB(0, 1), cB + hstepB, voffB); PG8_STAGE(PG8_SA(0, 1), cA + hstepA, voffA);
    if (wr == 1) PG8_BAR;
    PG8_WAIT_V(4); PG8_BAR;
    PG8_STAGE(PG8_SB(1, 0), cB + kstep, voffB); PG8_STAGE(PG8_SA(1, 0), cA + kstep, voffA); PG8_STAGE(PG8_SB(1, 1), cB + hstepB + kstep, voffB);
    PG8_WAIT_V(6); PG8_BAR;
    for (;;) {
        const bool has_next = S.next(ui + 1, nxt);
        const char* nA = has_next ? (const char*)g.A + (size_t)nxt.pm * tstepA : cA; const char* nB = has_next ? (const char*)g.Bt + (size_t)nxt.pn * tstepB : cB;
        for (int t = 0; t < nt; t += 2) {
            const bool last = (t == nt - 2);
            const char* a1 = cA + (size_t)(t + 1) * kstep;
            const char* a2 = last ? nA : cA + (size_t)(t + 2) * kstep; const char* b2 = last ? nB : cB + (size_t)(t + 2) * kstep;
            const char* a3 = a2 + kstep; const char* b3 = b2 + kstep;
            PG8_LDB(B0, 0, 0); PG8_SCHED; PG8_LDA(At, 0, 0); PG8_STAGE(PG8_SA(1, 1), a1 + hstepA, voffA);
            PG8_WAIT_L(8); PG8_BAR; PG8_WAIT_L(0); PG8_MMA(0, 0, At, B0); PG8_BAR; PG8_SCHED;
            PG8_LDB(B1, 0, 1); PG8_STAGE(PG8_SB(0, 0), b2, voffB);
            PG8_BAR; PG8_WAIT_L(0); PG8_MMA(0, 1, At, B1); PG8_BAR;
            PG8_LDA(At, 0, 1); PG8_STAGE(PG8_SA(0, 0), a2, voffA);
            PG8_BAR; PG8_WAIT_L(0); PG8_MMA(1, 0, At, B0); PG8_BAR; PG8_SCHED;
            PG8_STAGE(PG8_SB(0, 1), b2 + hstepB, voffB);
            PG8_WAIT_V(6); PG8_BAR; PG8_MMA(1, 1, At, B1); PG8_BAR;
            PG8_LDB(B0, 1, 0); PG8_SCHED; PG8_LDA(At, 1, 0); PG8_STAGE(PG8_SA(0, 1), a2 + hstepA, voffA);
            PG8_WAIT_L(8); PG8_BAR; PG8_WAIT_L(0); PG8_MMA(0, 0, At, B0); PG8_BAR; PG8_SCHED;
            PG8_LDB(B1, 1, 1); PG8_STAGE(PG8_SB(1, 0), b3, voffB);
            PG8_BAR; PG8_WAIT_L(0); PG8_MMA(0, 1, At, B1); PG8_BAR;
            PG8_LDA(At, 1, 1); PG8_STAGE(PG8_SA(1, 0), a3, voffA);
            PG8_BAR; PG8_WAIT_L(0); PG8_MMA(1, 0, At, B0); PG8_BAR; PG8_SCHED;
            PG8_STAGE(PG8_SB(1, 1), b3 + hstepB, voffB);
            PG8_WAIT_V(6); PG8_BAR; PG8_MMA(1, 1, At, B1); PG8_BAR;
        }
        { int fr2 = fr, fq2 = fq, wr2 = wr, wc2 = wc; asm volatile("" : "+v"(fr2), "+v"(fq2), "+s"(wr2), "+s"(wc2));
          E(acc, cur, wr2, wc2, fr2, fq2); }
        if (has_next) mk_voff();
        if (!has_next) break;
#pragma unroll
        for (int a = 0; a < 2; ++a)
#pragma unroll
            for (int b = 0; b < 2; ++b)
#pragma unroll
                for (int m = 0; m < 4; ++m)
#pragma unroll
                    for (int n = 0; n < 2; ++n) acc[a][b][m][n] = (f32x4){0.f, 0.f, 0.f, 0.f};
        cur = nxt; cA = nA; cB = nB; ++ui;
    }
    PG8_WAIT_V(0);
    if (wr == 0) PG8_BAR;
    PG8_BAR;
#undef PG8_SA
#undef PG8_SB
#undef PG8_STAGE
#undef PG8_LDA
#undef PG8_LDB
#undef PG8_MMA
#undef PG8_WAIT_V
#undef PG8_WAIT_L
#undef PG8_BAR
#undef PG8_SCHED
}
}
using pg8::Unit;
typedef const f32x4 (&AccRef)[2][2][4][2];

DI void row_bk(int row, int& b, int& key) { if (row < ML) { b = row >> 12; key = row & 4095; } else { const int rc = row - ML; b = rc >> 8; key = SEQ + (rc & 255); } }
DI void rope8(f32x4& v0, f32x4& v1, int row, int axis, int fq, int lane, const f32x2* rope) {
    const int l = row & 4095, pos = axis ? (l & 63) : (l >> 6);
    const f32x2* t = rope + pos * 16 + 8 * (fq & 1);
    const float sgn = (fq < 2) ? -1.f : 1.f;
#pragma unroll
    for (int j = 0; j < 4; ++j) {
        const float p0 = shx(v0[j], 32, lane), p1 = shx(v1[j], 32, lane);
        const f32x2 c0 = t[j], c1 = t[4 + j];
        v0[j] = v0[j] * c0.x + sgn * p0 * c0.y; v1[j] = v1[j] * c1.x + sgn * p1 * c1.y;
    }
}

struct EpiU {
    static constexpr bool PERM = true;
    bf16_t* U; float* ssq; bf16_t* VnT; const f32x2* rope; float qscale;
    DI void operator()(AccRef acc, const Unit& u, int wr, int wc, int fr, int fq) const {
        const int pn = u.pn, rowb = u.pm * 256 + wr * 64 + fr;
        if (pn == 8 || pn == 9) {
#pragma unroll
            for (int ai = 0; ai < 2; ++ai)
#pragma unroll
                for (int m = 0; m < 4; ++m) { int b, key; row_bk(rowb + ai * 128 + m * 16, b, key);
#pragma unroll
                    for (int bj = 0; bj < 2; ++bj) { const int hn = 2 * (pn - 8) + bj;
#pragma unroll
                        for (int n = 0; n < 2; ++n) { bf16_t* dst = VnT + ((size_t)((b * 4 + hn) * 128 + 32 * wc + 8 * fq + 4 * n)) * KEYS + key;
#pragma unroll
                            for (int j = 0; j < 4; ++j) dst[(size_t)j * KEYS] = f2bf(acc[ai][bj][m][n][j]); } } }
            return;
        }
        const float sc = (pn == 4 || pn == 5) ? qscale : 1.f;
#pragma unroll
        for (int ai = 0; ai < 2; ++ai)
#pragma unroll
            for (int m = 0; m < 4; ++m) { const int row = rowb + ai * 128 + m * 16; float ss = 0.f;
#pragma unroll
                for (int bj = 0; bj < 2; ++bj) { f32x4 v0 = acc[ai][bj][m][0] * sc, v1 = acc[ai][bj][m][1] * sc;
                    if (pn == 12 && bj == 0 && wc < 2 && row < ML) rope8(v0, v1, row, wc & 1, fq, fq * 16 + fr, rope);
                    ss += sq4(v0) + sq4(v1);
                    *(u32x4*)(U + (size_t)row * UC + 256 * pn + 128 * bj + 32 * wc + 8 * fq) = pk8(v0, v1); }
                if (pn < 4) { ss += shx(ss, 16, fq * 16 + fr); ss += shx(ss, 32, fq * 16 + fr); if (fq == 0) ssq[(size_t)row * 16 + pn * 4 + wc] = ss; } }
    }
};
DI float row_rstd(const float* ssq, int row, int which) { const f32x4 a = *(const f32x4*)(ssq + (size_t)row * 16 + which * 8), b = *(const f32x4*)(ssq + (size_t)row * 16 + which * 8 + 4);
    const float s = ((a[0] + a[1]) + (a[2] + a[3])) + ((b[0] + b[1]) + (b[2] + b[3])); return __builtin_amdgcn_rsqf(s * (1.f / 512.f) + EPS); }
struct EpiQ {
    static constexpr bool PERM = true;
    bf16_t* Q; const float* ssq; const f32x2* rope; float scale;
    DI void operator()(AccRef acc, const Unit& u, int wr, int wc, int fr, int fq) const {
        const int rowb = u.pm * 256 + wr * 64 + fr;
#pragma unroll
        for (int ai = 0; ai < 2; ++ai)
#pragma unroll
            for (int m = 0; m < 4; ++m) { const int row = rowb + ai * 128 + m * 16; const float rs = row_rstd(ssq, row, 0) * scale;
#pragma unroll
                for (int bj = 0; bj < 2; ++bj) { const int c32 = 256 * u.pn + 128 * bj + 32 * wc; f32x4 v0 = acc[ai][bj][m][0] * rs, v1 = acc[ai][bj][m][1] * rs;
                    if (((c32 >> 6) % 3) == 2 && row < ML) rope8(v0, v1, row, (c32 >> 5) & 1, fq, fq * 16 + fr, rope);
                    *(u32x4*)(Q + (size_t)row * 1536 + c32 + 8 * fq) = pk8(v0, v1); } }
    }
};
struct EpiKV {
    static constexpr bool PERM = true;
    bf16_t* KN; bf16_t* VT; const float* ssq;
    DI void operator()(AccRef acc, const Unit& u, int wr, int wc, int fr, int fq) const {
        const int pn = u.pn, rowb = u.pm * 256 + wr * 64 + fr;
#pragma unroll
        for (int ai = 0; ai < 2; ++ai)
#pragma unroll
            for (int m = 0; m < 4; ++m) { const int row = rowb + ai * 128 + m * 16; const float rs = row_rstd(ssq, row, 1); int b, key; row_bk(row, b, key);
#pragma unroll
                for (int bj = 0; bj < 2; ++bj) {
                    if (pn < 4) { *(u32x4*)(KN + (size_t)row * 1024 + 256 * pn + 128 * bj + 32 * wc + 8 * fq) = pk8(acc[ai][bj][m][0] * rs, acc[ai][bj][m][1] * rs); }
                    else { const int h = 2 * (pn - 4) + bj;
#pragma unroll
                        for (int n = 0; n < 2; ++n) { bf16_t* dst = VT + ((size_t)((b * 8 + h) * 128 + 32 * wc + 8 * fq + 4 * n)) * KEYS + key;
#pragma unroll
                            for (int j = 0; j < 4; ++j) dst[(size_t)j * KEYS] = f2bf(acc[ai][bj][m][n][j] * rs); } } } }
    }
};
struct EpiY {
    static constexpr bool PERM = true;
    bf16_t* YT; bf16_t* YTc;
    DI void operator()(AccRef acc, const Unit& u, int wr, int wc, int fr, int fq) const {
        const int g = u.pm;
#pragma unroll
        for (int ai = 0; ai < 2; ++ai)
#pragma unroll
            for (int m = 0; m < 4; ++m) { const int d = 64 * wr + 16 * m + fr;
#pragma unroll
                for (int bj = 0; bj < 2; ++bj) { const int tok = 256 * u.pn + 128 * bj + 32 * wc + 8 * fq; const u32x4 w = pk8(acc[ai][bj][m][0], acc[ai][bj][m][1]);
                    if (tok < ML) { const int b = tok >> 12, l = tok & 4095; *(u32x4*)(YT + ((size_t)((b * 4 + g) * 128 + d)) * 8192 + ai * 4096 + l) = w; }
                    else { const int tc = tok - ML, b = tc >> 8, l = tc & 255; *(u32x4*)(YTc + ((size_t)((b * 4 + g) * 128 + d)) * 512 + ai * 256 + l) = w; } } }
    }
};
struct EpiF {
    static constexpr bool PERM = true;
    bf16_t* CAT; int ctx;
    DI void operator()(AccRef acc, const Unit& u, int wr, int wc, int fr, int fq) const {
        const int b = u.pn >> 1;
#pragma unroll
        for (int ai = 0; ai < 2; ++ai)
#pragma unroll
            for (int m = 0; m < 4; ++m) { const int lp = u.pm * 256 + 128 * ai + 64 * wr + 16 * m + fr; const int row = ctx ? (ML + b * 256 + lp) : (b * 4096 + lp);
#pragma unroll
                for (int bj = 0; bj < 2; ++bj) { const int g = 2 * (u.pn & 1) + bj;
                    *(u32x4*)(CAT + (size_t)row * D + 1536 + g * 128 + 32 * wc + 8 * fq) = pk8(acc[ai][bj][m][0], acc[ai][bj][m][1]); } }
    }
};
struct EpiRes {
    static constexpr bool PERM = false;
    const float* xl; const float* xc; float* out; const float* gate;
    DI void operator()(AccRef acc, const Unit& u, int wr, int wc, int fr, int fq) const {
        const int row0 = u.pm * 256; const int midx = row0 < ML ? (row0 >> 12) : 4;
        const float* src = row0 < ML ? xl : (xc - (size_t)ML * D);
        const float* gp = gate + (size_t)midx * 12288;
        const int col0 = u.pn * 256 + wc * 32 + 4 * fq;
        f32x4 gv[2][2];
#pragma unroll
        for (int bj = 0; bj < 2; ++bj)
#pragma unroll
            for (int n = 0; n < 2; ++n) gv[bj][n] = *(const f32x4*)(gp + col0 + bj * 128 + n * 16);
#pragma unroll
        for (int ai = 0; ai < 2; ++ai)
#pragma unroll
            for (int m = 0; m < 4; ++m) { const size_t off = (size_t)(row0 + wr * 64 + fr + ai * 128 + m * 16) * D + col0;
#pragma unroll
                for (int bj = 0; bj < 2; ++bj)
#pragma unroll
                    for (int n = 0; n < 2; ++n) { const f32x4 xv = *(const f32x4*)(src + off + bj * 128 + n * 16);
                        *(f32x4*)(out + off + bj * 128 + n * 16) = xv + gv[bj][n] * acc[ai][bj][m][n]; }
                asm volatile("" ::: "memory"); }
    }
};
DI float dpp_ror1(float v) { return __builtin_bit_cast(float, __builtin_amdgcn_update_dpp(0, __builtin_bit_cast(int, v), 0x121, 0xf, 0xf, false)); }
DI float dpp_ror15(float v) { return __builtin_bit_cast(float, __builtin_amdgcn_update_dpp(0, __builtin_bit_cast(int, v), 0x12f, 0xf, 0xf, false)); }
struct EpiConv {
    static constexpr bool PERM = true;
    bf16_t* ACT; const float* cw; const float* cb; int Mq;
    DI void operator()(AccRef acc, const Unit& u, int wr, int wc, int fr, int fq) const {
#pragma unroll
        for (int n = 0; n < 2; ++n) {
            const int cg_ = 128 * u.pn + 32 * wc + 8 * fq + 4 * n;
#pragma unroll
            for (int ai = 0; ai < 2; ++ai) {
                const int tok0 = 248 * u.pm - 1 + 62 * (2 * ai + wr);
                f32x4 o[4];
#pragma unroll
                for (int bj = 0; bj < 2; ++bj) {
                    f32x4 w[2][4];
#pragma unroll
                    for (int t = 0; t < 3; ++t) w[bj][t] = *(const f32x4*)(cw + (size_t)t * 2 * DFF + bj * DFF + cg_);
                    w[bj][3] = *(const f32x4*)(cb + bj * DFF + cg_);
#pragma unroll
                    for (int m = 0; m < 4; ++m) {
                        const int tok = tok0 + 16 * m + fr; const int msk = tok < ML ? 4095 : 255;
                        const bool hu = (tok & msk) != 0, hd = ((tok + 1) & msk) != 0;
                        f32x4 r = acc[ai][bj][m][n] * w[bj][1] + w[bj][3];
#pragma unroll
                        for (int j = 0; j < 4; ++j) {
                            const float su = (m > 0 && fr == 15) ? acc[ai][bj][(m + 3) & 3][n][j] : acc[ai][bj][m][n][j];
                            const float sd = (m < 3 && fr == 0) ? acc[ai][bj][(m + 1) & 3][n][j] : acc[ai][bj][m][n][j];
                            const float uu = dpp_ror1(su), dd = dpp_ror15(sd);
                            r[j] += hu ? uu * w[bj][0][j] : 0.f; r[j] += hd ? dd * w[bj][2][j] : 0.f; }
                        if (bj == 0) {
#pragma unroll
                            for (int j = 0; j < 4; ++j) o[m][j] = r[j] * __builtin_amdgcn_rcpf(1.f + __builtin_amdgcn_exp2f(-LOG2E * r[j]));
                        } else o[m] = o[m] * r;
                    }
                }
#pragma unroll
                for (int m = 0; m < 4; ++m) { const int li = 16 * m + fr, tok = tok0 + li;
                    if (li >= 1 && li <= 62 && tok < Mq) { u32x2 v; v.x = pk2(o[m][0], o[m][1]); v.y = pk2(o[m][2], o[m][3]);
                        *(u32x2*)(ACT + (size_t)tok * DFF + cg_) = v; } }
            }
        }
    }
};

struct Frame {
    LAS unsigned char* lds; unsigned char* ldsg; int tid, lane, wave, G, vcu;
    const Params& P; unsigned char* ws;
    DI const float* inp(int i) const { return as_global(P.in[i]); }
    DI float* outp() const { return as_global(P.out); }
    DI int nrep(int d) const { int n = 1 + d; asm volatile("" : "+s"(n)); return n; }
    DI void refresh() { int t = threadIdx.x; asm volatile("" : "+v"(t)); tid = t; lane = t & 63; wave = __builtin_amdgcn_readfirstlane(t >> 6);
        long z = 0; asm volatile("" : "+s"(z)); ws = P.ws + z;
        int g = gridDim.x, bx = blockIdx.x; asm volatile("" : "+s"(g), "+s"(bx)); G = g; vcu = (g % 8 == 0) ? (bx % 8) * (g / 8) + bx / 8 : bx; }
};

DI void p_mod(const Frame& F) {
    LAS float* sv = (LAS float*)F.lds; LAS float* red = sv + 5 * 2048;
    const float* c = F.inp(1); const float* cc = F.inp(3);
    for (int i = F.tid; i < 5 * 2048; i += NT) { const int r = i >> 11, k = i & 2047; const float v = r < 4 ? c[r * 2048 + k] : cc[k]; sv[i] = v / (1.f + __expf(-v)); }
    __syncthreads();
    float* mod = (float*)(F.ws + WS_MOD);
    for (int tile = F.vcu; tile < 768; tile += F.G) {
        const int l = tile / 384, colb = (tile % 384) * 32, cl = F.tid & 31, kg = F.tid >> 5;
        const float* w = F.inp(4) + (size_t)l * 2048 * 12288 + colb + cl;
        float a0 = 0.f, a1 = 0.f, a2 = 0.f, a3 = 0.f, a4 = 0.f;
#pragma unroll 16
        for (int k = kg * 128; k < kg * 128 + 128; ++k) { const float wv = __builtin_nontemporal_load(w + (size_t)k * 12288); a0 += sv[k] * wv; a1 += sv[2048 + k] * wv; a2 += sv[4096 + k] * wv; a3 += sv[6144 + k] * wv; a4 += sv[8192 + k] * wv; }
        LAS float* rp = red + (kg * 32 + cl) * 5; rp[0] = a0; rp[1] = a1; rp[2] = a2; rp[3] = a3; rp[4] = a4;
        __syncthreads();
        if (F.tid < 160) { const int r = F.tid >> 5; float s = 0.f;
#pragma unroll
            for (int q = 0; q < 16; ++q) s += red[(q * 32 + cl) * 5 + r];
            mod[(size_t)(l * 5 + r) * 12288 + colb + cl] = s + F.inp(5)[l * 12288 + colb + cl]; }
        __syncthreads();
    }
}
DI void p_tables(const Frame& F) {
    const int gt = F.vcu * NT + F.tid, gn = F.G * NT;
    LAS f32x2* t4096 = (LAS f32x2*)F.lds;
    __syncthreads();
    for (int i = F.tid; i < 4096; i += NT) { f32x2 v; v.x = cospif((float)i / 2048.f); v.y = sinpif((float)i / 2048.f); t4096[i] = v; }
    __syncthreads();
    f32x2* rope = (f32x2*)(F.ws + WS_ROPE);
    for (int i = gt; i < 1024; i += gn) { const int pos = i >> 4, k = i & 15; const float fr = powf(10000.f, -(float)k / 16.f); const float a = (float)pos * fr; f32x2 v; v.x = cosf(a); v.y = sinf(a); rope[i] = v; }
    if (gt < 32) ((unsigned*)(F.ws + WS_CTR))[gt] = 0u;
    if (F.tid == 0) *(float**)(F.ws + WS_CTR + 128) = F.outp();
    bf16_t* dc = (bf16_t*)F.outp() + (size_t)4096 * 8192;
    for (int i = gt; i < 256 * 512; i += gn) { const int lp = i >> 9, cc = i & 511, part = cc >> 8, l = cc & 255; const f32x2 t = t4096[((lp * l) & 255) * 16];
        dc[i] = f2bf((part ? -t.y : t.x) * (1.f / 16.f)); }
    bf16_t* wc = (bf16_t*)(F.ws + WS_WC); const float* wf = F.inp(14);
    for (int i = gt; i < 2 * 4 * 2 * 128 * 128; i += gn) {
        const int d = i & 127, cch = (i >> 7) & 127, part = (i >> 14) & 1, g = (i >> 15) & 3, l = i >> 17;
        const float* wp = wf + ((size_t)(l * 4 + g) * 128) * 128 + d; float sacc = 0.f;
        for (int c2 = 0; c2 < 128; ++c2) { const f32x2 t = t4096[((cch * c2) & 127) * 32]; sacc += (part ? t.y : t.x) * wp[(size_t)c2 * 128]; }
        sacc *= 0.08838834764831845f;
        bf16_t* row = wc + ((size_t)l * 1024 + (g * 2 + part) * 128 + d) * 512;
#pragma unroll
        for (int g2 = 0; g2 < 4; ++g2) row[g2 * 128 + cch] = (g2 == g) ? f2bf(sacc) : (bf16_t)0;
    }
    bf16_t* dft = (bf16_t*)F.outp();
    for (int ch = gt; ch < 4096 * 1024; ch += gn) { const int lp = ch >> 10, c8 = ch & 1023, part = c8 >> 9, l0 = (c8 & 511) * 8; f32x4 a, b;
#pragma unroll
        for (int j = 0; j < 4; ++j) { const f32x2 t0 = t4096[(lp * (l0 + j)) & 4095], t1 = t4096[(lp * (l0 + 4 + j)) & 4095];
            a[j] = (part ? -t0.y : t0.x) * (1.f / 64.f); b[j] = (part ? -t1.y : t1.x) * (1.f / 64.f); }
        *(u32x4*)(dft + (size_t)lp * 8192 + part * 4096 + l0) = pk8(a, b); }
    __syncthreads();
}
struct CvDesc { const float* src; const float* kscale; bf16_t* dst; int K, Nsrc, Ndst, mapid, ntiles; };
DI int cv_map(int mapid, int n) {
    if (mapid == 1) return n < 1024 ? n : (n < 3072 ? n + 64 : (n < 3136 ? n - 2048 : -1));
    if (mapid == 2) { const int which = n >> 10, h = (n >> 7) & 7, j = n & 127; return h * 256 + which * 128 + j; }
    if (mapid == 3) { const int pn = n >> 8, bj = (n >> 7) & 1, q = n & 127; return bj * DFF + pn * 128 + q; }
    return n;
}
DI CvDesc cv_desc(const Frame& F, int m) {
    const int l = m / 6, j = m % 6; CvDesc d; d.kscale = nullptr; d.mapid = 0;
    if (j == 0) { d.src = F.inp(8) + (size_t)l * D * INC; d.K = D; d.Nsrc = INC; d.dst = (bf16_t*)(F.ws + WS_WIN) + (size_t)l * UC * D; d.Ndst = UC; d.mapid = 1; }
    else if (j == 1) { d.src = F.inp(10) + (size_t)l * 512 * 1536; d.K = 512; d.Nsrc = 1536; d.dst = (bf16_t*)(F.ws + WS_WUQ) + (size_t)l * 1536 * 512; d.Ndst = 1536; d.kscale = F.inp(9) + l * 512; }
    else if (j == 2) { d.src = F.inp(12) + (size_t)l * 512 * 2048; d.K = 512; d.Nsrc = 2048; d.dst = (bf16_t*)(F.ws + WS_WUKV) + (size_t)l * 2048 * 512; d.Ndst = 2048; d.kscale = F.inp(11) + l * 512; d.mapid = 2; }
    else if (j == 3) { d.src = F.inp(15) + (size_t)l * D * D; d.K = D; d.Nsrc = D; d.dst = (bf16_t*)(F.ws + WS_WOUT) + (size_t)l * D * D; d.Ndst = D; }
    else if (j == 4) { d.src = F.inp(16) + (size_t)l * D * 2 * DFF; d.K = D; d.Nsrc = 2 * DFF; d.dst = (bf16_t*)(F.ws + WS_WUP) + (size_t)l * 2 * DFF * D; d.Ndst = 2 * DFF; d.mapid = 3; }
    else { d.src = F.inp(19) + (size_t)l * DFF * D; d.K = DFF; d.Nsrc = D; d.dst = (bf16_t*)(F.ws + WS_WDN) + (size_t)l * D * DFF; d.Ndst = D; }
    d.ntiles = (d.Ndst / 128) * (d.K / 64); return d;
}
struct CvTile { const float* src; const float* kscale; bf16_t* dst; int K, Nsrc, sc0, sc1, n0, k0; bool ok; };
DI CvTile cv_tile(const Frame& F, int t) {
    CvTile r; r.ok = false;
    for (int m = 0; m < 12; ++m) { const CvDesc d = cv_desc(F, m);
        if (t < d.ntiles) { const int ntn = d.Ndst / 128; r.n0 = (t % ntn) * 128; r.k0 = (t / ntn) * 64; r.src = d.src; r.kscale = d.kscale; r.dst = d.dst; r.K = d.K; r.Nsrc = d.Nsrc;
            r.sc0 = cv_map(d.mapid, r.n0); r.sc1 = cv_map(d.mapid, r.n0 + 64); r.ok = true; return r; }
        t -= d.ntiles; }
    return r;
}
DI void cv_load(const Frame& F, const CvTile& t, f32x4 (&r)[4]) {
#pragma unroll
    for (int h = 0; h < 2; ++h) { const int sc = h ? t.sc1 : t.sc0;
#pragma unroll
        for (int p = 0; p < 2; ++p) { const int kk = p * 32 + (F.tid >> 4);
            f32x4 v = {0.f, 0.f, 0.f, 0.f};
            if (sc >= 0) { v = __builtin_nontemporal_load((const f32x4*)(t.src + (size_t)(t.k0 + kk) * t.Nsrc + sc + (F.tid & 15) * 4)); if (t.kscale) v *= t.kscale[t.k0 + kk]; }
            r[h * 2 + p] = v; } }
}
DI void p_convert(const Frame& F) {
    LAS float* ts = (LAS float*)F.lds;
    int t = F.vcu; CvTile cur = cv_tile(F, t); f32x4 r[4]; int buf = 0;
    if (cur.ok) cv_load(F, cur, r);
    while (cur.ok) {
        LAS float* tb = ts + buf * (2 * 64 * 65);
#pragma unroll
        for (int h = 0; h < 2; ++h)
#pragma unroll
            for (int p = 0; p < 2; ++p) { const int kk = p * 32 + (F.tid >> 4); LAS float* q = tb + h * (64 * 65) + kk * 65 + (F.tid & 15) * 4;
                q[0] = r[h * 2 + p][0]; q[1] = r[h * 2 + p][1]; q[2] = r[h * 2 + p][2]; q[3] = r[h * 2 + p][3]; }
        __syncthreads();
        const CvTile nxt = cv_tile(F, t + F.G);
        if (nxt.ok) cv_load(F, nxt, r);
#pragma unroll
        for (int h = 0; h < 2; ++h) { const int n = F.tid >> 3, kc = F.tid & 7; const LAS float* q = tb + h * (64 * 65) + n; f32x4 a, b;
#pragma unroll
            for (int j = 0; j < 4; ++j) { a[j] = q[(kc * 8 + j) * 65]; b[j] = q[(kc * 8 + 4 + j) * 65]; }
            *(u32x4*)(cur.dst + (size_t)(cur.n0 + h * 64 + n) * cur.K + cur.k0 + kc * 8) = pk8(a, b); }
        buf ^= 1; t += F.G; cur = nxt;
    }
    __syncthreads();
}

DI void norm_phase(const Frame& F, const float* xl, const float* xc, int M, const float* g, const float* modl, int sh_off, int sc_off, bf16_t* H, float* outf) {
    const int gw = F.vcu * 8 + F.wave, nw = F.G * 8;
    for (int row = gw; row < M; row += nw) {
        const float* xr = row < ML ? xl + (size_t)row * D : xc + (size_t)(row - ML) * D;
        f32x4 v[8]; float ss = 0.f;
#pragma unroll
        for (int i = 0; i < 4; ++i) { v[2 * i] = *(const f32x4*)(xr + i * 512 + F.lane * 8); v[2 * i + 1] = *(const f32x4*)(xr + i * 512 + F.lane * 8 + 4); ss += sq4(v[2 * i]) + sq4(v[2 * i + 1]); }
#pragma unroll
        for (int o = 32; o >= 1; o >>= 1) ss += shx(ss, o, F.lane);
        const float rs = __builtin_amdgcn_rsqf(ss * (1.f / 2048.f) + EPS);
        const int midx = row < ML ? (row >> 12) : 4;
#pragma unroll
        for (int i = 0; i < 4; ++i) { const int col = i * 512 + F.lane * 8;
            const f32x4 g0 = *(const f32x4*)(g + col), g1 = *(const f32x4*)(g + col + 4);
            if (outf) { *(f32x4*)(outf + (size_t)row * D + col) = v[2 * i] * rs * g0; *(f32x4*)(outf + (size_t)row * D + col + 4) = v[2 * i + 1] * rs * g1; }
            else { const float* mp = modl + (size_t)midx * 12288 + col;
                const f32x4 s0 = *(const f32x4*)(mp + sc_off), s1 = *(const f32x4*)(mp + sc_off + 4), h0 = *(const f32x4*)(mp + sh_off), h1 = *(const f32x4*)(mp + sh_off + 4);
                *(u32x4*)(H + (size_t)row * D + col) = pk8(v[2 * i] * rs * g0 * (1.f + s0) + h0, v[2 * i + 1] * rs * g1 * (1.f + s1) + h1); } }
    }
}

struct AttnItem {
    const bf16_t* q; const bf16_t* kn; const bf16_t* kr; const bf16_t* vt; bf16_t* o;
    int ldq, ldk, ldo, lat_row0, ctx_row0, t0, ntl, nctx, mode, r0, hn;
};
template <int DQ>
DI void attn_item(const Frame& F, const AttnItem& it, const LAS float* rpb_lds) {
    constexpr int KP = DQ + 8, VP = 72, KS = DQ / 16;
    constexpr int KBYTES = 64 * KP * 2, VBYTES = 128 * VP * 2;
    LAS unsigned char* base = F.lds;
    int tid = threadIdx.x; asm volatile("" : "+v"(tid));
    const int lane = tid & 63, w = __builtin_amdgcn_readfirstlane(tid >> 6), qq = lane & 31, hh = lane >> 5;
    const bool grpB = w >= 4;
    const int ntile = it.ntl + it.nctx;
    u32x4 rk[2], rr, rv[2];
    auto gload = [&](int ti) {
        int rowb, vcol;
        if (ti < it.ntl) { const int kt = it.t0 + ti; rowb = it.lat_row0 + kt * 64; vcol = kt * 64; } else { const int j = ti - it.ntl; rowb = it.ctx_row0 + j * 64; vcol = SEQ + j * 64; }
#pragma unroll
        for (int i = 0; i < 2; ++i) { const int id = tid + i * NT; rk[i] = *(const u32x4*)(it.kn + (size_t)(rowb + (id >> 4)) * it.ldk + (id & 15) * 8);
            rv[i] = *(const u32x4*)(it.vt + (size_t)(id >> 3) * KEYS + vcol + (id & 7) * 8); }
        if (DQ == 192) rr = *(const u32x4*)(it.kr + (size_t)(rowb + (tid >> 3)) * UC + (tid & 7) * 8);
    };
    auto lstore = [&](int ti) {
        LAS unsigned char* kb = base + (ti & 1) * KBYTES; LAS unsigned char* vb = base + 2 * KBYTES + (ti % 3) * VBYTES;
#pragma unroll
        for (int i = 0; i < 2; ++i) { const int id = tid + i * NT; *(LAS u32x4*)(kb + ((id >> 4) * KP + (id & 15) * 8) * 2) = rk[i];
            *(LAS u32x4*)(vb + ((id >> 3) * VP + (id & 7) * 8) * 2) = rv[i]; }
        if (DQ == 192) *(LAS u32x4*)(kb + ((tid >> 3) * KP + 128 + (tid & 7) * 8) * 2) = rr;
    };
    bf16x8 qf[KS];
    { const bf16_t* qp = it.q + (size_t)(32 * w + qq) * it.ldq + 8 * hh;
#pragma unroll
        for (int ks = 0; ks < KS; ++ks) qf[ks] = *(const bf16x8*)(qp + 16 * ks); }
    f32x16 o[4];
#pragma unroll
    for (int db = 0; db < 4; ++db)
#pragma unroll
        for (int i = 0; i < 16; ++i) o[db][i] = 0.f;
    f32x16 s[2];
    float mrun = -INFINITY, lrun = 0.f;
    const int r = it.r0 + (w >> 1), wq = 32 * (w & 1) + qq;
    const int rs = min(max(r - 4, 0), 56), cs = min(max(wq - 8, 0), 48);
    auto active = [&](int ti) { const int krow = it.t0 + ti; return !(it.mode == 1 && ti < it.ntl && (krow < rs || krow > rs + 7)); };
    auto qk = [&](int ti) {
        if (!active(ti)) return;
        const int krow_l = (qq & 3) + 4 * ((qq >> 3) & 1) + 8 * ((qq >> 2) & 1) + 16 * (qq >> 4);
        LAS unsigned char* kb = base + (ti & 1) * KBYTES + (krow_l * KP + 8 * hh) * 2;
#pragma unroll
        for (int blk = 0; blk < 2; ++blk)
#pragma unroll
            for (int i = 0; i < 16; ++i) s[blk][i] = 0.f;
        bf16x8 kf[3][2];
#pragma unroll
        for (int p = 0; p < 2; ++p)
#pragma unroll
            for (int blk = 0; blk < 2; ++blk) kf[p][blk] = *(const LAS bf16x8*)(kb + (32 * blk * KP + 16 * p) * 2);
#pragma unroll
        for (int ks = 0; ks < KS; ++ks) {
            if (ks + 2 < KS) {
#pragma unroll
                for (int blk = 0; blk < 2; ++blk) kf[(ks + 2) % 3][blk] = *(const LAS bf16x8*)(kb + (32 * blk * KP + 16 * (ks + 2)) * 2); }
            __builtin_amdgcn_sched_barrier(0);
#pragma unroll
            for (int blk = 0; blk < 2; ++blk) s[blk] = __builtin_amdgcn_mfma_f32_32x32x16_bf16(kf[ks % 3][blk], qf[ks], s[blk], 0, 0, 0);
            __builtin_amdgcn_sched_barrier(0);
        }
    };
    auto smpv = [&](int ti) {
        if (!active(ti)) return;
        LAS unsigned char* vb = base + 2 * KBYTES + (ti % 3) * VBYTES;
        if (it.mode == 1 && ti < it.ntl) {
            const int krow = it.t0 + ti;
            const LAS float* bp = rpb_lds + it.hn * 465 + (krow - r + 7) * 31 - wq + 15;
#pragma unroll
            for (int blk = 0; blk < 2; ++blk)
#pragma unroll
                for (int i = 0; i < 16; ++i) { const int kc = 32 * blk + (i & 3) + 4 * ((i >> 2) & 1) + 8 * hh + 16 * (i >> 3); const bool ok = kc >= cs && kc < cs + 16;
                    const int kcc = ok ? kc : cs; s[blk][i] = ok ? s[blk][i] + bp[kcc] : -INFINITY; }
        }
        float mx = s[0][0];
#pragma unroll
        for (int blk = 0; blk < 2; ++blk)
#pragma unroll
            for (int i = 0; i < 16; ++i) mx = fmaxf(mx, s[blk][i]);
        mx = fmaxf(mx, shx(mx, 32, lane));
        const float mnew = fmaxf(mrun, mx), alpha = __builtin_amdgcn_exp2f(mrun - mnew);
        mrun = mnew;
        float ps = 0.f;
#pragma unroll
        for (int blk = 0; blk < 2; ++blk)
#pragma unroll
            for (int i = 0; i < 16; ++i) { const float p = __builtin_amdgcn_exp2f(s[blk][i] - mnew); s[blk][i] = p; ps += p; }
        lrun = lrun * alpha + ps;
        if (__builtin_amdgcn_ballot_w64(alpha != 1.f) != 0ull) {
#pragma unroll
            for (int db = 0; db < 4; ++db)
#pragma unroll
                for (int i = 0; i < 16; ++i) o[db][i] *= alpha;
        }
        LAS unsigned char* vq = vb + (qq * VP + 8 * hh) * 2;
        auto vload = [&](int step, int db) { return *(const LAS bf16x8*)(vq + (32 * db * VP + 16 * step) * 2); };
        bf16x8 vf[2][4];
#pragma unroll
        for (int db = 0; db < 4; ++db) vf[0][db] = vload(0, db);
#pragma unroll
        for (int st = 0; st < 4; ++st) {
            if (st + 1 < 4) {
#pragma unroll
                for (int db = 0; db < 4; ++db) vf[(st + 1) & 1][db] = vload(st + 1, db); }
            __builtin_amdgcn_sched_barrier(0);
            const int blk = st >> 1, s2 = st & 1;
            u32x4 pw; pw.x = pk2(s[blk][8 * s2], s[blk][8 * s2 + 1]); pw.y = pk2(s[blk][8 * s2 + 2], s[blk][8 * s2 + 3]);
            pw.z = pk2(s[blk][8 * s2 + 4], s[blk][8 * s2 + 5]); pw.w = pk2(s[blk][8 * s2 + 6], s[blk][8 * s2 + 7]);
            const bf16x8 pf = __builtin_bit_cast(bf16x8, pw);
#pragma unroll
            for (int db = 0; db < 4; ++db) o[db] = __builtin_amdgcn_mfma_f32_32x32x16_bf16(vf[st & 1][db], pf, o[db], 0, 0, 0);
            __builtin_amdgcn_sched_barrier(0);
        }
    };

    __syncthreads();
    gload(0); lstore(0);
    if (ntile > 1) gload(1);
    __syncthreads();
    for (int ti = 0; ti < ntile; ++ti) {
        qk(ti);
        if (grpB) { if (ti + 1 < ntile) lstore(ti + 1); if (ti + 2 < ntile) gload(ti + 2); __syncthreads(); }
        smpv(ti);
        if (!grpB) { if (ti + 1 < ntile) lstore(ti + 1); if (ti + 2 < ntile) gload(ti + 2); __syncthreads(); }
    }
    const float lt = lrun + shx(lrun, 32, lane), inv = 1.f / lt;
    bf16_t* op = it.o + (size_t)(32 * w + qq) * it.ldo + 4 * hh;
#pragma unroll
    for (int db = 0; db < 4; ++db)
#pragma unroll
        for (int ig = 0; ig < 4; ++ig) { u32x2 v; v.x = pk2(o[db][4 * ig] * inv, o[db][4 * ig + 1] * inv); v.y = pk2(o[db][4 * ig + 2] * inv, o[db][4 * ig + 3] * inv);
            *(u32x2*)(op + 32 * db + 8 * ig) = v; }
}

#ifndef MLAREP
#define MLAREP 1
#endif
DI void mixer_attention(const Frame& F, int layer, int cidx) {
    const int nitems = (layer == 0 ? 816 : 768) + 512 * (MLAREP - 1);
    bf16_t* U = (bf16_t*)(F.ws + WS_U); bf16_t* Q = (bf16_t*)(F.ws + WS_Q); bf16_t* KN = (bf16_t*)(F.ws + WS_KN);
    bf16_t* VT = (bf16_t*)(F.ws + WS_VT); bf16_t* VNT = (bf16_t*)(F.ws + WS_VNT); bf16_t* CAT = (bf16_t*)(F.ws + WS_CAT);
    unsigned* ctr = (unsigned*)(F.ws + WS_CTR) + cidx;
    LAS float* rpb = (LAS float*)(F.lds + 112 * 1024);
    volatile LAS int* slot = (volatile LAS int*)(F.lds + 112 * 1024 + 8192);
    __syncthreads();
    for (int i = F.tid; i < 4 * 465; i += NT) rpb[i] = F.inp(13)[layer * 4 * 465 + i] * LOG2E;
    for (int step = 0;; ++step) {
        int idx;
        if (step < 2) idx = F.vcu + 256 * step;
        else {
            __syncthreads();
            if (F.tid == 0) *slot = (int)atomicAdd(ctr, 1u);
            __syncthreads();
            idx = 512 + *slot;
        }
        if (idx >= nitems) break;
        AttnItem it; it.kr = nullptr; it.mode = 0; it.r0 = 0; it.hn = 0; it.nctx = 4;
        if (idx < 512 || (idx >= 768 && idx < 800)) {
            int b, h, row0;
            if (idx < 512) { b = idx >> 7; h = (idx >> 4) & 7; row0 = b * 4096 + (idx & 15) * 256; it.t0 = 0; it.ntl = 64; }
            else { const int j = idx - 768; b = j >> 3; h = j & 7; row0 = ML + b * 256; it.t0 = 0; it.ntl = 0; }
            it.q = Q + (size_t)row0 * 1536 + h * 192; it.ldq = 1536;
            it.kn = KN + h * 128; it.ldk = 1024; it.kr = U + U_KR;
            it.vt = VT + (size_t)(b * 8 + h) * 128 * KEYS;
            it.o = CAT + (size_t)row0 * D + h * 128; it.ldo = D;
            it.lat_row0 = b * 4096; it.ctx_row0 = ML + b * 256;
            attn_item<192>(F, it, rpb);
        } else {
            int b, hn, row0;
            if (idx < 768) { const int j = idx - 512; b = j >> 6; hn = (j >> 4) & 3; const int R = j & 15; row0 = b * 4096 + R * 256;
                const int rlo = max(4 * R - 4, 0), rhi = min(max(4 * R - 1, 0), 56) + 7; it.t0 = rlo; it.ntl = rhi - rlo + 1; it.mode = 1; it.r0 = 4 * R; it.hn = hn; }
            else { const int j = idx - 800; b = j >> 2; hn = j & 3; row0 = ML + b * 256; it.t0 = 0; it.ntl = 0; }
            it.q = U + (size_t)row0 * UC + U_QN + hn * 128; it.ldq = UC;
            it.kn = U + U_KN + hn * 128; it.ldk = UC;
            it.vt = VNT + (size_t)(b * 4 + hn) * 128 * KEYS;
            it.o = CAT + (size_t)row0 * D + 1024 + hn * 128; it.ldo = D;
            it.lat_row0 = b * 4096; it.ctx_row0 = ML + b * 256;
            attn_item<128>(F, it, rpb);
        }
    }
}

#ifndef PHMASK
#define PHMASK 0x7ff
#endif
#define PH(k) (((PHMASK) >> (k)) & 1)
#ifndef DUPMASK
#define DUPMASK 0x000
#endif
#define REP(k) for (int rep_ = 0, nrep_ = F.nrep((DUPMASK >> (k)) & 1); rep_ < nrep_; ++rep_)
#define Hbuf ((bf16_t*)(F.ws + WS_H))
#define H (Hbuf + D)
#define X ((float*)(F.ws + WS_X))
#define U ((bf16_t*)(F.ws + WS_U))
#define SSQ ((float*)(F.ws + WS_SSQ))
#define CAT ((bf16_t*)(F.ws + WS_CAT))
#define mod ((const float*)(F.ws + WS_MOD))
#define rope ((const f32x2*)(F.ws + WS_ROPE))
#define GSYNC() do { grid.sync(); F.refresh(); } while (0)
DI void layer_body(Frame& F, cg::grid_group& grid, const int l) {
        const int Mq = l == 0 ? MT : ML;
#define modl (mod + (size_t)l * 5 * 12288)
#define xl (l == 0 ? F.inp(0) : (const float*)X)
#define xc (l == 0 ? F.inp(2) : (const float*)(X + (size_t)ML * D))
        REP(1) {
        if (PH(1)) norm_phase(F, xl, xc, MT, F.inp(6) + l * D, modl, 0, 2048, H, nullptr);
        GSYNC(); }
        REP(2) {
        { pg8::Gemm g{H, (const bf16_t*)(F.ws + WS_WIN) + (size_t)l * UC * D, D, D, D, 0};
          pg8::Sched S; S.init(MT / 256, UC / 256, F.G, F.vcu, 0);
          EpiU E{U, SSQ, (bf16_t*)(F.ws + WS_VNT), rope, 0.08838834764831845f * LOG2E};
          if (PH(2)) pg8::gemm_phase(F.lds, g, S, E); }
        GSYNC(); }
        REP(3) {
        { int start = 0;
          { pg8::Gemm g{U + U_CQ, (const bf16_t*)(F.ws + WS_WUQ) + (size_t)l * 1536 * 512, UC, 512, 512, 0};
            pg8::Sched S; S.init(Mq / 256, 6, F.G, F.vcu, start); start += (Mq / 256) * 6;
            EpiQ E{(bf16_t*)(F.ws + WS_Q), SSQ, rope, 0.07216878364870323f * LOG2E};
            if (PH(3)) pg8::gemm_phase(F.lds, g, S, E); }
          { pg8::Gemm g{U + U_CKV, (const bf16_t*)(F.ws + WS_WUKV) + (size_t)l * 2048 * 512, UC, 512, 512, 0};
            pg8::Sched S; S.init(MT / 256, 8, F.G, F.vcu, start); start += (MT / 256) * 8;
            EpiKV E{(bf16_t*)(F.ws + WS_KN), (bf16_t*)(F.ws + WS_VT), SSQ};
            if (PH(4)) pg8::gemm_phase(F.lds, g, S, E); }
          { pg8::Gemm g{(const bf16_t*)(F.ws + WS_WC) + (size_t)l * 1024 * 512, U + U_F, 512, UC, 512, 0};
            pg8::Sched S; S.init(4, Mq / 256, F.G, F.vcu, start);
            EpiY E{(bf16_t*)(F.ws + WS_YT), (bf16_t*)(F.ws + WS_YTC)};
            if (PH(5)) pg8::gemm_phase(F.lds, g, S, E); } }
        GSYNC(); }
        REP(7) {
        if (F.vcu < 128 || (l == 0 && F.vcu < 136)) {
            const bool cx = F.vcu >= 128; const int ld = cx ? 512 : 8192;
            long zo = 0; asm volatile("" : "+s"(zo)); const bf16_t* dftp = (const bf16_t*)F.P.out + zo;
            pg8::Gemm g{dftp + (cx ? (size_t)4096 * 8192 : (size_t)0), (const bf16_t*)(F.ws + (cx ? WS_YTC : WS_YT)), ld, ld, ld, 0};
            pg8::OneUnit S; S.u.pm = cx ? 0 : (F.vcu & 15); S.u.pn = cx ? (F.vcu - 128) : (F.vcu >> 4); S.has = true;
            EpiF E{CAT, cx ? 1 : 0}; if (PH(6)) pg8::gemm_phase(F.lds, g, S, E); }
        if (PH(7)) mixer_attention(F, l, l + 2 * rep_);
        GSYNC(); }
        REP(8) {
        { pg8::Gemm g{CAT, (const bf16_t*)(F.ws + WS_WOUT) + (size_t)l * D * D, D, D, D, 0};
          pg8::Sched S; S.init(Mq / 256, 8, F.G, F.vcu, 0);
          EpiRes E{xl, xc, X, modl + 4096};
          if (PH(8)) pg8::gemm_phase(F.lds, g, S, E); }
        GSYNC(); }
        REP(4) {
        if (PH(1)) norm_phase(F, X, X + (size_t)ML * D, Mq, F.inp(7) + l * D, modl, 6144, 8192, H, nullptr);
        GSYNC(); }
        REP(10) {
        { pg8::Gemm g{Hbuf, (const bf16_t*)(F.ws + WS_WUP) + (size_t)l * 2 * DFF * D, D, D, D, 1};
          pg8::Sched S; S.init((Mq + 247) / 248, 44, F.G, F.vcu, 0);
          EpiConv E{(bf16_t*)(F.ws + WS_ACT), F.inp(17) + (size_t)l * 3 * 2 * DFF, F.inp(18) + (size_t)l * 2 * DFF, Mq};
          if (PH(10)) pg8::gemm_phase(F.lds, g, S, E); }
        GSYNC(); }
        { pg8::Gemm g{(const bf16_t*)(F.ws + WS_ACT), (const bf16_t*)(F.ws + WS_WDN) + (size_t)l * D * DFF, DFF, DFF, DFF, 0};
          pg8::Sched S; S.init(Mq / 256, 8, F.G, F.vcu, 0);
          EpiRes E{X, X + (size_t)ML * D, X, modl + 10240};
          if (PH(9)) pg8::gemm_phase(F.lds, g, S, E); }
        GSYNC();

}

__global__ void __launch_bounds__(NT) fwd_megakernel(Params p) {
    extern __shared__ __attribute__((aligned(16))) unsigned char lds_raw[];
    cg::grid_group grid = cg::this_grid();
    const int tid_ = threadIdx.x, G_ = gridDim.x, bx_ = blockIdx.x;
    Frame F{(LAS unsigned char*)lds_raw, lds_raw, tid_, tid_ & 63, __builtin_amdgcn_readfirstlane(tid_ >> 6), G_, (G_ % 8 == 0) ? (bx_ % 8) * (G_ / 8) + bx_ / 8 : bx_, p, p.ws};
    REP(0) { if (PH(0)) { p_mod(F);
    p_tables(F);
    p_convert(F); }
    GSYNC(); }

    for (int l = 0; l < 2; ++l) layer_body(F, grid, l);
    if (PH(1)) norm_phase(F, X, X, ML, F.inp(20), nullptr, 0, 0, nullptr, F.outp());
}
#undef Hbuf
#undef H
#undef X
#undef U
#undef SSQ
#undef CAT
#undef mod
#undef rope
#undef modl
#undef xl
#undef xc


extern "C" void kernel_launch(void* const* d_in, const int* in_sizes, int n_in, void* d_out, int out_size, void* d_ws, size_t ws_size, hipStream_t stream) {
    static int grid_blocks = 0;
    if (!grid_blocks) {
        int dev = 0, cus = 0, per_cu = 0;
        hipGetDevice(&dev);
        hipDeviceGetAttribute(&cus, hipDeviceAttributeMultiprocessorCount, dev);
        hipFuncSetAttribute((const void*)fwd_megakernel, hipFuncAttributeMaxDynamicSharedMemorySize, LDS_BYTES);
        hipOccupancyMaxActiveBlocksPerMultiprocessor(&per_cu, (const void*)fwd_megakernel, NT, LDS_BYTES);
        if (per_cu < 1) { fprintf(stderr, "occupancy query says %d blocks/CU\n", per_cu); per_cu = 1; }
        grid_blocks = cus;
        if (ws_size < WS_END) fprintf(stderr, "workspace too small: %zu < %zu\n", ws_size, (size_t)WS_END);
    }
    Params p{};
    for (int i = 0; i < 21; ++i) p.in[i] = (const float*)d_in[i];
    p.out = (float*)d_out; p.ws = (unsigned char*)d_ws;
    void* args[] = {&p};
    hipError_t e = hipLaunchCooperativeKernel((const void*)fwd_megakernel, dim3(grid_blocks), dim3(NT), args, LDS_BYTES, stream);
    if (e != hipSuccess) fprintf(stderr, "cooperative launch failed: %s (grid %d)\n", hipGetErrorString(e), grid_blocks);
}
```

```cpp
#include <hip/hip_runtime.h>
#include <hip/hip_cooperative_groups.h>
#include <cstdio>
namespace cg = cooperative_groups;

#define LAS __attribute__((address_space(3)))
#define GAS __attribute__((address_space(1)))
template <class T> __device__ __forceinline__ T* as_global(T* p) { return p; }
#define DI __device__ __forceinline__
typedef unsigned short bf16_t;
typedef short bf16x8 __attribute__((ext_vector_type(8)));
typedef short s16x4 __attribute__((ext_vector_type(4)));
typedef float f32x4 __attribute__((ext_vector_type(4)));
typedef float f32x2 __attribute__((ext_vector_type(2)));
typedef float f32x16 __attribute__((ext_vector_type(16)));
typedef unsigned u32x4 __attribute__((ext_vector_type(4)));
typedef unsigned u32x2 __attribute__((ext_vector_type(2)));
typedef __bf16 bfv2 __attribute__((ext_vector_type(2)));

constexpr int D = 2048, NB = 4, SEQ = 4096, CTXL = 256, ML = NB * SEQ, MC = NB * CTXL, MT = ML + MC;
constexpr int INC = 3136, UC = 3328;
constexpr int U_CQ = 0, U_CKV = 512, U_QN = 1024, U_KN = 1536, U_VN = 2048, U_F = 2560, U_KR = 3072;
constexpr int DFF = 5632, KEYS = SEQ + CTXL;
constexpr size_t DO_DFT = 0, DO_DFTC = (size_t)4096 * 4096, DO_FF = DO_DFTC + 256 * 512;
static_assert((DO_FF + (size_t)(ML + MC) * 1024) * 2 <= (size_t)ML * 2048 * 4, "d_out scratch");
constexpr float EPS = 1e-6f, LOG2E = 1.4426950408889634f;
constexpr int NT = 512;
constexpr int LDS_BYTES = 136 * 1024;

constexpr size_t al(size_t x) { return (x + 255) & ~(size_t)255; }
constexpr size_t WS_WIN = 0;
constexpr size_t WS_WUQ = WS_WIN + al((size_t)2 * UC * D * 2);
constexpr size_t WS_WUKV = WS_WUQ + al((size_t)2 * 1536 * 512 * 2);
constexpr size_t WS_WOUT = WS_WUKV + al((size_t)2 * 4096 * 512 * 2);
constexpr size_t WS_WUP = WS_WOUT + al((size_t)2 * D * D * 2);
constexpr size_t WS_WDN = WS_WUP + al((size_t)2 * 2 * DFF * D * 2);
constexpr size_t WS_WC = WS_WDN + al((size_t)2 * D * DFF * 2);
constexpr size_t WS_DFTC = WS_WC + al((size_t)2 * 1024 * 1024 * 2);
constexpr size_t WS_TRIG = WS_DFTC + al((size_t)256 * 512 * 2);
constexpr size_t WS_ROPE = WS_TRIG + al(4096 * 8);
constexpr size_t WS_MOD = WS_ROPE + al(64 * 16 * 8);
constexpr size_t WS_CTR = WS_MOD + al((size_t)2 * 5 * 12288 * 4);
constexpr size_t WS_X = WS_CTR + 256;
constexpr size_t WS_H = WS_X + al((size_t)MT * D * 4);
constexpr size_t H_ROWS = 1 + MT + 256;
constexpr size_t WS_CAT = WS_H + al(H_ROWS * D * 2);
constexpr size_t WS_YTC = WS_CAT + al((size_t)MT * D * 2);
constexpr size_t WS_U = WS_YTC + al((size_t)2048 * 512 * 2);
constexpr size_t WS_SSQ = WS_U + al((size_t)MT * UC * 2);
constexpr size_t WS_Q = WS_SSQ + al((size_t)MT * 16 * 4);
constexpr size_t WS_KN = WS_Q + al((size_t)MT * 1536 * 2);
constexpr size_t WS_VT = WS_KN + al((size_t)MT * 1024 * 2);
constexpr size_t WS_VNT = WS_VT + al((size_t)32 * 128 * KEYS * 2);
constexpr size_t WS_YT = WS_VNT + al((size_t)16 * 128 * KEYS * 2);
constexpr size_t WS_END = WS_YT + al((size_t)2048 * 8192 * 2);
constexpr size_t WS_ACT = WS_U;
static_assert(WS_ACT + (size_t)MT * DFF * 2 <= WS_END, "ACT alias");
static_assert((size_t)4096 * 8192 * 2 <= H_ROWS * D * 2, "DFT alias");
static_assert(WS_END <= (size_t)805306368, "workspace");

struct Params { const float* in[21]; float* out; unsigned char* ws; };

DI unsigned pk2(float a, float b) { f32x2 v = {a, b}; bfv2 r = __builtin_convertvector(v, bfv2); return __builtin_bit_cast(unsigned, r); }
DI bf16_t f2bf(float a) { return (bf16_t)(pk2(a, 0.f) & 0xffffu); }
DI float shx(float v, int m, int lane) { return __builtin_bit_cast(float, __builtin_amdgcn_ds_bpermute((lane ^ m) << 2, __builtin_bit_cast(int, v))); }
DI float sq4(f32x4 v) { return (v[0] * v[0] + v[1] * v[1]) + (v[2] * v[2] + v[3] * v[3]); }
DI u32x4 pk8(f32x4 a, f32x4 b) { u32x4 w; w.x = pk2(a[0], a[1]); w.y = pk2(a[2], a[3]); w.z = pk2(b[0], b[1]); w.w = pk2(b[2], b[3]); return w; }

namespace pg8 {
constexpr int BM = 256, BK = 64, HALF = 128, HTB = HALF * BK * 2, STAGE_BYTES = 8 * HTB;
DI int lds_byte(int r, int c) { const int st = (r >> 4) * 2 + (c >> 5), rr = r & 15, cc = c & 31, ob = rr * 64 + cc * 2; return st * 1024 + (ob ^ (((ob >> 9) & 1) << 5)); }
DI void stage_rc(int b, int& R, int& C) { const int st = b / 1024, sb = b % 1024, swz = sb ^ (((sb >> 9) & 1) << 5); R = (st >> 1) * 16 + swz / 64; C = (st & 1) * 32 + (swz % 64) / 2; }
DI int perm32(int rho) { const int n = rho >> 4, i = rho & 15; return 8 * (i >> 2) + 4 * n + (i & 3); }
struct Unit { int pm, pn; };
struct Gemm { const bf16_t* A; const bf16_t* Bt; int lda, ldb, K; int conv; };

struct Sched {
    int nM, nN, cnt, G, c, i0, start;
    DI void init(int nM_, int nN_, int G_, int c_, int start_) { nM = nM_; nN = nN_; cnt = nM * nN; G = G_; c = c_; start = start_;
        i0 = (start_ > c_) ? (start_ - c_ + G_ - 1) / G_ : 0; }
    DI bool next(int i, Unit& u) const {
        const long L = (long)(i0 + i) * G + c - start; if (L >= cnt) return false;
        const int w = (int)L, nig = 8 * nN, gid = w / nig, fm = gid * 8, gsz = (nM - fm) < 8 ? (nM - fm) : 8;
        u.pm = fm + ((w % nig) % gsz); u.pn = (w % nig) / gsz; return true;
    }
};
struct OneUnit { Unit u; bool has; DI bool next(int i, Unit& o) const { o = u; return has && i == 0; } };

template <class Epi, class SchedT>
DI void gemm_phase(LAS unsigned char* lds, const Gemm g, const SchedT& S, const Epi& E) {
    int tid = threadIdx.x; asm volatile("" : "+v"(tid));
    const int wid = __builtin_amdgcn_readfirstlane(tid >> 6), lane = tid & 63, wr = wid >> 2, wc = wid & 3, fr = lane & 15, fq = lane >> 4;
    const int K = g.K, nt = K / BK;
    unsigned voffA[2], voffB[2];
    auto mk_voff = [&]() { int t2 = threadIdx.x; asm volatile("" : "+v"(t2));
#pragma unroll
        for (int i = 0; i < 2; ++i) { int R, C; stage_rc(t2 * 16 + i * 8192, R, C); const int Rb = Epi::PERM ? ((R & ~31) + perm32(R & 31)) : R;
            const int Ra = g.conv ? ((R >> 6) * 62 + (R & 63)) : R;
            voffA[i] = (unsigned)(Ra * g.lda + C) * 2u; voffB[i] = (unsigned)(Rb * g.ldb + C) * 2u; } };
    mk_voff();
    const size_t kstep = (size_t)(BK * 2);
    const size_t hstepA = (size_t)(g.conv ? 124 : HALF) * g.lda * 2, hstepB = (size_t)HALF * g.ldb * 2;
    const size_t tstepA = 2 * hstepA, tstepB = 2 * hstepB;
    const unsigned ldsw = (unsigned)wid * 1024u;
    const int aoff = lds_byte(wr * 64 + fr, fq * 8), boff = lds_byte(wc * 32 + fr, fq * 8);
#define PG8_SA(b, h) (((b) * 2 + (h)) * HTB)
#define PG8_SB(b, h) ((4 + (b) * 2 + (h)) * HTB)
#define PG8_STAGE(bufoff, gbase, voff) do { _Pragma("unroll") for (int _i = 0; _i < 2; ++_i) \
        __builtin_amdgcn_global_load_lds((const unsigned*)((const char*)(gbase) + (voff)[_i]), (LAS unsigned*)(lds + (bufoff) + ldsw + _i * 8192), 16, 0, 0); } while (0)
#define PG8_LDA(dst, b, h) do { _Pragma("unroll") for (int m = 0; m < 4; ++m) _Pragma("unroll") for (int k = 0; k < 2; ++k) dst[m][k] = *(const LAS bf16x8*)(lds + PG8_SA(b, h) + aoff + m * 2048 + k * 1024); } while (0)
#define PG8_LDB(dst, b, h) do { _Pragma("unroll") for (int n = 0; n < 2; ++n) _Pragma("unroll") for (int k = 0; k < 2; ++k) dst[n][k] = *(const LAS bf16x8*)(lds + PG8_SB(b, h) + boff + n * 2048 + k * 1024); } while (0)
#define PG8_MMA(ai, bj, At, Bt) do { __builtin_amdgcn_s_setprio(1); _Pragma("unroll") for (int m = 0; m < 4; ++m) _Pragma("unroll") for (int n = 0; n < 2; ++n) _Pragma("unroll") for (int k = 0; k < 2; ++k) \
        acc[ai][bj][m][n] = __builtin_amdgcn_mfma_f32_16x16x32_bf16(Bt[n][k], At[m][k], acc[ai][bj][m][n], 0, 0, 0); __builtin_amdgcn_s_setprio(0); } while (0)
#define PG8_WAIT_V(n) asm volatile("s_waitcnt vmcnt(" #n ")" ::: "memory")
#define PG8_WAIT_L(n) asm volatile("s_waitcnt lgkmcnt(" #n ")" ::: "memory")
#define PG8_BAR __builtin_amdgcn_s_barrier()
#define PG8_SCHED __builtin_amdgcn_sched_barrier(0)
    Unit cur, nxt; int ui = 0;
    if (!S.next(0, cur)) return;
    f32x4 acc[2][2][4][2];
#pragma unroll
    for (int a = 0; a < 2; ++a)
#pragma unroll
        for (int b = 0; b < 2; ++b)
#pragma unroll
            for (int m = 0; m < 4; ++m)
#pragma unroll
                for (int n = 0; n < 2; ++n) acc[a][b][m][n] = (f32x4){0.f, 0.f, 0.f, 0.f};
    bf16x8 At[4][2], B0[2][2], B1[2][2];
    const char* cA = (const char*)g.A + (size_t)cur.pm * tstepA; const char* cB = (const char*)g.Bt + (size_t)cur.pn * tstepB;
    PG8_STAGE(PG8_SB(0, 0), cB, voffB); PG8_STAGE(PG8_SA(0, 0), cA, voffA); PG8_STAGE(PG8_SB(0, 1), cB + hstepB, voffB); PG8_STAGE(PG8_SA(0, 1), cA + hstepA, voffA);
    if (wr == 1) PG8_BAR;
    PG8_WAIT_V(4); PG8_BAR;
    PG8_STAGE(PG8_SB(1, 0), cB + kstep, voffB); PG8_STAGE(PG8_SA(1, 0), cA + kstep, voffA); PG8_STAGE(PG8_SB(1, 1), cB + hstepB + kstep, voffB);
    PG8_WAIT_V(6); PG8_BAR;
    for (;;) {
        const bool has_next = S.next(ui + 1, nxt);
        const char* nA = has_next ? (const char*)g.A + (size_t)nxt.pm * tstepA : cA; const char* nB = has_next ? (const char*)g.Bt + (size_t)nxt.pn * tstepB : cB;
        for (int t = 0; t < nt; t += 2) {
            const bool last = (t == nt - 2);
            const char* a1 = cA + (size_t)(t + 1) * kstep;
            const char* a2 = last ? nA : cA + (size_t)(t + 2) * kstep; const char* b2 = last ? nB : cB + (size_t)(t + 2) * kstep;
            const char* a3 = a2 + kstep; const char* b3 = b2 + kstep;
            PG8_LDB(B0, 0, 0); PG8_SCHED; PG8_LDA(At, 0, 0); PG8_STAGE(PG8_SA(1, 1), a1 + hstepA, voffA);
            PG8_WAIT_L(8); PG8_BAR; PG8_WAIT_L(0); PG8_MMA(0, 0, At, B0); PG8_BAR; PG8_SCHED;
            PG8_LDB(B1, 0, 1); PG8_STAGE(PG8_SB(0, 0), b2, voffB);
            PG8_BAR; PG8_WAIT_L(0); PG8_MMA(0, 1, At, B1); PG8_BAR;
            PG8_LDA(At, 0, 1); PG8_STAGE(PG8_SA(0, 0), a2, voffA);
            PG8_BAR; PG8_WAIT_L(0); PG8_MMA(1, 0, At, B0); PG8_BAR; PG8_SCHED;
            PG8_STAGE(PG8_SB(0, 1), b2 + hstepB, voffB);
            PG8_WAIT_V(6); PG8_BAR; PG8_MMA(1, 1, At, B1); PG8_BAR;
            PG8_LDB(B0, 1, 0); PG8_SCHED; PG8_LDA(At, 1, 0); PG8_STAGE(PG8_SA(0, 1), a2 + hstepA, voffA);
            PG8_WAIT_L(8); PG8_BAR; PG8_WAIT_L(0); PG8_MMA(0, 0, At, B0); PG8_BAR; PG8_SCHED;
            PG8_LDB(B1, 1, 1); PG8_STAGE(PG8_SB(1, 0), b3, voffB);
            PG8_BAR; PG8_WAIT_L(0); PG8_MMA(0, 1, At, B1); PG8_BAR;
            PG8_LDA(At, 1, 1); PG8_STAGE(PG8_SA(1, 0), a3, voffA);
            PG8_BAR; PG8_WAIT_L(0); PG8_MMA(1, 0, At, B0); PG8_BAR; PG8_SCHED;
            PG8_STAGE(PG8_SB(1, 1), b3 + hstepB, voffB);
            PG8_WAIT_V(6); PG8_BAR; PG8_MMA(1, 1, At, B1); PG8_BAR;
        }
        { int fr2 = fr, fq2 = fq, wr2 = wr, wc2 = wc; asm volatile("" : "+v"(fr2), "+v"(fq2), "+s"(wr2), "+s"(wc2));
          E(acc, cur, wr2, wc2, fr2, fq2); }
        if (has_next) mk_voff();
        if (!has_next) break;
#pragma unroll
        for (int a = 0; a < 2; ++a)
#pragma unroll
            for (int b = 0; b < 2; ++b)
#pragma unroll
                for (int m = 0; m < 4; ++m)
#pragma unroll
                    for (int n = 0; n < 2; ++n) acc[a][b][m][n] = (f32x4){0.f, 0.f, 0.f, 0.f};
        cur = nxt; cA = nA; cB = nB; ++ui;
    }
    PG8_WAIT_V(0);
    if (wr == 0) PG8_BAR;
    PG8_BAR;
#undef PG8_SA
#undef PG8_SB
#undef PG8_STAGE
#undef PG8_LDA
#undef PG8_LDB
#undef PG8_MMA
#undef PG8_WAIT_V
#undef PG8_WAIT_L
#undef PG8_BAR
#undef PG8_SCHED
}
}
using pg8::Unit;
typedef const f32x4 (&AccRef)[2][2][4][2];

DI void row_bk(int row, int& b, int& key) { if (row < ML) { b = row >> 12; key = row & 4095; } else { const int rc = row - ML; b = rc >> 8; key = SEQ + (rc & 255); } }
DI void rope8(f32x4& v0, f32x4& v1, int row, int axis, int fq, int lane, const f32x2* rope) {
    const int l = row & 4095, pos = axis ? (l & 63) : (l >> 6);
    const f32x2* t = rope + pos * 16 + 8 * (fq & 1);
    const float sgn = (fq < 2) ? -1.f : 1.f;
#pragma unroll
    for (int j = 0; j < 4; ++j) {
        const float p0 = shx(v0[j], 32, lane), p1 = shx(v1[j], 32, lane);
        const f32x2 c0 = t[j], c1 = t[4 + j];
        v0[j] = v0[j] * c0.x + sgn * p0 * c0.y; v1[j] = v1[j] * c1.x + sgn * p1 * c1.y;
    }
}

struct EpiU {
    static constexpr bool PERM = true;
    bf16_t* U; float* ssq; bf16_t* VnT; const f32x2* rope; float qscale; bf16_t* FF;
    DI void operator()(AccRef acc, const Unit& u, int wr, int wc, int fr, int fq) const {
        const int pn = u.pn, rowb = u.pm * 256 + wr * 64 + fr;
        if (pn == 10 || pn == 11) {
#pragma unroll
            for (int ai = 0; ai < 2; ++ai)
#pragma unroll
                for (int m = 0; m < 4; ++m) { const int row = rowb + ai * 128 + m * 16; const int mrow = (row & ~4095) | ((4096 - (row & 4095)) & 4095);
#pragma unroll
                    for (int bj = 0; bj < 2; ++bj) { const int c = 256 * (pn - 10) + 128 * bj + 32 * wc + 8 * fq; const u32x4 w = pk8(acc[ai][bj][m][0], acc[ai][bj][m][1]);
                        *(u32x4*)(FF + (size_t)row * 1024 + c) = w;
                        if (row < ML) *(u32x4*)(FF + (size_t)mrow * 1024 + 512 + c) = w; } }
            return;
        }
        if (pn == 8 || pn == 9) {
#pragma unroll
            for (int ai = 0; ai < 2; ++ai)
#pragma unroll
                for (int m = 0; m < 4; ++m) { int b, key; row_bk(rowb + ai * 128 + m * 16, b, key);
#pragma unroll
                    for (int bj = 0; bj < 2; ++bj) { const int hn = 2 * (pn - 8) + bj;
#pragma unroll
                        for (int n = 0; n < 2; ++n) { bf16_t* dst = VnT + ((size_t)((b * 4 + hn) * 128 + 32 * wc + 8 * fq + 4 * n)) * KEYS + key;
#pragma unroll
                            for (int j = 0; j < 4; ++j) dst[(size_t)j * KEYS] = f2bf(acc[ai][bj][m][n][j]); } } }
            return;
        }
        const float sc = (pn == 4 || pn == 5) ? qscale : 1.f;
#pragma unroll
        for (int ai = 0; ai < 2; ++ai)
#pragma unroll
            for (int m = 0; m < 4; ++m) { const int row = rowb + ai * 128 + m * 16; float ss = 0.f;
#pragma unroll
                for (int bj = 0; bj < 2; ++bj) { f32x4 v0 = acc[ai][bj][m][0] * sc, v1 = acc[ai][bj][m][1] * sc;
                    if (pn == 12 && bj == 0 && wc < 2 && row < ML) rope8(v0, v1, row, wc & 1, fq, fq * 16 + fr, rope);
                    ss += sq4(v0) + sq4(v1);
                    *(u32x4*)(U + (size_t)row * UC + 256 * pn + 128 * bj + 32 * wc + 8 * fq) = pk8(v0, v1); }
                if (pn < 4) { ss += shx(ss, 16, fq * 16 + fr); ss += shx(ss, 32, fq * 16 + fr); if (fq == 0) ssq[(size_t)row * 16 + pn * 4 + wc] = ss; } }
    }
};
DI float row_rstd(const float* ssq, int row, int which) { const f32x4 a = *(const f32x4*)(ssq + (size_t)row * 16 + which * 8), b = *(const f32x4*)(ssq + (size_t)row * 16 + which * 8 + 4);
    const float s = ((a[0] + a[1]) + (a[2] + a[3])) + ((b[0] + b[1]) + (b[2] + b[3])); return __builtin_amdgcn_rsqf(s * (1.f / 512.f) + EPS); }
struct EpiQ {
    static constexpr bool PERM = true;
    bf16_t* Q; const float* ssq; const f32x2* rope; float scale;
    DI void operator()(AccRef acc, const Unit& u, int wr, int wc, int fr, int fq) const {
        const int rowb = u.pm * 256 + wr * 64 + fr;
#pragma unroll
        for (int ai = 0; ai < 2; ++ai)
#pragma unroll
            for (int m = 0; m < 4; ++m) { const int row = rowb + ai * 128 + m * 16; const float rs = row_rstd(ssq, row, 0) * scale;
#pragma unroll
                for (int bj = 0; bj < 2; ++bj) { const int c32 = 256 * u.pn + 128 * bj + 32 * wc; f32x4 v0 = acc[ai][bj][m][0] * rs, v1 = acc[ai][bj][m][1] * rs;
                    if (((c32 >> 6) % 3) == 2 && row < ML) rope8(v0, v1, row, (c32 >> 5) & 1, fq, fq * 16 + fr, rope);
                    *(u32x4*)(Q + (size_t)row * 1536 + c32 + 8 * fq) = pk8(v0, v1); } }
    }
};
struct EpiKV {
    static constexpr bool PERM = true;
    bf16_t* KN; bf16_t* VT; const float* ssq;
    DI void operator()(AccRef acc, const Unit& u, int wr, int wc, int fr, int fq) const {
        const int pn = u.pn, rowb = u.pm * 256 + wr * 64 + fr;
#pragma unroll
        for (int ai = 0; ai < 2; ++ai)
#pragma unroll
            for (int m = 0; m < 4; ++m) { const int row = rowb + ai * 128 + m * 16; const float rs = row_rstd(ssq, row, 1); int b, key; row_bk(row, b, key);
#pragma unroll
                for (int bj = 0; bj < 2; ++bj) {
                    if (pn < 4) { *(u32x4*)(KN + (size_t)row * 1024 + 256 * pn + 128 * bj + 32 * wc + 8 * fq) = pk8(acc[ai][bj][m][0] * rs, acc[ai][bj][m][1] * rs); }
                    else { const int h = 2 * (pn - 4) + bj;
#pragma unroll
                        for (int n = 0; n < 2; ++n) { bf16_t* dst = VT + ((size_t)((b * 8 + h) * 128 + 32 * wc + 8 * fq + 4 * n)) * KEYS + key;
#pragma unroll
                            for (int j = 0; j < 4; ++j) dst[(size_t)j * KEYS] = f2bf(acc[ai][bj][m][n][j] * rs); } } } }
    }
};
struct EpiY {
    static constexpr bool PERM = true;
    bf16_t* YT; bf16_t* YTc; int tok_base;
    DI void operator()(AccRef acc, const Unit& u, int wr, int wc, int fr, int fq) const {
        const int g = u.pm;
#pragma unroll
        for (int ai = 0; ai < 2; ++ai)
#pragma unroll
            for (int m = 0; m < 4; ++m) { const int d = 64 * wr + 16 * m + fr;
#pragma unroll
                for (int bj = 0; bj < 2; ++bj) { const int tok = tok_base + 256 * u.pn + 128 * bj + 32 * wc + 8 * fq; const u32x4 w = pk8(acc[ai][bj][m][0], acc[ai][bj][m][1]);
                    if (tok < ML) { const int b = tok >> 12, l = tok & 4095; bf16_t* rowp = YT + ((size_t)((b * 4 + g) * 128 + d)) * 4096;
                        if (l < 2048) {
                            if (ai == 0) *(u32x4*)(rowp + l) = w;
                            else if (l != 0) *(u32x4*)(rowp + 2048 + l) = w;
                            else { bf16_t* q = rowp + 2048; q[1] = (bf16_t)(w.x >> 16); q[2] = (bf16_t)w.y; q[3] = (bf16_t)(w.y >> 16); q[4] = (bf16_t)w.z; q[5] = (bf16_t)(w.z >> 16); q[6] = (bf16_t)w.w; q[7] = (bf16_t)(w.w >> 16); }
                        } else if (l == 2048 && ai == 0) rowp[2048] = (bf16_t)w.x;
                    } else { const int tc = tok - ML, b = tc >> 8, l = tc & 255; *(u32x4*)(YTc + ((size_t)((b * 4 + g) * 128 + d)) * 512 + ai * 256 + l) = w; } } }
    }
};
struct SchedY {
    int G, c, i0, start;
    DI void init(int G_, int c_, int start_) { G = G_; c = c_; start = start_; i0 = (start_ > c_) ? (start_ - c_ + G_ - 1) / G_ : 0; }
    DI bool next(int i, Unit& u) const { const int L = (i0 + i) * G + c - start; if (L >= 144) return false; const int bt = L >> 2; u.pm = L & 3; u.pn = (bt / 9) * 16 + (bt % 9); return true; }
};
struct EpiF {
    static constexpr bool PERM = true;
    bf16_t* CAT; int ctx;
    DI void operator()(AccRef acc, const Unit& u, int wr, int wc, int fr, int fq) const {
        const int b = u.pn >> 1;
#pragma unroll
        for (int ai = 0; ai < 2; ++ai)
#pragma unroll
            for (int m = 0; m < 4; ++m) { const int lp = u.pm * 256 + 128 * ai + 64 * wr + 16 * m + fr; const int row = ctx ? (ML + b * 256 + lp) : (b * 4096 + lp);
#pragma unroll
                for (int bj = 0; bj < 2; ++bj) { const int g = 2 * (u.pn & 1) + bj;
                    *(u32x4*)(CAT + (size_t)row * D + 1536 + g * 128 + 32 * wc + 8 * fq) = pk8(acc[ai][bj][m][0], acc[ai][bj][m][1]); } }
    }
};
struct EpiRes {
    static constexpr bool PERM = false;
    const float* xl; const float* xc; float* out; const float* gate;
    DI void operator()(AccRef acc, const Unit& u, int wr, int wc, int fr, int fq) const {
        const int row0 = u.pm * 256; const int midx = row0 < ML ? (row0 >> 12) : 4;
        const float* src = row0 < ML ? xl : (xc - (size_t)ML * D);
        const float* gp = gate + (size_t)midx * 12288;
        const int col0 = u.pn * 256 + wc * 32 + 4 * fq;
        f32x4 gv[2][2];
#pragma unroll
        for (int bj = 0; bj < 2; ++bj)
#pragma unroll
            for (int n = 0; n < 2; ++n) gv[bj][n] = *(const f32x4*)(gp + col0 + bj * 128 + n * 16);
#pragma unroll
        for (int ai = 0; ai < 2; ++ai)
#pragma unroll
            for (int m = 0; m < 4; ++m) { const size_t off = (size_t)(row0 + wr * 64 + fr + ai * 128 + m * 16) * D + col0;
#pragma unroll
                for (int bj = 0; bj < 2; ++bj)
#pragma unroll
                    for (int n = 0; n < 2; ++n) { const f32x4 xv = *(const f32x4*)(src + off + bj * 128 + n * 16);
                        *(f32x4*)(out + off + bj * 128 + n * 16) = xv + gv[bj][n] * acc[ai][bj][m][n]; }
                asm volatile("" ::: "memory"); }
    }
};
DI float dpp_ror1(float v) { return __builtin_bit_cast(float, __builtin_amdgcn_update_dpp(0, __builtin_bit_cast(int, v), 0x121, 0xf, 0xf, false)); }
DI float dpp_ror15(float v) { return __builtin_bit_cast(float, __builtin_amdgcn_update_dpp(0, __builtin_bit_cast(int, v), 0x12f, 0xf, 0xf, false)); }
struct EpiConv {
    static constexpr bool PERM = true;
    bf16_t* ACT; const float* cw; const float* cb; int Mq;
    DI void operator()(AccRef acc, const Unit& u, int wr, int wc, int fr, int fq) const {
#pragma unroll
        for (int n = 0; n < 2; ++n) {
            const int cg_ = 128 * u.pn + 32 * wc + 8 * fq + 4 * n;
#pragma unroll
            for (int ai = 0; ai < 2; ++ai) {
                const int tok0 = 248 * u.pm - 1 + 62 * (2 * ai + wr);
                f32x4 o[4];
#pragma unroll
                for (int bj = 0; bj < 2; ++bj) {
                    f32x4 w[2][4];
#pragma unroll
                    for (int t = 0; t < 3; ++t) w[bj][t] = *(const f32x4*)(cw + (size_t)t * 2 * DFF + bj * DFF + cg_);
                    w[bj][3] = *(const f32x4*)(cb + bj * DFF + cg_);
#pragma unroll
                    for (int m = 0; m < 4; ++m) {
                        const int tok = tok0 + 16 * m + fr; const int msk = tok < ML ? 4095 : 255;
                        const bool hu = (tok & msk) != 0, hd = ((tok + 1) & msk) != 0;
                        f32x4 r = acc[ai][bj][m][n] * w[bj][1] + w[bj][3];
#pragma unroll
                        for (int j = 0; j < 4; ++j) {
                            const float su = (m > 0 && fr == 15) ? acc[ai][bj][(m + 3) & 3][n][j] : acc[ai][bj][m][n][j];
                            const float sd = (m < 3 && fr == 0) ? acc[ai][bj][(m + 1) & 3][n][j] : acc[ai][bj][m][n][j];
                            const float uu = dpp_ror1(su), dd = dpp_ror15(sd);
                            r[j] += hu ? uu * w[bj][0][j] : 0.f; r[j] += hd ? dd * w[bj][2][j] : 0.f; }
                        if (bj == 0) {
#pragma unroll
                            for (int j = 0; j < 4; ++j) o[m][j] = r[j] * __builtin_amdgcn_rcpf(1.f + __builtin_amdgcn_exp2f(-LOG2E * r[j]));
                        } else o[m] = o[m] * r;
                    }
                }
#pragma unroll
                for (int m = 0; m < 4; ++m) { const int li = 16 * m + fr, tok = tok0 + li;
                    if (li >= 1 && li <= 62 && tok < Mq) { u32x2 v; v.x = pk2(o[m][0], o[m][1]); v.y = pk2(o[m][2], o[m][3]);
                        *(u32x2*)(ACT + (size_t)tok * DFF + cg_) = v; } }
            }
        }
    }
};

struct Frame {
    LAS unsigned char* lds; unsigned char* ldsg; int tid, lane, wave, G, vcu;
    const Params& P; unsigned char* ws;
    DI const float* inp(int i) const { return as_global(P.in[i]); }
    DI float* outp() const { return as_global(P.out); }
    DI int nrep(int d) const { int n = 1 + d; asm volatile("" : "+s"(n)); return n; }
    DI void refresh() { int t = threadIdx.x; asm volatile("" : "+v"(t)); tid = t; lane = t & 63; wave = __builtin_amdgcn_readfirstlane(t >> 6);
        long z = 0; asm volatile("" : "+s"(z)); ws = P.ws + z;
        int g = gridDim.x, bx = blockIdx.x; asm volatile("" : "+s"(g), "+s"(bx)); G = g; vcu = (g % 8 == 0) ? (bx % 8) * (g / 8) + bx / 8 : bx; }
};

DI void p_mod(const Frame& F) {
    LAS float* sv = (LAS float*)F.lds; LAS float* red = sv + 5 * 2048;
    const float* c = F.inp(1); const float* cc = F.inp(3);
    for (int i = F.tid; i < 5 * 2048; i += NT) { const int r = i >> 11, k = i & 2047; const float v = r < 4 ? c[r * 2048 + k] : cc[k]; sv[i] = v / (1.f + __expf(-v)); }
    __syncthreads();
    float* mod = (float*)(F.ws + WS_MOD);
    for (int tile = F.vcu; tile < 768; tile += F.G) {
        const int l = tile / 384, colb = (tile % 384) * 32, cl = F.tid & 31, kg = F.tid >> 5;
        const float* w = F.inp(4) + (size_t)l * 2048 * 12288 + colb + cl;
        float a0 = 0.f, a1 = 0.f, a2 = 0.f, a3 = 0.f, a4 = 0.f;
#pragma unroll 16
        for (int k = kg * 128; k < kg * 128 + 128; ++k) { const float wv = __builtin_nontemporal_load(w + (size_t)k * 12288); a0 += sv[k] * wv; a1 += sv[2048 + k] * wv; a2 += sv[4096 + k] * wv; a3 += sv[6144 + k] * wv; a4 += sv[8192 + k] * wv; }
        LAS float* rp = red + (kg * 32 + cl) * 5; rp[0] = a0; rp[1] = a1; rp[2] = a2; rp[3] = a3; rp[4] = a4;
        __syncthreads();
        if (F.tid < 160) { const int r = F.tid >> 5; float s = 0.f;
#pragma unroll
            for (int q = 0; q < 16; ++q) s += red[(q * 32 + cl) * 5 + r];
            mod[(size_t)(l * 5 + r) * 12288 + colb + cl] = s + F.inp(5)[l * 12288 + colb + cl]; }
        __syncthreads();
    }
}
DI void p_tables(const Frame& F) {
    const int gt = F.vcu * NT + F.tid, gn = F.G * NT;
    LAS f32x2* t4096 = (LAS f32x2*)F.lds;
    __syncthreads();
    for (int i = F.tid; i < 4096; i += NT) { f32x2 v; v.x = cospif((float)i / 2048.f); v.y = sinpif((float)i / 2048.f); t4096[i] = v; }
    __syncthreads();
    f32x2* rope = (f32x2*)(F.ws + WS_ROPE);
    for (int i = gt; i < 1024; i += gn) { const int pos = i >> 4, k = i & 15; const float fr = powf(10000.f, -(float)k / 16.f); const float a = (float)pos * fr; f32x2 v; v.x = cosf(a); v.y = sinf(a); rope[i] = v; }
    if (gt < 32) ((unsigned*)(F.ws + WS_CTR))[gt] = 0u;
    if (F.tid == 0) *(float**)(F.ws + WS_CTR + 128) = F.outp();
    bf16_t* dc = (bf16_t*)F.outp() + DO_DFTC;
    for (int i = gt; i < 256 * 512; i += gn) { const int lp = i >> 9, cc = i & 511, part = cc >> 8, l = cc & 255; const f32x2 t = t4096[((lp * l) & 255) * 16];
        dc[i] = f2bf((part ? -t.y : t.x) * (1.f / 16.f)); }
    bf16_t* wc = (bf16_t*)(F.ws + WS_WC); const float* wf = F.inp(14);
    for (int i = gt; i < 2 * 4 * 2 * 128 * 128; i += gn) {
        const int d = i & 127, cch = (i >> 7) & 127, part = (i >> 14) & 1, g = (i >> 15) & 3, l = i >> 17;
        const float* wp = wf + ((size_t)(l * 4 + g) * 128) * 128 + d; float sacc = 0.f;
        for (int c2 = 0; c2 < 128; ++c2) { const f32x2 t = t4096[((cch * c2) & 127) * 32]; sacc += (part ? t.y : t.x) * wp[(size_t)c2 * 128]; }
        sacc *= 0.08838834764831845f;
        bf16_t* row = wc + ((size_t)l * 1024 + (g * 2 + part) * 128 + d) * 1024;
#pragma unroll
        for (int g2 = 0; g2 < 4; ++g2) { row[g2 * 128 + cch] = (g2 == g) ? f2bf(sacc) : (bf16_t)0; row[512 + g2 * 128 + cch] = (g2 == g) ? f2bf(part ? -sacc : sacc) : (bf16_t)0; }
    }
    bf16_t* dft = (bf16_t*)F.outp() + DO_DFT;
    for (int ch = gt; ch < 4096 * 512; ch += gn) { const int lp = ch >> 9, k0 = (ch & 511) * 8; f32x4 a, b;
#pragma unroll
        for (int j = 0; j < 8; ++j) { const int k = k0 + j; const f32x2 t = t4096[(lp * (k & 2047) + (k == 2048 ? lp * 2048 : 0)) & 4095];
            const float v = (k <= 2048 ? t.x : -t.y) * ((k == 0 || k == 2048) ? (1.f / 128.f) : (1.f / 64.f));
            if (j < 4) a[j] = v; else b[j - 4] = v; }
        *(u32x4*)(dft + (size_t)lp * 4096 + k0) = pk8(a, b); }
    __syncthreads();
}
struct CvDesc { const float* src; const float* kscale; bf16_t* dst; int K, Nsrc, Ndst, mapid, ntiles; };
DI int cv_map(int mapid, int n) {
    if (mapid == 1) return n < 1024 ? n : (n < 3072 ? n + 64 : (n < 3136 ? n - 2048 : -1));
    if (mapid == 2) { const int which = n >> 10, h = (n >> 7) & 7, j = n & 127; return h * 256 + which * 128 + j; }
    if (mapid == 3) { const int pn = n >> 8, bj = (n >> 7) & 1, q = n & 127; return bj * DFF + pn * 128 + q; }
    return n;
}
DI CvDesc cv_desc(const Frame& F, int m) {
    const int l = m / 6, j = m % 6; CvDesc d; d.kscale = nullptr; d.mapid = 0;
    if (j == 0) { d.src = F.inp(8) + (size_t)l * D * INC; d.K = D; d.Nsrc = INC; d.dst = (bf16_t*)(F.ws + WS_WIN) + (size_t)l * UC * D; d.Ndst = UC; d.mapid = 1; }
    else if (j == 1) { d.src = F.inp(10) + (size_t)l * 512 * 1536; d.K = 512; d.Nsrc = 1536; d.dst = (bf16_t*)(F.ws + WS_WUQ) + (size_t)l * 1536 * 512; d.Ndst = 1536; d.kscale = F.inp(9) + l * 512; }
    else if (j == 2) { d.src = F.inp(12) + (size_t)l * 512 * 2048; d.K = 512; d.Nsrc = 2048; d.dst = (bf16_t*)(F.ws + WS_WUKV) + (size_t)l * 2048 * 512; d.Ndst = 2048; d.kscale = F.inp(11) + l * 512; d.mapid = 2; }
    else if (j == 3) { d.src = F.inp(15) + (size_t)l * D * D; d.K = D; d.Nsrc = D; d.dst = (bf16_t*)(F.ws + WS_WOUT) + (size_t)l * D * D; d.Ndst = D; }
    else if (j == 4) { d.src = F.inp(16) + (size_t)l * D * 2 * DFF; d.K = D; d.Nsrc = 2 * DFF; d.dst = (bf16_t*)(F.ws + WS_WUP) + (size_t)l * 2 * DFF * D; d.Ndst = 2 * DFF; d.mapid = 3; }
    else { d.src = F.inp(19) + (size_t)l * DFF * D; d.K = DFF; d.Nsrc = D; d.dst = (bf16_t*)(F.ws + WS_WDN) + (size_t)l * D * DFF; d.Ndst = D; }
    d.ntiles = (d.Ndst / 128) * (d.K / 64); return d;
}
struct CvTile { const float* src; const float* kscale; bf16_t* dst; int K, Nsrc, sc0, sc1, n0, k0; bool ok; };
DI CvTile cv_tile(const Frame& F, int t) {
    CvTile r; r.ok = false;
    for (int m = 0; m < 12; ++m) { const CvDesc d = cv_desc(F, m);
        if (t < d.ntiles) { const int ntn = d.Ndst / 128; r.n0 = (t % ntn) * 128; r.k0 = (t / ntn) * 64; r.src = d.src; r.kscale = d.kscale; r.dst = d.dst; r.K = d.K; r.Nsrc = d.Nsrc;
            r.sc0 = cv_map(d.mapid, r.n0); r.sc1 = cv_map(d.mapid, r.n0 + 64); r.ok = true; return r; }
        t -= d.ntiles; }
    return r;
}
DI void cv_load(const Frame& F, const CvTile& t, f32x4 (&r)[4]) {
#pragma unroll
    for (int h = 0; h < 2; ++h) { const int sc = h ? t.sc1 : t.sc0;
#pragma unroll
        for (int p = 0; p < 2; ++p) { const int kk = p * 32 + (F.tid >> 4);
            f32x4 v = {0.f, 0.f, 0.f, 0.f};
            if (sc >= 0) { v = __builtin_nontemporal_load((const f32x4*)(t.src + (size_t)(t.k0 + kk) * t.Nsrc + sc + (F.tid & 15) * 4)); if (t.kscale) v *= t.kscale[t.k0 + kk]; }
            r[h * 2 + p] = v; } }
}
DI void p_convert(const Frame& F) {
    LAS float* ts = (LAS float*)F.lds;
    int t = F.vcu; CvTile cur = cv_tile(F, t); f32x4 r[4]; int buf = 0;
    if (cur.ok) cv_load(F, cur, r);
    while (cur.ok) {
        LAS float* tb = ts + buf * (2 * 64 * 65);
#pragma unroll
        for (int h = 0; h < 2; ++h)
#pragma unroll
            for (int p = 0; p < 2; ++p) { const int kk = p * 32 + (F.tid >> 4); LAS float* q = tb + h * (64 * 65) + kk * 65 + (F.tid & 15) * 4;
                q[0] = r[h * 2 + p][0]; q[1] = r[h * 2 + p][1]; q[2] = r[h * 2 + p][2]; q[3] = r[h * 2 + p][3]; }
        __syncthreads();
        const CvTile nxt = cv_tile(F, t + F.G);
        if (nxt.ok) cv_load(F, nxt, r);
#pragma unroll
        for (int h = 0; h < 2; ++h) { const int n = F.tid >> 3, kc = F.tid & 7; const LAS float* q = tb + h * (64 * 65) + n; f32x4 a, b;
#pragma unroll
            for (int j = 0; j < 4; ++j) { a[j] = q[(kc * 8 + j) * 65]; b[j] = q[(kc * 8 + 4 + j) * 65]; }
            *(u32x4*)(cur.dst + (size_t)(cur.n0 + h * 64 + n) * cur.K + cur.k0 + kc * 8) = pk8(a, b); }
        buf ^= 1; t += F.G; cur = nxt;
    }
    __syncthreads();
}

DI void norm_phase(const Frame& F, const float* xl, const float* xc, int M, const float* g, const float* modl, int sh_off, int sc_off, bf16_t* H, float* outf) {
    const int gw = F.vcu * 8 + F.wave, nw = F.G * 8;
    for (int row = gw; row < M; row += nw) {
        const float* xr = row < ML ? xl + (size_t)row * D : xc + (size_t)(row - ML) * D;
        f32x4 v[8]; float ss = 0.f;
#pragma unroll
        for (int i = 0; i < 4; ++i) { v[2 * i] = *(const f32x4*)(xr + i * 512 + F.lane * 8); v[2 * i + 1] = *(const f32x4*)(xr + i * 512 + F.lane * 8 + 4); ss += sq4(v[2 * i]) + sq4(v[2 * i + 1]); }
#pragma unroll
        for (int o = 32; o >= 1; o >>= 1) ss += shx(ss, o, F.lane);
        const float rs = __builtin_amdgcn_rsqf(ss * (1.f / 2048.f) + EPS);
        const int midx = row < ML ? (row >> 12) : 4;
#pragma unroll
        for (int i = 0; i < 4; ++i) { const int col = i * 512 + F.lane * 8;
            const f32x4 g0 = *(const f32x4*)(g + col), g1 = *(const f32x4*)(g + col + 4);
            if (outf) { *(f32x4*)(outf + (size_t)row * D + col) = v[2 * i] * rs * g0; *(f32x4*)(outf + (size_t)row * D + col + 4) = v[2 * i + 1] * rs * g1; }
            else { const float* mp = modl + (size_t)midx * 12288 + col;
                const f32x4 s0 = *(const f32x4*)(mp + sc_off), s1 = *(const f32x4*)(mp + sc_off + 4), h0 = *(const f32x4*)(mp + sh_off), h1 = *(const f32x4*)(mp + sh_off + 4);
                *(u32x4*)(H + (size_t)row * D + col) = pk8(v[2 * i] * rs * g0 * (1.f + s0) + h0, v[2 * i + 1] * rs * g1 * (1.f + s1) + h1); } }
    }
}

struct AttnItem {
    const bf16_t* q; const bf16_t* kn; const bf16_t* kr; const bf16_t* vt; bf16_t* o;
    int ldq, ldk, ldo, lat_row0, ctx_row0, t0, ntl, nctx, mode, r0, hn;
};
template <int DQ>
DI void attn_item(const Frame& F, const AttnItem& it, const LAS float* rpb_lds) {
    constexpr int KP = DQ + 8, VP = 72, KS = DQ / 16;
    constexpr int KBYTES = 64 * KP * 2, VBYTES = 128 * VP * 2;
    LAS unsigned char* base = F.lds;
    int tid = threadIdx.x; asm volatile("" : "+v"(tid));
    const int lane = tid & 63, w = __builtin_amdgcn_readfirstlane(tid >> 6), qq = lane & 31, hh = lane >> 5;
    const bool grpB = w >= 4;
    const int ntile = it.ntl + it.nctx;
    u32x4 rk[2], rr, rv[2];
    auto gload = [&](int ti) {
        int rowb, vcol;
        if (ti < it.ntl) { const int kt = it.t0 + ti; rowb = it.lat_row0 + kt * 64; vcol = kt * 64; } else { const int j = ti - it.ntl; rowb = it.ctx_row0 + j * 64; vcol = SEQ + j * 64; }
#pragma unroll
        for (int i = 0; i < 2; ++i) { const int id = tid + i * NT; rk[i] = *(const u32x4*)(it.kn + (size_t)(rowb + (id >> 4)) * it.ldk + (id & 15) * 8);
            rv[i] = *(const u32x4*)(it.vt + (size_t)(id >> 3) * KEYS + vcol + (id & 7) * 8); }
        if (DQ == 192) rr = *(const u32x4*)(it.kr + (size_t)(rowb + (tid >> 3)) * UC + (tid & 7) * 8);
    };
    auto lstore = [&](int ti) {
        LAS unsigned char* kb = base + (ti & 1) * KBYTES; LAS unsigned char* vb = base + 2 * KBYTES + (ti % 3) * VBYTES;
#pragma unroll
        for (int i = 0; i < 2; ++i) { const int id = tid + i * NT; *(LAS u32x4*)(kb + ((id >> 4) * KP + (id & 15) * 8) * 2) = rk[i];
            *(LAS u32x4*)(vb + ((id >> 3) * VP + (id & 7) * 8) * 2) = rv[i]; }
        if (DQ == 192) *(LAS u32x4*)(kb + ((tid >> 3) * KP + 128 + (tid & 7) * 8) * 2) = rr;
    };
    bf16x8 qf[KS];
    { const bf16_t* qp = it.q + (size_t)(32 * w + qq) * it.ldq + 8 * hh;
#pragma unroll
        for (int ks = 0; ks < KS; ++ks) qf[ks] = *(const bf16x8*)(qp + 16 * ks); }
    f32x16 o[4];
#pragma unroll
    for (int db = 0; db < 4; ++db)
#pragma unroll
        for (int i = 0; i < 16; ++i) o[db][i] = 0.f;
    f32x16 s[2];
    float mrun = -INFINITY, lrun = 0.f;
    const int r = it.r0 + (w >> 1), wq = 32 * (w & 1) + qq;
    const int rs = min(max(r - 4, 0), 56), cs = min(max(wq - 8, 0), 48);
    auto active = [&](int ti) { const int krow = it.t0 + ti; return !(it.mode == 1 && ti < it.ntl && (krow < rs || krow > rs + 7)); };
    auto qk = [&](int ti) {
        if (!active(ti)) return;
        const int krow_l = (qq & 3) + 4 * ((qq >> 3) & 1) + 8 * ((qq >> 2) & 1) + 16 * (qq >> 4);
        LAS unsigned char* kb = base + (ti & 1) * KBYTES + (krow_l * KP + 8 * hh) * 2;
#pragma unroll
        for (int blk = 0; blk < 2; ++blk)
#pragma unroll
            for (int i = 0; i < 16; ++i) s[blk][i] = 0.f;
        bf16x8 kf[3][2];
#pragma unroll
        for (int p = 0; p < 2; ++p)
#pragma unroll
            for (int blk = 0; blk < 2; ++blk) kf[p][blk] = *(const LAS bf16x8*)(kb + (32 * blk * KP + 16 * p) * 2);
#pragma unroll
        for (int ks = 0; ks < KS; ++ks) {
            if (ks + 2 < KS) {
#pragma unroll
                for (int blk = 0; blk < 2; ++blk) kf[(ks + 2) % 3][blk] = *(const LAS bf16x8*)(kb + (32 * blk * KP + 16 * (ks + 2)) * 2); }
            __builtin_amdgcn_sched_barrier(0);
#pragma unroll
            for (int blk = 0; blk < 2; ++blk) s[blk] = __builtin_amdgcn_mfma_f32_32x32x16_bf16(kf[ks % 3][blk], qf[ks], s[blk], 0, 0, 0);
            __builtin_amdgcn_sched_barrier(0);
        }
    };
    auto smpv = [&](int ti) {
        if (!active(ti)) return;
        LAS unsigned char* vb = base + 2 * KBYTES + (ti % 3) * VBYTES;
        if (it.mode == 1 && ti < it.ntl) {
            const int krow = it.t0 + ti;
            const LAS float* bp = rpb_lds + it.hn * 465 + (krow - r + 7) * 31 - wq + 15;
#pragma unroll
            for (int blk = 0; blk < 2; ++blk)
#pragma unroll
                for (int i = 0; i < 16; ++i) { const int kc = 32 * blk + (i & 3) + 4 * ((i >> 2) & 1) + 8 * hh + 16 * (i >> 3); const bool ok = kc >= cs && kc < cs + 16;
                    const int kcc = ok ? kc : cs; s[blk][i] = ok ? s[blk][i] + bp[kcc] : -INFINITY; }
        }
        float mx = s[0][0];
#pragma unroll
        for (int blk = 0; blk < 2; ++blk)
#pragma unroll
            for (int i = 0; i < 16; ++i) mx = fmaxf(mx, s[blk][i]);
        mx = fmaxf(mx, shx(mx, 32, lane));
        const float mnew = fmaxf(mrun, mx), alpha = __builtin_amdgcn_exp2f(mrun - mnew);
        mrun = mnew;
        float ps = 0.f;
#pragma unroll
        for (int blk = 0; blk < 2; ++blk)
#pragma unroll
            for (int i = 0; i < 16; ++i) { const float p = __builtin_amdgcn_exp2f(s[blk][i] - mnew); s[blk][i] = p; ps += p; }
        lrun = lrun * alpha + ps;
        if (__builtin_amdgcn_ballot_w64(alpha != 1.f) != 0ull) {
#pragma unroll
            for (int db = 0; db < 4; ++db)
#pragma unroll
                for (int i = 0; i < 16; ++i) o[db][i] *= alpha;
        }
        LAS unsigned char* vq = vb + (qq * VP + 8 * hh) * 2;
        auto vload = [&](int step, int db) { return *(const LAS bf16x8*)(vq + (32 * db * VP + 16 * step) * 2); };
        bf16x8 vf[2][4];
#pragma unroll
        for (int db = 0; db < 4; ++db) vf[0][db] = vload(0, db);
#pragma unroll
        for (int st = 0; st < 4; ++st) {
            if (st + 1 < 4) {
#pragma unroll
                for (int db = 0; db < 4; ++db) vf[(st + 1) & 1][db] = vload(st + 1, db); }
            __builtin_amdgcn_sched_barrier(0);
            const int blk = st >> 1, s2 = st & 1;
            u32x4 pw; pw.x = pk2(s[blk][8 * s2], s[blk][8 * s2 + 1]); pw.y = pk2(s[blk][8 * s2 + 2], s[blk][8 * s2 + 3]);
            pw.z = pk2(s[blk][8 * s2 + 4], s[blk][8 * s2 + 5]); pw.w = pk2(s[blk][8 * s2 + 6], s[blk][8 * s2 + 7]);
            const bf16x8 pf = __builtin_bit_cast(bf16x8, pw);
#pragma unroll
            for (int db = 0; db < 4; ++db) o[db] = __builtin_amdgcn_mfma_f32_32x32x16_bf16(vf[st & 1][db], pf, o[db], 0, 0, 0);
            __builtin_amdgcn_sched_barrier(0);
        }
    };

    __syncthreads();
    gload(0); lstore(0);
    if (ntile > 1) gload(1);
    __syncthreads();
    for (int ti = 0; ti < ntile; ++ti) {
        qk(ti);
        if (grpB) { if (ti + 1 < ntile) lstore(ti + 1); if (ti + 2 < ntile) gload(ti + 2); __syncthreads(); }
        smpv(ti);
        if (!grpB) { if (ti + 1 < ntile) lstore(ti + 1); if (ti + 2 < ntile) gload(ti + 2); __syncthreads(); }
    }
    const float lt = lrun + shx(lrun, 32, lane), inv = 1.f / lt;
    bf16_t* op = it.o + (size_t)(32 * w + qq) * it.ldo + 4 * hh;
#pragma unroll
    for (int db = 0; db < 4; ++db)
#pragma unroll
        for (int ig = 0; ig < 4; ++ig) { u32x2 v; v.x = pk2(o[db][4 * ig] * inv, o[db][4 * ig + 1] * inv); v.y = pk2(o[db][4 * ig + 2] * inv, o[db][4 * ig + 3] * inv);
            *(u32x2*)(op + 32 * db + 8 * ig) = v; }
}

#ifndef MLAREP
#define MLAREP 1
#endif
DI void mixer_attention(const Frame& F, int layer, int cidx) {
    const int nitems = (layer == 0 ? 816 : 768) + 512 * (MLAREP - 1);
    bf16_t* U = (bf16_t*)(F.ws + WS_U); bf16_t* Q = (bf16_t*)(F.ws + WS_Q); bf16_t* KN = (bf16_t*)(F.ws + WS_KN);
    bf16_t* VT = (bf16_t*)(F.ws + WS_VT); bf16_t* VNT = (bf16_t*)(F.ws + WS_VNT); bf16_t* CAT = (bf16_t*)(F.ws + WS_CAT);
    unsigned* ctr = (unsigned*)(F.ws + WS_CTR) + cidx;
    LAS float* rpb = (LAS float*)(F.lds + 112 * 1024);
    volatile LAS int* slot = (volatile LAS int*)(F.lds + 112 * 1024 + 8192);
    __syncthreads();
    for (int i = F.tid; i < 4 * 465; i += NT) rpb[i] = F.inp(13)[layer * 4 * 465 + i] * LOG2E;
    for (int step = 0;; ++step) {
        int idx;
        if (step < 2) idx = F.vcu + 256 * step;
        else {
            __syncthreads();
            if (F.tid == 0) *slot = (int)atomicAdd(ctr, 1u);
            __syncthreads();
            idx = 512 + *slot;
        }
        if (idx >= nitems) break;
        AttnItem it; it.kr = nullptr; it.mode = 0; it.r0 = 0; it.hn = 0; it.nctx = 4;
        if (idx < 512 || (idx >= 768 && idx < 800)) {
            int b, h, row0;
            if (idx < 512) { b = idx >> 7; h = (idx >> 4) & 7; row0 = b * 4096 + (idx & 15) * 256; it.t0 = 0; it.ntl = 64; }
            else { const int j = idx - 768; b = j >> 3; h = j & 7; row0 = ML + b * 256; it.t0 = 0; it.ntl = 0; }
            it.q = Q + (size_t)row0 * 1536 + h * 192; it.ldq = 1536;
            it.kn = KN + h * 128; it.ldk = 1024; it.kr = U + U_KR;
            it.vt = VT + (size_t)(b * 8 + h) * 128 * KEYS;
            it.o = CAT + (size_t)row0 * D + h * 128; it.ldo = D;
            it.lat_row0 = b * 4096; it.ctx_row0 = ML + b * 256;
            attn_item<192>(F, it, rpb);
        } else {
            int b, hn, row0;
            if (idx < 768) { const int j = idx - 512; b = j >> 6; hn = (j >> 4) & 3; const int R = j & 15; row0 = b * 4096 + R * 256;
                const int rlo = max(4 * R - 4, 0), rhi = min(max(4 * R - 1, 0), 56) + 7; it.t0 = rlo; it.ntl = rhi - rlo + 1; it.mode = 1; it.r0 = 4 * R; it.hn = hn; }
            else { const int j = idx - 800; b = j >> 2; hn = j & 3; row0 = ML + b * 256; it.t0 = 0; it.ntl = 0; }
            it.q = U + (size_t)row0 * UC + U_QN + hn * 128; it.ldq = UC;
            it.kn = U + U_KN + hn * 128; it.ldk = UC;
            it.vt = VNT + (size_t)(b * 4 + hn) * 128 * KEYS;
            it.o = CAT + (size_t)row0 * D + 1024 + hn * 128; it.ldo = D;
            it.lat_row0 = b * 4096; it.ctx_row0 = ML + b * 256;
            attn_item<128>(F, it, rpb);
        }
    }
}

#ifndef PHMASK
#define PHMASK 0x7ff
#endif
#define PH(k) (((PHMASK) >> (k)) & 1)
#ifndef DUPMASK
#define DUPMASK 0x000
#endif
#define REP(k) for (int rep_ = 0, nrep_ = F.nrep((DUPMASK >> (k)) & 1); rep_ < nrep_; ++rep_)
#define Hbuf ((bf16_t*)(F.ws + WS_H))
#define H (Hbuf + D)
#define X ((float*)(F.ws + WS_X))
#define U ((bf16_t*)(F.ws + WS_U))
#define SSQ ((float*)(F.ws + WS_SSQ))
#define CAT ((bf16_t*)(F.ws + WS_CAT))
#define mod ((const float*)(F.ws + WS_MOD))
#define rope ((const f32x2*)(F.ws + WS_ROPE))
#define GSYNC() do { grid.sync(); F.refresh(); } while (0)
DI void layer_body(Frame& F, cg::grid_group& grid, const int l) {
        const int Mq = l == 0 ? MT : ML;
#define modl (mod + (size_t)l * 5 * 12288)
#define xl (l == 0 ? F.inp(0) : (const float*)X)
#define xc (l == 0 ? F.inp(2) : (const float*)(X + (size_t)ML * D))
        REP(1) {
        if (PH(1)) norm_phase(F, xl, xc, MT, F.inp(6) + l * D, modl, 0, 2048, H, nullptr);
        GSYNC(); }
        REP(2) {
        { pg8::Gemm g{H, (const bf16_t*)(F.ws + WS_WIN) + (size_t)l * UC * D, D, D, D, 0};
          pg8::Sched S; S.init(MT / 256, UC / 256, F.G, F.vcu, 0);
          EpiU E{U, SSQ, (bf16_t*)(F.ws + WS_VNT), rope, 0.08838834764831845f * LOG2E, (bf16_t*)F.outp() + DO_FF};
          if (PH(2)) pg8::gemm_phase(F.lds, g, S, E); }
        GSYNC(); }
        REP(3) {
        { int start = 0;
          { pg8::Gemm g{U + U_CQ, (const bf16_t*)(F.ws + WS_WUQ) + (size_t)l * 1536 * 512, UC, 512, 512, 0};
            pg8::Sched S; S.init(Mq / 256, 6, F.G, F.vcu, start); start += (Mq / 256) * 6;
            EpiQ E{(bf16_t*)(F.ws + WS_Q), SSQ, rope, 0.07216878364870323f * LOG2E};
            if (PH(3)) pg8::gemm_phase(F.lds, g, S, E); }
          { pg8::Gemm g{U + U_CKV, (const bf16_t*)(F.ws + WS_WUKV) + (size_t)l * 2048 * 512, UC, 512, 512, 0};
            pg8::Sched S; S.init(MT / 256, 8, F.G, F.vcu, start); start += (MT / 256) * 8;
            EpiKV E{(bf16_t*)(F.ws + WS_KN), (bf16_t*)(F.ws + WS_VT), SSQ};
            if (PH(4)) pg8::gemm_phase(F.lds, g, S, E); }
          { pg8::Gemm g{(const bf16_t*)(F.ws + WS_WC) + (size_t)l * 1024 * 1024, (const bf16_t*)F.outp() + DO_FF, 1024, 1024, 1024, 0};
            SchedY S; S.init(F.G, F.vcu, start); start += 144;
            EpiY E{(bf16_t*)(F.ws + WS_YT), (bf16_t*)(F.ws + WS_YTC), 0};
            if (PH(5)) pg8::gemm_phase(F.lds, g, S, E); }
          if (l == 0) { pg8::Gemm g{(const bf16_t*)(F.ws + WS_WC) + (size_t)l * 1024 * 1024, (const bf16_t*)F.outp() + DO_FF + (size_t)ML * 1024, 1024, 1024, 512, 0};
            pg8::Sched S; S.init(4, MC / 256, F.G, F.vcu, start);
            EpiY E{(bf16_t*)(F.ws + WS_YT), (bf16_t*)(F.ws + WS_YTC), ML};
            if (PH(5)) pg8::gemm_phase(F.lds, g, S, E); } }
        GSYNC(); }
        REP(7) {
        if (F.vcu < 128 || (l == 0 && F.vcu < 136)) {
            const bool cx = F.vcu >= 128; const int ld = cx ? 512 : 4096;
            long zo = 0; asm volatile("" : "+s"(zo)); const bf16_t* dftp = (const bf16_t*)F.P.out + zo;
            pg8::Gemm g{dftp + (cx ? DO_DFTC : DO_DFT), (const bf16_t*)(F.ws + (cx ? WS_YTC : WS_YT)), ld, ld, ld, 0};
            pg8::OneUnit S; S.u.pm = cx ? 0 : (F.vcu & 15); S.u.pn = cx ? (F.vcu - 128) : (F.vcu >> 4); S.has = true;
            EpiF E{CAT, cx ? 1 : 0}; if (PH(6)) pg8::gemm_phase(F.lds, g, S, E); }
        if (PH(7)) mixer_attention(F, l, l + 2 * rep_);
        GSYNC(); }
        REP(8) {
        { pg8::Gemm g{CAT, (const bf16_t*)(F.ws + WS_WOUT) + (size_t)l * D * D, D, D, D, 0};
          pg8::Sched S; S.init(Mq / 256, 8, F.G, F.vcu, 0);
          EpiRes E{xl, xc, X, modl + 4096};
          if (PH(8)) pg8::gemm_phase(F.lds, g, S, E); }
        GSYNC(); }
        REP(4) {
        if (PH(1)) norm_phase(F, X, X + (size_t)ML * D, Mq, F.inp(7) + l * D, modl, 6144, 8192, H, nullptr);
        GSYNC(); }
        REP(10) {
        { pg8::Gemm g{Hbuf, (const bf16_t*)(F.ws + WS_WUP) + (size_t)l * 2 * DFF * D, D, D, D, 1};
          pg8::Sched S; S.init((Mq + 247) / 248, 44, F.G, F.vcu, 0);
          EpiConv E{(bf16_t*)(F.ws + WS_ACT), F.inp(17) + (size_t)l * 3 * 2 * DFF, F.inp(18) + (size_t)l * 2 * DFF, Mq};
          if (PH(10)) pg8::gemm_phase(F.lds, g, S, E); }
        GSYNC(); }
        { pg8::Gemm g{(const bf16_t*)(F.ws + WS_ACT), (const bf16_t*)(F.ws + WS_WDN) + (size_t)l * D * DFF, DFF, DFF, DFF, 0};
          pg8::Sched S; S.init(Mq / 256, 8, F.G, F.vcu, 0);
          EpiRes E{X, X + (size_t)ML * D, X, modl + 10240};
          if (PH(9)) pg8::gemm_phase(F.lds, g, S, E); }
        GSYNC();

}

__global__ void __launch_bounds__(NT) fwd_megakernel(Params p) {
    extern __shared__ __attribute__((aligned(16))) unsigned char lds_raw[];
    cg::grid_group grid = cg::this_grid();
    const int tid_ = threadIdx.x, G_ = gridDim.x, bx_ = blockIdx.x;
    Frame F{(LAS unsigned char*)lds_raw, lds_raw, tid_, tid_ & 63, __builtin_amdgcn_readfirstlane(tid_ >> 6), G_, (G_ % 8 == 0) ? (bx_ % 8) * (G_ / 8) + bx_ / 8 : bx_, p, p.ws};
    REP(0) { if (PH(0)) { p_mod(F);
    p_tables(F);
    p_convert(F); }
    GSYNC(); }

    for (int l = 0; l < 2; ++l) layer_body(F, grid, l);
    if (PH(1)) norm_phase(F, X, X, ML, F.inp(20), nullptr, 0, 0, nullptr, F.outp());
}
#undef Hbuf
#undef H
#undef X
#undef U
#undef SSQ
#undef CAT
#undef mod
#undef rope
#undef modl
#undef xl
#undef xc


extern "C" void kernel_launch(void* const* d_in, const int* in_sizes, int n_in, void* d_out, int out_size, void* d_ws, size_t ws_size, hipStream_t stream) {
    static int grid_blocks = 0;
    if (!grid_blocks) {
        int dev = 0, cus = 0, per_cu = 0;
        hipGetDevice(&dev);
        hipDeviceGetAttribute(&cus, hipDeviceAttributeMultiprocessorCount, dev);
        hipFuncSetAttribute((const void*)fwd_megakernel, hipFuncAttributeMaxDynamicSharedMemorySize, LDS_BYTES);
        hipOccupancyMaxActiveBlocksPerMultiprocessor(&per_cu, (const void*)fwd_megakernel, NT, LDS_BYTES);
        if (per_cu < 1) { fprintf(stderr, "occupancy query says %d blocks/CU\n", per_cu); per_cu = 1; }
        grid_blocks = cus;
        if (ws_size < WS_END) fprintf(stderr, "workspace too small: %zu < %zu\n", ws_size, (size_t)WS_END);
    }
    Params p{};
    for (int i = 0; i < 21; ++i) p.in[i] = (const float*)d_in[i];
    p.out = (float*)d_out; p.ws = (unsigned char*)d_ws;
    void* args[] = {&p};
    hipError_t e = hipLaunchCooperativeKernel((const void*)fwd_megakernel, dim3(grid_blocks), dim3(NT), args, LDS_BYTES, stream);
    if (e != hipSuccess) fprintf(stderr, "cooperative launch failed: %s (grid %d)\n", hipGetErrorString(e), grid_blocks);
}
```

```cpp
#include <hip/hip_runtime.h>
#include <hip/hip_cooperative_groups.h>
#include <cstdio>
namespace cg = cooperative_groups;

#define LAS __attribute__((address_space(3)))
#define GAS __attribute__((address_space(1)))
template <class T> __device__ __forceinline__ T* as_global(T* p) { return p; }
#define DI __device__ __forceinline__
typedef unsigned short bf16_t;
typedef short bf16x8 __attribute__((ext_vector_type(8)));
typedef short s16x4 __attribute__((ext_vector_type(4)));
typedef float f32x4 __attribute__((ext_vector_type(4)));
typedef float f32x2 __attribute__((ext_vector_type(2)));
typedef float f32x16 __attribute__((ext_vector_type(16)));
typedef unsigned u32x4 __attribute__((ext_vector_type(4)));
typedef unsigned u32x2 __attribute__((ext_vector_type(2)));
typedef __bf16 bfv2 __attribute__((ext_vector_type(2)));

constexpr int D = 2048, NB = 4, SEQ = 4096, CTXL = 256, ML = NB * SEQ, MC = NB * CTXL, MT = ML + MC;
constexpr int INC = 3136, UC = 3328;
constexpr int U_CQ = 0, U_CKV = 512, U_QN = 1024, U_KN = 1536, U_VN = 2048, U_F = 2560, U_KR = 3072;
constexpr int DFF = 5632, KEYS = SEQ + CTXL;
constexpr size_t DO_DFT = 0, DO_DFTC = (size_t)4096 * 4096, DO_FF = DO_DFTC + 256 * 512;
static_assert((DO_FF + (size_t)(ML + MC) * 1024) * 2 <= (size_t)ML * 2048 * 4, "d_out scratch");
constexpr float EPS = 1e-6f, LOG2E = 1.4426950408889634f;
constexpr int NT = 512;
constexpr int LDS_BYTES = 136 * 1024;

constexpr size_t al(size_t x) { return (x + 255) & ~(size_t)255; }
constexpr size_t WS_WIN = 0;
constexpr size_t WS_WUQ = WS_WIN + al((size_t)2 * UC * D * 2);
constexpr size_t WS_WUKV = WS_WUQ + al((size_t)2 * 1536 * 512 * 2);
constexpr size_t WS_WOUT = WS_WUKV + al((size_t)2 * 4096 * 512 * 2);
constexpr size_t WS_WUP = WS_WOUT + al((size_t)2 * D * D * 2);
constexpr size_t WS_WDN = WS_WUP + al((size_t)2 * 2 * DFF * D * 2);
constexpr size_t WS_WC = WS_WDN + al((size_t)2 * D * DFF * 2);
constexpr size_t WS_DFTC = WS_WC + al((size_t)2 * 1024 * 1024 * 2);
constexpr size_t WS_TRIG = WS_DFTC + al((size_t)256 * 512 * 2);
constexpr size_t WS_ROPE = WS_TRIG + al(4096 * 8);
constexpr size_t WS_MOD = WS_ROPE + al(64 * 16 * 8);
constexpr size_t WS_CTR = WS_MOD + al((size_t)2 * 5 * 12288 * 4);
constexpr size_t WS_X = WS_CTR + 256;
constexpr size_t WS_H = WS_X + al((size_t)MT * D * 4);
constexpr size_t H_ROWS = 1 + MT + 256;
constexpr size_t WS_CAT = WS_H + al(H_ROWS * D * 2);
constexpr size_t WS_YTC = WS_CAT + al((size_t)MT * D * 2);
constexpr size_t WS_U = WS_YTC + al((size_t)2048 * 512 * 2);
constexpr size_t WS_SSQ = WS_U + al((size_t)MT * UC * 2);
constexpr size_t WS_Q = WS_SSQ + al((size_t)MT * 16 * 4);
constexpr size_t WS_KN = WS_Q + al((size_t)MT * 1536 * 2);
constexpr size_t WS_VT = WS_KN + al((size_t)MT * 1024 * 2);
constexpr size_t WS_VNT = WS_VT + al((size_t)32 * 128 * KEYS * 2);
constexpr size_t WS_YT = WS_VNT + al((size_t)16 * 128 * KEYS * 2);
constexpr size_t WS_END = WS_YT + al((size_t)2048 * 8192 * 2);
constexpr size_t WS_ACT = WS_U;
static_assert(WS_ACT + (size_t)MT * DFF * 2 <= WS_END, "ACT alias");
static_assert((size_t)4096 * 8192 * 2 <= H_ROWS * D * 2, "DFT alias");
static_assert(WS_END <= (size_t)805306368, "workspace");

struct Params { const float* in[21]; float* out; unsigned char* ws; };

DI unsigned pk2(float a, float b) { f32x2 v = {a, b}; bfv2 r = __builtin_convertvector(v, bfv2); return __builtin_bit_cast(unsigned, r); }
DI bf16_t f2bf(float a) { return (bf16_t)(pk2(a, 0.f) & 0xffffu); }
DI float shx(float v, int m, int lane) { return __builtin_bit_cast(float, __builtin_amdgcn_ds_bpermute((lane ^ m) << 2, __builtin_bit_cast(int, v))); }
DI f32x4 bf4(u32x2 w) { f32x4 r; r[0] = __builtin_bit_cast(float, w.x << 16); r[1] = __builtin_bit_cast(float, w.x & 0xffff0000u); r[2] = __builtin_bit_cast(float, w.y << 16); r[3] = __builtin_bit_cast(float, w.y & 0xffff0000u); return r; }
DI float sq4(f32x4 v) { return (v[0] * v[0] + v[1] * v[1]) + (v[2] * v[2] + v[3] * v[3]); }
DI u32x4 pk8(f32x4 a, f32x4 b) { u32x4 w; w.x = pk2(a[0], a[1]); w.y = pk2(a[2], a[3]); w.z = pk2(b[0], b[1]); w.w = pk2(b[2], b[3]); return w; }

namespace pg8 {
constexpr int BM = 256, BK = 64, HALF = 128, HTB = HALF * BK * 2, STAGE_BYTES = 8 * HTB;
DI int lds_byte(int r, int c) { const int st = (r >> 4) * 2 + (c >> 5), rr = r & 15, cc = c & 31, ob = rr * 64 + cc * 2; return st * 1024 + (ob ^ (((ob >> 9) & 1) << 5)); }
DI void stage_rc(int b, int& R, int& C) { const int st = b / 1024, sb = b % 1024, swz = sb ^ (((sb >> 9) & 1) << 5); R = (st >> 1) * 16 + swz / 64; C = (st & 1) * 32 + (swz % 64) / 2; }
DI int perm32(int rho) { const int n = rho >> 4, i = rho & 15; return 8 * (i >> 2) + 4 * n + (i & 3); }
struct Unit { int pm, pn, kob; };
struct Gemm { const bf16_t* A; const bf16_t* Bt; int lda, ldb, K; int conv; };

struct Sched {
    int nM, nN, cnt, G, c, i0, start, kobm = 0;
    DI void init(int nM_, int nN_, int G_, int c_, int start_) { nM = nM_; nN = nN_; cnt = nM * nN; G = G_; c = c_; start = start_;
        i0 = (start_ > c_) ? (start_ - c_ + G_ - 1) / G_ : 0; }
    DI bool next(int i, Unit& u) const {
        const long L = (long)(i0 + i) * G + c - start; if (L >= cnt) return false;
        const int w = (int)L, nig = 8 * nN, gid = w / nig, fm = gid * 8, gsz = (nM - fm) < 8 ? (nM - fm) : 8;
        u.pm = fm + ((w % nig) % gsz); u.pn = (w % nig) / gsz; u.kob = kobm * u.pm; return true;
    }
};
struct OneUnit { Unit u; bool has; DI bool next(int i, Unit& o) const { o = u; return has && i == 0; } };

template <class Epi, class SchedT>
DI void gemm_phase(LAS unsigned char* lds, const Gemm g, const SchedT& S, const Epi& E) {
    int tid = threadIdx.x; asm volatile("" : "+v"(tid));
    const int wid = __builtin_amdgcn_readfirstlane(tid >> 6), lane = tid & 63, wr = wid >> 2, wc = wid & 3, fr = lane & 15, fq = lane >> 4;
    const int K = g.K, nt = K / BK;
    unsigned voffA[2], voffB[2];
    auto mk_voff = [&]() { int t2 = threadIdx.x; asm volatile("" : "+v"(t2));
#pragma unroll
        for (int i = 0; i < 2; ++i) { int R, C; stage_rc(t2 * 16 + i * 8192, R, C); const int Rb = Epi::PERM ? ((R & ~31) + perm32(R & 31)) : R;
            const int Ra = g.conv ? ((R >> 6) * 62 + (R & 63)) : R;
            voffA[i] = (unsigned)(Ra * g.lda + C) * 2u; voffB[i] = (unsigned)(Rb * g.ldb + C) * 2u; } };
    mk_voff();
    const size_t kstep = (size_t)(BK * 2);
    const size_t hstepA = (size_t)(g.conv ? 124 : HALF) * g.lda * 2, hstepB = (size_t)HALF * g.ldb * 2;
    const size_t tstepA = 2 * hstepA, tstepB = 2 * hstepB;
    const unsigned ldsw = (unsigned)wid * 1024u;
    const int aoff = lds_byte(wr * 64 + fr, fq * 8), boff = lds_byte(wc * 32 + fr, fq * 8);
#define PG8_SA(b, h) (((b) * 2 + (h)) * HTB)
#define PG8_SB(b, h) ((4 + (b) * 2 + (h)) * HTB)
#define PG8_STAGE(bufoff, gbase, voff) do { _Pragma("unroll") for (int _i = 0; _i < 2; ++_i) \
        __builtin_amdgcn_global_load_lds((const unsigned*)((const char*)(gbase) + (voff)[_i]), (LAS unsigned*)(lds + (bufoff) + ldsw + _i * 8192), 16, 0, 0); } while (0)
#define PG8_LDA(dst, b, h) do { _Pragma("unroll") for (int m = 0; m < 4; ++m) _Pragma("unroll") for (int k = 0; k < 2; ++k) dst[m][k] = *(const LAS bf16x8*)(lds + PG8_SA(b, h) + aoff + m * 2048 + k * 1024); } while (0)
#define PG8_LDB(dst, b, h) do { _Pragma("unroll") for (int n = 0; n < 2; ++n) _Pragma("unroll") for (int k = 0; k < 2; ++k) dst[n][k] = *(const LAS bf16x8*)(lds + PG8_SB(b, h) + boff + n * 2048 + k * 1024); } while (0)
#define PG8_MMA(ai, bj, At, Bt) do { __builtin_amdgcn_s_setprio(1); _Pragma("unroll") for (int m = 0; m < 4; ++m) _Pragma("unroll") for (int n = 0; n < 2; ++n) _Pragma("unroll") for (int k = 0; k < 2; ++k) \
        acc[ai][bj][m][n] = __builtin_amdgcn_mfma_f32_16x16x32_bf16(Bt[n][k], At[m][k], acc[ai][bj][m][n], 0, 0, 0); __builtin_amdgcn_s_setprio(0); } while (0)
#define PG8_WAIT_V(n) asm volatile("s_waitcnt vmcnt(" #n ")" ::: "memory")
#define PG8_WAIT_L(n) asm volatile("s_waitcnt lgkmcnt(" #n ")" ::: "memory")
#define PG8_BAR __builtin_amdgcn_s_barrier()
#define PG8_SCHED __builtin_amdgcn_sched_barrier(0)
    Unit cur, nxt; int ui = 0;
    if (!S.next(0, cur)) return;
    f32x4 acc[2][2][4][2];
#pragma unroll
    for (int a = 0; a < 2; ++a)
#pragma unroll
        for (int b = 0; b < 2; ++b)
#pragma unroll
            for (int m = 0; m < 4; ++m)
#pragma unroll
                for (int n = 0; n < 2; ++n) acc[a][b][m][n] = (f32x4){0.f, 0.f, 0.f, 0.f};
    bf16x8 At[4][2], B0[2][2], B1[2][2];
    const char* cA = (const char*)g.A + (size_t)cur.pm * tstepA; const char* cB = (const char*)g.Bt + (size_t)cur.pn * tstepB + (size_t)cur.kob * 2;
    PG8_STAGE(PG8_SB(0, 0), cB, voffB); PG8_STAGE(PG8_SA(0, 0), cA, voffA); PG8_STAGE(PG8_SB(0, 1), cB + hstepB, voffB); PG8_STAGE(PG8_SA(0, 1), cA + hstepA, voffA);
    if (wr == 1) PG8_BAR;
    PG8_WAIT_V(4); PG8_BAR;
    PG8_STAGE(PG8_SB(1, 0), cB + kstep, voffB); PG8_STAGE(PG8_SA(1, 0), cA + kstep, voffA); PG8_STAGE(PG8_SB(1, 1), cB + hstepB + kstep, voffB);
    PG8_WAIT_V(6); PG8_BAR;
    for (;;) {
        const bool has_next = S.next(ui + 1, nxt);
        const char* nA = has_next ? (const char*)g.A + (size_t)nxt.pm * tstepA : cA; const char* nB = has_next ? (const char*)g.Bt + (size_t)nxt.pn * tstepB + (size_t)nxt.kob * 2 : cB;
        for (int t = 0; t < nt; t += 2) {
            const bool last = (t == nt - 2);
            const char* a1 = cA + (size_t)(t + 1) * kstep;
            const char* a2 = last ? nA : cA + (size_t)(t + 2) * kstep; const char* b2 = last ? nB : cB + (size_t)(t + 2) * kstep;
            const char* a3 = a2 + kstep; const char* b3 = b2 + kstep;
            PG8_LDB(B0, 0, 0); PG8_SCHED; PG8_LDA(At, 0, 0); PG8_STAGE(PG8_SA(1, 1), a1 + hstepA, voffA);
            PG8_WAIT_L(8); PG8_BAR; PG8_WAIT_L(0); PG8_MMA(0, 0, At, B0); PG8_BAR; PG8_SCHED;
            PG8_LDB(B1, 0, 1); PG8_STAGE(PG8_SB(0, 0), b2, voffB);
            PG8_BAR; PG8_WAIT_L(0); PG8_MMA(0, 1, At, B1); PG8_BAR;
            PG8_LDA(At, 0, 1); PG8_STAGE(PG8_SA(0, 0), a2, voffA);
            PG8_BAR; PG8_WAIT_L(0); PG8_MMA(1, 0, At, B0); PG8_BAR; PG8_SCHED;
            PG8_STAGE(PG8_SB(0, 1), b2 + hstepB, voffB);
            PG8_WAIT_V(6); PG8_BAR; PG8_MMA(1, 1, At, B1); PG8_BAR;
            PG8_LDB(B0, 1, 0); PG8_SCHED; PG8_LDA(At, 1, 0); PG8_STAGE(PG8_SA(0, 1), a2 + hstepA, voffA);
            PG8_WAIT_L(8); PG8_BAR; PG8_WAIT_L(0); PG8_MMA(0, 0, At, B0); PG8_BAR; PG8_SCHED;
            PG8_LDB(B1, 1, 1); PG8_STAGE(PG8_SB(1, 0), b3, voffB);
            PG8_BAR; PG8_WAIT_L(0); PG8_MMA(0, 1, At, B1); PG8_BAR;
            PG8_LDA(At, 1, 1); PG8_STAGE(PG8_SA(1, 0), a3, voffA);
            PG8_BAR; PG8_WAIT_L(0); PG8_MMA(1, 0, At, B0); PG8_BAR; PG8_SCHED;
            PG8_STAGE(PG8_SB(1, 1), b3 + hstepB, voffB);
            PG8_WAIT_V(6); PG8_BAR; PG8_MMA(1, 1, At, B1); PG8_BAR;
        }
        { int fr2 = fr, fq2 = fq, wr2 = wr, wc2 = wc; asm volatile("" : "+v"(fr2), "+v"(fq2), "+s"(wr2), "+s"(wc2));
          E(acc, cur, wr2, wc2, fr2, fq2); }
        if (has_next) mk_voff();
        if (!has_next) break;
#pragma unroll
        for (int a = 0; a < 2; ++a)
#pragma unroll
            for (int b = 0; b < 2; ++b)
#pragma unroll
                for (int m = 0; m < 4; ++m)
#pragma unroll
                    for (int n = 0; n < 2; ++n) acc[a][b][m][n] = (f32x4){0.f, 0.f, 0.f, 0.f};
        cur = nxt; cA = nA; cB = nB; ++ui;
    }
    PG8_WAIT_V(0);
    if (wr == 0) PG8_BAR;
    PG8_BAR;
#undef PG8_SA
#undef PG8_SB
#undef PG8_STAGE
#undef PG8_LDA
#undef PG8_LDB
#undef PG8_MMA
#undef PG8_WAIT_V
#undef PG8_WAIT_L
#undef PG8_BAR
#undef PG8_SCHED
}
}
using pg8::Unit;
typedef const f32x4 (&AccRef)[2][2][4][2];

DI void row_bk(int row, int& b, int& key) { if (row < ML) { b = row >> 12; key = row & 4095; } else { const int rc = row - ML; b = rc >> 8; key = SEQ + (rc & 255); } }
DI void rope8(f32x4& v0, f32x4& v1, int row, int axis, int fq, int lane, const f32x2* rope) {
    const int l = row & 4095, pos = axis ? (l & 63) : (l >> 6);
    const f32x2* t = rope + pos * 16 + 8 * (fq & 1);
    const float sgn = (fq < 2) ? -1.f : 1.f;
#pragma unroll
    for (int j = 0; j < 4; ++j) {
        const float p0 = shx(v0[j], 32, lane), p1 = shx(v1[j], 32, lane);
        const f32x2 c0 = t[j], c1 = t[4 + j];
        v0[j] = v0[j] * c0.x + sgn * p0 * c0.y; v1[j] = v1[j] * c1.x + sgn * p1 * c1.y;
    }
}

struct EpiU {
    static constexpr bool PERM = true;
    bf16_t* U; float* ssq; bf16_t* VnT; const f32x2* rope; float qscale; bf16_t* FF;
    DI void operator()(AccRef acc, const Unit& u, int wr, int wc, int fr, int fq) const {
        const int pn = u.pn, rowb = u.pm * 256 + wr * 64 + fr;
        if (pn == 10 || pn == 11) {
#pragma unroll
            for (int ai = 0; ai < 2; ++ai)
#pragma unroll
                for (int m = 0; m < 4; ++m) { const int row = rowb + ai * 128 + m * 16; const int mrow = row < ML ? ((row & ~4095) | ((4096 - (row & 4095)) & 4095)) : row;
#pragma unroll
                    for (int bj = 0; bj < 2; ++bj) { const int c = 256 * (2 * (pn - 10) + bj) + 32 * wc + 8 * fq; const u32x4 w = pk8(acc[ai][bj][m][0], acc[ai][bj][m][1]);
                        *(u32x4*)(FF + (size_t)row * 1024 + c) = w;
                        *(u32x4*)(FF + (size_t)mrow * 1024 + 128 + c) = (row < ML) ? w : (u32x4){0u, 0u, 0u, 0u}; } }
            return;
        }
        if (pn == 8 || pn == 9) {
#pragma unroll
            for (int ai = 0; ai < 2; ++ai)
#pragma unroll
                for (int m = 0; m < 4; ++m) { int b, key; row_bk(rowb + ai * 128 + m * 16, b, key);
#pragma unroll
                    for (int bj = 0; bj < 2; ++bj) { const int hn = 2 * (pn - 8) + bj;
#pragma unroll
                        for (int n = 0; n < 2; ++n) { bf16_t* dst = VnT + ((size_t)((b * 4 + hn) * 128 + 32 * wc + 8 * fq + 4 * n)) * KEYS + key;
#pragma unroll
                            for (int j = 0; j < 4; ++j) dst[(size_t)j * KEYS] = f2bf(acc[ai][bj][m][n][j]); } } }
            return;
        }
        const float sc = (pn == 4 || pn == 5) ? qscale : 1.f;
#pragma unroll
        for (int ai = 0; ai < 2; ++ai)
#pragma unroll
            for (int m = 0; m < 4; ++m) { const int row = rowb + ai * 128 + m * 16; float ss = 0.f;
#pragma unroll
                for (int bj = 0; bj < 2; ++bj) { f32x4 v0 = acc[ai][bj][m][0] * sc, v1 = acc[ai][bj][m][1] * sc;
                    if (pn == 12 && bj == 0 && wc < 2 && row < ML) rope8(v0, v1, row, wc & 1, fq, fq * 16 + fr, rope);
                    ss += sq4(v0) + sq4(v1);
                    *(u32x4*)(U + (size_t)row * UC + 256 * pn + 128 * bj + 32 * wc + 8 * fq) = pk8(v0, v1); }
                if (pn < 4) { ss += shx(ss, 16, fq * 16 + fr); ss += shx(ss, 32, fq * 16 + fr); if (fq == 0) ssq[(size_t)row * 16 + pn * 4 + wc] = ss; } }
    }
};
DI float row_rstd(const float* ssq, int row, int which) { const f32x4 a = *(const f32x4*)(ssq + (size_t)row * 16 + which * 8), b = *(const f32x4*)(ssq + (size_t)row * 16 + which * 8 + 4);
    const float s = ((a[0] + a[1]) + (a[2] + a[3])) + ((b[0] + b[1]) + (b[2] + b[3])); return __builtin_amdgcn_rsqf(s * (1.f / 512.f) + EPS); }
struct EpiQ {
    static constexpr bool PERM = true;
    bf16_t* Q; const float* ssq; const f32x2* rope; float scale;
    DI void operator()(AccRef acc, const Unit& u, int wr, int wc, int fr, int fq) const {
        const int rowb = u.pm * 256 + wr * 64 + fr;
#pragma unroll
        for (int ai = 0; ai < 2; ++ai)
#pragma unroll
            for (int m = 0; m < 4; ++m) { const int row = rowb + ai * 128 + m * 16; const float rs = row_rstd(ssq, row, 0) * scale;
#pragma unroll
                for (int bj = 0; bj < 2; ++bj) { const int c32 = 256 * u.pn + 128 * bj + 32 * wc; f32x4 v0 = acc[ai][bj][m][0] * rs, v1 = acc[ai][bj][m][1] * rs;
                    if (((c32 >> 6) % 3) == 2 && row < ML) rope8(v0, v1, row, (c32 >> 5) & 1, fq, fq * 16 + fr, rope);
                    *(u32x4*)(Q + (size_t)row * 1536 + c32 + 8 * fq) = pk8(v0, v1); } }
    }
};
struct EpiKV {
    static constexpr bool PERM = true;
    bf16_t* KN; bf16_t* VT; const float* ssq;
    DI void operator()(AccRef acc, const Unit& u, int wr, int wc, int fr, int fq) const {
        const int pn = u.pn, rowb = u.pm * 256 + wr * 64 + fr;
#pragma unroll
        for (int ai = 0; ai < 2; ++ai)
#pragma unroll
            for (int m = 0; m < 4; ++m) { const int row = rowb + ai * 128 + m * 16; const float rs = row_rstd(ssq, row, 1); int b, key; row_bk(row, b, key);
#pragma unroll
                for (int bj = 0; bj < 2; ++bj) {
                    if (pn < 4) { *(u32x4*)(KN + (size_t)row * 1024 + 256 * pn + 128 * bj + 32 * wc + 8 * fq) = pk8(acc[ai][bj][m][0] * rs, acc[ai][bj][m][1] * rs); }
                    else { const int h = 2 * (pn - 4) + bj;
#pragma unroll
                        for (int n = 0; n < 2; ++n) { bf16_t* dst = VT + ((size_t)((b * 8 + h) * 128 + 32 * wc + 8 * fq + 4 * n)) * KEYS + key;
#pragma unroll
                            for (int j = 0; j < 4; ++j) dst[(size_t)j * KEYS] = f2bf(acc[ai][bj][m][n][j] * rs); } } } }
    }
};
struct EpiY {
    static constexpr bool PERM = true;
    bf16_t* YT; bf16_t* YTc; int tok_base;
    DI void operator()(AccRef acc, const Unit& u, int wr, int wc, int fr, int fq) const {
        const int g = u.pm;
#pragma unroll
        for (int ai = 0; ai < 2; ++ai)
#pragma unroll
            for (int m = 0; m < 4; ++m) { const int d = 64 * wr + 16 * m + fr;
#pragma unroll
                for (int bj = 0; bj < 2; ++bj) { const int tok = tok_base + 256 * u.pn + 128 * bj + 32 * wc + 8 * fq; const u32x4 w = pk8(acc[ai][bj][m][0], acc[ai][bj][m][1]);
                    if (tok < ML) { const int b = tok >> 12, l = tok & 4095; bf16_t* rowp = YT + ((size_t)((b * 4 + g) * 128 + d)) * 4096;
                        if (l < 2048) {
                            if (ai == 0) *(u32x4*)(rowp + l) = w;
                            else if (l != 0) *(u32x4*)(rowp + 2048 + l) = w;
                            else { bf16_t* q = rowp + 2048; q[1] = (bf16_t)(w.x >> 16); q[2] = (bf16_t)w.y; q[3] = (bf16_t)(w.y >> 16); q[4] = (bf16_t)w.z; q[5] = (bf16_t)(w.z >> 16); q[6] = (bf16_t)w.w; q[7] = (bf16_t)(w.w >> 16); }
                        } else if (l == 2048 && ai == 0) rowp[2048] = (bf16_t)w.x;
                    } else { const int tc = tok - ML, b = tc >> 8, l = tc & 255; *(u32x4*)(YTc + ((size_t)((b * 4 + g) * 128 + d)) * 512 + ai * 256 + l) = w; } } }
    }
};
struct SchedY {
    int G, c, i0, start;
    DI void init(int G_, int c_, int start_) { G = G_; c = c_; start = start_; i0 = (start_ > c_) ? (start_ - c_ + G_ - 1) / G_ : 0; }
    DI bool next(int i, Unit& u) const { const int L = (i0 + i) * G + c - start; if (L >= 144) return false; const int bt = L >> 2; u.pm = L & 3; u.pn = (bt / 9) * 16 + (bt % 9); u.kob = 256 * u.pm; return true; }
};
struct EpiF {
    static constexpr bool PERM = true;
    bf16_t* CAT; int ctx;
    DI void operator()(AccRef acc, const Unit& u, int wr, int wc, int fr, int fq) const {
        const int b = u.pn >> 1;
#pragma unroll
        for (int ai = 0; ai < 2; ++ai)
#pragma unroll
            for (int m = 0; m < 4; ++m) { const int lp = u.pm * 256 + 128 * ai + 64 * wr + 16 * m + fr; const int row = ctx ? (ML + b * 256 + lp) : (b * 4096 + lp);
#pragma unroll
                for (int bj = 0; bj < 2; ++bj) { const int g = 2 * (u.pn & 1) + bj;
                    *(u32x4*)(CAT + (size_t)row * D + 1536 + g * 128 + 32 * wc + 8 * fq) = pk8(acc[ai][bj][m][0], acc[ai][bj][m][1]); } }
    }
};
struct EpiRes {
    static constexpr bool PERM = false;
    const float* xl; const float* xc; const bf16_t* xb; bf16_t* out; const float* gate;
    DI void operator()(AccRef acc, const Unit& u, int wr, int wc, int fr, int fq) const {
        const int row0 = u.pm * 256; const int midx = row0 < ML ? (row0 >> 12) : 4;
        const float* src = row0 < ML ? xl : (xc - (size_t)ML * D);
        const float* gp = gate + (size_t)midx * 12288;
        const int col0 = u.pn * 256 + wc * 32 + 4 * fq;
        f32x4 gv[2][2];
#pragma unroll
        for (int bj = 0; bj < 2; ++bj)
#pragma unroll
            for (int n = 0; n < 2; ++n) gv[bj][n] = *(const f32x4*)(gp + col0 + bj * 128 + n * 16);
        if (xb) {
#pragma unroll
            for (int ai = 0; ai < 2; ++ai)
#pragma unroll
                for (int m = 0; m < 4; ++m) { const size_t off = (size_t)(row0 + wr * 64 + fr + ai * 128 + m * 16) * D + col0;
#pragma unroll
                    for (int bj = 0; bj < 2; ++bj)
#pragma unroll
                        for (int n = 0; n < 2; ++n) { const size_t o2 = off + bj * 128 + n * 16;
                            const f32x4 r = bf4(*(const u32x2*)(xb + o2)) + gv[bj][n] * acc[ai][bj][m][n];
                            u32x2 w; w.x = pk2(r[0], r[1]); w.y = pk2(r[2], r[3]); *(u32x2*)(out + o2) = w; }
                    asm volatile("" ::: "memory"); }
        } else {
#pragma unroll
            for (int ai = 0; ai < 2; ++ai)
#pragma unroll
                for (int m = 0; m < 4; ++m) { const size_t off = (size_t)(row0 + wr * 64 + fr + ai * 128 + m * 16) * D + col0;
#pragma unroll
                    for (int bj = 0; bj < 2; ++bj)
#pragma unroll
                        for (int n = 0; n < 2; ++n) { const size_t o2 = off + bj * 128 + n * 16;
                            const f32x4 r = *(const f32x4*)(src + o2) + gv[bj][n] * acc[ai][bj][m][n];
                            u32x2 w; w.x = pk2(r[0], r[1]); w.y = pk2(r[2], r[3]); *(u32x2*)(out + o2) = w; }
                    asm volatile("" ::: "memory"); }
        }
    }
};
DI float dpp_ror1(float v) { return __builtin_bit_cast(float, __builtin_amdgcn_update_dpp(0, __builtin_bit_cast(int, v), 0x121, 0xf, 0xf, false)); }
DI float dpp_ror15(float v) { return __builtin_bit_cast(float, __builtin_amdgcn_update_dpp(0, __builtin_bit_cast(int, v), 0x12f, 0xf, 0xf, false)); }
struct EpiConv {
    static constexpr bool PERM = true;
    bf16_t* ACT; const float* cw; const float* cb; int Mq;
    DI void operator()(AccRef acc, const Unit& u, int wr, int wc, int fr, int fq) const {
#pragma unroll
        for (int n = 0; n < 2; ++n) {
            const int cg_ = 128 * u.pn + 32 * wc + 8 * fq + 4 * n;
#pragma unroll
            for (int ai = 0; ai < 2; ++ai) {
                const int tok0 = 248 * u.pm - 1 + 62 * (2 * ai + wr);
                f32x4 o[4];
#pragma unroll
                for (int bj = 0; bj < 2; ++bj) {
                    f32x4 w[2][4];
#pragma unroll
                    for (int t = 0; t < 3; ++t) w[bj][t] = *(const f32x4*)(cw + (size_t)t * 2 * DFF + bj * DFF + cg_);
                    w[bj][3] = *(const f32x4*)(cb + bj * DFF + cg_);
#pragma unroll
                    for (int m = 0; m < 4; ++m) {
                        const int tok = tok0 + 16 * m + fr; const int msk = tok < ML ? 4095 : 255;
                        const bool hu = (tok & msk) != 0, hd = ((tok + 1) & msk) != 0;
                        f32x4 r = acc[ai][bj][m][n] * w[bj][1] + w[bj][3];
#pragma unroll
                        for (int j = 0; j < 4; ++j) {
                            const float su = (m > 0 && fr == 15) ? acc[ai][bj][(m + 3) & 3][n][j] : acc[ai][bj][m][n][j];
                            const float sd = (m < 3 && fr == 0) ? acc[ai][bj][(m + 1) & 3][n][j] : acc[ai][bj][m][n][j];
                            const float uu = dpp_ror1(su), dd = dpp_ror15(sd);
                            r[j] += hu ? uu * w[bj][0][j] : 0.f; r[j] += hd ? dd * w[bj][2][j] : 0.f; }
                        if (bj == 0) {
#pragma unroll
                            for (int j = 0; j < 4; ++j) o[m][j] = r[j] * __builtin_amdgcn_rcpf(1.f + __builtin_amdgcn_exp2f(-LOG2E * r[j]));
                        } else o[m] = o[m] * r;
                    }
                }
#pragma unroll
                for (int m = 0; m < 4; ++m) { const int li = 16 * m + fr, tok = tok0 + li;
                    if (li >= 1 && li <= 62 && tok < Mq) { u32x2 v; v.x = pk2(o[m][0], o[m][1]); v.y = pk2(o[m][2], o[m][3]);
                        *(u32x2*)(ACT + (size_t)tok * DFF + cg_) = v; } }
            }
        }
    }
};

struct Frame {
    LAS unsigned char* lds; unsigned char* ldsg; int tid, lane, wave, G, vcu;
    const Params& P; unsigned char* ws;
    DI const float* inp(int i) const { return as_global(P.in[i]); }
    DI float* outp() const { return as_global(P.out); }
    DI int nrep(int d) const { int n = 1 + d; asm volatile("" : "+s"(n)); return n; }
    DI void refresh() { int t = threadIdx.x; asm volatile("" : "+v"(t)); tid = t; lane = t & 63; wave = __builtin_amdgcn_readfirstlane(t >> 6);
        long z = 0; asm volatile("" : "+s"(z)); ws = P.ws + z;
        int g = gridDim.x, bx = blockIdx.x; asm volatile("" : "+s"(g), "+s"(bx)); G = g; vcu = (g % 8 == 0) ? (bx % 8) * (g / 8) + bx / 8 : bx; }
};

DI void p_mod(const Frame& F) {
    LAS float* sv = (LAS float*)F.lds; LAS float* red = sv + 5 * 2048;
    const float* c = F.inp(1); const float* cc = F.inp(3);
    for (int i = F.tid; i < 5 * 2048; i += NT) { const int r = i >> 11, k = i & 2047; const float v = r < 4 ? c[r * 2048 + k] : cc[k]; sv[i] = v / (1.f + __expf(-v)); }
    __syncthreads();
    float* mod = (float*)(F.ws + WS_MOD);
    for (int tile = F.vcu; tile < 768; tile += F.G) {
        const int l = tile / 384, colb = (tile % 384) * 32, cl = F.tid & 31, kg = F.tid >> 5;
        const float* w = F.inp(4) + (size_t)l * 2048 * 12288 + colb + cl;
        float a0 = 0.f, a1 = 0.f, a2 = 0.f, a3 = 0.f, a4 = 0.f;
#pragma unroll 16
        for (int k = kg * 128; k < kg * 128 + 128; ++k) { const float wv = __builtin_nontemporal_load(w + (size_t)k * 12288); a0 += sv[k] * wv; a1 += sv[2048 + k] * wv; a2 += sv[4096 + k] * wv; a3 += sv[6144 + k] * wv; a4 += sv[8192 + k] * wv; }
        LAS float* rp = red + (kg * 32 + cl) * 5; rp[0] = a0; rp[1] = a1; rp[2] = a2; rp[3] = a3; rp[4] = a4;
        __syncthreads();
        if (F.tid < 160) { const int r = F.tid >> 5; float s = 0.f;
#pragma unroll
            for (int q = 0; q < 16; ++q) s += red[(q * 32 + cl) * 5 + r];
            mod[(size_t)(l * 5 + r) * 12288 + colb + cl] = s + F.inp(5)[l * 12288 + colb + cl]; }
        __syncthreads();
    }
}
DI void p_tables(const Frame& F) {
    const int gt = F.vcu * NT + F.tid, gn = F.G * NT;
    LAS f32x2* t4096 = (LAS f32x2*)F.lds;
    __syncthreads();
    for (int i = F.tid; i < 4096; i += NT) { f32x2 v; v.x = cospif((float)i / 2048.f); v.y = sinpif((float)i / 2048.f); t4096[i] = v; }
    __syncthreads();
    f32x2* rope = (f32x2*)(F.ws + WS_ROPE);
    for (int i = gt; i < 1024; i += gn) { const int pos = i >> 4, k = i & 15; const float fr = powf(10000.f, -(float)k / 16.f); const float a = (float)pos * fr; f32x2 v; v.x = cosf(a); v.y = sinf(a); rope[i] = v; }
    if (gt < 32) ((unsigned*)(F.ws + WS_CTR))[gt] = 0u;
    if (F.tid == 0) *(float**)(F.ws + WS_CTR + 128) = F.outp();
    bf16_t* dc = (bf16_t*)F.outp() + DO_DFTC;
    for (int i = gt; i < 256 * 512; i += gn) { const int lp = i >> 9, cc = i & 511, part = cc >> 8, l = cc & 255; const f32x2 t = t4096[((lp * l) & 255) * 16];
        dc[i] = f2bf((part ? -t.y : t.x) * (1.f / 16.f)); }
    bf16_t* wc = (bf16_t*)(F.ws + WS_WC); const float* wf = F.inp(14);
    for (int i = gt; i < 2 * 4 * 2 * 128 * 128; i += gn) {
        const int d = i & 127, cch = (i >> 7) & 127, part = (i >> 14) & 1, g = (i >> 15) & 3, l = i >> 17;
        const float* wp = wf + ((size_t)(l * 4 + g) * 128) * 128 + d; float sacc = 0.f;
        for (int c2 = 0; c2 < 128; ++c2) { const f32x2 t = t4096[((cch * c2) & 127) * 32]; sacc += (part ? t.y : t.x) * wp[(size_t)c2 * 128]; }
        sacc *= 0.08838834764831845f;
        bf16_t* row = wc + ((size_t)l * 1024 + (g * 2 + part) * 128 + d) * 256;
        row[cch] = f2bf(sacc); row[128 + cch] = f2bf(part ? -sacc : sacc);
    }
    bf16_t* dft = (bf16_t*)F.outp() + DO_DFT;
    for (int ch = gt; ch < 4096 * 512; ch += gn) { const int lp = ch >> 9, k0 = (ch & 511) * 8; f32x4 a, b;
#pragma unroll
        for (int j = 0; j < 8; ++j) { const int k = k0 + j; const f32x2 t = t4096[(lp * (k & 2047) + (k == 2048 ? lp * 2048 : 0)) & 4095];
            const float v = (k <= 2048 ? t.x : -t.y) * ((k == 0 || k == 2048) ? (1.f / 128.f) : (1.f / 64.f));
            if (j < 4) a[j] = v; else b[j - 4] = v; }
        *(u32x4*)(dft + (size_t)lp * 4096 + k0) = pk8(a, b); }
    __syncthreads();
}
struct CvDesc { const float* src; const float* kscale; bf16_t* dst; int K, Nsrc, Ndst, mapid, ntiles; };
DI int cv_map(int mapid, int n) {
    if (mapid == 1) return n < 1024 ? n : (n < 3072 ? n + 64 : (n < 3136 ? n - 2048 : -1));
    if (mapid == 2) { const int which = n >> 10, h = (n >> 7) & 7, j = n & 127; return h * 256 + which * 128 + j; }
    if (mapid == 3) { const int pn = n >> 8, bj = (n >> 7) & 1, q = n & 127; return bj * DFF + pn * 128 + q; }
    return n;
}
DI CvDesc cv_desc(const Frame& F, int m) {
    const int l = m / 6, j = m % 6; CvDesc d; d.kscale = nullptr; d.mapid = 0;
    if (j == 0) { d.src = F.inp(8) + (size_t)l * D * INC; d.K = D; d.Nsrc = INC; d.dst = (bf16_t*)(F.ws + WS_WIN) + (size_t)l * UC * D; d.Ndst = UC; d.mapid = 1; }
    else if (j == 1) { d.src = F.inp(10) + (size_t)l * 512 * 1536; d.K = 512; d.Nsrc = 1536; d.dst = (bf16_t*)(F.ws + WS_WUQ) + (size_t)l * 1536 * 512; d.Ndst = 1536; d.kscale = F.inp(9) + l * 512; }
    else if (j == 2) { d.src = F.inp(12) + (size_t)l * 512 * 2048; d.K = 512; d.Nsrc = 2048; d.dst = (bf16_t*)(F.ws + WS_WUKV) + (size_t)l * 2048 * 512; d.Ndst = 2048; d.kscale = F.inp(11) + l * 512; d.mapid = 2; }
    else if (j == 3) { d.src = F.inp(15) + (size_t)l * D * D; d.K = D; d.Nsrc = D; d.dst = (bf16_t*)(F.ws + WS_WOUT) + (size_t)l * D * D; d.Ndst = D; }
    else if (j == 4) { d.src = F.inp(16) + (size_t)l * D * 2 * DFF; d.K = D; d.Nsrc = 2 * DFF; d.dst = (bf16_t*)(F.ws + WS_WUP) + (size_t)l * 2 * DFF * D; d.Ndst = 2 * DFF; d.mapid = 3; }
    else { d.src = F.inp(19) + (size_t)l * DFF * D; d.K = DFF; d.Nsrc = D; d.dst = (bf16_t*)(F.ws + WS_WDN) + (size_t)l * D * DFF; d.Ndst = D; }
    d.ntiles = (d.Ndst / 128) * (d.K / 64); return d;
}
struct CvTile { const float* src; const float* kscale; bf16_t* dst; int K, Nsrc, sc0, sc1, n0, k0; bool ok; };
DI CvTile cv_tile(const Frame& F, int t) {
    CvTile r; r.ok = false;
    for (int m = 0; m < 12; ++m) { const CvDesc d = cv_desc(F, m);
        if (t < d.ntiles) { const int ntn = d.Ndst / 128; r.n0 = (t % ntn) * 128; r.k0 = (t / ntn) * 64; r.src = d.src; r.kscale = d.kscale; r.dst = d.dst; r.K = d.K; r.Nsrc = d.Nsrc;
            r.sc0 = cv_map(d.mapid, r.n0); r.sc1 = cv_map(d.mapid, r.n0 + 64); r.ok = true; return r; }
        t -= d.ntiles; }
    return r;
}
DI void cv_load(const Frame& F, const CvTile& t, f32x4 (&r)[4]) {
#pragma unroll
    for (int h = 0; h < 2; ++h) { const int sc = h ? t.sc1 : t.sc0;
#pragma unroll
        for (int p = 0; p < 2; ++p) { const int kk = p * 32 + (F.tid >> 4);
            f32x4 v = {0.f, 0.f, 0.f, 0.f};
            if (sc >= 0) { v = __builtin_nontemporal_load((const f32x4*)(t.src + (size_t)(t.k0 + kk) * t.Nsrc + sc + (F.tid & 15) * 4)); if (t.kscale) v *= t.kscale[t.k0 + kk]; }
            r[h * 2 + p] = v; } }
}
DI void p_convert(const Frame& F) {
    LAS float* ts = (LAS float*)F.lds;
    int t = F.vcu; CvTile cur = cv_tile(F, t); f32x4 r[4]; int buf = 0;
    if (cur.ok) cv_load(F, cur, r);
    while (cur.ok) {
        LAS float* tb = ts + buf * (2 * 64 * 65);
#pragma unroll
        for (int h = 0; h < 2; ++h)
#pragma unroll
            for (int p = 0; p < 2; ++p) { const int kk = p * 32 + (F.tid >> 4); LAS float* q = tb + h * (64 * 65) + kk * 65 + (F.tid & 15) * 4;
                q[0] = r[h * 2 + p][0]; q[1] = r[h * 2 + p][1]; q[2] = r[h * 2 + p][2]; q[3] = r[h * 2 + p][3]; }
        __syncthreads();
        const CvTile nxt = cv_tile(F, t + F.G);
        if (nxt.ok) cv_load(F, nxt, r);
#pragma unroll
        for (int h = 0; h < 2; ++h) { const int n = F.tid >> 3, kc = F.tid & 7; const LAS float* q = tb + h * (64 * 65) + n; f32x4 a, b;
#pragma unroll
            for (int j = 0; j < 4; ++j) { a[j] = q[(kc * 8 + j) * 65]; b[j] = q[(kc * 8 + 4 + j) * 65]; }
            *(u32x4*)(cur.dst + (size_t)(cur.n0 + h * 64 + n) * cur.K + cur.k0 + kc * 8) = pk8(a, b); }
        buf ^= 1; t += F.G; cur = nxt;
    }
    __syncthreads();
}

DI void norm_phase(const Frame& F, const float* xl, const float* xc, const bf16_t* xb, int M, const float* g, const float* modl, int sh_off, int sc_off, bf16_t* H, float* outf) {
    const int gw = F.vcu * 8 + F.wave, nw = F.G * 8;
    for (int row = gw; row < M; row += nw) {
        f32x4 v[8]; float ss = 0.f;
        if (xb) {
#pragma unroll
            for (int i = 0; i < 4; ++i) { const u32x4 w = *(const u32x4*)(xb + (size_t)row * D + i * 512 + F.lane * 8); v[2 * i] = bf4((u32x2){w.x, w.y}); v[2 * i + 1] = bf4((u32x2){w.z, w.w}); ss += sq4(v[2 * i]) + sq4(v[2 * i + 1]); }
        } else { const float* xr = row < ML ? xl + (size_t)row * D : xc + (size_t)(row - ML) * D;
#pragma unroll
            for (int i = 0; i < 4; ++i) { v[2 * i] = *(const f32x4*)(xr + i * 512 + F.lane * 8); v[2 * i + 1] = *(const f32x4*)(xr + i * 512 + F.lane * 8 + 4); ss += sq4(v[2 * i]) + sq4(v[2 * i + 1]); } }
#pragma unroll
        for (int o = 32; o >= 1; o >>= 1) ss += shx(ss, o, F.lane);
        const float rs = __builtin_amdgcn_rsqf(ss * (1.f / 2048.f) + EPS);
        const int midx = row < ML ? (row >> 12) : 4;
#pragma unroll
        for (int i = 0; i < 4; ++i) { const int col = i * 512 + F.lane * 8;
            const f32x4 g0 = *(const f32x4*)(g + col), g1 = *(const f32x4*)(g + col + 4);
            if (outf) { *(f32x4*)(outf + (size_t)row * D + col) = v[2 * i] * rs * g0; *(f32x4*)(outf + (size_t)row * D + col + 4) = v[2 * i + 1] * rs * g1; }
            else { const float* mp = modl + (size_t)midx * 12288 + col;
                const f32x4 s0 = *(const f32x4*)(mp + sc_off), s1 = *(const f32x4*)(mp + sc_off + 4), h0 = *(const f32x4*)(mp + sh_off), h1 = *(const f32x4*)(mp + sh_off + 4);
                *(u32x4*)(H + (size_t)row * D + col) = pk8(v[2 * i] * rs * g0 * (1.f + s0) + h0, v[2 * i + 1] * rs * g1 * (1.f + s1) + h1); } }
    }
}

struct AttnItem {
    const bf16_t* q; const bf16_t* kn; const bf16_t* kr; const bf16_t* vt; bf16_t* o;
    int ldq, ldk, ldo, lat_row0, ctx_row0, t0, ntl, nctx, mode, r0, hn;
};
template <int DQ>
DI void attn_item(const Frame& F, const AttnItem& it, const LAS float* rpb_lds) {
    constexpr int KP = DQ + 8, VP = 72, KS = DQ / 16;
    constexpr int KBYTES = 64 * KP * 2, VBYTES = 128 * VP * 2;
    LAS unsigned char* base = F.lds;
    int tid = threadIdx.x; asm volatile("" : "+v"(tid));
    const int lane = tid & 63, w = __builtin_amdgcn_readfirstlane(tid >> 6), qq = lane & 31, hh = lane >> 5;
    const bool grpB = w >= 4;
    const int ntile = it.ntl + it.nctx;
    u32x4 rk[2], rr, rv[2];
    auto gload = [&](int ti) {
        int rowb, vcol;
        if (ti < it.ntl) { const int kt = it.t0 + ti; rowb = it.lat_row0 + kt * 64; vcol = kt * 64; } else { const int j = ti - it.ntl; rowb = it.ctx_row0 + j * 64; vcol = SEQ + j * 64; }
#pragma unroll
        for (int i = 0; i < 2; ++i) { const int id = tid + i * NT; rk[i] = *(const u32x4*)(it.kn + (size_t)(rowb + (id >> 4)) * it.ldk + (id & 15) * 8);
            rv[i] = *(const u32x4*)(it.vt + (size_t)(id >> 3) * KEYS + vcol + (id & 7) * 8); }
        if (DQ == 192) rr = *(const u32x4*)(it.kr + (size_t)(rowb + (tid >> 3)) * UC + (tid & 7) * 8);
    };
    auto lstore = [&](int ti) {
        LAS unsigned char* kb = base + (ti & 1) * KBYTES; LAS unsigned char* vb = base + 2 * KBYTES + (ti % 3) * VBYTES;
#pragma unroll
        for (int i = 0; i < 2; ++i) { const int id = tid + i * NT; *(LAS u32x4*)(kb + ((id >> 4) * KP + (id & 15) * 8) * 2) = rk[i];
            *(LAS u32x4*)(vb + ((id >> 3) * VP + (id & 7) * 8) * 2) = rv[i]; }
        if (DQ == 192) *(LAS u32x4*)(kb + ((tid >> 3) * KP + 128 + (tid & 7) * 8) * 2) = rr;
    };
    bf16x8 qf[KS];
    { const bf16_t* qp = it.q + (size_t)(32 * w + qq) * it.ldq + 8 * hh;
#pragma unroll
        for (int ks = 0; ks < KS; ++ks) qf[ks] = *(const bf16x8*)(qp + 16 * ks); }
    f32x16 o[4];
#pragma unroll
    for (int db = 0; db < 4; ++db)
#pragma unroll
        for (int i = 0; i < 16; ++i) o[db][i] = 0.f;
    f32x16 s[2];
    float mrun = -INFINITY, lrun = 0.f;
    const int r = it.r0 + (w >> 1), wq = 32 * (w & 1) + qq;
    const int rs = min(max(r - 4, 0), 56), cs = min(max(wq - 8, 0), 48);
    auto active = [&](int ti) { const int krow = it.t0 + ti; return !(it.mode == 1 && ti < it.ntl && (krow < rs || krow > rs + 7)); };
    auto qk = [&](int ti) {
        if (!active(ti)) return;
        const int krow_l = (qq & 3) + 4 * ((qq >> 3) & 1) + 8 * ((qq >> 2) & 1) + 16 * (qq >> 4);
        LAS unsigned char* kb = base + (ti & 1) * KBYTES + (krow_l * KP + 8 * hh) * 2;
#pragma unroll
        for (int blk = 0; blk < 2; ++blk)
#pragma unroll
            for (int i = 0; i < 16; ++i) s[blk][i] = 0.f;
        bf16x8 kf[3][2];
#pragma unroll
        for (int p = 0; p < 2; ++p)
#pragma unroll
            for (int blk = 0; blk < 2; ++blk) kf[p][blk] = *(const LAS bf16x8*)(kb + (32 * blk * KP + 16 * p) * 2);
#pragma unroll
        for (int ks = 0; ks < KS; ++ks) {
            if (ks + 2 < KS) {
#pragma unroll
                for (int blk = 0; blk < 2; ++blk) kf[(ks + 2) % 3][blk] = *(const LAS bf16x8*)(kb + (32 * blk * KP + 16 * (ks + 2)) * 2); }
            __builtin_amdgcn_sched_barrier(0);
#pragma unroll
            for (int blk = 0; blk < 2; ++blk) s[blk] = __builtin_amdgcn_mfma_f32_32x32x16_bf16(kf[ks % 3][blk], qf[ks], s[blk], 0, 0, 0);
            __builtin_amdgcn_sched_barrier(0);
        }
    };
    auto smpv = [&](int ti) {
        if (!active(ti)) return;
        LAS unsigned char* vb = base + 2 * KBYTES + (ti % 3) * VBYTES;
        if (it.mode == 1 && ti < it.ntl) {
            const int krow = it.t0 + ti;
            const LAS float* bp = rpb_lds + it.hn * 465 + (krow - r + 7) * 31 - wq + 15;
#pragma unroll
            for (int blk = 0; blk < 2; ++blk)
#pragma unroll
                for (int i = 0; i < 16; ++i) { const int kc = 32 * blk + (i & 3) + 4 * ((i >> 2) & 1) + 8 * hh + 16 * (i >> 3); const bool ok = kc >= cs && kc < cs + 16;
                    const int kcc = ok ? kc : cs; s[blk][i] = ok ? s[blk][i] + bp[kcc] : -INFINITY; }
        }
        float mx = s[0][0];
#pragma unroll
        for (int blk = 0; blk < 2; ++blk)
#pragma unroll
            for (int i = 0; i < 16; ++i) mx = fmaxf(mx, s[blk][i]);
        mx = fmaxf(mx, shx(mx, 32, lane));
        const float mnew = fmaxf(mrun, mx), alpha = __builtin_amdgcn_exp2f(mrun - mnew);
        mrun = mnew;
        float ps = 0.f;
#pragma unroll
        for (int blk = 0; blk < 2; ++blk)
#pragma unroll
            for (int i = 0; i < 16; ++i) { const float p = __builtin_amdgcn_exp2f(s[blk][i] - mnew); s[blk][i] = p; ps += p; }
        lrun = lrun * alpha + ps;
        if (__builtin_amdgcn_ballot_w64(alpha != 1.f) != 0ull) {
#pragma unroll
            for (int db = 0; db < 4; ++db)
#pragma unroll
                for (int i = 0; i < 16; ++i) o[db][i] *= alpha;
        }
        LAS unsigned char* vq = vb + (qq * VP + 8 * hh) * 2;
        auto vload = [&](int step, int db) { return *(const LAS bf16x8*)(vq + (32 * db * VP + 16 * step) * 2); };
        bf16x8 vf[2][4];
#pragma unroll
        for (int db = 0; db < 4; ++db) vf[0][db] = vload(0, db);
#pragma unroll
        for (int st = 0; st < 4; ++st) {
            if (st + 1 < 4) {
#pragma unroll
                for (int db = 0; db < 4; ++db) vf[(st + 1) & 1][db] = vload(st + 1, db); }
            __builtin_amdgcn_sched_barrier(0);
            const int blk = st >> 1, s2 = st & 1;
            u32x4 pw; pw.x = pk2(s[blk][8 * s2], s[blk][8 * s2 + 1]); pw.y = pk2(s[blk][8 * s2 + 2], s[blk][8 * s2 + 3]);
            pw.z = pk2(s[blk][8 * s2 + 4], s[blk][8 * s2 + 5]); pw.w = pk2(s[blk][8 * s2 + 6], s[blk][8 * s2 + 7]);
            const bf16x8 pf = __builtin_bit_cast(bf16x8, pw);
#pragma unroll
            for (int db = 0; db < 4; ++db) o[db] = __builtin_amdgcn_mfma_f32_32x32x16_bf16(vf[st & 1][db], pf, o[db], 0, 0, 0);
            __builtin_amdgcn_sched_barrier(0);
        }
    };

    __syncthreads();
    gload(0); lstore(0);
    if (ntile > 1) gload(1);
    __syncthreads();
    for (int ti = 0; ti < ntile; ++ti) {
        qk(ti);
        if (grpB) { if (ti + 1 < ntile) lstore(ti + 1); if (ti + 2 < ntile) gload(ti + 2); __syncthreads(); }
        smpv(ti);
        if (!grpB) { if (ti + 1 < ntile) lstore(ti + 1); if (ti + 2 < ntile) gload(ti + 2); __syncthreads(); }
    }
    const float lt = lrun + shx(lrun, 32, lane), inv = 1.f / lt;
    bf16_t* op = it.o + (size_t)(32 * w + qq) * it.ldo + 4 * hh;
#pragma unroll
    for (int db = 0; db < 4; ++db)
#pragma unroll
        for (int ig = 0; ig < 4; ++ig) { u32x2 v; v.x = pk2(o[db][4 * ig] * inv, o[db][4 * ig + 1] * inv); v.y = pk2(o[db][4 * ig + 2] * inv, o[db][4 * ig + 3] * inv);
            *(u32x2*)(op + 32 * db + 8 * ig) = v; }
}

#ifndef MLAREP
#define MLAREP 1
#endif
DI void mixer_attention(const Frame& F, int layer, int cidx) {
    const int nitems = (layer == 0 ? 816 : 768) + 512 * (MLAREP - 1);
    bf16_t* U = (bf16_t*)(F.ws + WS_U); bf16_t* Q = (bf16_t*)(F.ws + WS_Q); bf16_t* KN = (bf16_t*)(F.ws + WS_KN);
    bf16_t* VT = (bf16_t*)(F.ws + WS_VT); bf16_t* VNT = (bf16_t*)(F.ws + WS_VNT); bf16_t* CAT = (bf16_t*)(F.ws + WS_CAT);
    unsigned* ctr = (unsigned*)(F.ws + WS_CTR) + cidx;
    LAS float* rpb = (LAS float*)(F.lds + 112 * 1024);
    volatile LAS int* slot = (volatile LAS int*)(F.lds + 112 * 1024 + 8192);
    __syncthreads();
    for (int i = F.tid; i < 4 * 465; i += NT) rpb[i] = F.inp(13)[layer * 4 * 465 + i] * LOG2E;
    for (int step = 0;; ++step) {
        int idx;
        if (step < 2) idx = F.vcu + 256 * step;
        else {
            __syncthreads();
            if (F.tid == 0) *slot = (int)atomicAdd(ctr, 1u);
            __syncthreads();
            idx = 512 + *slot;
        }
        if (idx >= nitems) break;
        AttnItem it; it.kr = nullptr; it.mode = 0; it.r0 = 0; it.hn = 0; it.nctx = 4;
        if (idx < 512 || (idx >= 768 && idx < 800)) {
            int b, h, row0;
            if (idx < 512) { b = idx >> 7; h = (idx >> 4) & 7; row0 = b * 4096 + (idx & 15) * 256; it.t0 = 0; it.ntl = 64; }
            else { const int j = idx - 768; b = j >> 3; h = j & 7; row0 = ML + b * 256; it.t0 = 0; it.ntl = 0; }
            it.q = Q + (size_t)row0 * 1536 + h * 192; it.ldq = 1536;
            it.kn = KN + h * 128; it.ldk = 1024; it.kr = U + U_KR;
            it.vt = VT + (size_t)(b * 8 + h) * 128 * KEYS;
            it.o = CAT + (size_t)row0 * D + h * 128; it.ldo = D;
            it.lat_row0 = b * 4096; it.ctx_row0 = ML + b * 256;
            attn_item<192>(F, it, rpb);
        } else {
            int b, hn, row0;
            if (idx < 768) { const int j = idx - 512; b = j >> 6; hn = (j >> 4) & 3; const int R = j & 15; row0 = b * 4096 + R * 256;
                const int rlo = max(4 * R - 4, 0), rhi = min(max(4 * R - 1, 0), 56) + 7; it.t0 = rlo; it.ntl = rhi - rlo + 1; it.mode = 1; it.r0 = 4 * R; it.hn = hn; }
            else { const int j = idx - 800; b = j >> 2; hn = j & 3; row0 = ML + b * 256; it.t0 = 0; it.ntl = 0; }
            it.q = U + (size_t)row0 * UC + U_QN + hn * 128; it.ldq = UC;
            it.kn = U + U_KN + hn * 128; it.ldk = UC;
            it.vt = VNT + (size_t)(b * 4 + hn) * 128 * KEYS;
            it.o = CAT + (size_t)row0 * D + 1024 + hn * 128; it.ldo = D;
            it.lat_row0 = b * 4096; it.ctx_row0 = ML + b * 256;
            attn_item<128>(F, it, rpb);
        }
    }
}

#ifndef PHMASK
#define PHMASK 0x7ff
#endif
#define PH(k) (((PHMASK) >> (k)) & 1)
#ifndef DUPMASK
#define DUPMASK 0x000
#endif
#define REP(k) for (int rep_ = 0, nrep_ = F.nrep((DUPMASK >> (k)) & 1); rep_ < nrep_; ++rep_)
#define Hbuf ((bf16_t*)(F.ws + WS_H))
#define H (Hbuf + D)
#define X ((bf16_t*)(F.ws + WS_X))
#define U ((bf16_t*)(F.ws + WS_U))
#define SSQ ((float*)(F.ws + WS_SSQ))
#define CAT ((bf16_t*)(F.ws + WS_CAT))
#define mod ((const float*)(F.ws + WS_MOD))
#define rope ((const f32x2*)(F.ws + WS_ROPE))
#define GSYNC() do { grid.sync(); F.refresh(); } while (0)
DI void layer_body(Frame& F, cg::grid_group& grid, const int l) {
        const int Mq = l == 0 ? MT : ML;
#define modl (mod + (size_t)l * 5 * 12288)
#define xbl (l == 0 ? (const bf16_t*)nullptr : (const bf16_t*)X)
        REP(1) {
        if (PH(1)) norm_phase(F, F.inp(0), F.inp(2), xbl, MT, F.inp(6) + l * D, modl, 0, 2048, H, nullptr);
        GSYNC(); }
        REP(2) {
        { pg8::Gemm g{H, (const bf16_t*)(F.ws + WS_WIN) + (size_t)l * UC * D, D, D, D, 0};
          pg8::Sched S; S.init(MT / 256, UC / 256, F.G, F.vcu, 0);
          EpiU E{U, SSQ, (bf16_t*)(F.ws + WS_VNT), rope, 0.08838834764831845f * LOG2E, (bf16_t*)F.outp() + DO_FF};
          if (PH(2)) pg8::gemm_phase(F.lds, g, S, E); }
        GSYNC(); }
        REP(3) {
        { int start = 0;
          { pg8::Gemm g{U + U_CQ, (const bf16_t*)(F.ws + WS_WUQ) + (size_t)l * 1536 * 512, UC, 512, 512, 0};
            pg8::Sched S; S.init(Mq / 256, 6, F.G, F.vcu, start); start += (Mq / 256) * 6;
            EpiQ E{(bf16_t*)(F.ws + WS_Q), SSQ, rope, 0.07216878364870323f * LOG2E};
            if (PH(3)) pg8::gemm_phase(F.lds, g, S, E); }
          { pg8::Gemm g{U + U_CKV, (const bf16_t*)(F.ws + WS_WUKV) + (size_t)l * 2048 * 512, UC, 512, 512, 0};
            pg8::Sched S; S.init(MT / 256, 8, F.G, F.vcu, start); start += (MT / 256) * 8;
            EpiKV E{(bf16_t*)(F.ws + WS_KN), (bf16_t*)(F.ws + WS_VT), SSQ};
            if (PH(4)) pg8::gemm_phase(F.lds, g, S, E); }
          { pg8::Gemm g{(const bf16_t*)(F.ws + WS_WC) + (size_t)l * 1024 * 256, (const bf16_t*)F.outp() + DO_FF, 256, 1024, 256, 0};
            SchedY S; S.init(F.G, F.vcu, start); start += 144;
            EpiY E{(bf16_t*)(F.ws + WS_YT), (bf16_t*)(F.ws + WS_YTC), 0};
            if (PH(5)) pg8::gemm_phase(F.lds, g, S, E); }
          if (l == 0) { pg8::Gemm g{(const bf16_t*)(F.ws + WS_WC) + (size_t)l * 1024 * 256, (const bf16_t*)F.outp() + DO_FF + (size_t)ML * 1024, 256, 1024, 256, 0};
            pg8::Sched S; S.init(4, MC / 256, F.G, F.vcu, start); S.kobm = 256;
            EpiY E{(bf16_t*)(F.ws + WS_YT), (bf16_t*)(F.ws + WS_YTC), ML};
            if (PH(5)) pg8::gemm_phase(F.lds, g, S, E); } }
        GSYNC(); }
        REP(7) {
        if (F.vcu < 128 || (l == 0 && F.vcu < 136)) {
            const bool cx = F.vcu >= 128; const int ld = cx ? 512 : 4096;
            long zo = 0; asm volatile("" : "+s"(zo)); const bf16_t* dftp = (const bf16_t*)F.P.out + zo;
            pg8::Gemm g{dftp + (cx ? DO_DFTC : DO_DFT), (const bf16_t*)(F.ws + (cx ? WS_YTC : WS_YT)), ld, ld, ld, 0};
            pg8::OneUnit S; S.u.pm = cx ? 0 : (F.vcu & 15); S.u.pn = cx ? (F.vcu - 128) : (F.vcu >> 4); S.u.kob = 0; S.has = true;
            EpiF E{CAT, cx ? 1 : 0}; if (PH(6)) pg8::gemm_phase(F.lds, g, S, E); }
        if (PH(7)) mixer_attention(F, l, l + 2 * rep_);
        GSYNC(); }
        REP(8) {
        { pg8::Gemm g{CAT, (const bf16_t*)(F.ws + WS_WOUT) + (size_t)l * D * D, D, D, D, 0};
          pg8::Sched S; S.init(Mq / 256, 8, F.G, F.vcu, 0);
          EpiRes E{F.inp(0), F.inp(2), xbl, X, modl + 4096};
          if (PH(8)) pg8::gemm_phase(F.lds, g, S, E); }
        GSYNC(); }
        REP(4) {
        if (PH(1)) norm_phase(F, nullptr, nullptr, X, Mq, F.inp(7) + l * D, modl, 6144, 8192, H, nullptr);
        GSYNC(); }
        REP(10) {
        { pg8::Gemm g{Hbuf, (const bf16_t*)(F.ws + WS_WUP) + (size_t)l * 2 * DFF * D, D, D, D, 1};
          pg8::Sched S; S.init((Mq + 247) / 248, 44, F.G, F.vcu, 0);
          EpiConv E{(bf16_t*)(F.ws + WS_ACT), F.inp(17) + (size_t)l * 3 * 2 * DFF, F.inp(18) + (size_t)l * 2 * DFF, Mq};
          if (PH(10)) pg8::gemm_phase(F.lds, g, S, E); }
        GSYNC(); }
        { pg8::Gemm g{(const bf16_t*)(F.ws + WS_ACT), (const bf16_t*)(F.ws + WS_WDN) + (size_t)l * D * DFF, DFF, DFF, DFF, 0};
          pg8::Sched S; S.init(Mq / 256, 8, F.G, F.vcu, 0);
          EpiRes E{nullptr, nullptr, X, X, modl + 10240};
          if (PH(9)) pg8::gemm_phase(F.lds, g, S, E); }
        GSYNC();

}

__global__ void __launch_bounds__(NT) fwd_megakernel(Params p) {
    extern __shared__ __attribute__((aligned(16))) unsigned char lds_raw[];
    cg::grid_group grid = cg::this_grid();
    const int tid_ = threadIdx.x, G_ = gridDim.x, bx_ = blockIdx.x;
    Frame F{(LAS unsigned char*)lds_raw, lds_raw, tid_, tid_ & 63, __builtin_amdgcn_readfirstlane(tid_ >> 6), G_, (G_ % 8 == 0) ? (bx_ % 8) * (G_ / 8) + bx_ / 8 : bx_, p, p.ws};
    REP(0) { if (PH(0)) { p_mod(F);
    p_tables(F);
    p_convert(F); }
    GSYNC(); }

    for (int l = 0; l < 2; ++l) layer_body(F, grid, l);
    if (PH(1)) norm_phase(F, nullptr, nullptr, X, ML, F.inp(20), nullptr, 0, 0, nullptr, F.outp());
}
#undef Hbuf
#undef H
#undef X
#undef U
#undef SSQ
#undef CAT
#undef mod
#undef rope
#undef modl
#undef xbl


extern "C" void kernel_launch(void* const* d_in, const int* in_sizes, int n_in, void* d_out, int out_size, void* d_ws, size_t ws_size, hipStream_t stream) {
    static int grid_blocks = 0;
    if (!grid_blocks) {
        int dev = 0, cus = 0, per_cu = 0;
        hipGetDevice(&dev);
        hipDeviceGetAttribute(&cus, hipDeviceAttributeMultiprocessorCount, dev);
        hipFuncSetAttribute((const void*)fwd_megakernel, hipFuncAttributeMaxDynamicSharedMemorySize, LDS_BYTES);
        hipOccupancyMaxActiveBlocksPerMultiprocessor(&per_cu, (const void*)fwd_megakernel, NT, LDS_BYTES);
        if (per_cu < 1) { fprintf(stderr, "occupancy query says %d blocks/CU\n", per_cu); per_cu = 1; }
        grid_blocks = cus;
        if (ws_size < WS_END) fprintf(stderr, "workspace too small: %zu < %zu\n", ws_size, (size_t)WS_END);
    }
    Params p{};
    for (int i = 0; i < 21; ++i) p.in[i] = (const float*)d_in[i];
    p.out = (float*)d_out; p.ws = (unsigned char*)d_ws;
    void* args[] = {&p};
    hipError_t e = hipLaunchCooperativeKernel((const void*)fwd_megakernel, dim3(grid_blocks), dim3(NT), args, LDS_BYTES, stream);
    if (e != hipSuccess) fprintf(stderr, "cooperative launch failed: %s (grid %d)\n", hipGetErrorString(e), grid_blocks);
}
```

```cpp
#include <hip/hip_runtime.h>
#include <hip/hip_cooperative_groups.h>
#include <cstdio>
namespace cg = cooperative_groups;

#define LAS __attribute__((address_space(3)))
#define GAS __attribute__((address_space(1)))
template <class T> __device__ __forceinline__ T* as_global(T* p) { return p; }
#define DI __device__ __forceinline__
typedef unsigned short bf16_t;
typedef short bf16x8 __attribute__((ext_vector_type(8)));
typedef short s16x4 __attribute__((ext_vector_type(4)));
typedef float f32x4 __attribute__((ext_vector_type(4)));
typedef float f32x2 __attribute__((ext_vector_type(2)));
typedef float f32x16 __attribute__((ext_vector_type(16)));
typedef unsigned u32x4 __attribute__((ext_vector_type(4)));
typedef unsigned u32x2 __attribute__((ext_vector_type(2)));
typedef __bf16 bfv2 __attribute__((ext_vector_type(2)));

constexpr int D = 2048, NB = 4, SEQ = 4096, CTXL = 256, ML = NB * SEQ, MC = NB * CTXL, MT = ML + MC;
constexpr int INC = 3136, UC = 3328;
constexpr int U_CQ = 0, U_CKV = 512, U_QN = 1024, U_KN = 1536, U_VN = 2048, U_F = 2560, U_KR = 3072;
constexpr int DFF = 5632, KEYS = SEQ + CTXL;
constexpr size_t DO_DFT = 0, DO_DFTC = (size_t)4096 * 4096, DO_FF = DO_DFTC + 256 * 512;
static_assert((DO_FF + (size_t)(ML + MC) * 1024) * 2 <= (size_t)ML * 2048 * 4, "d_out scratch");
constexpr float EPS = 1e-6f, LOG2E = 1.4426950408889634f;
constexpr int NT = 512;
constexpr int LDS_BYTES = 136 * 1024;

constexpr size_t al(size_t x) { return (x + 255) & ~(size_t)255; }
constexpr size_t WS_WIN = 0;
constexpr size_t WS_WUQ = WS_WIN + al((size_t)2 * UC * D * 2);
constexpr size_t WS_WUKV = WS_WUQ + al((size_t)2 * 1536 * 512 * 2);
constexpr size_t WS_WOUT = WS_WUKV + al((size_t)2 * 4096 * 512 * 2);
constexpr size_t WS_WUP = WS_WOUT + al((size_t)2 * D * D * 2);
constexpr size_t WS_WDN = WS_WUP + al((size_t)2 * 2 * DFF * D * 2);
constexpr size_t WS_WC = WS_WDN + al((size_t)2 * D * DFF * 2);
constexpr size_t WS_DFTC = WS_WC + al((size_t)2 * 1024 * 1024 * 2);
constexpr size_t WS_TRIG = WS_DFTC + al((size_t)256 * 512 * 2);
constexpr size_t WS_ROPE = WS_TRIG + al(4096 * 8);
constexpr size_t WS_MOD = WS_ROPE + al(64 * 16 * 8);
constexpr size_t WS_CTR = WS_MOD + al((size_t)2 * 5 * 12288 * 4);
constexpr size_t WS_BAR = WS_CTR + 256;
constexpr size_t WS_X = WS_BAR + 16384;
constexpr size_t WS_H = WS_X + al((size_t)MT * D * 4);
constexpr size_t H_ROWS = 1 + MT + 256;
constexpr size_t WS_CAT = WS_H + al(H_ROWS * D * 2);
constexpr size_t WS_YTC = WS_CAT + al((size_t)MT * D * 2);
constexpr size_t WS_U = WS_YTC + al((size_t)2048 * 512 * 2);
constexpr size_t WS_SSQ = WS_U + al((size_t)MT * UC * 2);
constexpr size_t WS_Q = WS_SSQ + al((size_t)MT * 16 * 4);
constexpr size_t WS_KN = WS_Q + al((size_t)MT * 1536 * 2);
constexpr size_t WS_VT = WS_KN + al((size_t)MT * 1024 * 2);
constexpr size_t WS_VNT = WS_VT + al((size_t)32 * 128 * KEYS * 2);
constexpr size_t WS_YT = WS_VNT + al((size_t)16 * 128 * KEYS * 2);
constexpr size_t WS_END = WS_YT + al((size_t)2048 * 8192 * 2);
constexpr size_t WS_ACT = WS_U;
static_assert(WS_ACT + (size_t)MT * DFF * 2 <= WS_END, "ACT alias");
static_assert((size_t)4096 * 8192 * 2 <= H_ROWS * D * 2, "DFT alias");
static_assert(WS_END <= (size_t)805306368, "workspace");

struct Params { const float* in[21]; float* out; unsigned char* ws; };

DI unsigned pk2(float a, float b) { f32x2 v = {a, b}; bfv2 r = __builtin_convertvector(v, bfv2); return __builtin_bit_cast(unsigned, r); }
DI bf16_t f2bf(float a) { return (bf16_t)(pk2(a, 0.f) & 0xffffu); }
DI float shx(float v, int m, int lane) { return __builtin_bit_cast(float, __builtin_amdgcn_ds_bpermute((lane ^ m) << 2, __builtin_bit_cast(int, v))); }
DI f32x4 bf4(u32x2 w) { f32x4 r; r[0] = __builtin_bit_cast(float, w.x << 16); r[1] = __builtin_bit_cast(float, w.x & 0xffff0000u); r[2] = __builtin_bit_cast(float, w.y << 16); r[3] = __builtin_bit_cast(float, w.y & 0xffff0000u); return r; }
DI float sq4(f32x4 v) { return (v[0] * v[0] + v[1] * v[1]) + (v[2] * v[2] + v[3] * v[3]); }
DI u32x4 pk8(f32x4 a, f32x4 b) { u32x4 w; w.x = pk2(a[0], a[1]); w.y = pk2(a[2], a[3]); w.z = pk2(b[0], b[1]); w.w = pk2(b[2], b[3]); return w; }

namespace pg8 {
constexpr int BM = 256, BK = 64, HALF = 128, HTB = HALF * BK * 2, STAGE_BYTES = 8 * HTB;
DI int lds_byte(int r, int c) { const int st = (r >> 4) * 2 + (c >> 5), rr = r & 15, cc = c & 31, ob = rr * 64 + cc * 2; return st * 1024 + (ob ^ (((ob >> 9) & 1) << 5)); }
DI void stage_rc(int b, int& R, int& C) { const int st = b / 1024, sb = b % 1024, swz = sb ^ (((sb >> 9) & 1) << 5); R = (st >> 1) * 16 + swz / 64; C = (st & 1) * 32 + (swz % 64) / 2; }
DI int perm32(int rho) { const int n = rho >> 4, i = rho & 15; return 8 * (i >> 2) + 4 * n + (i & 3); }
struct Unit { int pm, pn, kob; };
struct Gemm { const bf16_t* A; const bf16_t* Bt; int lda, ldb, K; int conv; };

struct Sched {
    int nM, nN, cnt, G, c, i0, start, kobm = 0;
    DI void init(int nM_, int nN_, int G_, int c_, int start_) { nM = nM_; nN = nN_; cnt = nM * nN; G = G_; c = c_; start = start_;
        i0 = (start_ > c_) ? (start_ - c_ + G_ - 1) / G_ : 0; }
    DI bool next(int i, Unit& u) const {
        const long L = (long)(i0 + i) * G + c - start; if (L >= cnt) return false;
        const int w = (int)L, nig = 8 * nN, gid = w / nig, fm = gid * 8, gsz = (nM - fm) < 8 ? (nM - fm) : 8;
        u.pm = fm + ((w % nig) % gsz); u.pn = (w % nig) / gsz; u.kob = kobm * u.pm; return true;
    }
};
struct OneUnit { Unit u; bool has; DI bool next(int i, Unit& o) const { o = u; return has && i == 0; } };

template <class Epi, class SchedT>
DI void gemm_phase(LAS unsigned char* lds, const Gemm g, const SchedT& S, const Epi& E) {
    int tid = threadIdx.x; asm volatile("" : "+v"(tid));
    const int wid = __builtin_amdgcn_readfirstlane(tid >> 6), lane = tid & 63, wr = wid >> 2, wc = wid & 3, fr = lane & 15, fq = lane >> 4;
    const int K = g.K, nt = K / BK;
    unsigned voffA[2], voffB[2];
    auto mk_voff = [&]() { int t2 = threadIdx.x; asm volatile("" : "+v"(t2));
#pragma unroll
        for (int i = 0; i < 2; ++i) { int R, C; stage_rc(t2 * 16 + i * 8192, R, C); const int Rb = Epi::PERM ? ((R & ~31) + perm32(R & 31)) : R;
            const int Ra = g.conv ? ((R >> 6) * 62 + (R & 63)) : R;
            voffA[i] = (unsigned)(Ra * g.lda + C) * 2u; voffB[i] = (unsigned)(Rb * g.ldb + C) * 2u; } };
    mk_voff();
    const size_t kstep = (size_t)(BK * 2);
    const size_t hstepA = (size_t)(g.conv ? 124 : HALF) * g.lda * 2, hstepB = (size_t)HALF * g.ldb * 2;
    const size_t tstepA = 2 * hstepA, tstepB = 2 * hstepB;
    const unsigned ldsw = (unsigned)wid * 1024u;
    const int aoff = lds_byte(wr * 64 + fr, fq * 8), boff = lds_byte(wc * 32 + fr, fq * 8);
#define PG8_SA(b, h) (((b) * 2 + (h)) * HTB)
#define PG8_SB(b, h) ((4 + (b) * 2 + (h)) * HTB)
#define PG8_STAGE(bufoff, gbase, voff) do { _Pragma("unroll") for (int _i = 0; _i < 2; ++_i) \
        __builtin_amdgcn_global_load_lds((const unsigned*)((const char*)(gbase) + (voff)[_i]), (LAS unsigned*)(lds + (bufoff) + ldsw + _i * 8192), 16, 0, 0); } while (0)
#define PG8_LDA(dst, b, h) do { _Pragma("unroll") for (int m = 0; m < 4; ++m) _Pragma("unroll") for (int k = 0; k < 2; ++k) dst[m][k] = *(const LAS bf16x8*)(lds + PG8_SA(b, h) + aoff + m * 2048 + k * 1024); } while (0)
#define PG8_LDB(dst, b, h) do { _Pragma("unroll") for (int n = 0; n < 2; ++n) _Pragma("unroll") for (int k = 0; k < 2; ++k) dst[n][k] = *(const LAS bf16x8*)(lds + PG8_SB(b, h) + boff + n * 2048 + k * 1024); } while (0)
#define PG8_MMA(ai, bj, At, Bt) do { __builtin_amdgcn_s_setprio(1); _Pragma("unroll") for (int m = 0; m < 4; ++m) _Pragma("unroll") for (int n = 0; n < 2; ++n) _Pragma("unroll") for (int k = 0; k < 2; ++k) \
        acc[ai][bj][m][n] = __builtin_amdgcn_mfma_f32_16x16x32_bf16(Bt[n][k], At[m][k], acc[ai][bj][m][n], 0, 0, 0); __builtin_amdgcn_s_setprio(0); } while (0)
#define PG8_WAIT_V(n) asm volatile("s_waitcnt vmcnt(" #n ")" ::: "memory")
#define PG8_WAIT_L(n) asm volatile("s_waitcnt lgkmcnt(" #n ")" ::: "memory")
#define PG8_BAR __builtin_amdgcn_s_barrier()
#define PG8_SCHED __builtin_amdgcn_sched_barrier(0)
    Unit cur, nxt; int ui = 0;
    if (!S.next(0, cur)) return;
    f32x4 acc[2][2][4][2];
#pragma unroll
    for (int a = 0; a < 2; ++a)
#pragma unroll
        for (int b = 0; b < 2; ++b)
#pragma unroll
            for (int m = 0; m < 4; ++m)
#pragma unroll
                for (int n = 0; n < 2; ++n) acc[a][b][m][n] = (f32x4){0.f, 0.f, 0.f, 0.f};
    bf16x8 At[4][2], B0[2][2], B1[2][2];
    const char* cA = (const char*)g.A + (size_t)cur.pm * tstepA; const char* cB = (const char*)g.Bt + (size_t)cur.pn * tstepB + (size_t)cur.kob * 2;
    PG8_STAGE(PG8_SB(0, 0), cB, voffB); PG8_STAGE(PG8_SA(0, 0), cA, voffA); PG8_STAGE(PG8_SB(0, 1), cB + hstepB, voffB); PG8_STAGE(PG8_SA(0, 1), cA + hstepA, voffA);
    if (wr == 1) PG8_BAR;
    PG8_WAIT_V(4); PG8_BAR;
    PG8_STAGE(PG8_SB(1, 0), cB + kstep, voffB); PG8_STAGE(PG8_SA(1, 0), cA + kstep, voffA); PG8_STAGE(PG8_SB(1, 1), cB + hstepB + kstep, voffB);
    PG8_WAIT_V(6); PG8_BAR;
    for (;;) {
        const bool has_next = S.next(ui + 1, nxt);
        const char* nA = has_next ? (const char*)g.A + (size_t)nxt.pm * tstepA : cA; const char* nB = has_next ? (const char*)g.Bt + (size_t)nxt.pn * tstepB + (size_t)nxt.kob * 2 : cB;
        for (int t = 0; t < nt; t += 2) {
            const bool last = (t == nt - 2);
            const char* a1 = cA + (size_t)(t + 1) * kstep;
            const char* a2 = last ? nA : cA + (size_t)(t + 2) * kstep; const char* b2 = last ? nB : cB + (size_t)(t + 2) * kstep;
            const char* a3 = a2 + kstep; const char* b3 = b2 + kstep;
            PG8_LDB(B0, 0, 0); PG8_SCHED; PG8_LDA(At, 0, 0); PG8_STAGE(PG8_SA(1, 1), a1 + hstepA, voffA);
            PG8_WAIT_L(8); PG8_BAR; PG8_WAIT_L(0); PG8_MMA(0, 0, At, B0); PG8_BAR; PG8_SCHED;
            PG8_LDB(B1, 0, 1); PG8_STAGE(PG8_SB(0, 0), b2, voffB);
            PG8_BAR; PG8_WAIT_L(0); PG8_MMA(0, 1, At, B1); PG8_BAR;
            PG8_LDA(At, 0, 1); PG8_STAGE(PG8_SA(0, 0), a2, voffA);
            PG8_BAR; PG8_WAIT_L(0); PG8_MMA(1, 0, At, B0); PG8_BAR; PG8_SCHED;
            PG8_STAGE(PG8_SB(0, 1), b2 + hstepB, voffB);
            PG8_WAIT_V(6); PG8_BAR; PG8_MMA(1, 1, At, B1); PG8_BAR;
            PG8_LDB(B0, 1, 0); PG8_SCHED; PG8_LDA(At, 1, 0); PG8_STAGE(PG8_SA(0, 1), a2 + hstepA, voffA);
            PG8_WAIT_L(8); PG8_BAR; PG8_WAIT_L(0); PG8_MMA(0, 0, At, B0); PG8_BAR; PG8_SCHED;
            PG8_LDB(B1, 1, 1); PG8_STAGE(PG8_SB(1, 0), b3, voffB);
            PG8_BAR; PG8_WAIT_L(0); PG8_MMA(0, 1, At, B1); PG8_BAR;
            PG8_LDA(At, 1, 1); PG8_STAGE(PG8_SA(1, 0), a3, voffA);
            PG8_BAR; PG8_WAIT_L(0); PG8_MMA(1, 0, At, B0); PG8_BAR; PG8_SCHED;
            PG8_STAGE(PG8_SB(1, 1), b3 + hstepB, voffB);
            PG8_WAIT_V(6); PG8_BAR; PG8_MMA(1, 1, At, B1); PG8_BAR;
        }
        { int fr2 = fr, fq2 = fq, wr2 = wr, wc2 = wc; asm volatile("" : "+v"(fr2), "+v"(fq2), "+s"(wr2), "+s"(wc2));
          E(acc, cur, wr2, wc2, fr2, fq2); }
        if (has_next) mk_voff();
        if (!has_next) break;
#pragma unroll
        for (int a = 0; a < 2; ++a)
#pragma unroll
            for (int b = 0; b < 2; ++b)
#pragma unroll
                for (int m = 0; m < 4; ++m)
#pragma unroll
                    for (int n = 0; n < 2; ++n) acc[a][b][m][n] = (f32x4){0.f, 0.f, 0.f, 0.f};
        cur = nxt; cA = nA; cB = nB; ++ui;
    }
    PG8_WAIT_V(0);
    if (wr == 0) PG8_BAR;
    PG8_BAR;
#undef PG8_SA
#undef PG8_SB
#undef PG8_STAGE
#undef PG8_LDA
#undef PG8_LDB
#undef PG8_MMA
#undef PG8_WAIT_V
#undef PG8_WAIT_L
#undef PG8_BAR
#undef PG8_SCHED
}
}
using pg8::Unit;
typedef const f32x4 (&AccRef)[2][2][4][2];

DI void row_bk(int row, int& b, int& key) { if (row < ML) { b = row >> 12; key = row & 4095; } else { const int rc = row - ML; b = rc >> 8; key = SEQ + (rc & 255); } }
DI void rope8(f32x4& v0, f32x4& v1, int row, int axis, int fq, int lane, const f32x2* rope) {
    const int l = row & 4095, pos = axis ? (l & 63) : (l >> 6);
    const f32x2* t = rope + pos * 16 + 8 * (fq & 1);
    const float sgn = (fq < 2) ? -1.f : 1.f;
#pragma unroll
    for (int j = 0; j < 4; ++j) {
        const float p0 = shx(v0[j], 32, lane), p1 = shx(v1[j], 32, lane);
        const f32x2 c0 = t[j], c1 = t[4 + j];
        v0[j] = v0[j] * c0.x + sgn * p0 * c0.y; v1[j] = v1[j] * c1.x + sgn * p1 * c1.y;
    }
}

struct EpiU {
    static constexpr bool PERM = true;
    bf16_t* U; float* ssq; bf16_t* VnT; const f32x2* rope; float qscale; bf16_t* FF;
    DI void operator()(AccRef acc, const Unit& u, int wr, int wc, int fr, int fq) const {
        const int pn = u.pn, rowb = u.pm * 256 + wr * 64 + fr;
        if (pn == 10 || pn == 11) {
#pragma unroll
            for (int ai = 0; ai < 2; ++ai)
#pragma unroll
                for (int m = 0; m < 4; ++m) { const int row = rowb + ai * 128 + m * 16; const int mrow = row < ML ? ((row & ~4095) | ((4096 - (row & 4095)) & 4095)) : row;
#pragma unroll
                    for (int bj = 0; bj < 2; ++bj) { const int c = 256 * (2 * (pn - 10) + bj) + 32 * wc + 8 * fq; const u32x4 w = pk8(acc[ai][bj][m][0], acc[ai][bj][m][1]);
                        *(u32x4*)(FF + (size_t)row * 1024 + c) = w;
                        *(u32x4*)(FF + (size_t)mrow * 1024 + 128 + c) = (row < ML) ? w : (u32x4){0u, 0u, 0u, 0u}; } }
            return;
        }
        if (pn == 8 || pn == 9) {
#pragma unroll
            for (int ai = 0; ai < 2; ++ai)
#pragma unroll
                for (int m = 0; m < 4; ++m) { int b, key; row_bk(rowb + ai * 128 + m * 16, b, key);
#pragma unroll
                    for (int bj = 0; bj < 2; ++bj) { const int hn = 2 * (pn - 8) + bj;
#pragma unroll
                        for (int n = 0; n < 2; ++n) { bf16_t* dst = VnT + ((size_t)((b * 4 + hn) * 128 + 32 * wc + 8 * fq + 4 * n)) * KEYS + key;
#pragma unroll
                            for (int j = 0; j < 4; ++j) dst[(size_t)j * KEYS] = f2bf(acc[ai][bj][m][n][j]); } } }
            return;
        }
        const float sc = (pn == 4 || pn == 5) ? qscale : 1.f;
#pragma unroll
        for (int ai = 0; ai < 2; ++ai)
#pragma unroll
            for (int m = 0; m < 4; ++m) { const int row = rowb + ai * 128 + m * 16; float ss = 0.f;
#pragma unroll
                for (int bj = 0; bj < 2; ++bj) { f32x4 v0 = acc[ai][bj][m][0] * sc, v1 = acc[ai][bj][m][1] * sc;
                    if (pn == 12 && bj == 0 && wc < 2 && row < ML) rope8(v0, v1, row, wc & 1, fq, fq * 16 + fr, rope);
                    ss += sq4(v0) + sq4(v1);
                    *(u32x4*)(U + (size_t)row * UC + 256 * pn + 128 * bj + 32 * wc + 8 * fq) = pk8(v0, v1); }
                if (pn < 4) { ss += shx(ss, 16, fq * 16 + fr); ss += shx(ss, 32, fq * 16 + fr); if (fq == 0) ssq[(size_t)row * 16 + pn * 4 + wc] = ss; } }
    }
};
DI float row_rstd(const float* ssq, int row, int which) { const f32x4 a = *(const f32x4*)(ssq + (size_t)row * 16 + which * 8), b = *(const f32x4*)(ssq + (size_t)row * 16 + which * 8 + 4);
    const float s = ((a[0] + a[1]) + (a[2] + a[3])) + ((b[0] + b[1]) + (b[2] + b[3])); return __builtin_amdgcn_rsqf(s * (1.f / 512.f) + EPS); }
struct EpiQ {
    static constexpr bool PERM = true;
    bf16_t* Q; const float* ssq; const f32x2* rope; float scale;
    DI void operator()(AccRef acc, const Unit& u, int wr, int wc, int fr, int fq) const {
        const int rowb = u.pm * 256 + wr * 64 + fr;
#pragma unroll
        for (int ai = 0; ai < 2; ++ai)
#pragma unroll
            for (int m = 0; m < 4; ++m) { const int row = rowb + ai * 128 + m * 16; const float rs = row_rstd(ssq, row, 0) * scale;
#pragma unroll
                for (int bj = 0; bj < 2; ++bj) { const int c32 = 256 * u.pn + 128 * bj + 32 * wc; f32x4 v0 = acc[ai][bj][m][0] * rs, v1 = acc[ai][bj][m][1] * rs;
                    if (((c32 >> 6) % 3) == 2 && row < ML) rope8(v0, v1, row, (c32 >> 5) & 1, fq, fq * 16 + fr, rope);
                    *(u32x4*)(Q + (size_t)row * 1536 + c32 + 8 * fq) = pk8(v0, v1); } }
    }
};
struct EpiKV {
    static constexpr bool PERM = true;
    bf16_t* KN; bf16_t* VT; const float* ssq;
    DI void operator()(AccRef acc, const Unit& u, int wr, int wc, int fr, int fq) const {
        const int pn = u.pn, rowb = u.pm * 256 + wr * 64 + fr;
#pragma unroll
        for (int ai = 0; ai < 2; ++ai)
#pragma unroll
            for (int m = 0; m < 4; ++m) { const int row = rowb + ai * 128 + m * 16; const float rs = row_rstd(ssq, row, 1); int b, key; row_bk(row, b, key);
#pragma unroll
                for (int bj = 0; bj < 2; ++bj) {
                    if (pn < 4) { *(u32x4*)(KN + (size_t)row * 1024 + 256 * pn + 128 * bj + 32 * wc + 8 * fq) = pk8(acc[ai][bj][m][0] * rs, acc[ai][bj][m][1] * rs); }
                    else { const int h = 2 * (pn - 4) + bj;
#pragma unroll
                        for (int n = 0; n < 2; ++n) { bf16_t* dst = VT + ((size_t)((b * 8 + h) * 128 + 32 * wc + 8 * fq + 4 * n)) * KEYS + key;
#pragma unroll
                            for (int j = 0; j < 4; ++j) dst[(size_t)j * KEYS] = f2bf(acc[ai][bj][m][n][j] * rs); } } } }
    }
};
struct EpiY {
    static constexpr bool PERM = true;
    bf16_t* YT; bf16_t* YTc; int tok_base;
    DI void operator()(AccRef acc, const Unit& u, int wr, int wc, int fr, int fq) const {
        const int g = u.pm;
#pragma unroll
        for (int ai = 0; ai < 2; ++ai)
#pragma unroll
            for (int m = 0; m < 4; ++m) { const int d = 64 * wr + 16 * m + fr;
#pragma unroll
                for (int bj = 0; bj < 2; ++bj) { const int tok = tok_base + 256 * u.pn + 128 * bj + 32 * wc + 8 * fq; const u32x4 w = pk8(acc[ai][bj][m][0], acc[ai][bj][m][1]);
                    if (tok < ML) { const int b = tok >> 12, l = tok & 4095; bf16_t* rowp = YT + ((size_t)((b * 4 + g) * 128 + d)) * 4096;
                        if (l < 2048) {
                            if (ai == 0) *(u32x4*)(rowp + l) = w;
                            else if (l != 0) *(u32x4*)(rowp + 2048 + l) = w;
                            else { bf16_t* q = rowp + 2048; q[1] = (bf16_t)(w.x >> 16); q[2] = (bf16_t)w.y; q[3] = (bf16_t)(w.y >> 16); q[4] = (bf16_t)w.z; q[5] = (bf16_t)(w.z >> 16); q[6] = (bf16_t)w.w; q[7] = (bf16_t)(w.w >> 16); }
                        } else if (l == 2048 && ai == 0) rowp[2048] = (bf16_t)w.x;
                    } else { const int tc = tok - ML, b = tc >> 8, l = tc & 255; *(u32x4*)(YTc + ((size_t)((b * 4 + g) * 128 + d)) * 512 + ai * 256 + l) = w; } } }
    }
};
struct SchedY {
    int G, c, i0, start;
    DI void init(int G_, int c_, int start_) { G = G_; c = c_; start = start_; i0 = (start_ > c_) ? (start_ - c_ + G_ - 1) / G_ : 0; }
    DI bool next(int i, Unit& u) const { const int L = (i0 + i) * G + c - start; if (L >= 144) return false; const int bt = L >> 2; u.pm = L & 3; u.pn = (bt / 9) * 16 + (bt % 9); u.kob = 256 * u.pm; return true; }
};
struct EpiF {
    static constexpr bool PERM = true;
    bf16_t* CAT; int ctx;
    DI void operator()(AccRef acc, const Unit& u, int wr, int wc, int fr, int fq) const {
        const int b = u.pn >> 1;
#pragma unroll
        for (int ai = 0; ai < 2; ++ai)
#pragma unroll
            for (int m = 0; m < 4; ++m) { const int lp = u.pm * 256 + 128 * ai + 64 * wr + 16 * m + fr; const int row = ctx ? (ML + b * 256 + lp) : (b * 4096 + lp);
#pragma unroll
                for (int bj = 0; bj < 2; ++bj) { const int g = 2 * (u.pn & 1) + bj;
                    *(u32x4*)(CAT + (size_t)row * D + 1536 + g * 128 + 32 * wc + 8 * fq) = pk8(acc[ai][bj][m][0], acc[ai][bj][m][1]); } }
    }
};
struct EpiRes {
    static constexpr bool PERM = false;
    const float* xl; const float* xc; const bf16_t* xb; bf16_t* out; const float* gate;
    DI void operator()(AccRef acc, const Unit& u, int wr, int wc, int fr, int fq) const {
        const int row0 = u.pm * 256; const int midx = row0 < ML ? (row0 >> 12) : 4;
        const float* src = row0 < ML ? xl : (xc - (size_t)ML * D);
        const float* gp = gate + (size_t)midx * 12288;
        const int col0 = u.pn * 256 + wc * 32 + 4 * fq;
        f32x4 gv[2][2];
#pragma unroll
        for (int bj = 0; bj < 2; ++bj)
#pragma unroll
            for (int n = 0; n < 2; ++n) gv[bj][n] = *(const f32x4*)(gp + col0 + bj * 128 + n * 16);
        if (xb) {
#pragma unroll
            for (int ai = 0; ai < 2; ++ai)
#pragma unroll
                for (int m = 0; m < 4; ++m) { const size_t off = (size_t)(row0 + wr * 64 + fr + ai * 128 + m * 16) * D + col0;
#pragma unroll
                    for (int bj = 0; bj < 2; ++bj)
#pragma unroll
                        for (int n = 0; n < 2; ++n) { const size_t o2 = off + bj * 128 + n * 16;
                            const f32x4 r = bf4(*(const u32x2*)(xb + o2)) + gv[bj][n] * acc[ai][bj][m][n];
                            u32x2 w; w.x = pk2(r[0], r[1]); w.y = pk2(r[2], r[3]); *(u32x2*)(out + o2) = w; }
                    asm volatile("" ::: "memory"); }
        } else {
#pragma unroll
            for (int ai = 0; ai < 2; ++ai)
#pragma unroll
                for (int m = 0; m < 4; ++m) { const size_t off = (size_t)(row0 + wr * 64 + fr + ai * 128 + m * 16) * D + col0;
#pragma unroll
                    for (int bj = 0; bj < 2; ++bj)
#pragma unroll
                        for (int n = 0; n < 2; ++n) { const size_t o2 = off + bj * 128 + n * 16;
                            const f32x4 r = *(const f32x4*)(src + o2) + gv[bj][n] * acc[ai][bj][m][n];
                            u32x2 w; w.x = pk2(r[0], r[1]); w.y = pk2(r[2], r[3]); *(u32x2*)(out + o2) = w; }
                    asm volatile("" ::: "memory"); }
        }
    }
};
DI float dpp_ror1(float v) { return __builtin_bit_cast(float, __builtin_amdgcn_update_dpp(0, __builtin_bit_cast(int, v), 0x121, 0xf, 0xf, false)); }
DI float dpp_ror15(float v) { return __builtin_bit_cast(float, __builtin_amdgcn_update_dpp(0, __builtin_bit_cast(int, v), 0x12f, 0xf, 0xf, false)); }
struct EpiConv {
    static constexpr bool PERM = true;
    bf16_t* ACT; const float* cw; const float* cb; int Mq;
    DI void operator()(AccRef acc, const Unit& u, int wr, int wc, int fr, int fq) const {
#pragma unroll
        for (int n = 0; n < 2; ++n) {
            const int cg_ = 128 * u.pn + 32 * wc + 8 * fq + 4 * n;
#pragma unroll
            for (int ai = 0; ai < 2; ++ai) {
                const int tok0 = 248 * u.pm - 1 + 62 * (2 * ai + wr);
                f32x4 o[4];
#pragma unroll
                for (int bj = 0; bj < 2; ++bj) {
                    f32x4 w[2][4];
#pragma unroll
                    for (int t = 0; t < 3; ++t) w[bj][t] = *(const f32x4*)(cw + (size_t)t * 2 * DFF + bj * DFF + cg_);
                    w[bj][3] = *(const f32x4*)(cb + bj * DFF + cg_);
#pragma unroll
                    for (int m = 0; m < 4; ++m) {
                        const int tok = tok0 + 16 * m + fr; const int msk = tok < ML ? 4095 : 255;
                        const bool hu = (tok & msk) != 0, hd = ((tok + 1) & msk) != 0;
                        f32x4 r = acc[ai][bj][m][n] * w[bj][1] + w[bj][3];
#pragma unroll
                        for (int j = 0; j < 4; ++j) {
                            const float su = (m > 0 && fr == 15) ? acc[ai][bj][(m + 3) & 3][n][j] : acc[ai][bj][m][n][j];
                            const float sd = (m < 3 && fr == 0) ? acc[ai][bj][(m + 1) & 3][n][j] : acc[ai][bj][m][n][j];
                            const float uu = dpp_ror1(su), dd = dpp_ror15(sd);
                            r[j] += hu ? uu * w[bj][0][j] : 0.f; r[j] += hd ? dd * w[bj][2][j] : 0.f; }
                        if (bj == 0) {
#pragma unroll
                            for (int j = 0; j < 4; ++j) o[m][j] = r[j] * __builtin_amdgcn_rcpf(1.f + __builtin_amdgcn_exp2f(-LOG2E * r[j]));
                        } else o[m] = o[m] * r;
                    }
                }
#pragma unroll
                for (int m = 0; m < 4; ++m) { const int li = 16 * m + fr, tok = tok0 + li;
                    if (li >= 1 && li <= 62 && tok < Mq) { u32x2 v; v.x = pk2(o[m][0], o[m][1]); v.y = pk2(o[m][2], o[m][3]);
                        *(u32x2*)(ACT + (size_t)tok * DFF + cg_) = v; } }
            }
        }
    }
};

struct Frame {
    LAS unsigned char* lds; unsigned char* ldsg; int tid, lane, wave, G, vcu;
    const Params& P; unsigned char* ws;
    DI const float* inp(int i) const { return as_global(P.in[i]); }
    DI float* outp() const { return as_global(P.out); }
    DI int nrep(int d) const { int n = 1 + d; asm volatile("" : "+s"(n)); return n; }
    DI void refresh() { int t = threadIdx.x; asm volatile("" : "+v"(t)); tid = t; lane = t & 63; wave = __builtin_amdgcn_readfirstlane(t >> 6);
        long z = 0; asm volatile("" : "+s"(z)); ws = P.ws + z;
        int g = gridDim.x, bx = blockIdx.x; asm volatile("" : "+s"(g), "+s"(bx)); G = g; vcu = (g % 8 == 0) ? (bx % 8) * (g / 8) + bx / 8 : bx; }
};

DI void p_mod(const Frame& F) {
    LAS float* sv = (LAS float*)F.lds; LAS float* red = sv + 5 * 2048;
    const float* c = F.inp(1); const float* cc = F.inp(3);
    for (int i = F.tid; i < 5 * 2048; i += NT) { const int r = i >> 11, k = i & 2047; const float v = r < 4 ? c[r * 2048 + k] : cc[k]; sv[i] = v / (1.f + __expf(-v)); }
    __syncthreads();
    float* mod = (float*)(F.ws + WS_MOD);
    for (int tile = F.vcu; tile < 768; tile += F.G) {
        const int l = tile / 384, colb = (tile % 384) * 32, cl = F.tid & 31, kg = F.tid >> 5;
        const float* w = F.inp(4) + (size_t)l * 2048 * 12288 + colb + cl;
        float a0 = 0.f, a1 = 0.f, a2 = 0.f, a3 = 0.f, a4 = 0.f;
#pragma unroll 32
        for (int k = kg * 128; k < kg * 128 + 128; ++k) { const float wv = __builtin_nontemporal_load(w + (size_t)k * 12288); a0 += sv[k] * wv; a1 += sv[2048 + k] * wv; a2 += sv[4096 + k] * wv; a3 += sv[6144 + k] * wv; a4 += sv[8192 + k] * wv; }
        LAS float* rp = red + (kg * 32 + cl) * 5; rp[0] = a0; rp[1] = a1; rp[2] = a2; rp[3] = a3; rp[4] = a4;
        __syncthreads();
        if (F.tid < 160) { const int r = F.tid >> 5; float s = 0.f;
#pragma unroll
            for (int q = 0; q < 16; ++q) s += red[(q * 32 + cl) * 5 + r];
            mod[(size_t)(l * 5 + r) * 12288 + colb + cl] = s + F.inp(5)[l * 12288 + colb + cl]; }
        __syncthreads();
    }
}
DI void p_tables(const Frame& F) {
    const int gt = F.vcu * NT + F.tid, gn = F.G * NT;
    LAS f32x2* t4096 = (LAS f32x2*)F.lds;
    __syncthreads();
    for (int i = F.tid; i < 4096; i += NT) { f32x2 v; v.x = cospif((float)i / 2048.f); v.y = sinpif((float)i / 2048.f); t4096[i] = v; }
    __syncthreads();
    f32x2* rope = (f32x2*)(F.ws + WS_ROPE);
    for (int i = gt; i < 1024; i += gn) { const int pos = i >> 4, k = i & 15; const float fr = powf(10000.f, -(float)k / 16.f); const float a = (float)pos * fr; f32x2 v; v.x = cosf(a); v.y = sinf(a); rope[i] = v; }
    if (gt < 32) ((unsigned*)(F.ws + WS_CTR))[gt] = 0u;
    if (F.tid == 0) *(float**)(F.ws + WS_CTR + 128) = F.outp();
    bf16_t* dc = (bf16_t*)F.outp() + DO_DFTC;
    for (int i = gt; i < 256 * 512; i += gn) { const int lp = i >> 9, cc = i & 511, part = cc >> 8, l = cc & 255; const f32x2 t = t4096[((lp * l) & 255) * 16];
        dc[i] = f2bf((part ? -t.y : t.x) * (1.f / 16.f)); }
    bf16_t* wc = (bf16_t*)(F.ws + WS_WC); const float* wf = F.inp(14);
    for (int i = gt; i < 2 * 4 * 2 * 128 * 128; i += gn) {
        const int d = i & 127, cch = (i >> 7) & 127, part = (i >> 14) & 1, g = (i >> 15) & 3, l = i >> 17;
        const float* wp = wf + ((size_t)(l * 4 + g) * 128) * 128 + d; float sacc = 0.f;
        for (int c2 = 0; c2 < 128; ++c2) { const f32x2 t = t4096[((cch * c2) & 127) * 32]; sacc += (part ? t.y : t.x) * wp[(size_t)c2 * 128]; }
        sacc *= 0.08838834764831845f;
        bf16_t* row = wc + ((size_t)l * 1024 + (g * 2 + part) * 128 + d) * 256;
        row[cch] = f2bf(sacc); row[128 + cch] = f2bf(part ? -sacc : sacc);
    }
    bf16_t* dft = (bf16_t*)F.outp() + DO_DFT;
    for (int ch = gt; ch < 4096 * 512; ch += gn) { const int lp = ch >> 9, k0 = (ch & 511) * 8; f32x4 a, b;
#pragma unroll
        for (int j = 0; j < 8; ++j) { const int k = k0 + j; const f32x2 t = t4096[(lp * (k & 2047) + (k == 2048 ? lp * 2048 : 0)) & 4095];
            const float v = (k <= 2048 ? t.x : -t.y) * ((k == 0 || k == 2048) ? (1.f / 128.f) : (1.f / 64.f));
            if (j < 4) a[j] = v; else b[j - 4] = v; }
        *(u32x4*)(dft + (size_t)lp * 4096 + k0) = pk8(a, b); }
    __syncthreads();
}
struct CvDesc { const float* src; const float* kscale; bf16_t* dst; int K, Nsrc, Ndst, mapid, ntiles; };
DI int cv_map(int mapid, int n) {
    if (mapid == 1) return n < 1024 ? n : (n < 3072 ? n + 64 : (n < 3136 ? n - 2048 : -1));
    if (mapid == 2) { const int which = n >> 10, h = (n >> 7) & 7, j = n & 127; return h * 256 + which * 128 + j; }
    if (mapid == 3) { const int pn = n >> 8, bj = (n >> 7) & 1, q = n & 127; return bj * DFF + pn * 128 + q; }
    return n;
}
DI CvDesc cv_desc(const Frame& F, int m) {
    const int l = m / 6, j = m % 6; CvDesc d; d.kscale = nullptr; d.mapid = 0;
    if (j == 0) { d.src = F.inp(8) + (size_t)l * D * INC; d.K = D; d.Nsrc = INC; d.dst = (bf16_t*)(F.ws + WS_WIN) + (size_t)l * UC * D; d.Ndst = UC; d.mapid = 1; }
    else if (j == 1) { d.src = F.inp(10) + (size_t)l * 512 * 1536; d.K = 512; d.Nsrc = 1536; d.dst = (bf16_t*)(F.ws + WS_WUQ) + (size_t)l * 1536 * 512; d.Ndst = 1536; d.kscale = F.inp(9) + l * 512; }
    else if (j == 2) { d.src = F.inp(12) + (size_t)l * 512 * 2048; d.K = 512; d.Nsrc = 2048; d.dst = (bf16_t*)(F.ws + WS_WUKV) + (size_t)l * 2048 * 512; d.Ndst = 2048; d.kscale = F.inp(11) + l * 512; d.mapid = 2; }
    else if (j == 3) { d.src = F.inp(15) + (size_t)l * D * D; d.K = D; d.Nsrc = D; d.dst = (bf16_t*)(F.ws + WS_WOUT) + (size_t)l * D * D; d.Ndst = D; }
    else if (j == 4) { d.src = F.inp(16) + (size_t)l * D * 2 * DFF; d.K = D; d.Nsrc = 2 * DFF; d.dst = (bf16_t*)(F.ws + WS_WUP) + (size_t)l * 2 * DFF * D; d.Ndst = 2 * DFF; d.mapid = 3; }
    else { d.src = F.inp(19) + (size_t)l * DFF * D; d.K = DFF; d.Nsrc = D; d.dst = (bf16_t*)(F.ws + WS_WDN) + (size_t)l * D * DFF; d.Ndst = D; }
    d.ntiles = (d.Ndst / 128) * (d.K / 64); return d;
}
struct CvTile { const float* src; const float* kscale; bf16_t* dst; int K, Nsrc, sc0, sc1, n0, k0; bool ok; };
DI CvTile cv_tile(const Frame& F, int t) {
    CvTile r; r.ok = false;
    for (int m = 0; m < 12; ++m) { const CvDesc d = cv_desc(F, m);
        if (t < d.ntiles) { const int ntn = d.Ndst / 128; r.n0 = (t % ntn) * 128; r.k0 = (t / ntn) * 64; r.src = d.src; r.kscale = d.kscale; r.dst = d.dst; r.K = d.K; r.Nsrc = d.Nsrc;
            r.sc0 = cv_map(d.mapid, r.n0); r.sc1 = cv_map(d.mapid, r.n0 + 64); r.ok = true; return r; }
        t -= d.ntiles; }
    return r;
}
DI void cv_load(const Frame& F, const CvTile& t, f32x4 (&r)[4]) {
#pragma unroll
    for (int h = 0; h < 2; ++h) { const int sc = h ? t.sc1 : t.sc0;
#pragma unroll
        for (int p = 0; p < 2; ++p) { const int kk = p * 32 + (F.tid >> 4);
            f32x4 v = {0.f, 0.f, 0.f, 0.f};
            if (sc >= 0) { v = __builtin_nontemporal_load((const f32x4*)(t.src + (size_t)(t.k0 + kk) * t.Nsrc + sc + (F.tid & 15) * 4)); if (t.kscale) v *= t.kscale[t.k0 + kk]; }
            r[h * 2 + p] = v; } }
}
DI void p_convert(const Frame& F) {
    LAS float* ts = (LAS float*)F.lds;
    int t = F.vcu; CvTile cur = cv_tile(F, t), nx1 = cv_tile(F, t + F.G); f32x4 r0[4], r1[4]; int buf = 0;
    if (cur.ok) cv_load(F, cur, r0);
    if (nx1.ok) cv_load(F, nx1, r1);
    while (cur.ok) {
        LAS float* tb = ts + buf * (2 * 64 * 65);
#pragma unroll
        for (int h = 0; h < 2; ++h)
#pragma unroll
            for (int p = 0; p < 2; ++p) { const int kk = p * 32 + (F.tid >> 4); LAS float* q = tb + h * (64 * 65) + kk * 65 + (F.tid & 15) * 4;
                q[0] = r0[h * 2 + p][0]; q[1] = r0[h * 2 + p][1]; q[2] = r0[h * 2 + p][2]; q[3] = r0[h * 2 + p][3]; }
        __syncthreads();
#pragma unroll
        for (int i = 0; i < 4; ++i) r0[i] = r1[i];
        const CvTile nx2 = cv_tile(F, t + 2 * F.G);
        if (nx2.ok) cv_load(F, nx2, r1);
#pragma unroll
        for (int h = 0; h < 2; ++h) { const int n = F.tid >> 3, kc = F.tid & 7; const LAS float* q = tb + h * (64 * 65) + n; f32x4 a, b;
#pragma unroll
            for (int j = 0; j < 4; ++j) { a[j] = q[(kc * 8 + j) * 65]; b[j] = q[(kc * 8 + 4 + j) * 65]; }
            *(u32x4*)(cur.dst + (size_t)(cur.n0 + h * 64 + n) * cur.K + cur.k0 + kc * 8) = pk8(a, b); }
        buf ^= 1; t += F.G; cur = nx1; nx1 = nx2;
    }
    __syncthreads();
}

DI void norm_phase(const Frame& F, const float* xl, const float* xc, const bf16_t* xb, int M, const float* g, const float* modl, int sh_off, int sc_off, bf16_t* H, float* outf) {
    const int gw = F.vcu * 8 + F.wave, nw = F.G * 8;
    for (int row = gw; row < M; row += nw) {
        f32x4 v[8]; float ss = 0.f;
        if (xb) {
#pragma unroll
            for (int i = 0; i < 4; ++i) { const u32x4 w = *(const u32x4*)(xb + (size_t)row * D + i * 512 + F.lane * 8); v[2 * i] = bf4((u32x2){w.x, w.y}); v[2 * i + 1] = bf4((u32x2){w.z, w.w}); ss += sq4(v[2 * i]) + sq4(v[2 * i + 1]); }
        } else { const float* xr = row < ML ? xl + (size_t)row * D : xc + (size_t)(row - ML) * D;
#pragma unroll
            for (int i = 0; i < 4; ++i) { v[2 * i] = *(const f32x4*)(xr + i * 512 + F.lane * 8); v[2 * i + 1] = *(const f32x4*)(xr + i * 512 + F.lane * 8 + 4); ss += sq4(v[2 * i]) + sq4(v[2 * i + 1]); } }
#pragma unroll
        for (int o = 32; o >= 1; o >>= 1) ss += shx(ss, o, F.lane);
        const float rs = __builtin_amdgcn_rsqf(ss * (1.f / 2048.f) + EPS);
        const int midx = row < ML ? (row >> 12) : 4;
#pragma unroll
        for (int i = 0; i < 4; ++i) { const int col = i * 512 + F.lane * 8;
            const f32x4 g0 = *(const f32x4*)(g + col), g1 = *(const f32x4*)(g + col + 4);
            if (outf) { *(f32x4*)(outf + (size_t)row * D + col) = v[2 * i] * rs * g0; *(f32x4*)(outf + (size_t)row * D + col + 4) = v[2 * i + 1] * rs * g1; }
            else { const float* mp = modl + (size_t)midx * 12288 + col;
                const f32x4 s0 = *(const f32x4*)(mp + sc_off), s1 = *(const f32x4*)(mp + sc_off + 4), h0 = *(const f32x4*)(mp + sh_off), h1 = *(const f32x4*)(mp + sh_off + 4);
                *(u32x4*)(H + (size_t)row * D + col) = pk8(v[2 * i] * rs * g0 * (1.f + s0) + h0, v[2 * i + 1] * rs * g1 * (1.f + s1) + h1); } }
    }
}

struct AttnItem {
    const bf16_t* q; const bf16_t* kn; const bf16_t* kr; const bf16_t* vt; bf16_t* o;
    int ldq, ldk, ldo, lat_row0, ctx_row0, t0, ntl, nctx, mode, r0, hn;
};
template <int DQ>
DI void attn_item(const Frame& F, const AttnItem& it, const LAS float* rpb_lds) {
    constexpr int KP = DQ + 8, VP = 72, KS = DQ / 16;
    constexpr int KBYTES = 64 * KP * 2, VBYTES = 128 * VP * 2;
    LAS unsigned char* base = F.lds;
    int tid = threadIdx.x; asm volatile("" : "+v"(tid));
    const int lane = tid & 63, w = __builtin_amdgcn_readfirstlane(tid >> 6), qq = lane & 31, hh = lane >> 5;
    const bool grpB = w >= 4;
    const int ntile = it.ntl + it.nctx;
    u32x4 rk[2], rr, rv[2];
    auto gload = [&](int ti) {
        int rowb, vcol;
        if (ti < it.ntl) { const int kt = it.t0 + ti; rowb = it.lat_row0 + kt * 64; vcol = kt * 64; } else { const int j = ti - it.ntl; rowb = it.ctx_row0 + j * 64; vcol = SEQ + j * 64; }
#pragma unroll
        for (int i = 0; i < 2; ++i) { const int id = tid + i * NT; rk[i] = *(const u32x4*)(it.kn + (size_t)(rowb + (id >> 4)) * it.ldk + (id & 15) * 8);
            rv[i] = *(const u32x4*)(it.vt + (size_t)(id >> 3) * KEYS + vcol + (id & 7) * 8); }
        if (DQ == 192) rr = *(const u32x4*)(it.kr + (size_t)(rowb + (tid >> 3)) * UC + (tid & 7) * 8);
    };
    auto lstore = [&](int ti) {
        LAS unsigned char* kb = base + (ti & 1) * KBYTES; LAS unsigned char* vb = base + 2 * KBYTES + (ti % 3) * VBYTES;
#pragma unroll
        for (int i = 0; i < 2; ++i) { const int id = tid + i * NT; *(LAS u32x4*)(kb + ((id >> 4) * KP + (id & 15) * 8) * 2) = rk[i];
            *(LAS u32x4*)(vb + ((id >> 3) * VP + (id & 7) * 8) * 2) = rv[i]; }
        if (DQ == 192) *(LAS u32x4*)(kb + ((tid >> 3) * KP + 128 + (tid & 7) * 8) * 2) = rr;
    };
    bf16x8 qf[KS];
    { const bf16_t* qp = it.q + (size_t)(32 * w + qq) * it.ldq + 8 * hh;
#pragma unroll
        for (int ks = 0; ks < KS; ++ks) qf[ks] = *(const bf16x8*)(qp + 16 * ks); }
    f32x16 o[4];
#pragma unroll
    for (int db = 0; db < 4; ++db)
#pragma unroll
        for (int i = 0; i < 16; ++i) o[db][i] = 0.f;
    f32x16 s[2];
    float mrun = -INFINITY, lrun = 0.f;
    const int r = it.r0 + (w >> 1), wq = 32 * (w & 1) + qq;
    const int rs = min(max(r - 4, 0), 56), cs = min(max(wq - 8, 0), 48);
    auto active = [&](int ti) { const int krow = it.t0 + ti; return !(it.mode == 1 && ti < it.ntl && (krow < rs || krow > rs + 7)); };
    auto qk = [&](int ti) {
        if (!active(ti)) return;
        const int krow_l = (qq & 3) + 4 * ((qq >> 3) & 1) + 8 * ((qq >> 2) & 1) + 16 * (qq >> 4);
        LAS unsigned char* kb = base + (ti & 1) * KBYTES + (krow_l * KP + 8 * hh) * 2;
#pragma unroll
        for (int blk = 0; blk < 2; ++blk)
#pragma unroll
            for (int i = 0; i < 16; ++i) s[blk][i] = 0.f;
        bf16x8 kf[3][2];
#pragma unroll
        for (int p = 0; p < 2; ++p)
#pragma unroll
            for (int blk = 0; blk < 2; ++blk) kf[p][blk] = *(const LAS bf16x8*)(kb + (32 * blk * KP + 16 * p) * 2);
#pragma unroll
        for (int ks = 0; ks < KS; ++ks) {
            if (ks + 2 < KS) {
#pragma unroll
                for (int blk = 0; blk < 2; ++blk) kf[(ks + 2) % 3][blk] = *(const LAS bf16x8*)(kb + (32 * blk * KP + 16 * (ks + 2)) * 2); }
            __builtin_amdgcn_sched_barrier(0);
#pragma unroll
            for (int blk = 0; blk < 2; ++blk) s[blk] = __builtin_amdgcn_mfma_f32_32x32x16_bf16(kf[ks % 3][blk], qf[ks], s[blk], 0, 0, 0);
            __builtin_amdgcn_sched_barrier(0);
        }
    };
    auto smpv = [&](int ti) {
        if (!active(ti)) return;
        LAS unsigned char* vb = base + 2 * KBYTES + (ti % 3) * VBYTES;
        if (it.mode == 1 && ti < it.ntl) {
            const int krow = it.t0 + ti;
            const LAS float* bp = rpb_lds + it.hn * 465 + (krow - r + 7) * 31 - wq + 15;
#pragma unroll
            for (int blk = 0; blk < 2; ++blk)
#pragma unroll
                for (int i = 0; i < 16; ++i) { const int kc = 32 * blk + (i & 3) + 4 * ((i >> 2) & 1) + 8 * hh + 16 * (i >> 3); const bool ok = kc >= cs && kc < cs + 16;
                    const int kcc = ok ? kc : cs; s[blk][i] = ok ? s[blk][i] + bp[kcc] : -INFINITY; }
        }
        float mx = s[0][0];
#pragma unroll
        for (int blk = 0; blk < 2; ++blk)
#pragma unroll
            for (int i = 0; i < 16; ++i) mx = fmaxf(mx, s[blk][i]);
        mx = fmaxf(mx, shx(mx, 32, lane));
        const float mnew = fmaxf(mrun, mx), alpha = __builtin_amdgcn_exp2f(mrun - mnew);
        mrun = mnew;
        float ps = 0.f;
#pragma unroll
        for (int blk = 0; blk < 2; ++blk)
#pragma unroll
            for (int i = 0; i < 16; ++i) { const float p = __builtin_amdgcn_exp2f(s[blk][i] - mnew); s[blk][i] = p; ps += p; }
        lrun = lrun * alpha + ps;
        if (__builtin_amdgcn_ballot_w64(alpha != 1.f) != 0ull) {
#pragma unroll
            for (int db = 0; db < 4; ++db)
#pragma unroll
                for (int i = 0; i < 16; ++i) o[db][i] *= alpha;
        }
        LAS unsigned char* vq = vb + (qq * VP + 8 * hh) * 2;
        auto vload = [&](int step, int db) { return *(const LAS bf16x8*)(vq + (32 * db * VP + 16 * step) * 2); };
        bf16x8 vf[2][4];
#pragma unroll
        for (int db = 0; db < 4; ++db) vf[0][db] = vload(0, db);
#pragma unroll
        for (int st = 0; st < 4; ++st) {
            if (st + 1 < 4) {
#pragma unroll
                for (int db = 0; db < 4; ++db) vf[(st + 1) & 1][db] = vload(st + 1, db); }
            __builtin_amdgcn_sched_barrier(0);
            const int blk = st >> 1, s2 = st & 1;
            u32x4 pw; pw.x = pk2(s[blk][8 * s2], s[blk][8 * s2 + 1]); pw.y = pk2(s[blk][8 * s2 + 2], s[blk][8 * s2 + 3]);
            pw.z = pk2(s[blk][8 * s2 + 4], s[blk][8 * s2 + 5]); pw.w = pk2(s[blk][8 * s2 + 6], s[blk][8 * s2 + 7]);
            const bf16x8 pf = __builtin_bit_cast(bf16x8, pw);
#pragma unroll
            for (int db = 0; db < 4; ++db) o[db] = __builtin_amdgcn_mfma_f32_32x32x16_bf16(vf[st & 1][db], pf, o[db], 0, 0, 0);
            __builtin_amdgcn_sched_barrier(0);
        }
    };

    __syncthreads();
    gload(0); lstore(0);
    if (ntile > 1) gload(1);
    __syncthreads();
    for (int ti = 0; ti < ntile; ++ti) {
        qk(ti);
        if (grpB) { if (ti + 1 < ntile) lstore(ti + 1); if (ti + 2 < ntile) gload(ti + 2); __syncthreads(); }
        smpv(ti);
        if (!grpB) { if (ti + 1 < ntile) lstore(ti + 1); if (ti + 2 < ntile) gload(ti + 2); __syncthreads(); }
    }
    const float lt = lrun + shx(lrun, 32, lane), inv = 1.f / lt;
    bf16_t* op = it.o + (size_t)(32 * w + qq) * it.ldo + 4 * hh;
#pragma unroll
    for (int db = 0; db < 4; ++db)
#pragma unroll
        for (int ig = 0; ig < 4; ++ig) { u32x2 v; v.x = pk2(o[db][4 * ig] * inv, o[db][4 * ig + 1] * inv); v.y = pk2(o[db][4 * ig + 2] * inv, o[db][4 * ig + 3] * inv);
            *(u32x2*)(op + 32 * db + 8 * ig) = v; }
}

#ifndef MLAREP
#define MLAREP 1
#endif
DI void mixer_attention(const Frame& F, int layer, int cidx) {
    const int nitems = (layer == 0 ? 816 : 768) + 512 * (MLAREP - 1);
    bf16_t* U = (bf16_t*)(F.ws + WS_U); bf16_t* Q = (bf16_t*)(F.ws + WS_Q); bf16_t* KN = (bf16_t*)(F.ws + WS_KN);
    bf16_t* VT = (bf16_t*)(F.ws + WS_VT); bf16_t* VNT = (bf16_t*)(F.ws + WS_VNT); bf16_t* CAT = (bf16_t*)(F.ws + WS_CAT);
    unsigned* ctr = (unsigned*)(F.ws + WS_CTR) + cidx;
    LAS float* rpb = (LAS float*)(F.lds + 112 * 1024);
    volatile LAS int* slot = (volatile LAS int*)(F.lds + 112 * 1024 + 8192);
    __syncthreads();
    for (int i = F.tid; i < 4 * 465; i += NT) rpb[i] = F.inp(13)[layer * 4 * 465 + i] * LOG2E;
    for (int step = 0;; ++step) {
        int idx;
        if (step < 2) idx = F.vcu + 256 * step;
        else {
            __syncthreads();
            if (F.tid == 0) *slot = (int)atomicAdd(ctr, 1u);
            __syncthreads();
            idx = 512 + *slot;
        }
        if (idx >= nitems) break;
        AttnItem it; it.kr = nullptr; it.mode = 0; it.r0 = 0; it.hn = 0; it.nctx = 4;
        if (idx < 512 || (idx >= 768 && idx < 800)) {
            int b, h, row0;
            if (idx < 512) { b = idx >> 7; h = (idx >> 4) & 7; row0 = b * 4096 + (idx & 15) * 256; it.t0 = 0; it.ntl = 64; }
            else { const int j = idx - 768; b = j >> 3; h = j & 7; row0 = ML + b * 256; it.t0 = 0; it.ntl = 0; }
            it.q = Q + (size_t)row0 * 1536 + h * 192; it.ldq = 1536;
            it.kn = KN + h * 128; it.ldk = 1024; it.kr = U + U_KR;
            it.vt = VT + (size_t)(b * 8 + h) * 128 * KEYS;
            it.o = CAT + (size_t)row0 * D + h * 128; it.ldo = D;
            it.lat_row0 = b * 4096; it.ctx_row0 = ML + b * 256;
            attn_item<192>(F, it, rpb);
        } else {
            int b, hn, row0;
            if (idx < 768) { const int j = idx - 512; b = j >> 6; hn = (j >> 4) & 3; const int R = j & 15; row0 = b * 4096 + R * 256;
                const int rlo = max(4 * R - 4, 0), rhi = min(max(4 * R - 1, 0), 56) + 7; it.t0 = rlo; it.ntl = rhi - rlo + 1; it.mode = 1; it.r0 = 4 * R; it.hn = hn; }
            else { const int j = idx - 800; b = j >> 2; hn = j & 3; row0 = ML + b * 256; it.t0 = 0; it.ntl = 0; }
            it.q = U + (size_t)row0 * UC + U_QN + hn * 128; it.ldq = UC;
            it.kn = U + U_KN + hn * 128; it.ldk = UC;
            it.vt = VNT + (size_t)(b * 4 + hn) * 128 * KEYS;
            it.o = CAT + (size_t)row0 * D + 1024 + hn * 128; it.ldo = D;
            it.lat_row0 = b * 4096; it.ctx_row0 = ML + b * 256;
            attn_item<128>(F, it, rpb);
        }
    }
}


#define XB_TMO      128
#define XB_XCNT(j)  (256  + 64 * (j))
#define XB_XSUB(j)  (1280 + 64 * (j))
#define XB_XGEN(j)  (2304 + 64 * (j))
#define XB_TOP      3328
#define XB_TOPGEN   3392
#define XCD_BAR_WORDS 3456
#define XB_SPIN_CAP (1u << 18)
__device__ __forceinline__ unsigned xb_ld(unsigned* p)              { return __hip_atomic_load(p, __ATOMIC_RELAXED, __HIP_MEMORY_SCOPE_AGENT); }
__device__ __forceinline__ unsigned xb_add(unsigned* p, unsigned v) { return __hip_atomic_fetch_add(p, v, __ATOMIC_RELAXED, __HIP_MEMORY_SCOPE_AGENT); }
__device__ __forceinline__ unsigned xb_xcc_id() { return (unsigned)__builtin_amdgcn_s_getreg((3 << 11) | 20) & 0xFu; }
#define XB_SPIN(cond, bar) do { unsigned _sp = 0; while (cond) { __builtin_amdgcn_s_sleep(1); \
    if ((++_sp & 255u) == 0u) { if (xb_ld(&(bar)[XB_TMO])) break; if (_sp > XB_SPIN_CAP) { atomicAdd(&(bar)[XB_TMO], 1u); break; } } } } while (0)
struct XcdBarrier { unsigned* bar; unsigned x; volatile LAS unsigned* st; };
__device__ __forceinline__ XcdBarrier xcd_barrier_post(unsigned* bar, volatile LAS unsigned* st) {
    XcdBarrier b; b.bar = bar; b.x = xb_xcc_id(); b.st = st;
    if (threadIdx.x == 0) (void)xb_add(&bar[XB_XCNT(b.x)], 1u);
    return b;
}
__device__ __forceinline__ void xcd_barrier_complete(unsigned* bar, unsigned x, unsigned& nloc, unsigned& nx) {
    const unsigned G = gridDim.x * gridDim.y * gridDim.z;
    unsigned sum, cnt, mine, sp = 0u;
    for (;;) {
        sum = 0u; cnt = 0u; mine = 0u;
#pragma unroll
        for (unsigned j = 0; j < 16; ++j) { const unsigned c = xb_ld(&bar[XB_XCNT(j)]); sum += c; cnt += (c > 0u) ? 1u : 0u; mine = (j == x) ? c : mine; }
        if (sum == G) break;
        __builtin_amdgcn_s_sleep(1);
        if ((++sp & 255u) == 0u) { if (xb_ld(&bar[XB_TMO])) break; if (sp > XB_SPIN_CAP) { atomicAdd(&bar[XB_TMO], 1u); break; } }
    }
    nloc = mine > 0u ? mine : 1u; nx = cnt > 0u ? cnt : 1u;
}
__device__ __forceinline__ void xcd_barrier(const XcdBarrier& b) {
    asm volatile("s_waitcnt vmcnt(0)" ::: "memory");
    __syncthreads();
    if (threadIdx.x == 0) {
        unsigned* bar = b.bar;
        __builtin_amdgcn_s_waitcnt(0);
        unsigned nloc = b.st[0], nx = b.st[1];
        if (nloc == 0u) { xcd_barrier_complete(bar, b.x, nloc, nx); b.st[0] = nloc; b.st[1] = nx; }
        const unsigned old = xb_add(&bar[XB_XSUB(b.x)], 1u);
        const unsigned gen = old / nloc;
        if (old + 1u == (gen + 1u) * nloc) {
            __builtin_amdgcn_fence(__ATOMIC_RELEASE, "agent");
            asm volatile("s_waitcnt vmcnt(0)" ::: "memory");
            const unsigned og = xb_add(&bar[XB_TOP], 1u);
            const unsigned tg = og / nx;
            if (og + 1u == (tg + 1u) * nx) xb_add(&bar[XB_TOPGEN], 1u);
            else XB_SPIN(xb_ld(&bar[XB_TOPGEN]) == tg, bar);
            __builtin_amdgcn_fence(__ATOMIC_ACQUIRE, "agent");
            xb_add(&bar[XB_XGEN(b.x)], 1u);
            asm volatile("s_waitcnt vmcnt(0)" ::: "memory");
        } else {
            XB_SPIN(xb_ld(&bar[XB_XGEN(b.x)]) == gen, bar);
            __builtin_amdgcn_fence(__ATOMIC_ACQUIRE, "agent");
            asm volatile("s_waitcnt vmcnt(0)" ::: "memory");
        }
    }
    __syncthreads();
}

#ifndef PHMASK
#define PHMASK 0x7ff
#endif
#define PH(k) (((PHMASK) >> (k)) & 1)
#ifndef DUPMASK
#define DUPMASK 0x000
#endif
#define REP(k) for (int rep_ = 0, nrep_ = F.nrep((DUPMASK >> (k)) & 1); rep_ < nrep_; ++rep_)
#define Hbuf ((bf16_t*)(F.ws + WS_H))
#define H (Hbuf + D)
#define X ((bf16_t*)(F.ws + WS_X))
#define U ((bf16_t*)(F.ws + WS_U))
#define SSQ ((float*)(F.ws + WS_SSQ))
#define CAT ((bf16_t*)(F.ws + WS_CAT))
#define mod ((const float*)(F.ws + WS_MOD))
#define rope ((const f32x2*)(F.ws + WS_ROPE))
#define GSYNC() do { F.refresh(); { XcdBarrier xb_{(unsigned*)(F.ws + WS_BAR), xb_xcc_id(), (volatile LAS unsigned*)(F.lds + 135 * 1024)}; xcd_barrier(xb_); } F.refresh(); } while (0)
DI void layer_body(Frame& F, const int l) {
        const int Mq = l == 0 ? MT : ML;
#define modl (mod + (size_t)l * 5 * 12288)
#define xbl (l == 0 ? (const bf16_t*)nullptr : (const bf16_t*)X)
        REP(1) {
        if (PH(1)) norm_phase(F, F.inp(0), F.inp(2), xbl, MT, F.inp(6) + l * D, modl, 0, 2048, H, nullptr);
        GSYNC(); }
        REP(2) {
        { pg8::Gemm g{H, (const bf16_t*)(F.ws + WS_WIN) + (size_t)l * UC * D, D, D, D, 0};
          pg8::Sched S; S.init(MT / 256, UC / 256, F.G, F.vcu, 0);
          EpiU E{U, SSQ, (bf16_t*)(F.ws + WS_VNT), rope, 0.08838834764831845f * LOG2E, (bf16_t*)F.outp() + DO_FF};
          if (PH(2)) pg8::gemm_phase(F.lds, g, S, E); }
        GSYNC(); }
        REP(3) {
        { int start = 0;
          { pg8::Gemm g{U + U_CQ, (const bf16_t*)(F.ws + WS_WUQ) + (size_t)l * 1536 * 512, UC, 512, 512, 0};
            pg8::Sched S; S.init(Mq / 256, 6, F.G, F.vcu, start); start += (Mq / 256) * 6;
            EpiQ E{(bf16_t*)(F.ws + WS_Q), SSQ, rope, 0.07216878364870323f * LOG2E};
            if (PH(3)) pg8::gemm_phase(F.lds, g, S, E); }
          { pg8::Gemm g{U + U_CKV, (const bf16_t*)(F.ws + WS_WUKV) + (size_t)l * 2048 * 512, UC, 512, 512, 0};
            pg8::Sched S; S.init(MT / 256, 8, F.G, F.vcu, start); start += (MT / 256) * 8;
            EpiKV E{(bf16_t*)(F.ws + WS_KN), (bf16_t*)(F.ws + WS_VT), SSQ};
            if (PH(4)) pg8::gemm_phase(F.lds, g, S, E); }
          { pg8::Gemm g{(const bf16_t*)(F.ws + WS_WC) + (size_t)l * 1024 * 256, (const bf16_t*)F.outp() + DO_FF, 256, 1024, 256, 0};
            SchedY S; S.init(F.G, F.vcu, start); start += 144;
            EpiY E{(bf16_t*)(F.ws + WS_YT), (bf16_t*)(F.ws + WS_YTC), 0};
            if (PH(5)) pg8::gemm_phase(F.lds, g, S, E); }
          if (l == 0) { pg8::Gemm g{(const bf16_t*)(F.ws + WS_WC) + (size_t)l * 1024 * 256, (const bf16_t*)F.outp() + DO_FF + (size_t)ML * 1024, 256, 1024, 256, 0};
            pg8::Sched S; S.init(4, MC / 256, F.G, F.vcu, start); S.kobm = 256;
            EpiY E{(bf16_t*)(F.ws + WS_YT), (bf16_t*)(F.ws + WS_YTC), ML};
            if (PH(5)) pg8::gemm_phase(F.lds, g, S, E); } }
        GSYNC(); }
        REP(7) {
        if (F.vcu < 128 || (l == 0 && F.vcu < 136)) {
            const bool cx = F.vcu >= 128; const int ld = cx ? 512 : 4096;
            long zo = 0; asm volatile("" : "+s"(zo)); const bf16_t* dftp = (const bf16_t*)F.P.out + zo;
            pg8::Gemm g{dftp + (cx ? DO_DFTC : DO_DFT), (const bf16_t*)(F.ws + (cx ? WS_YTC : WS_YT)), ld, ld, ld, 0};
            pg8::OneUnit S; S.u.pm = cx ? 0 : (F.vcu & 15); S.u.pn = cx ? (F.vcu - 128) : (F.vcu >> 4); S.u.kob = 0; S.has = true;
            EpiF E{CAT, cx ? 1 : 0}; if (PH(6)) pg8::gemm_phase(F.lds, g, S, E); }
        if (PH(7)) mixer_attention(F, l, l + 2 * rep_);
        GSYNC(); }
        REP(8) {
        { pg8::Gemm g{CAT, (const bf16_t*)(F.ws + WS_WOUT) + (size_t)l * D * D, D, D, D, 0};
          pg8::Sched S; S.init(Mq / 256, 8, F.G, F.vcu, 0);
          EpiRes E{F.inp(0), F.inp(2), xbl, X, modl + 4096};
          if (PH(8)) pg8::gemm_phase(F.lds, g, S, E); }
        GSYNC(); }
        REP(4) {
        if (PH(1)) norm_phase(F, nullptr, nullptr, X, Mq, F.inp(7) + l * D, modl, 6144, 8192, H, nullptr);
        GSYNC(); }
        REP(10) {
        { pg8::Gemm g{Hbuf, (const bf16_t*)(F.ws + WS_WUP) + (size_t)l * 2 * DFF * D, D, D, D, 1};
          pg8::Sched S; S.init((Mq + 247) / 248, 44, F.G, F.vcu, 0);
          EpiConv E{(bf16_t*)(F.ws + WS_ACT), F.inp(17) + (size_t)l * 3 * 2 * DFF, F.inp(18) + (size_t)l * 2 * DFF, Mq};
          if (PH(10)) pg8::gemm_phase(F.lds, g, S, E); }
        GSYNC(); }
        { pg8::Gemm g{(const bf16_t*)(F.ws + WS_ACT), (const bf16_t*)(F.ws + WS_WDN) + (size_t)l * D * DFF, DFF, DFF, DFF, 0};
          pg8::Sched S; S.init(Mq / 256, 8, F.G, F.vcu, 0);
          EpiRes E{nullptr, nullptr, X, X, modl + 10240};
          if (PH(9)) pg8::gemm_phase(F.lds, g, S, E); }
        GSYNC();

}

__global__ void __launch_bounds__(NT) fwd_megakernel(Params p) {
    extern __shared__ __attribute__((aligned(16))) unsigned char lds_raw[];
    cg::grid_group grid = cg::this_grid();
    const int tid_ = threadIdx.x, G_ = gridDim.x, bx_ = blockIdx.x;
    Frame F{(LAS unsigned char*)lds_raw, lds_raw, tid_, tid_ & 63, __builtin_amdgcn_readfirstlane(tid_ >> 6), G_, (G_ % 8 == 0) ? (bx_ % 8) * (G_ / 8) + bx_ / 8 : bx_, p, p.ws};
    volatile LAS unsigned* xst = (volatile LAS unsigned*)(F.lds + 135 * 1024);
    if (F.tid == 0) { xst[0] = 0u; xst[1] = 0u; }
    __syncthreads();
    (void)xcd_barrier_post((unsigned*)(p.ws + WS_BAR), xst);
    REP(0) { if (PH(0)) { p_mod(F);
    p_tables(F);
    p_convert(F); }
    grid.sync(); F.refresh(); }

    for (int l = 0; l < 2; ++l) layer_body(F, l);
    if (PH(1)) norm_phase(F, nullptr, nullptr, X, ML, F.inp(20), nullptr, 0, 0, nullptr, F.outp());
}
#undef Hbuf
#undef H
#undef X
#undef U
#undef SSQ
#undef CAT
#undef mod
#undef rope
#undef modl
#undef xbl


extern "C" void kernel_launch(void* const* d_in, const int* in_sizes, int n_in, void* d_out, int out_size, void* d_ws, size_t ws_size, hipStream_t stream) {
    static int grid_blocks = 0;
    if (!grid_blocks) {
        int dev = 0, cus = 0, per_cu = 0;
        hipGetDevice(&dev);
        hipDeviceGetAttribute(&cus, hipDeviceAttributeMultiprocessorCount, dev);
        hipFuncSetAttribute((const void*)fwd_megakernel, hipFuncAttributeMaxDynamicSharedMemorySize, LDS_BYTES);
        hipOccupancyMaxActiveBlocksPerMultiprocessor(&per_cu, (const void*)fwd_megakernel, NT, LDS_BYTES);
        if (per_cu < 1) { fprintf(stderr, "occupancy query says %d blocks/CU\n", per_cu); per_cu = 1; }
        grid_blocks = cus;
        if (ws_size < WS_END) fprintf(stderr, "workspace too small: %zu < %zu\n", ws_size, (size_t)WS_END);
    }
    Params p{};
    for (int i = 0; i < 21; ++i) p.in[i] = (const float*)d_in[i];
    p.out = (float*)d_out; p.ws = (unsigned char*)d_ws;
    hipMemsetAsync((unsigned char*)d_ws + WS_BAR, 0, 16384, stream);
    void* args[] = {&p};
    hipError_t e = hipLaunchCooperativeKernel((const void*)fwd_megakernel, dim3(grid_blocks), dim3(NT), args, LDS_BYTES, stream);
    if (e != hipSuccess) fprintf(stderr, "cooperative launch failed: %s (grid %d)\n", hipGetErrorString(e), grid_blocks);
}
```

```cpp
#include <hip/hip_runtime.h>
#include <hip/hip_cooperative_groups.h>
#include <cstdio>
namespace cg = cooperative_groups;

#define LAS __attribute__((address_space(3)))
#define GAS __attribute__((address_space(1)))
template <class T> __device__ __forceinline__ T* as_global(T* p) { return p; }
#define DI __device__ __forceinline__
typedef unsigned short bf16_t;
typedef short bf16x8 __attribute__((ext_vector_type(8)));
typedef short s16x4 __attribute__((ext_vector_type(4)));
typedef float f32x4 __attribute__((ext_vector_type(4)));
typedef float f32x2 __attribute__((ext_vector_type(2)));
typedef float f32x16 __attribute__((ext_vector_type(16)));
typedef unsigned u32x4 __attribute__((ext_vector_type(4)));
typedef unsigned u32x2 __attribute__((ext_vector_type(2)));
typedef __bf16 bfv2 __attribute__((ext_vector_type(2)));

constexpr int D = 2048, NB = 4, SEQ = 4096, CTXL = 256, ML = NB * SEQ, MC = NB * CTXL, MT = ML + MC;
constexpr int INC = 3136, UC = 3328;
constexpr int U_CQ = 0, U_CKV = 512, U_QN = 1024, U_KN = 1536, U_VN = 2048, U_F = 2560, U_KR = 3072;
constexpr int DFF = 5632, KEYS = SEQ + CTXL;
constexpr size_t DO_DFT = 0, DO_DFTC = (size_t)4096 * 4096, DO_FF = DO_DFTC + 256 * 512;
static_assert((DO_FF + (size_t)(ML + MC) * 1024) * 2 <= (size_t)ML * 2048 * 4, "d_out scratch");
constexpr float EPS = 1e-6f, LOG2E = 1.4426950408889634f;
constexpr int NT = 512;
constexpr int LDS_BYTES = 136 * 1024;

constexpr size_t al(size_t x) { return (x + 255) & ~(size_t)255; }
constexpr size_t WS_WIN = 0;
constexpr size_t WS_WUQ = WS_WIN + al((size_t)2 * UC * D * 2);
constexpr size_t WS_WUKV = WS_WUQ + al((size_t)2 * 1536 * 512 * 2);
constexpr size_t WS_WOUT = WS_WUKV + al((size_t)2 * 4096 * 512 * 2);
constexpr size_t WS_WUP = WS_WOUT + al((size_t)2 * D * D * 2);
constexpr size_t WS_WDN = WS_WUP + al((size_t)2 * 2 * DFF * D * 2);
constexpr size_t WS_WC = WS_WDN + al((size_t)2 * D * DFF * 2);
constexpr size_t WS_DFTC = WS_WC + al((size_t)2 * 1024 * 1024 * 2);
constexpr size_t WS_TRIG = WS_DFTC + al((size_t)256 * 512 * 2);
constexpr size_t WS_ROPE = WS_TRIG + al(4096 * 8);
constexpr size_t WS_MOD = WS_ROPE + al(64 * 16 * 8);
constexpr size_t WS_CTR = WS_MOD + al((size_t)2 * 5 * 12288 * 4);
constexpr size_t WS_BAR = WS_CTR + 256;
constexpr size_t WS_X = WS_BAR + 16384;
constexpr size_t WS_H = WS_X + al((size_t)MT * D * 4);
constexpr size_t H_ROWS = 1 + MT + 256;
constexpr size_t WS_CAT = WS_H + al(H_ROWS * D * 2);
constexpr size_t WS_YTC = WS_CAT + al((size_t)MT * D * 2);
constexpr size_t WS_U = WS_YTC + al((size_t)2048 * 512 * 2);
constexpr size_t WS_SSQ = WS_U + al((size_t)MT * UC * 2);
constexpr size_t WS_Q = WS_SSQ + al((size_t)MT * 16 * 4);
constexpr size_t WS_KN = WS_Q + al((size_t)MT * 1536 * 2);
constexpr size_t WS_VT = WS_KN + al((size_t)MT * 1024 * 2);
constexpr size_t WS_VNT = WS_VT + al((size_t)32 * 128 * KEYS * 2);
constexpr size_t WS_YT = WS_VNT + al((size_t)16 * 128 * KEYS * 2);
constexpr size_t WS_END = WS_YT + al((size_t)2048 * 8192 * 2);
constexpr size_t WS_ACT = WS_U;
static_assert(WS_ACT + (size_t)MT * DFF * 2 <= WS_END, "ACT alias");
static_assert((size_t)4096 * 8192 * 2 <= H_ROWS * D * 2, "DFT alias");
static_assert(WS_END <= (size_t)805306368, "workspace");

struct Params { const float* in[21]; float* out; unsigned char* ws; };

DI unsigned pk2(float a, float b) { f32x2 v = {a, b}; bfv2 r = __builtin_convertvector(v, bfv2); return __builtin_bit_cast(unsigned, r); }
DI bf16_t f2bf(float a) { return (bf16_t)(pk2(a, 0.f) & 0xffffu); }
DI float shx(float v, int m, int lane) { return __builtin_bit_cast(float, __builtin_amdgcn_ds_bpermute((lane ^ m) << 2, __builtin_bit_cast(int, v))); }
DI f32x4 bf4(u32x2 w) { f32x4 r; r[0] = __builtin_bit_cast(float, w.x << 16); r[1] = __builtin_bit_cast(float, w.x & 0xffff0000u); r[2] = __builtin_bit_cast(float, w.y << 16); r[3] = __builtin_bit_cast(float, w.y & 0xffff0000u); return r; }
DI float sq4(f32x4 v) { return (v[0] * v[0] + v[1] * v[1]) + (v[2] * v[2] + v[3] * v[3]); }
DI u32x4 pk8(f32x4 a, f32x4 b) { u32x4 w; w.x = pk2(a[0], a[1]); w.y = pk2(a[2], a[3]); w.z = pk2(b[0], b[1]); w.w = pk2(b[2], b[3]); return w; }

namespace pg8 {
constexpr int BM = 256, BK = 64, HALF = 128, HTB = HALF * BK * 2, STAGE_BYTES = 8 * HTB;
DI int lds_byte(int r, int c) { const int st = (r >> 4) * 2 + (c >> 5), rr = r & 15, cc = c & 31, ob = rr * 64 + cc * 2; return st * 1024 + (ob ^ (((ob >> 9) & 1) << 5)); }
DI void stage_rc(int b, int& R, int& C) { const int st = b / 1024, sb = b % 1024, swz = sb ^ (((sb >> 9) & 1) << 5); R = (st >> 1) * 16 + swz / 64; C = (st & 1) * 32 + (swz % 64) / 2; }
DI int perm32(int rho) { const int n = rho >> 4, i = rho & 15; return 8 * (i >> 2) + 4 * n + (i & 3); }
struct Unit { int pm, pn, kob; };
struct Gemm { const bf16_t* A; const bf16_t* Bt; int lda, ldb, K; int conv; };

struct Sched {
    int nM, nN, cnt, G, c, i0, start, kobm = 0;
    DI void init(int nM_, int nN_, int G_, int c_, int start_) { nM = nM_; nN = nN_; cnt = nM * nN; G = G_; c = c_; start = start_;
        i0 = (start_ > c_) ? (start_ - c_ + G_ - 1) / G_ : 0; }
    DI bool next(int i, Unit& u) const {
        const long L = (long)(i0 + i) * G + c - start; if (L >= cnt) return false;
        const int w = (int)L, nig = 8 * nN, gid = w / nig, fm = gid * 8, gsz = (nM - fm) < 8 ? (nM - fm) : 8;
        u.pm = fm + ((w % nig) % gsz); u.pn = (w % nig) / gsz; u.kob = kobm * u.pm; return true;
    }
};
struct OneUnit { Unit u; bool has; DI bool next(int i, Unit& o) const { o = u; return has && i == 0; } };

template <class Epi, class SchedT>
DI void gemm_phase(LAS unsigned char* lds, const Gemm g, const SchedT& S, const Epi& E) {
    int tid = threadIdx.x; asm volatile("" : "+v"(tid));
    const int wid = __builtin_amdgcn_readfirstlane(tid >> 6), lane = tid & 63, wr = wid >> 2, wc = wid & 3, fr = lane & 15, fq = lane >> 4;
    const int K = g.K, nt = K / BK;
    unsigned voffA[2], voffB[2];
    auto mk_voff = [&]() { int t2 = threadIdx.x; asm volatile("" : "+v"(t2));
#pragma unroll
        for (int i = 0; i < 2; ++i) { int R, C; stage_rc(t2 * 16 + i * 8192, R, C); const int Rb = Epi::PERM ? ((R & ~31) + perm32(R & 31)) : R;
            const int Ra = g.conv ? ((R >> 6) * 126 + (R & 63)) : R;
            voffA[i] = (unsigned)(Ra * g.lda + C) * 2u; voffB[i] = (unsigned)(Rb * g.ldb + C) * 2u; } };
    mk_voff();
    const size_t kstep = (size_t)(BK * 2);
    const size_t hstepA = (size_t)(g.conv ? 64 : HALF) * g.lda * 2, hstepB = (size_t)HALF * g.ldb * 2;
    const size_t tstepA = g.conv ? (size_t)252 * g.lda * 2 : 2 * hstepA, tstepB = 2 * hstepB;
    const unsigned ldsw = (unsigned)wid * 1024u;
    const int aoff = lds_byte(wr * 64 + fr, fq * 8), boff = lds_byte(wc * 32 + fr, fq * 8);
#define PG8_SA(b, h) (((b) * 2 + (h)) * HTB)
#define PG8_SB(b, h) ((4 + (b) * 2 + (h)) * HTB)
#define PG8_STAGE(bufoff, gbase, voff) do { _Pragma("unroll") for (int _i = 0; _i < 2; ++_i) \
        __builtin_amdgcn_global_load_lds((const unsigned*)((const char*)(gbase) + (voff)[_i]), (LAS unsigned*)(lds + (bufoff) + ldsw + _i * 8192), 16, 0, 0); } while (0)
#define PG8_LDA(dst, b, h) do { _Pragma("unroll") for (int m = 0; m < 4; ++m) _Pragma("unroll") for (int k = 0; k < 2; ++k) dst[m][k] = *(const LAS bf16x8*)(lds + PG8_SA(b, h) + aoff + m * 2048 + k * 1024); } while (0)
#define PG8_LDB(dst, b, h) do { _Pragma("unroll") for (int n = 0; n < 2; ++n) _Pragma("unroll") for (int k = 0; k < 2; ++k) dst[n][k] = *(const LAS bf16x8*)(lds + PG8_SB(b, h) + boff + n * 2048 + k * 1024); } while (0)
#define PG8_MMA(ai, bj, At, Bt) do { __builtin_amdgcn_s_setprio(1); _Pragma("unroll") for (int m = 0; m < 4; ++m) _Pragma("unroll") for (int n = 0; n < 2; ++n) _Pragma("unroll") for (int k = 0; k < 2; ++k) \
        acc[ai][bj][m][n] = __builtin_amdgcn_mfma_f32_16x16x32_bf16(Bt[n][k], At[m][k], acc[ai][bj][m][n], 0, 0, 0); __builtin_amdgcn_s_setprio(0); } while (0)
#define PG8_WAIT_V(n) asm volatile("s_waitcnt vmcnt(" #n ")" ::: "memory")
#define PG8_WAIT_L(n) asm volatile("s_waitcnt lgkmcnt(" #n ")" ::: "memory")
#define PG8_BAR __builtin_amdgcn_s_barrier()
#define PG8_SCHED __builtin_amdgcn_sched_barrier(0)
    Unit cur, nxt; int ui = 0;
    if (!S.next(0, cur)) return;
    f32x4 acc[2][2][4][2];
#pragma unroll
    for (int a = 0; a < 2; ++a)
#pragma unroll
        for (int b = 0; b < 2; ++b)
#pragma unroll
            for (int m = 0; m < 4; ++m)
#pragma unroll
                for (int n = 0; n < 2; ++n) acc[a][b][m][n] = (f32x4){0.f, 0.f, 0.f, 0.f};
    bf16x8 At[4][2], B0[2][2], B1[2][2];
    const char* cA = (const char*)g.A + (size_t)cur.pm * tstepA; const char* cB = (const char*)g.Bt + (size_t)cur.pn * tstepB + (size_t)cur.kob * 2;
    PG8_STAGE(PG8_SB(0, 0), cB, voffB); PG8_STAGE(PG8_SA(0, 0), cA, voffA); PG8_STAGE(PG8_SB(0, 1), cB + hstepB, voffB); PG8_STAGE(PG8_SA(0, 1), cA + hstepA, voffA);
    if (wr == 1) PG8_BAR;
    PG8_WAIT_V(4); PG8_BAR;
    PG8_STAGE(PG8_SB(1, 0), cB + kstep, voffB); PG8_STAGE(PG8_SA(1, 0), cA + kstep, voffA); PG8_STAGE(PG8_SB(1, 1), cB + hstepB + kstep, voffB);
    PG8_WAIT_V(6); PG8_BAR;
    for (;;) {
        const bool has_next = S.next(ui + 1, nxt);
        const char* nA = has_next ? (const char*)g.A + (size_t)nxt.pm * tstepA : cA; const char* nB = has_next ? (const char*)g.Bt + (size_t)nxt.pn * tstepB + (size_t)nxt.kob * 2 : cB;
        for (int t = 0; t < nt; t += 2) {
            const bool last = (t == nt - 2);
            const char* a1 = cA + (size_t)(t + 1) * kstep;
            const char* a2 = last ? nA : cA + (size_t)(t + 2) * kstep; const char* b2 = last ? nB : cB + (size_t)(t + 2) * kstep;
            const char* a3 = a2 + kstep; const char* b3 = b2 + kstep;
            PG8_LDB(B0, 0, 0); PG8_SCHED; PG8_LDA(At, 0, 0); PG8_STAGE(PG8_SA(1, 1), a1 + hstepA, voffA);
            PG8_WAIT_L(8); PG8_BAR; PG8_WAIT_L(0); PG8_MMA(0, 0, At, B0); PG8_BAR; PG8_SCHED;
            PG8_LDB(B1, 0, 1); PG8_STAGE(PG8_SB(0, 0), b2, voffB);
            PG8_BAR; PG8_WAIT_L(0); PG8_MMA(0, 1, At, B1); PG8_BAR;
            PG8_LDA(At, 0, 1); PG8_STAGE(PG8_SA(0, 0), a2, voffA);
            PG8_BAR; PG8_WAIT_L(0); PG8_MMA(1, 0, At, B0); PG8_BAR; PG8_SCHED;
            PG8_STAGE(PG8_SB(0, 1), b2 + hstepB, voffB);
            PG8_WAIT_V(6); PG8_BAR; PG8_MMA(1, 1, At, B1); PG8_BAR;
            PG8_LDB(B0, 1, 0); PG8_SCHED; PG8_LDA(At, 1, 0); PG8_STAGE(PG8_SA(0, 1), a2 + hstepA, voffA);
            PG8_WAIT_L(8); PG8_BAR; PG8_WAIT_L(0); PG8_MMA(0, 0, At, B0); PG8_BAR; PG8_SCHED;
            PG8_LDB(B1, 1, 1); PG8_STAGE(PG8_SB(1, 0), b3, voffB);
            PG8_BAR; PG8_WAIT_L(0); PG8_MMA(0, 1, At, B1); PG8_BAR;
            PG8_LDA(At, 1, 1); PG8_STAGE(PG8_SA(1, 0), a3, voffA);
            PG8_BAR; PG8_WAIT_L(0); PG8_MMA(1, 0, At, B0); PG8_BAR; PG8_SCHED;
            PG8_STAGE(PG8_SB(1, 1), b3 + hstepB, voffB);
            PG8_WAIT_V(6); PG8_BAR; PG8_MMA(1, 1, At, B1); PG8_BAR;
        }
        { int fr2 = fr, fq2 = fq, wr2 = wr, wc2 = wc; asm volatile("" : "+v"(fr2), "+v"(fq2), "+s"(wr2), "+s"(wc2));
          E(acc, cur, wr2, wc2, fr2, fq2); }
        if (has_next) mk_voff();
        if (!has_next) break;
#pragma unroll
        for (int a = 0; a < 2; ++a)
#pragma unroll
            for (int b = 0; b < 2; ++b)
#pragma unroll
                for (int m = 0; m < 4; ++m)
#pragma unroll
                    for (int n = 0; n < 2; ++n) acc[a][b][m][n] = (f32x4){0.f, 0.f, 0.f, 0.f};
        cur = nxt; cA = nA; cB = nB; ++ui;
    }
    PG8_WAIT_V(0);
    if (wr == 0) PG8_BAR;
    PG8_BAR;
#undef PG8_SA
#undef PG8_SB
#undef PG8_STAGE
#undef PG8_LDA
#undef PG8_LDB
#undef PG8_MMA
#undef PG8_WAIT_V
#undef PG8_WAIT_L
#undef PG8_BAR
#undef PG8_SCHED
}
}
using pg8::Unit;
typedef const f32x4 (&AccRef)[2][2][4][2];

DI void row_bk(int row, int& b, int& key) { if (row < ML) { b = row >> 12; key = row & 4095; } else { const int rc = row - ML; b = rc >> 8; key = SEQ + (rc & 255); } }
DI void rope8(f32x4& v0, f32x4& v1, int row, int axis, int fq, int lane, const f32x2* rope) {
    const int l = row & 4095, pos = axis ? (l & 63) : (l >> 6);
    const f32x2* t = rope + pos * 16 + 8 * (fq & 1);
    const float sgn = (fq < 2) ? -1.f : 1.f;
#pragma unroll
    for (int j = 0; j < 4; ++j) {
        const float p0 = shx(v0[j], 32, lane), p1 = shx(v1[j], 32, lane);
        const f32x2 c0 = t[j], c1 = t[4 + j];
        v0[j] = v0[j] * c0.x + sgn * p0 * c0.y; v1[j] = v1[j] * c1.x + sgn * p1 * c1.y;
    }
}

struct EpiU {
    static constexpr bool PERM = true;
    bf16_t* U; float* ssq; bf16_t* VnT; const f32x2* rope; float qscale; bf16_t* FF;
    DI void operator()(AccRef acc, const Unit& u, int wr, int wc, int fr, int fq) const {
        const int pn = u.pn, rowb = u.pm * 256 + wr * 64 + fr;
        if (pn == 10 || pn == 11) {
#pragma unroll
            for (int ai = 0; ai < 2; ++ai)
#pragma unroll
                for (int m = 0; m < 4; ++m) { const int row = rowb + ai * 128 + m * 16; const int mrow = row < ML ? ((row & ~4095) | ((4096 - (row & 4095)) & 4095)) : row;
#pragma unroll
                    for (int bj = 0; bj < 2; ++bj) { const int c = 256 * (2 * (pn - 10) + bj) + 32 * wc + 8 * fq; const u32x4 w = pk8(acc[ai][bj][m][0], acc[ai][bj][m][1]);
                        *(u32x4*)(FF + (size_t)row * 1024 + c) = w;
                        *(u32x4*)(FF + (size_t)mrow * 1024 + 128 + c) = (row < ML) ? w : (u32x4){0u, 0u, 0u, 0u}; } }
            return;
        }
        if (pn == 8 || pn == 9) {
#pragma unroll
            for (int ai = 0; ai < 2; ++ai)
#pragma unroll
                for (int m = 0; m < 4; ++m) { int b, key; row_bk(rowb + ai * 128 + m * 16, b, key);
#pragma unroll
                    for (int bj = 0; bj < 2; ++bj) { const int hn = 2 * (pn - 8) + bj;
#pragma unroll
                        for (int n = 0; n < 2; ++n) { bf16_t* dst = VnT + ((size_t)((b * 4 + hn) * 128 + 32 * wc + 8 * fq + 4 * n)) * KEYS + key;
#pragma unroll
                            for (int j = 0; j < 4; ++j) dst[(size_t)j * KEYS] = f2bf(acc[ai][bj][m][n][j]); } } }
            return;
        }
        const float sc = (pn == 4 || pn == 5) ? qscale : 1.f;
#pragma unroll
        for (int ai = 0; ai < 2; ++ai)
#pragma unroll
            for (int m = 0; m < 4; ++m) { const int row = rowb + ai * 128 + m * 16; float ss = 0.f;
#pragma unroll
                for (int bj = 0; bj < 2; ++bj) { f32x4 v0 = acc[ai][bj][m][0] * sc, v1 = acc[ai][bj][m][1] * sc;
                    if (pn == 12 && bj == 0 && wc < 2 && row < ML) rope8(v0, v1, row, wc & 1, fq, fq * 16 + fr, rope);
                    ss += sq4(v0) + sq4(v1);
                    *(u32x4*)(U + (size_t)row * UC + 256 * pn + 128 * bj + 32 * wc + 8 * fq) = pk8(v0, v1); }
                if (pn < 4) { ss += shx(ss, 16, fq * 16 + fr); ss += shx(ss, 32, fq * 16 + fr); if (fq == 0) ssq[(size_t)row * 16 + pn * 4 + wc] = ss; } }
    }
};
DI float row_rstd(const float* ssq, int row, int which) { const f32x4 a = *(const f32x4*)(ssq + (size_t)row * 16 + which * 8), b = *(const f32x4*)(ssq + (size_t)row * 16 + which * 8 + 4);
    const float s = ((a[0] + a[1]) + (a[2] + a[3])) + ((b[0] + b[1]) + (b[2] + b[3])); return __builtin_amdgcn_rsqf(s * (1.f / 512.f) + EPS); }
struct EpiQ {
    static constexpr bool PERM = true;
    bf16_t* Q; const float* ssq; const f32x2* rope; float scale;
    DI void operator()(AccRef acc, const Unit& u, int wr, int wc, int fr, int fq) const {
        const int rowb = u.pm * 256 + wr * 64 + fr;
#pragma unroll
        for (int ai = 0; ai < 2; ++ai)
#pragma unroll
            for (int m = 0; m < 4; ++m) { const int row = rowb + ai * 128 + m * 16; const float rs = row_rstd(ssq, row, 0) * scale;
#pragma unroll
                for (int bj = 0; bj < 2; ++bj) { const int c32 = 256 * u.pn + 128 * bj + 32 * wc; f32x4 v0 = acc[ai][bj][m][0] * rs, v1 = acc[ai][bj][m][1] * rs;
                    if (((c32 >> 6) % 3) == 2 && row < ML) rope8(v0, v1, row, (c32 >> 5) & 1, fq, fq * 16 + fr, rope);
                    *(u32x4*)(Q + (size_t)row * 1536 + c32 + 8 * fq) = pk8(v0, v1); } }
    }
};
struct EpiKV {
    static constexpr bool PERM = true;
    bf16_t* KN; bf16_t* VT; const float* ssq;
    DI void operator()(AccRef acc, const Unit& u, int wr, int wc, int fr, int fq) const {
        const int pn = u.pn, rowb = u.pm * 256 + wr * 64 + fr;
#pragma unroll
        for (int ai = 0; ai < 2; ++ai)
#pragma unroll
            for (int m = 0; m < 4; ++m) { const int row = rowb + ai * 128 + m * 16; const float rs = row_rstd(ssq, row, 1); int b, key; row_bk(row, b, key);
#pragma unroll
                for (int bj = 0; bj < 2; ++bj) {
                    if (pn < 4) { *(u32x4*)(KN + (size_t)row * 1024 + 256 * pn + 128 * bj + 32 * wc + 8 * fq) = pk8(acc[ai][bj][m][0] * rs, acc[ai][bj][m][1] * rs); }
                    else { const int h = 2 * (pn - 4) + bj;
#pragma unroll
                        for (int n = 0; n < 2; ++n) { bf16_t* dst = VT + ((size_t)((b * 8 + h) * 128 + 32 * wc + 8 * fq + 4 * n)) * KEYS + key;
#pragma unroll
                            for (int j = 0; j < 4; ++j) dst[(size_t)j * KEYS] = f2bf(acc[ai][bj][m][n][j] * rs); } } } }
    }
};
struct EpiY {
    static constexpr bool PERM = true;
    bf16_t* YT; bf16_t* YTc; int tok_base;
    DI void operator()(AccRef acc, const Unit& u, int wr, int wc, int fr, int fq) const {
        const int g = u.pm;
#pragma unroll
        for (int ai = 0; ai < 2; ++ai)
#pragma unroll
            for (int m = 0; m < 4; ++m) { const int d = 64 * wr + 16 * m + fr;
#pragma unroll
                for (int bj = 0; bj < 2; ++bj) { const int tok = tok_base + 256 * u.pn + 128 * bj + 32 * wc + 8 * fq; const u32x4 w = pk8(acc[ai][bj][m][0], acc[ai][bj][m][1]);
                    if (tok < ML) { const int b = tok >> 12, l = tok & 4095; bf16_t* rowp = YT + ((size_t)((b * 4 + g) * 128 + d)) * 4096;
                        if (l < 2048) {
                            if (ai == 0) *(u32x4*)(rowp + l) = w;
                            else if (l != 0) *(u32x4*)(rowp + 2048 + l) = w;
                            else { bf16_t* q = rowp + 2048; q[1] = (bf16_t)(w.x >> 16); q[2] = (bf16_t)w.y; q[3] = (bf16_t)(w.y >> 16); q[4] = (bf16_t)w.z; q[5] = (bf16_t)(w.z >> 16); q[6] = (bf16_t)w.w; q[7] = (bf16_t)(w.w >> 16); }
                        } else if (l == 2048 && ai == 0) rowp[2048] = (bf16_t)w.x;
                    } else { const int tc = tok - ML, b = tc >> 8, l = tc & 255; *(u32x4*)(YTc + ((size_t)((b * 4 + g) * 128 + d)) * 512 + ai * 256 + l) = w; } } }
    }
};
struct SchedY {
    int G, c, i0, start;
    DI void init(int G_, int c_, int start_) { G = G_; c = c_; start = start_; i0 = (start_ > c_) ? (start_ - c_ + G_ - 1) / G_ : 0; }
    DI bool next(int i, Unit& u) const { const int L = (i0 + i) * G + c - start; if (L >= 144) return false; const int bt = L >> 2; u.pm = L & 3; u.pn = (bt / 9) * 16 + (bt % 9); u.kob = 256 * u.pm; return true; }
};
struct EpiF {
    static constexpr bool PERM = true;
    bf16_t* CAT; int ctx;
    DI void operator()(AccRef acc, const Unit& u, int wr, int wc, int fr, int fq) const {
        const int b = u.pn >> 1;
#pragma unroll
        for (int ai = 0; ai < 2; ++ai)
#pragma unroll
            for (int m = 0; m < 4; ++m) { const int lp = u.pm * 256 + 128 * ai + 64 * wr + 16 * m + fr; const int row = ctx ? (ML + b * 256 + lp) : (b * 4096 + lp);
#pragma unroll
                for (int bj = 0; bj < 2; ++bj) { const int g = 2 * (u.pn & 1) + bj;
                    *(u32x4*)(CAT + (size_t)row * D + 1536 + g * 128 + 32 * wc + 8 * fq) = pk8(acc[ai][bj][m][0], acc[ai][bj][m][1]); } }
    }
};
struct EpiRes {
    static constexpr bool PERM = false;
    const float* xl; const float* xc; const bf16_t* xb; bf16_t* out; const float* gate;
    DI void operator()(AccRef acc, const Unit& u, int wr, int wc, int fr, int fq) const {
        const int row0 = u.pm * 256; const int midx = row0 < ML ? (row0 >> 12) : 4;
        const float* src = row0 < ML ? xl : (xc - (size_t)ML * D);
        const float* gp = gate + (size_t)midx * 12288;
        const int col0 = u.pn * 256 + wc * 32 + 4 * fq;
        f32x4 gv[2][2];
#pragma unroll
        for (int bj = 0; bj < 2; ++bj)
#pragma unroll
            for (int n = 0; n < 2; ++n) gv[bj][n] = *(const f32x4*)(gp + col0 + bj * 128 + n * 16);
        if (xb) {
#pragma unroll
            for (int ai = 0; ai < 2; ++ai)
#pragma unroll
                for (int m = 0; m < 4; ++m) { const size_t off = (size_t)(row0 + wr * 64 + fr + ai * 128 + m * 16) * D + col0;
#pragma unroll
                    for (int bj = 0; bj < 2; ++bj)
#pragma unroll
                        for (int n = 0; n < 2; ++n) { const size_t o2 = off + bj * 128 + n * 16;
                            const f32x4 r = bf4(*(const u32x2*)(xb + o2)) + gv[bj][n] * acc[ai][bj][m][n];
                            u32x2 w; w.x = pk2(r[0], r[1]); w.y = pk2(r[2], r[3]); *(u32x2*)(out + o2) = w; }
                    asm volatile("" ::: "memory"); }
        } else {
#pragma unroll
            for (int ai = 0; ai < 2; ++ai)
#pragma unroll
                for (int m = 0; m < 4; ++m) { const size_t off = (size_t)(row0 + wr * 64 + fr + ai * 128 + m * 16) * D + col0;
#pragma unroll
                    for (int bj = 0; bj < 2; ++bj)
#pragma unroll
                        for (int n = 0; n < 2; ++n) { const size_t o2 = off + bj * 128 + n * 16;
                            const f32x4 r = *(const f32x4*)(src + o2) + gv[bj][n] * acc[ai][bj][m][n];
                            u32x2 w; w.x = pk2(r[0], r[1]); w.y = pk2(r[2], r[3]); *(u32x2*)(out + o2) = w; }
                    asm volatile("" ::: "memory"); }
        }
    }
};
DI float dpp_ror1(float v) { return __builtin_bit_cast(float, __builtin_amdgcn_update_dpp(0, __builtin_bit_cast(int, v), 0x121, 0xf, 0xf, false)); }
DI float dpp_ror15(float v) { return __builtin_bit_cast(float, __builtin_amdgcn_update_dpp(0, __builtin_bit_cast(int, v), 0x12f, 0xf, 0xf, false)); }
struct EpiConv {
    static constexpr bool PERM = true;
    bf16_t* ACT; const float* cw; const float* cb; int Mq;
    DI void operator()(AccRef acc, const Unit& u, int wr, int wc, int fr, int fq) const {
#pragma unroll
        for (int n = 0; n < 2; ++n) {
            const int cg_ = 128 * u.pn + 32 * wc + 8 * fq + 4 * n;
#pragma unroll
            for (int ai = 0; ai < 2; ++ai) {
                const int tok0 = 252 * u.pm - 1 + 126 * wr + 64 * ai;
                f32x4 o[4];
#pragma unroll
                for (int bj = 0; bj < 2; ++bj) {
                    f32x4 w[2][4];
#pragma unroll
                    for (int t = 0; t < 3; ++t) w[bj][t] = *(const f32x4*)(cw + (size_t)t * 2 * DFF + bj * DFF + cg_);
                    w[bj][3] = *(const f32x4*)(cb + bj * DFF + cg_);
#pragma unroll
                    for (int m = 0; m < 4; ++m) {
                        const int tok = tok0 + 16 * m + fr; const int msk = tok < ML ? 4095 : 255;
                        const bool hu = (tok & msk) != 0, hd = ((tok + 1) & msk) != 0;
                        f32x4 r = acc[ai][bj][m][n] * w[bj][1] + w[bj][3];
#pragma unroll
                        for (int j = 0; j < 4; ++j) {
                            const float su = ((m > 0 || ai == 1) && fr == 15) ? (m > 0 ? acc[ai][bj][(m + 3) & 3][n][j] : acc[0][bj][3][n][j]) : acc[ai][bj][m][n][j];
                            const float sd = ((m < 3 || ai == 0) && fr == 0) ? (m < 3 ? acc[ai][bj][(m + 1) & 3][n][j] : acc[1][bj][0][n][j]) : acc[ai][bj][m][n][j];
                            const float uu = dpp_ror1(su), dd = dpp_ror15(sd);
                            r[j] += hu ? uu * w[bj][0][j] : 0.f; r[j] += hd ? dd * w[bj][2][j] : 0.f; }
                        if (bj == 0) {
#pragma unroll
                            for (int j = 0; j < 4; ++j) o[m][j] = r[j] * __builtin_amdgcn_rcpf(1.f + __builtin_amdgcn_exp2f(-LOG2E * r[j]));
                        } else o[m] = o[m] * r;
                    }
                }
#pragma unroll
                for (int m = 0; m < 4; ++m) { const int li = 64 * ai + 16 * m + fr, tok = tok0 + 16 * m + fr;
                    if (li >= 1 && li <= 126 && tok < Mq) { u32x2 v; v.x = pk2(o[m][0], o[m][1]); v.y = pk2(o[m][2], o[m][3]);
                        *(u32x2*)(ACT + (size_t)tok * DFF + cg_) = v; } }
            }
        }
    }
};

struct Frame {
    LAS unsigned char* lds; unsigned char* ldsg; int tid, lane, wave, G, vcu;
    const Params& P; unsigned char* ws;
    DI const float* inp(int i) const { return as_global(P.in[i]); }
    DI float* outp() const { return as_global(P.out); }
    DI int nrep(int d) const { int n = 1 + d; asm volatile("" : "+s"(n)); return n; }
    DI void refresh() { int t = threadIdx.x; asm volatile("" : "+v"(t)); tid = t; lane = t & 63; wave = __builtin_amdgcn_readfirstlane(t >> 6);
        long z = 0; asm volatile("" : "+s"(z)); ws = P.ws + z;
        int g = gridDim.x, bx = blockIdx.x; asm volatile("" : "+s"(g), "+s"(bx)); G = g; vcu = (g % 8 == 0) ? (bx % 8) * (g / 8) + bx / 8 : bx; }
};

DI void p_mod(const Frame& F) {
    LAS float* sv = (LAS float*)F.lds; LAS float* red = sv + 5 * 2048;
    const float* c = F.inp(1); const float* cc = F.inp(3);
    for (int i = F.tid; i < 5 * 2048; i += NT) { const int r = i >> 11, k = i & 2047; const float v = r < 4 ? c[r * 2048 + k] : cc[k]; sv[i] = v / (1.f + __expf(-v)); }
    __syncthreads();
    float* mod = (float*)(F.ws + WS_MOD);
    for (int tile = F.vcu; tile < 768; tile += F.G) {
        const int l = tile / 384, colb = (tile % 384) * 32, cl = F.tid & 31, kg = F.tid >> 5;
        const float* w = F.inp(4) + (size_t)l * 2048 * 12288 + colb + cl;
        float a0 = 0.f, a1 = 0.f, a2 = 0.f, a3 = 0.f, a4 = 0.f;
#pragma unroll 32
        for (int k = kg * 128; k < kg * 128 + 128; ++k) { const float wv = __builtin_nontemporal_load(w + (size_t)k * 12288); a0 += sv[k] * wv; a1 += sv[2048 + k] * wv; a2 += sv[4096 + k] * wv; a3 += sv[6144 + k] * wv; a4 += sv[8192 + k] * wv; }
        LAS float* rp = red + (kg * 32 + cl) * 5; rp[0] = a0; rp[1] = a1; rp[2] = a2; rp[3] = a3; rp[4] = a4;
        __syncthreads();
        if (F.tid < 160) { const int r = F.tid >> 5; float s = 0.f;
#pragma unroll
            for (int q = 0; q < 16; ++q) s += red[(q * 32 + cl) * 5 + r];
            mod[(size_t)(l * 5 + r) * 12288 + colb + cl] = s + F.inp(5)[l * 12288 + colb + cl]; }
        __syncthreads();
    }
}
DI void p_tables(const Frame& F) {
    const int gt = F.vcu * NT + F.tid, gn = F.G * NT;
    LAS f32x2* t4096 = (LAS f32x2*)F.lds;
    __syncthreads();
    for (int i = F.tid; i < 4096; i += NT) { f32x2 v; v.x = cospif((float)i / 2048.f); v.y = sinpif((float)i / 2048.f); t4096[i] = v; }
    __syncthreads();
    f32x2* rope = (f32x2*)(F.ws + WS_ROPE);
    for (int i = gt; i < 1024; i += gn) { const int pos = i >> 4, k = i & 15; const float fr = powf(10000.f, -(float)k / 16.f); const float a = (float)pos * fr; f32x2 v; v.x = cosf(a); v.y = sinf(a); rope[i] = v; }
    if (gt < 32) ((unsigned*)(F.ws + WS_CTR))[gt] = 0u;
    if (F.tid == 0) *(float**)(F.ws + WS_CTR + 128) = F.outp();
    bf16_t* dc = (bf16_t*)F.outp() + DO_DFTC;
    for (int i = gt; i < 256 * 512; i += gn) { const int lp = i >> 9, cc = i & 511, part = cc >> 8, l = cc & 255; const f32x2 t = t4096[((lp * l) & 255) * 16];
        dc[i] = f2bf((part ? -t.y : t.x) * (1.f / 16.f)); }
    bf16_t* wc = (bf16_t*)(F.ws + WS_WC); const float* wf = F.inp(14);
    for (int i = gt; i < 2 * 4 * 2 * 128 * 128; i += gn) {
        const int d = i & 127, cch = (i >> 7) & 127, part = (i >> 14) & 1, g = (i >> 15) & 3, l = i >> 17;
        const float* wp = wf + ((size_t)(l * 4 + g) * 128) * 128 + d; float sacc = 0.f;
        for (int c2 = 0; c2 < 128; ++c2) { const f32x2 t = t4096[((cch * c2) & 127) * 32]; sacc += (part ? t.y : t.x) * wp[(size_t)c2 * 128]; }
        sacc *= 0.08838834764831845f;
        bf16_t* row = wc + ((size_t)l * 1024 + (g * 2 + part) * 128 + d) * 256;
        row[cch] = f2bf(sacc); row[128 + cch] = f2bf(part ? -sacc : sacc);
    }
    bf16_t* dft = (bf16_t*)F.outp() + DO_DFT;
    for (int ch = gt; ch < 4096 * 512; ch += gn) { const int lp = ch >> 9, k0 = (ch & 511) * 8; f32x4 a, b;
#pragma unroll
        for (int j = 0; j < 8; ++j) { const int k = k0 + j; const f32x2 t = t4096[(lp * (k & 2047) + (k == 2048 ? lp * 2048 : 0)) & 4095];
            const float v = (k <= 2048 ? t.x : -t.y) * ((k == 0 || k == 2048) ? (1.f / 128.f) : (1.f / 64.f));
            if (j < 4) a[j] = v; else b[j - 4] = v; }
        *(u32x4*)(dft + (size_t)lp * 4096 + k0) = pk8(a, b); }
    __syncthreads();
}
struct CvDesc { const float* src; const float* kscale; bf16_t* dst; int K, Nsrc, Ndst, mapid, ntiles; };
DI int cv_map(int mapid, int n) {
    if (mapid == 1) return n < 1024 ? n : (n < 3072 ? n + 64 : (n < 3136 ? n - 2048 : -1));
    if (mapid == 2) { const int which = n >> 10, h = (n >> 7) & 7, j = n & 127; return h * 256 + which * 128 + j; }
    if (mapid == 3) { const int pn = n >> 8, bj = (n >> 7) & 1, q = n & 127; return bj * DFF + pn * 128 + q; }
    return n;
}
DI CvDesc cv_desc(const Frame& F, int m) {
    const int l = m / 6, j = m % 6; CvDesc d; d.kscale = nullptr; d.mapid = 0;
    if (j == 0) { d.src = F.inp(8) + (size_t)l * D * INC; d.K = D; d.Nsrc = INC; d.dst = (bf16_t*)(F.ws + WS_WIN) + (size_t)l * UC * D; d.Ndst = UC; d.mapid = 1; }
    else if (j == 1) { d.src = F.inp(10) + (size_t)l * 512 * 1536; d.K = 512; d.Nsrc = 1536; d.dst = (bf16_t*)(F.ws + WS_WUQ) + (size_t)l * 1536 * 512; d.Ndst = 1536; d.kscale = F.inp(9) + l * 512; }
    else if (j == 2) { d.src = F.inp(12) + (size_t)l * 512 * 2048; d.K = 512; d.Nsrc = 2048; d.dst = (bf16_t*)(F.ws + WS_WUKV) + (size_t)l * 2048 * 512; d.Ndst = 2048; d.kscale = F.inp(11) + l * 512; d.mapid = 2; }
    else if (j == 3) { d.src = F.inp(15) + (size_t)l * D * D; d.K = D; d.Nsrc = D; d.dst = (bf16_t*)(F.ws + WS_WOUT) + (size_t)l * D * D; d.Ndst = D; }
    else if (j == 4) { d.src = F.inp(16) + (size_t)l * D * 2 * DFF; d.K = D; d.Nsrc = 2 * DFF; d.dst = (bf16_t*)(F.ws + WS_WUP) + (size_t)l * 2 * DFF * D; d.Ndst = 2 * DFF; d.mapid = 3; }
    else { d.src = F.inp(19) + (size_t)l * DFF * D; d.K = DFF; d.Nsrc = D; d.dst = (bf16_t*)(F.ws + WS_WDN) + (size_t)l * D * DFF; d.Ndst = D; }
    d.ntiles = (d.Ndst / 128) * (d.K / 64); return d;
}
struct CvTile { const float* src; const float* kscale; bf16_t* dst; int K, Nsrc, sc0, sc1, n0, k0; bool ok; };
DI CvTile cv_tile(const Frame& F, int t) {
    CvTile r; r.ok = false;
    for (int m = 0; m < 12; ++m) { const CvDesc d = cv_desc(F, m);
        if (t < d.ntiles) { const int ntn = d.Ndst / 128; r.n0 = (t % ntn) * 128; r.k0 = (t / ntn) * 64; r.src = d.src; r.kscale = d.kscale; r.dst = d.dst; r.K = d.K; r.Nsrc = d.Nsrc;
            r.sc0 = cv_map(d.mapid, r.n0); r.sc1 = cv_map(d.mapid, r.n0 + 64); r.ok = true; return r; }
        t -= d.ntiles; }
    return r;
}
DI void cv_load(const Frame& F, const CvTile& t, f32x4 (&r)[4]) {
#pragma unroll
    for (int h = 0; h < 2; ++h) { const int sc = h ? t.sc1 : t.sc0;
#pragma unroll
        for (int p = 0; p < 2; ++p) { const int kk = p * 32 + (F.tid >> 4);
            f32x4 v = {0.f, 0.f, 0.f, 0.f};
            if (sc >= 0) { v = __builtin_nontemporal_load((const f32x4*)(t.src + (size_t)(t.k0 + kk) * t.Nsrc + sc + (F.tid & 15) * 4)); if (t.kscale) v *= t.kscale[t.k0 + kk]; }
            r[h * 2 + p] = v; } }
}
DI void p_convert(const Frame& F) {
    LAS float* ts = (LAS float*)F.lds;
    int t = F.vcu; CvTile cur = cv_tile(F, t), nx1 = cv_tile(F, t + F.G); f32x4 r0[4], r1[4]; int buf = 0;
    if (cur.ok) cv_load(F, cur, r0);
    if (nx1.ok) cv_load(F, nx1, r1);
    while (cur.ok) {
        LAS float* tb = ts + buf * (2 * 64 * 65);
#pragma unroll
        for (int h = 0; h < 2; ++h)
#pragma unroll
            for (int p = 0; p < 2; ++p) { const int kk = p * 32 + (F.tid >> 4); LAS float* q = tb + h * (64 * 65) + kk * 65 + (F.tid & 15) * 4;
                q[0] = r0[h * 2 + p][0]; q[1] = r0[h * 2 + p][1]; q[2] = r0[h * 2 + p][2]; q[3] = r0[h * 2 + p][3]; }
        __syncthreads();
#pragma unroll
        for (int i = 0; i < 4; ++i) r0[i] = r1[i];
        const CvTile nx2 = cv_tile(F, t + 2 * F.G);
        if (nx2.ok) cv_load(F, nx2, r1);
#pragma unroll
        for (int h = 0; h < 2; ++h) { const int n = F.tid >> 3, kc = F.tid & 7; const LAS float* q = tb + h * (64 * 65) + n; f32x4 a, b;
#pragma unroll
            for (int j = 0; j < 4; ++j) { a[j] = q[(kc * 8 + j) * 65]; b[j] = q[(kc * 8 + 4 + j) * 65]; }
            *(u32x4*)(cur.dst + (size_t)(cur.n0 + h * 64 + n) * cur.K + cur.k0 + kc * 8) = pk8(a, b); }
        buf ^= 1; t += F.G; cur = nx1; nx1 = nx2;
    }
    __syncthreads();
}

DI void norm_phase(const Frame& F, const float* xl, const float* xc, const bf16_t* xb, int M, const float* g, const float* modl, int sh_off, int sc_off, bf16_t* H, float* outf) {
    const int gw = F.vcu * 8 + F.wave, nw = F.G * 8;
    for (int row = gw; row < M; row += nw) {
        f32x4 v[8]; float ss = 0.f;
        if (xb) {
#pragma unroll
            for (int i = 0; i < 4; ++i) { const u32x4 w = *(const u32x4*)(xb + (size_t)row * D + i * 512 + F.lane * 8); v[2 * i] = bf4((u32x2){w.x, w.y}); v[2 * i + 1] = bf4((u32x2){w.z, w.w}); ss += sq4(v[2 * i]) + sq4(v[2 * i + 1]); }
        } else { const float* xr = row < ML ? xl + (size_t)row * D : xc + (size_t)(row - ML) * D;
#pragma unroll
            for (int i = 0; i < 4; ++i) { v[2 * i] = *(const f32x4*)(xr + i * 512 + F.lane * 8); v[2 * i + 1] = *(const f32x4*)(xr + i * 512 + F.lane * 8 + 4); ss += sq4(v[2 * i]) + sq4(v[2 * i + 1]); } }
#pragma unroll
        for (int o = 32; o >= 1; o >>= 1) ss += shx(ss, o, F.lane);
        const float rs = __builtin_amdgcn_rsqf(ss * (1.f / 2048.f) + EPS);
        const int midx = row < ML ? (row >> 12) : 4;
#pragma unroll
        for (int i = 0; i < 4; ++i) { const int col = i * 512 + F.lane * 8;
            const f32x4 g0 = *(const f32x4*)(g + col), g1 = *(const f32x4*)(g + col + 4);
            if (outf) { *(f32x4*)(outf + (size_t)row * D + col) = v[2 * i] * rs * g0; *(f32x4*)(outf + (size_t)row * D + col + 4) = v[2 * i + 1] * rs * g1; }
            else { const float* mp = modl + (size_t)midx * 12288 + col;
                const f32x4 s0 = *(const f32x4*)(mp + sc_off), s1 = *(const f32x4*)(mp + sc_off + 4), h0 = *(const f32x4*)(mp + sh_off), h1 = *(const f32x4*)(mp + sh_off + 4);
                *(u32x4*)(H + (size_t)row * D + col) = pk8(v[2 * i] * rs * g0 * (1.f + s0) + h0, v[2 * i + 1] * rs * g1 * (1.f + s1) + h1); } }
    }
}

struct AttnItem {
    const bf16_t* q; const bf16_t* kn; const bf16_t* kr; const bf16_t* vt; bf16_t* o;
    int ldq, ldk, ldo, lat_row0, ctx_row0, t0, ntl, nctx, mode, r0, hn;
};
template <int DQ>
DI void attn_item(const Frame& F, const AttnItem& it, const LAS float* rpb_lds) {
    constexpr int KP = DQ + 8, VP = 72, KS = DQ / 16;
    constexpr int KBYTES = 64 * KP * 2, VBYTES = 128 * VP * 2;
    LAS unsigned char* base = F.lds;
    int tid = threadIdx.x; asm volatile("" : "+v"(tid));
    const int lane = tid & 63, w = __builtin_amdgcn_readfirstlane(tid >> 6), qq = lane & 31, hh = lane >> 5;
    const bool grpB = w >= 4;
    const int ntile = it.ntl + it.nctx;
    u32x4 rk[2], rr, rv[2];
    auto gload = [&](int ti) {
        int rowb, vcol;
        if (ti < it.ntl) { const int kt = it.t0 + ti; rowb = it.lat_row0 + kt * 64; vcol = kt * 64; } else { const int j = ti - it.ntl; rowb = it.ctx_row0 + j * 64; vcol = SEQ + j * 64; }
#pragma unroll
        for (int i = 0; i < 2; ++i) { const int id = tid + i * NT; rk[i] = *(const u32x4*)(it.kn + (size_t)(rowb + (id >> 4)) * it.ldk + (id & 15) * 8);
            rv[i] = *(const u32x4*)(it.vt + (size_t)(id >> 3) * KEYS + vcol + (id & 7) * 8); }
        if (DQ == 192) rr = *(const u32x4*)(it.kr + (size_t)(rowb + (tid >> 3)) * UC + (tid & 7) * 8);
    };
    auto lstore = [&](int ti) {
        LAS unsigned char* kb = base + (ti & 1) * KBYTES; LAS unsigned char* vb = base + 2 * KBYTES + (ti % 3) * VBYTES;
#pragma unroll
        for (int i = 0; i < 2; ++i) { const int id = tid + i * NT; *(LAS u32x4*)(kb + ((id >> 4) * KP + (id & 15) * 8) * 2) = rk[i];
            *(LAS u32x4*)(vb + ((id >> 3) * VP + (id & 7) * 8) * 2) = rv[i]; }
        if (DQ == 192) *(LAS u32x4*)(kb + ((tid >> 3) * KP + 128 + (tid & 7) * 8) * 2) = rr;
    };
    bf16x8 qf[KS];
    { const bf16_t* qp = it.q + (size_t)(32 * w + qq) * it.ldq + 8 * hh;
#pragma unroll
        for (int ks = 0; ks < KS; ++ks) qf[ks] = *(const bf16x8*)(qp + 16 * ks); }
    f32x16 o[4];
#pragma unroll
    for (int db = 0; db < 4; ++db)
#pragma unroll
        for (int i = 0; i < 16; ++i) o[db][i] = 0.f;
    f32x16 s[2];
    float mrun = -INFINITY, lrun = 0.f;
    const int r = it.r0 + (w >> 1), wq = 32 * (w & 1) + qq;
    const int rs = min(max(r - 4, 0), 56), cs = min(max(wq - 8, 0), 48);
    auto active = [&](int ti) { const int krow = it.t0 + ti; return !(it.mode == 1 && ti < it.ntl && (krow < rs || krow > rs + 7)); };
    auto qk = [&](int ti) {
        if (!active(ti)) return;
        const int krow_l = (qq & 3) + 4 * ((qq >> 3) & 1) + 8 * ((qq >> 2) & 1) + 16 * (qq >> 4);
        LAS unsigned char* kb = base + (ti & 1) * KBYTES + (krow_l * KP + 8 * hh) * 2;
#pragma unroll
        for (int blk = 0; blk < 2; ++blk)
#pragma unroll
            for (int i = 0; i < 16; ++i) s[blk][i] = 0.f;
        bf16x8 kf[3][2];
#pragma unroll
        for (int p = 0; p < 2; ++p)
#pragma unroll
            for (int blk = 0; blk < 2; ++blk) kf[p][blk] = *(const LAS bf16x8*)(kb + (32 * blk * KP + 16 * p) * 2);
#pragma unroll
        for (int ks = 0; ks < KS; ++ks) {
            if (ks + 2 < KS) {
#pragma unroll
                for (int blk = 0; blk < 2; ++blk) kf[(ks + 2) % 3][blk] = *(const LAS bf16x8*)(kb + (32 * blk * KP + 16 * (ks + 2)) * 2); }
            __builtin_amdgcn_sched_barrier(0);
#pragma unroll
            for (int blk = 0; blk < 2; ++blk) s[blk] = __builtin_amdgcn_mfma_f32_32x32x16_bf16(kf[ks % 3][blk], qf[ks], s[blk], 0, 0, 0);
            __builtin_amdgcn_sched_barrier(0);
        }
    };
    auto smpv = [&](int ti) {
        if (!active(ti)) return;
        LAS unsigned char* vb = base + 2 * KBYTES + (ti % 3) * VBYTES;
        if (it.mode == 1 && ti < it.ntl) {
            const int krow = it.t0 + ti;
            const LAS float* bp = rpb_lds + it.hn * 465 + (krow - r + 7) * 31 - wq + 15;
#pragma unroll
            for (int blk = 0; blk < 2; ++blk)
#pragma unroll
                for (int i = 0; i < 16; ++i) { const int kc = 32 * blk + (i & 3) + 4 * ((i >> 2) & 1) + 8 * hh + 16 * (i >> 3); const bool ok = kc >= cs && kc < cs + 16;
                    const int kcc = ok ? kc : cs; s[blk][i] = ok ? s[blk][i] + bp[kcc] : -INFINITY; }
        }
        float mx = s[0][0];
#pragma unroll
        for (int blk = 0; blk < 2; ++blk)
#pragma unroll
            for (int i = 0; i < 16; ++i) mx = fmaxf(mx, s[blk][i]);
        mx = fmaxf(mx, shx(mx, 32, lane));
        const float mnew = fmaxf(mrun, mx), alpha = __builtin_amdgcn_exp2f(mrun - mnew);
        mrun = mnew;
        float ps = 0.f;
#pragma unroll
        for (int blk = 0; blk < 2; ++blk)
#pragma unroll
            for (int i = 0; i < 16; ++i) { const float p = __builtin_amdgcn_exp2f(s[blk][i] - mnew); s[blk][i] = p; ps += p; }
        lrun = lrun * alpha + ps;
        if (__builtin_amdgcn_ballot_w64(alpha != 1.f) != 0ull) {
#pragma unroll
            for (int db = 0; db < 4; ++db)
#pragma unroll
                for (int i = 0; i < 16; ++i) o[db][i] *= alpha;
        }
        LAS unsigned char* vq = vb + (qq * VP + 8 * hh) * 2;
        auto vload = [&](int step, int db) { return *(const LAS bf16x8*)(vq + (32 * db * VP + 16 * step) * 2); };
        bf16x8 vf[2][4];
#pragma unroll
        for (int db = 0; db < 4; ++db) vf[0][db] = vload(0, db);
#pragma unroll
        for (int st = 0; st < 4; ++st) {
            if (st + 1 < 4) {
#pragma unroll
                for (int db = 0; db < 4; ++db) vf[(st + 1) & 1][db] = vload(st + 1, db); }
            __builtin_amdgcn_sched_barrier(0);
            const int blk = st >> 1, s2 = st & 1;
            u32x4 pw; pw.x = pk2(s[blk][8 * s2], s[blk][8 * s2 + 1]); pw.y = pk2(s[blk][8 * s2 + 2], s[blk][8 * s2 + 3]);
            pw.z = pk2(s[blk][8 * s2 + 4], s[blk][8 * s2 + 5]); pw.w = pk2(s[blk][8 * s2 + 6], s[blk][8 * s2 + 7]);
            const bf16x8 pf = __builtin_bit_cast(bf16x8, pw);
#pragma unroll
            for (int db = 0; db < 4; ++db) o[db] = __builtin_amdgcn_mfma_f32_32x32x16_bf16(vf[st & 1][db], pf, o[db], 0, 0, 0);
            __builtin_amdgcn_sched_barrier(0);
        }
    };

    __syncthreads();
    gload(0); lstore(0);
    if (ntile > 1) gload(1);
    __syncthreads();
    for (int ti = 0; ti < ntile; ++ti) {
        qk(ti);
        if (grpB) { if (ti + 1 < ntile) lstore(ti + 1); if (ti + 2 < ntile) gload(ti + 2); __syncthreads(); }
        smpv(ti);
        if (!grpB) { if (ti + 1 < ntile) lstore(ti + 1); if (ti + 2 < ntile) gload(ti + 2); __syncthreads(); }
    }
    const float lt = lrun + shx(lrun, 32, lane), inv = 1.f / lt;
    bf16_t* op = it.o + (size_t)(32 * w + qq) * it.ldo + 4 * hh;
#pragma unroll
    for (int db = 0; db < 4; ++db)
#pragma unroll
        for (int ig = 0; ig < 4; ++ig) { u32x2 v; v.x = pk2(o[db][4 * ig] * inv, o[db][4 * ig + 1] * inv); v.y = pk2(o[db][4 * ig + 2] * inv, o[db][4 * ig + 3] * inv);
            *(u32x2*)(op + 32 * db + 8 * ig) = v; }
}

#ifndef MLAREP
#define MLAREP 1
#endif
DI void mixer_attention(const Frame& F, int layer, int cidx) {
    const int nitems = (layer == 0 ? 816 : 768) + 512 * (MLAREP - 1);
    bf16_t* U = (bf16_t*)(F.ws + WS_U); bf16_t* Q = (bf16_t*)(F.ws + WS_Q); bf16_t* KN = (bf16_t*)(F.ws + WS_KN);
    bf16_t* VT = (bf16_t*)(F.ws + WS_VT); bf16_t* VNT = (bf16_t*)(F.ws + WS_VNT); bf16_t* CAT = (bf16_t*)(F.ws + WS_CAT);
    unsigned* ctr = (unsigned*)(F.ws + WS_CTR) + cidx;
    LAS float* rpb = (LAS float*)(F.lds + 112 * 1024);
    volatile LAS int* slot = (volatile LAS int*)(F.lds + 112 * 1024 + 8192);
    __syncthreads();
    for (int i = F.tid; i < 4 * 465; i += NT) rpb[i] = F.inp(13)[layer * 4 * 465 + i] * LOG2E;
    for (int step = 0;; ++step) {
        int idx;
        if (step < 2) idx = F.vcu + 256 * step;
        else {
            __syncthreads();
            if (F.tid == 0) *slot = (int)atomicAdd(ctr, 1u);
            __syncthreads();
            idx = 512 + *slot;
        }
        if (idx >= nitems) break;
        AttnItem it; it.kr = nullptr; it.mode = 0; it.r0 = 0; it.hn = 0; it.nctx = 4;
        if (idx < 512 || (idx >= 768 && idx < 800)) {
            int b, h, row0;
            if (idx < 512) { b = idx >> 7; h = (idx >> 4) & 7; row0 = b * 4096 + (idx & 15) * 256; it.t0 = 0; it.ntl = 64; }
            else { const int j = idx - 768; b = j >> 3; h = j & 7; row0 = ML + b * 256; it.t0 = 0; it.ntl = 0; }
            it.q = Q + (size_t)row0 * 1536 + h * 192; it.ldq = 1536;
            it.kn = KN + h * 128; it.ldk = 1024; it.kr = U + U_KR;
            it.vt = VT + (size_t)(b * 8 + h) * 128 * KEYS;
            it.o = CAT + (size_t)row0 * D + h * 128; it.ldo = D;
            it.lat_row0 = b * 4096; it.ctx_row0 = ML + b * 256;
            attn_item<192>(F, it, rpb);
        } else {
            int b, hn, row0;
            if (idx < 768) { const int j = idx - 512; b = j >> 6; hn = (j >> 4) & 3; const int R = j & 15; row0 = b * 4096 + R * 256;
                const int rlo = max(4 * R - 4, 0), rhi = min(max(4 * R - 1, 0), 56) + 7; it.t0 = rlo; it.ntl = rhi - rlo + 1; it.mode = 1; it.r0 = 4 * R; it.hn = hn; }
            else { const int j = idx - 800; b = j >> 2; hn = j & 3; row0 = ML + b * 256; it.t0 = 0; it.ntl = 0; }
            it.q = U + (size_t)row0 * UC + U_QN + hn * 128; it.ldq = UC;
            it.kn = U + U_KN + hn * 128; it.ldk = UC;
            it.vt = VNT + (size_t)(b * 4 + hn) * 128 * KEYS;
            it.o = CAT + (size_t)row0 * D + 1024 + hn * 128; it.ldo = D;
            it.lat_row0 = b * 4096; it.ctx_row0 = ML + b * 256;
            attn_item<128>(F, it, rpb);
        }
    }
}


#define XB_TMO      128
#define XB_XCNT(j)  (256  + 64 * (j))
#define XB_XSUB(j)  (1280 + 64 * (j))
#define XB_XGEN(j)  (2304 + 64 * (j))
#define XB_TOP      3328
#define XB_TOPGEN   3392
#define XCD_BAR_WORDS 3456
#define XB_SPIN_CAP (1u << 18)
__device__ __forceinline__ unsigned xb_ld(unsigned* p)              { return __hip_atomic_load(p, __ATOMIC_RELAXED, __HIP_MEMORY_SCOPE_AGENT); }
__device__ __forceinline__ unsigned xb_add(unsigned* p, unsigned v) { return __hip_atomic_fetch_add(p, v, __ATOMIC_RELAXED, __HIP_MEMORY_SCOPE_AGENT); }
__device__ __forceinline__ unsigned xb_xcc_id() { return (unsigned)__builtin_amdgcn_s_getreg((3 << 11) | 20) & 0xFu; }
#define XB_SPIN(cond, bar) do { unsigned _sp = 0; while (cond) { __builtin_amdgcn_s_sleep(1); \
    if ((++_sp & 255u) == 0u) { if (xb_ld(&(bar)[XB_TMO])) break; if (_sp > XB_SPIN_CAP) { atomicAdd(&(bar)[XB_TMO], 1u); break; } } } } while (0)
struct XcdBarrier { unsigned* bar; unsigned x; volatile LAS unsigned* st; };
__device__ __forceinline__ XcdBarrier xcd_barrier_post(unsigned* bar, volatile LAS unsigned* st) {
    XcdBarrier b; b.bar = bar; b.x = xb_xcc_id(); b.st = st;
    if (threadIdx.x == 0) (void)xb_add(&bar[XB_XCNT(b.x)], 1u);
    return b;
}
__device__ __forceinline__ void xcd_barrier_complete(unsigned* bar, unsigned x, unsigned& nloc, unsigned& nx) {
    const unsigned G = gridDim.x * gridDim.y * gridDim.z;
    unsigned sum, cnt, mine, sp = 0u;
    for (;;) {
        sum = 0u; cnt = 0u; mine = 0u;
#pragma unroll
        for (unsigned j = 0; j < 16; ++j) { const unsigned c = xb_ld(&bar[XB_XCNT(j)]); sum += c; cnt += (c > 0u) ? 1u : 0u; mine = (j == x) ? c : mine; }
        if (sum == G) break;
        __builtin_amdgcn_s_sleep(1);
        if ((++sp & 255u) == 0u) { if (xb_ld(&bar[XB_TMO])) break; if (sp > XB_SPIN_CAP) { atomicAdd(&bar[XB_TMO], 1u); break; } }
    }
    nloc = mine > 0u ? mine : 1u; nx = cnt > 0u ? cnt : 1u;
}
__device__ __forceinline__ void xcd_barrier(const XcdBarrier& b) {
    asm volatile("s_waitcnt vmcnt(0)" ::: "memory");
    __syncthreads();
    if (threadIdx.x == 0) {
        unsigned* bar = b.bar;
        __builtin_amdgcn_s_waitcnt(0);
        unsigned nloc = b.st[0], nx = b.st[1];
        if (nloc == 0u) { xcd_barrier_complete(bar, b.x, nloc, nx); b.st[0] = nloc; b.st[1] = nx; }
        const unsigned old = xb_add(&bar[XB_XSUB(b.x)], 1u);
        const unsigned gen = old / nloc;
        if (old + 1u == (gen + 1u) * nloc) {
            __builtin_amdgcn_fence(__ATOMIC_RELEASE, "agent");
            asm volatile("s_waitcnt vmcnt(0)" ::: "memory");
            const unsigned og = xb_add(&bar[XB_TOP], 1u);
            const unsigned tg = og / nx;
            if (og + 1u == (tg + 1u) * nx) xb_add(&bar[XB_TOPGEN], 1u);
            else XB_SPIN(xb_ld(&bar[XB_TOPGEN]) == tg, bar);
            __builtin_amdgcn_fence(__ATOMIC_ACQUIRE, "agent");
            xb_add(&bar[XB_XGEN(b.x)], 1u);
            asm volatile("s_waitcnt vmcnt(0)" ::: "memory");
        } else {
            XB_SPIN(xb_ld(&bar[XB_XGEN(b.x)]) == gen, bar);
            __builtin_amdgcn_fence(__ATOMIC_ACQUIRE, "agent");
            asm volatile("s_waitcnt vmcnt(0)" ::: "memory");
        }
    }
    __syncthreads();
}

#ifndef PHMASK
#define PHMASK 0x7ff
#endif
#define PH(k) (((PHMASK) >> (k)) & 1)
#ifndef DUPMASK
#define DUPMASK 0x000
#endif
#define REP(k) for (int rep_ = 0, nrep_ = F.nrep((DUPMASK >> (k)) & 1); rep_ < nrep_; ++rep_)
#define Hbuf ((bf16_t*)(F.ws + WS_H))
#define H (Hbuf + D)
#define X ((bf16_t*)(F.ws + WS_X))
#define U ((bf16_t*)(F.ws + WS_U))
#define SSQ ((float*)(F.ws + WS_SSQ))
#define CAT ((bf16_t*)(F.ws + WS_CAT))
#define mod ((const float*)(F.ws + WS_MOD))
#define rope ((const f32x2*)(F.ws + WS_ROPE))
#define GSYNC() do { F.refresh(); { XcdBarrier xb_{(unsigned*)(F.ws + WS_BAR), xb_xcc_id(), (volatile LAS unsigned*)(F.lds + 135 * 1024)}; xcd_barrier(xb_); } F.refresh(); } while (0)
DI void layer_body(Frame& F, const int l) {
        const int Mq = l == 0 ? MT : ML;
#define modl (mod + (size_t)l * 5 * 12288)
#define xbl (l == 0 ? (const bf16_t*)nullptr : (const bf16_t*)X)
        REP(1) {
        if (PH(1)) norm_phase(F, F.inp(0), F.inp(2), xbl, MT, F.inp(6) + l * D, modl, 0, 2048, H, nullptr);
        GSYNC(); }
        REP(2) {
        { pg8::Gemm g{H, (const bf16_t*)(F.ws + WS_WIN) + (size_t)l * UC * D, D, D, D, 0};
          pg8::Sched S; S.init(MT / 256, UC / 256, F.G, F.vcu, 0);
          EpiU E{U, SSQ, (bf16_t*)(F.ws + WS_VNT), rope, 0.08838834764831845f * LOG2E, (bf16_t*)F.outp() + DO_FF};
          if (PH(2)) pg8::gemm_phase(F.lds, g, S, E); }
        GSYNC(); }
        REP(3) {
        { int start = 0;
          { pg8::Gemm g{U + U_CQ, (const bf16_t*)(F.ws + WS_WUQ) + (size_t)l * 1536 * 512, UC, 512, 512, 0};
            pg8::Sched S; S.init(Mq / 256, 6, F.G, F.vcu, start); start += (Mq / 256) * 6;
            EpiQ E{(bf16_t*)(F.ws + WS_Q), SSQ, rope, 0.07216878364870323f * LOG2E};
            if (PH(3)) pg8::gemm_phase(F.lds, g, S, E); }
          { pg8::Gemm g{U + U_CKV, (const bf16_t*)(F.ws + WS_WUKV) + (size_t)l * 2048 * 512, UC, 512, 512, 0};
            pg8::Sched S; S.init(MT / 256, 8, F.G, F.vcu, start); start += (MT / 256) * 8;
            EpiKV E{(bf16_t*)(F.ws + WS_KN), (bf16_t*)(F.ws + WS_VT), SSQ};
            if (PH(4)) pg8::gemm_phase(F.lds, g, S, E); }
          { pg8::Gemm g{(const bf16_t*)(F.ws + WS_WC) + (size_t)l * 1024 * 256, (const bf16_t*)F.outp() + DO_FF, 256, 1024, 256, 0};
            SchedY S; S.init(F.G, F.vcu, start); start += 144;
            EpiY E{(bf16_t*)(F.ws + WS_YT), (bf16_t*)(F.ws + WS_YTC), 0};
            if (PH(5)) pg8::gemm_phase(F.lds, g, S, E); }
          if (l == 0) { pg8::Gemm g{(const bf16_t*)(F.ws + WS_WC) + (size_t)l * 1024 * 256, (const bf16_t*)F.outp() + DO_FF + (size_t)ML * 1024, 256, 1024, 256, 0};
            pg8::Sched S; S.init(4, MC / 256, F.G, F.vcu, start); S.kobm = 256;
            EpiY E{(bf16_t*)(F.ws + WS_YT), (bf16_t*)(F.ws + WS_YTC), ML};
            if (PH(5)) pg8::gemm_phase(F.lds, g, S, E); } }
        GSYNC(); }
        REP(7) {
        if (F.vcu < 128 || (l == 0 && F.vcu < 136)) {
            const bool cx = F.vcu >= 128; const int ld = cx ? 512 : 4096;
            long zo = 0; asm volatile("" : "+s"(zo)); const bf16_t* dftp = (const bf16_t*)F.P.out + zo;
            pg8::Gemm g{dftp + (cx ? DO_DFTC : DO_DFT), (const bf16_t*)(F.ws + (cx ? WS_YTC : WS_YT)), ld, ld, ld, 0};
            pg8::OneUnit S; S.u.pm = cx ? 0 : (F.vcu & 15); S.u.pn = cx ? (F.vcu - 128) : (F.vcu >> 4); S.u.kob = 0; S.has = true;
            EpiF E{CAT, cx ? 1 : 0}; if (PH(6)) pg8::gemm_phase(F.lds, g, S, E); }
        if (PH(7)) mixer_attention(F, l, l + 2 * rep_);
        GSYNC(); }
        REP(8) {
        { pg8::Gemm g{CAT, (const bf16_t*)(F.ws + WS_WOUT) + (size_t)l * D * D, D, D, D, 0};
          pg8::Sched S; S.init(Mq / 256, 8, F.G, F.vcu, 0);
          EpiRes E{F.inp(0), F.inp(2), xbl, X, modl + 4096};
          if (PH(8)) pg8::gemm_phase(F.lds, g, S, E); }
        GSYNC(); }
        REP(4) {
        if (PH(1)) norm_phase(F, nullptr, nullptr, X, Mq, F.inp(7) + l * D, modl, 6144, 8192, H, nullptr);
        GSYNC(); }
        REP(10) {
        { pg8::Gemm g{Hbuf, (const bf16_t*)(F.ws + WS_WUP) + (size_t)l * 2 * DFF * D, D, D, D, 1};
          pg8::Sched S; S.init((Mq + 251) / 252, 44, F.G, F.vcu, 0);
          EpiConv E{(bf16_t*)(F.ws + WS_ACT), F.inp(17) + (size_t)l * 3 * 2 * DFF, F.inp(18) + (size_t)l * 2 * DFF, Mq};
          if (PH(10)) pg8::gemm_phase(F.lds, g, S, E); }
        GSYNC(); }
        { pg8::Gemm g{(const bf16_t*)(F.ws + WS_ACT), (const bf16_t*)(F.ws + WS_WDN) + (size_t)l * D * DFF, DFF, DFF, DFF, 0};
          pg8::Sched S; S.init(Mq / 256, 8, F.G, F.vcu, 0);
          EpiRes E{nullptr, nullptr, X, X, modl + 10240};
          if (PH(9)) pg8::gemm_phase(F.lds, g, S, E); }
        GSYNC();

}

__global__ void __launch_bounds__(NT) fwd_megakernel(Params p) {
    extern __shared__ __attribute__((aligned(16))) unsigned char lds_raw[];
    cg::grid_group grid = cg::this_grid();
    const int tid_ = threadIdx.x, G_ = gridDim.x, bx_ = blockIdx.x;
    Frame F{(LAS unsigned char*)lds_raw, lds_raw, tid_, tid_ & 63, __builtin_amdgcn_readfirstlane(tid_ >> 6), G_, (G_ % 8 == 0) ? (bx_ % 8) * (G_ / 8) + bx_ / 8 : bx_, p, p.ws};
    volatile LAS unsigned* xst = (volatile LAS unsigned*)(F.lds + 135 * 1024);
    if (F.tid == 0) { xst[0] = 0u; xst[1] = 0u; }
    __syncthreads();
    (void)xcd_barrier_post((unsigned*)(p.ws + WS_BAR), xst);
    REP(0) { if (PH(0)) { p_mod(F);
    p_tables(F);
    p_convert(F); }
    grid.sync(); F.refresh(); }

    for (int l = 0; l < 2; ++l) layer_body(F, l);
    if (PH(1)) norm_phase(F, nullptr, nullptr, X, ML, F.inp(20), nullptr, 0, 0, nullptr, F.outp());
}
#undef Hbuf
#undef H
#undef X
#undef U
#undef SSQ
#undef CAT
#undef mod
#undef rope
#undef modl
#undef xbl


extern "C" void kernel_launch(void* const* d_in, const int* in_sizes, int n_in, void* d_out, int out_size, void* d_ws, size_t ws_size, hipStream_t stream) {
    static int grid_blocks = 0;
    if (!grid_blocks) {
        int dev = 0, cus = 0, per_cu = 0;
        hipGetDevice(&dev);
        hipDeviceGetAttribute(&cus, hipDeviceAttributeMultiprocessorCount, dev);
        hipFuncSetAttribute((const void*)fwd_megakernel, hipFuncAttributeMaxDynamicSharedMemorySize, LDS_BYTES);
        hipOccupancyMaxActiveBlocksPerMultiprocessor(&per_cu, (const void*)fwd_megakernel, NT, LDS_BYTES);
        if (per_cu < 1) { fprintf(stderr, "occupancy query says %d blocks/CU\n", per_cu); per_cu = 1; }
        grid_blocks = cus;
        if (ws_size < WS_END) fprintf(stderr, "workspace too small: %zu < %zu\n", ws_size, (size_t)WS_END);
    }
    Params p{};
    for (int i = 0; i < 21; ++i) p.in[i] = (const float*)d_in[i];
    p.out = (float*)d_out; p.ws = (unsigned char*)d_ws;
    hipMemsetAsync((unsigned char*)d_ws + WS_BAR, 0, 16384, stream);
    void* args[] = {&p};
    hipError_t e = hipLaunchCooperativeKernel((const void*)fwd_megakernel, dim3(grid_blocks), dim3(NT), args, LDS_BYTES, stream);
    if (e != hipSuccess) fprintf(stderr, "cooperative launch failed: %s (grid %d)\n", hipGetErrorString(e), grid_blocks);
}
```

```cpp
#include <hip/hip_runtime.h>
#include <hip/hip_cooperative_groups.h>
#include <cstdio>
namespace cg = cooperative_groups;

#define LAS __attribute__((address_space(3)))
#define GAS __attribute__((address_space(1)))
template <class T> __device__ __forceinline__ T* as_global(T* p) { return p; }
#define DI __device__ __forceinline__
typedef unsigned short bf16_t;
typedef short bf16x8 __attribute__((ext_vector_type(8)));
typedef short s16x4 __attribute__((ext_vector_type(4)));
typedef float f32x4 __attribute__((ext_vector_type(4)));
typedef float f32x2 __attribute__((ext_vector_type(2)));
typedef float f32x16 __attribute__((ext_vector_type(16)));
typedef unsigned u32x4 __attribute__((ext_vector_type(4)));
typedef unsigned u32x2 __attribute__((ext_vector_type(2)));
typedef __bf16 bfv2 __attribute__((ext_vector_type(2)));

constexpr int D = 2048, NB = 4, SEQ = 4096, CTXL = 256, ML = NB * SEQ, MC = NB * CTXL, MT = ML + MC;
constexpr int INC = 3136, UC = 3328;
constexpr int U_CQ = 0, U_CKV = 512, U_QN = 1024, U_KN = 1536, U_VN = 2048, U_F = 2560, U_KR = 3072;
constexpr int DFF = 5632, KEYS = SEQ + CTXL;
constexpr size_t DO_DFT = 0, DO_DFTC = (size_t)4096 * 4096, DO_FF = DO_DFTC + 256 * 512;
static_assert((DO_FF + (size_t)(ML + MC) * 1024) * 2 <= (size_t)ML * 2048 * 4, "d_out scratch");
constexpr float EPS = 1e-6f, LOG2E = 1.4426950408889634f;
constexpr int NT = 512;
constexpr int LDS_BYTES = 136 * 1024;

constexpr size_t al(size_t x) { return (x + 255) & ~(size_t)255; }
constexpr size_t WS_WIN = 0;
constexpr size_t WS_WUQ = WS_WIN + al((size_t)2 * UC * D * 2);
constexpr size_t WS_WUKV = WS_WUQ + al((size_t)2 * 1536 * 512 * 2);
constexpr size_t WS_WOUT = WS_WUKV + al((size_t)2 * 4096 * 512 * 2);
constexpr size_t WS_WUP = WS_WOUT + al((size_t)2 * D * D * 2);
constexpr size_t WS_WDN = WS_WUP + al((size_t)2 * 2 * DFF * D * 2);
constexpr size_t WS_WC = WS_WDN + al((size_t)2 * D * DFF * 2);
constexpr size_t WS_DFTC = WS_WC + al((size_t)2 * 1024 * 1024 * 2);
constexpr size_t WS_TRIG = WS_DFTC + al((size_t)256 * 512 * 2);
constexpr size_t WS_ROPE = WS_TRIG + al(4096 * 8);
constexpr size_t WS_MOD = WS_ROPE + al(64 * 16 * 8);
constexpr size_t WS_CTR = WS_MOD + al((size_t)2 * 5 * 12288 * 4);
constexpr size_t WS_BAR = WS_CTR + 256;
constexpr size_t WS_X = WS_BAR + 16384;
constexpr size_t WS_H = WS_X + al((size_t)MT * D * 4);
constexpr size_t H_ROWS = 1 + MT + 256;
constexpr size_t WS_CAT = WS_H + al(H_ROWS * D * 2);
constexpr size_t WS_YTC = WS_CAT + al((size_t)MT * D * 2);
constexpr size_t WS_U = WS_YTC + al((size_t)2048 * 512 * 2);
constexpr size_t WS_SSQ = WS_U + al((size_t)MT * UC * 2);
constexpr size_t WS_Q = WS_SSQ + al((size_t)MT * 16 * 4);
constexpr size_t WS_KN = WS_Q + al((size_t)MT * 1536 * 2);
constexpr size_t WS_VT = WS_KN + al((size_t)MT * 1024 * 2);
constexpr size_t WS_VNT = WS_VT + al((size_t)32 * 128 * KEYS * 2);
constexpr size_t WS_YT = WS_VNT + al((size_t)16 * 128 * KEYS * 2);
constexpr size_t WS_END = WS_YT + al((size_t)2048 * 8192 * 2);
constexpr size_t WS_ACT = WS_U;
static_assert(WS_ACT + (size_t)MT * DFF * 2 <= WS_END, "ACT alias");
static_assert((size_t)4096 * 8192 * 2 <= H_ROWS * D * 2, "DFT alias");
static_assert(WS_END <= (size_t)805306368, "workspace");

struct Params { const float* in[21]; float* out; unsigned char* ws; };

DI unsigned pk2(float a, float b) { f32x2 v = {a, b}; bfv2 r = __builtin_convertvector(v, bfv2); return __builtin_bit_cast(unsigned, r); }
DI bf16_t f2bf(float a) { return (bf16_t)(pk2(a, 0.f) & 0xffffu); }
DI float shx(float v, int m, int lane) { return __builtin_bit_cast(float, __builtin_amdgcn_ds_bpermute((lane ^ m) << 2, __builtin_bit_cast(int, v))); }
DI f32x4 bf4(u32x2 w) { f32x4 r; r[0] = __builtin_bit_cast(float, w.x << 16); r[1] = __builtin_bit_cast(float, w.x & 0xffff0000u); r[2] = __builtin_bit_cast(float, w.y << 16); r[3] = __builtin_bit_cast(float, w.y & 0xffff0000u); return r; }
DI float sq4(f32x4 v) { return (v[0] * v[0] + v[1] * v[1]) + (v[2] * v[2] + v[3] * v[3]); }
DI u32x4 pk8(f32x4 a, f32x4 b) { u32x4 w; w.x = pk2(a[0], a[1]); w.y = pk2(a[2], a[3]); w.z = pk2(b[0], b[1]); w.w = pk2(b[2], b[3]); return w; }

namespace pg8 {
constexpr int BM = 256, BK = 64, HALF = 128, HTB = HALF * BK * 2, STAGE_BYTES = 8 * HTB;
DI int lds_byte(int r, int c) { const int st = (r >> 4) * 2 + (c >> 5), rr = r & 15, cc = c & 31, ob = rr * 64 + cc * 2; return st * 1024 + (ob ^ (((ob >> 9) & 1) << 5)); }
DI void stage_rc(int b, int& R, int& C) { const int st = b / 1024, sb = b % 1024, swz = sb ^ (((sb >> 9) & 1) << 5); R = (st >> 1) * 16 + swz / 64; C = (st & 1) * 32 + (swz % 64) / 2; }
DI int perm32(int rho) { const int n = rho >> 4, i = rho & 15; return 8 * (i >> 2) + 4 * n + (i & 3); }
struct Unit { int pm, pn, kob; };
struct Gemm { const bf16_t* A; const bf16_t* Bt; int lda, ldb, K; int conv; };

struct Sched {
    int nM, nN, cnt, G, c, i0, start, kobm = 0;
    DI void init(int nM_, int nN_, int G_, int c_, int start_) { nM = nM_; nN = nN_; cnt = nM * nN; G = G_; c = c_; start = start_;
        i0 = (start_ > c_) ? (start_ - c_ + G_ - 1) / G_ : 0; }
    DI bool next(int i, Unit& u) const {
        const long L = (long)(i0 + i) * G + c - start; if (L >= cnt) return false;
        const int w = (int)L, nig = 8 * nN, gid = w / nig, fm = gid * 8, gsz = (nM - fm) < 8 ? (nM - fm) : 8;
        u.pm = fm + ((w % nig) % gsz); u.pn = (w % nig) / gsz; u.kob = kobm * u.pm; return true;
    }
};
struct OneUnit { Unit u; bool has; DI bool next(int i, Unit& o) const { o = u; return has && i == 0; } };

template <class Epi, class SchedT>
DI void gemm_phase(LAS unsigned char* lds, const Gemm g, const SchedT& S, const Epi& E) {
    int tid = threadIdx.x; asm volatile("" : "+v"(tid));
    const int wid = __builtin_amdgcn_readfirstlane(tid >> 6), lane = tid & 63, wr = wid >> 2, wc = wid & 3, fr = lane & 15, fq = lane >> 4;
    const int K = g.K, nt = K / BK;
    unsigned voffA[2], voffB[2];
    auto mk_voff = [&]() { int t2 = threadIdx.x; asm volatile("" : "+v"(t2));
#pragma unroll
        for (int i = 0; i < 2; ++i) { int R, C; stage_rc(t2 * 16 + i * 8192, R, C); const int Rb = Epi::PERM ? ((R & ~31) + perm32(R & 31)) : R;
            const int Ra = g.conv ? ((R >> 6) * 126 + (R & 63)) : R;
            voffA[i] = (unsigned)(Ra * g.lda + C) * 2u; voffB[i] = (unsigned)(Rb * g.ldb + C) * 2u; } };
    mk_voff();
    const size_t kstep = (size_t)(BK * 2);
    const size_t hstepA = (size_t)(g.conv ? 64 : HALF) * g.lda * 2, hstepB = (size_t)HALF * g.ldb * 2;
    const size_t tstepA = g.conv ? (size_t)252 * g.lda * 2 : 2 * hstepA, tstepB = 2 * hstepB;
    const unsigned ldsw = (unsigned)wid * 1024u;
    const int aoff = lds_byte(wr * 64 + fr, fq * 8), boff = lds_byte(wc * 32 + fr, fq * 8);
#define PG8_SA(b, h) (((b) * 2 + (h)) * HTB)
#define PG8_SB(b, h) ((4 + (b) * 2 + (h)) * HTB)
#define PG8_STAGE(bufoff, gbase, voff) do { _Pragma("unroll") for (int _i = 0; _i < 2; ++_i) \
        __builtin_amdgcn_global_load_lds((const unsigned*)((const char*)(gbase) + (voff)[_i]), (LAS unsigned*)(lds + (bufoff) + ldsw + _i * 8192), 16, 0, 0); } while (0)
#define PG8_LDA(dst, b, h) do { _Pragma("unroll") for (int m = 0; m < 4; ++m) _Pragma("unroll") for (int k = 0; k < 2; ++k) dst[m][k] = *(const LAS bf16x8*)(lds + PG8_SA(b, h) + aoff + m * 2048 + k * 1024); } while (0)
#define PG8_LDB(dst, b, h) do { _Pragma("unroll") for (int n = 0; n < 2; ++n) _Pragma("unroll") for (int k = 0; k < 2; ++k) dst[n][k] = *(const LAS bf16x8*)(lds + PG8_SB(b, h) + boff + n * 2048 + k * 1024); } while (0)
#define PG8_MMA(ai, bj, At, Bt) do { __builtin_amdgcn_s_setprio(1); _Pragma("unroll") for (int m = 0; m < 4; ++m) _Pragma("unroll") for (int n = 0; n < 2; ++n) _Pragma("unroll") for (int k = 0; k < 2; ++k) \
        acc[ai][bj][m][n] = __builtin_amdgcn_mfma_f32_16x16x32_bf16(Bt[n][k], At[m][k], acc[ai][bj][m][n], 0, 0, 0); __builtin_amdgcn_s_setprio(0); } while (0)
#define PG8_WAIT_V(n) asm volatile("s_waitcnt vmcnt(" #n ")" ::: "memory")
#define PG8_WAIT_L(n) asm volatile("s_waitcnt lgkmcnt(" #n ")" ::: "memory")
#define PG8_BAR __builtin_amdgcn_s_barrier()
#define PG8_SCHED __builtin_amdgcn_sched_barrier(0)
    Unit cur, nxt; int ui = 0;
    if (!S.next(0, cur)) return;
    f32x4 acc[2][2][4][2];
#pragma unroll
    for (int a = 0; a < 2; ++a)
#pragma unroll
        for (int b = 0; b < 2; ++b)
#pragma unroll
            for (int m = 0; m < 4; ++m)
#pragma unroll
                for (int n = 0; n < 2; ++n) acc[a][b][m][n] = (f32x4){0.f, 0.f, 0.f, 0.f};
    bf16x8 At[4][2], B0[2][2], B1[2][2];
    const char* cA = (const char*)g.A + (size_t)cur.pm * tstepA; const char* cB = (const char*)g.Bt + (size_t)cur.pn * tstepB + (size_t)cur.kob * 2;
    PG8_STAGE(PG8_SB(0, 0), cB, voffB); PG8_STAGE(PG8_SA(0, 0), cA, voffA); PG8_STAGE(PG8_SB(0, 1), cB + hstepB, voffB); PG8_STAGE(PG8_SA(0, 1), cA + hstepA, voffA);
    if (wr == 1) PG8_BAR;
    PG8_WAIT_V(4); PG8_BAR;
    PG8_STAGE(PG8_SB(1, 0), cB + kstep, voffB); PG8_STAGE(PG8_SA(1, 0), cA + kstep, voffA); PG8_STAGE(PG8_SB(1, 1), cB + hstepB + kstep, voffB);
    PG8_WAIT_V(6); PG8_BAR;
    for (;;) {
        const bool has_next = S.next(ui + 1, nxt);
        const char* nA = has_next ? (const char*)g.A + (size_t)nxt.pm * tstepA : cA; const char* nB = has_next ? (const char*)g.Bt + (size_t)nxt.pn * tstepB + (size_t)nxt.kob * 2 : cB;
        for (int t = 0; t < nt; t += 2) {
            const bool last = (t == nt - 2);
            const char* a1 = cA + (size_t)(t + 1) * kstep;
            const char* a2 = last ? nA : cA + (size_t)(t + 2) * kstep; const char* b2 = last ? nB : cB + (size_t)(t + 2) * kstep;
            const char* a3 = a2 + kstep; const char* b3 = b2 + kstep;
            PG8_LDB(B0, 0, 0); PG8_SCHED; PG8_LDA(At, 0, 0); PG8_STAGE(PG8_SA(1, 1), a1 + hstepA, voffA);
            PG8_WAIT_L(8); PG8_BAR; PG8_WAIT_L(0); PG8_MMA(0, 0, At, B0); PG8_BAR; PG8_SCHED;
            PG8_LDB(B1, 0, 1); PG8_STAGE(PG8_SB(0, 0), b2, voffB);
            PG8_BAR; PG8_WAIT_L(0); PG8_MMA(0, 1, At, B1); PG8_BAR;
            PG8_LDA(At, 0, 1); PG8_STAGE(PG8_SA(0, 0), a2, voffA);
            PG8_BAR; PG8_WAIT_L(0); PG8_MMA(1, 0, At, B0); PG8_BAR; PG8_SCHED;
            PG8_STAGE(PG8_SB(0, 1), b2 + hstepB, voffB);
            PG8_WAIT_V(6); PG8_BAR; PG8_MMA(1, 1, At, B1); PG8_BAR;
            PG8_LDB(B0, 1, 0); PG8_SCHED; PG8_LDA(At, 1, 0); PG8_STAGE(PG8_SA(0, 1), a2 + hstepA, voffA);
            PG8_WAIT_L(8); PG8_BAR; PG8_WAIT_L(0); PG8_MMA(0, 0, At, B0); PG8_BAR; PG8_SCHED;
            PG8_LDB(B1, 1, 1); PG8_STAGE(PG8_SB(1, 0), b3, voffB);
            PG8_BAR; PG8_WAIT_L(0); PG8_MMA(0, 1, At, B1); PG8_BAR;
            PG8_LDA(At, 1, 1); PG8_STAGE(PG8_SA(1, 0), a3, voffA);
            PG8_BAR; PG8_WAIT_L(0); PG8_MMA(1, 0, At, B0); PG8_BAR; PG8_SCHED;
            PG8_STAGE(PG8_SB(1, 1), b3 + hstepB, voffB);
            PG8_WAIT_V(6); PG8_BAR; PG8_MMA(1, 1, At, B1); PG8_BAR;
        }
        { int fr2 = fr, fq2 = fq, wr2 = wr, wc2 = wc; asm volatile("" : "+v"(fr2), "+v"(fq2), "+s"(wr2), "+s"(wc2));
          E(acc, cur, wr2, wc2, fr2, fq2); }
        if (has_next) mk_voff();
        if (!has_next) break;
#pragma unroll
        for (int a = 0; a < 2; ++a)
#pragma unroll
            for (int b = 0; b < 2; ++b)
#pragma unroll
                for (int m = 0; m < 4; ++m)
#pragma unroll
                    for (int n = 0; n < 2; ++n) acc[a][b][m][n] = (f32x4){0.f, 0.f, 0.f, 0.f};
        cur = nxt; cA = nA; cB = nB; ++ui;
    }
    PG8_WAIT_V(0);
    if (wr == 0) PG8_BAR;
    PG8_BAR;
#undef PG8_SA
#undef PG8_SB
#undef PG8_STAGE
#undef PG8_LDA
#undef PG8_LDB
#undef PG8_MMA
#undef PG8_WAIT_V
#undef PG8_WAIT_L
#undef PG8_BAR
#undef PG8_SCHED
}
}
using pg8::Unit;
typedef const f32x4 (&AccRef)[2][2][4][2];

DI void row_bk(int row, int& b, int& key) { if (row < ML) { b = row >> 12; key = row & 4095; } else { const int rc = row - ML; b = rc >> 8; key = SEQ + (rc & 255); } }
DI void rope8(f32x4& v0, f32x4& v1, int row, int axis, int fq, int lane, const f32x2* rope) {
    const int l = row & 4095, pos = axis ? (l & 63) : (l >> 6);
    const f32x2* t = rope + pos * 16 + 8 * (fq & 1);
    const float sgn = (fq < 2) ? -1.f : 1.f;
#pragma unroll
    for (int j = 0; j < 4; ++j) {
        const float p0 = shx(v0[j], 32, lane), p1 = shx(v1[j], 32, lane);
        const f32x2 c0 = t[j], c1 = t[4 + j];
        v0[j] = v0[j] * c0.x + sgn * p0 * c0.y; v1[j] = v1[j] * c1.x + sgn * p1 * c1.y;
    }
}

struct EpiU {
    static constexpr bool PERM = true;
    bf16_t* U; float* ssq; bf16_t* VnT; const f32x2* rope; float qscale; bf16_t* FF;
    DI void operator()(AccRef acc, const Unit& u, int wr, int wc, int fr, int fq) const {
        const int pn = u.pn, rowb = u.pm * 256 + wr * 64 + fr;
        if (pn == 10 || pn == 11) {
#pragma unroll
            for (int ai = 0; ai < 2; ++ai)
#pragma unroll
                for (int m = 0; m < 4; ++m) { const int row = rowb + ai * 128 + m * 16; const int mrow = row < ML ? ((row & ~4095) | ((4096 - (row & 4095)) & 4095)) : row;
#pragma unroll
                    for (int bj = 0; bj < 2; ++bj) { const int c = 256 * (2 * (pn - 10) + bj) + 32 * wc + 8 * fq; const u32x4 w = pk8(acc[ai][bj][m][0], acc[ai][bj][m][1]);
                        *(u32x4*)(FF + (size_t)row * 1024 + c) = w;
                        *(u32x4*)(FF + (size_t)mrow * 1024 + 128 + c) = (row < ML) ? w : (u32x4){0u, 0u, 0u, 0u}; } }
            return;
        }
        if (pn == 8 || pn == 9) {
#pragma unroll
            for (int ai = 0; ai < 2; ++ai)
#pragma unroll
                for (int m = 0; m < 4; ++m) { int b, key; row_bk(rowb + ai * 128 + m * 16, b, key);
#pragma unroll
                    for (int bj = 0; bj < 2; ++bj) { const int hn = 2 * (pn - 8) + bj;
#pragma unroll
                        for (int n = 0; n < 2; ++n) { bf16_t* dst = VnT + ((size_t)((b * 4 + hn) * 128 + 32 * wc + 8 * fq + 4 * n)) * KEYS + key;
#pragma unroll
                            for (int j = 0; j < 4; ++j) dst[(size_t)j * KEYS] = f2bf(acc[ai][bj][m][n][j]); } } }
            return;
        }
        const float sc = (pn == 4 || pn == 5) ? qscale : 1.f;
#pragma unroll
        for (int ai = 0; ai < 2; ++ai)
#pragma unroll
            for (int m = 0; m < 4; ++m) { const int row = rowb + ai * 128 + m * 16; float ss = 0.f;
#pragma unroll
                for (int bj = 0; bj < 2; ++bj) { f32x4 v0 = acc[ai][bj][m][0] * sc, v1 = acc[ai][bj][m][1] * sc;
                    if (pn == 12 && bj == 0 && wc < 2 && row < ML) rope8(v0, v1, row, wc & 1, fq, fq * 16 + fr, rope);
                    ss += sq4(v0) + sq4(v1);
                    *(u32x4*)(U + (size_t)row * UC + 256 * pn + 128 * bj + 32 * wc + 8 * fq) = pk8(v0, v1); }
                if (pn < 4) { ss += shx(ss, 16, fq * 16 + fr); ss += shx(ss, 32, fq * 16 + fr); if (fq == 0) ssq[(size_t)row * 16 + pn * 4 + wc] = ss; } }
    }
};
DI float row_rstd(const float* ssq, int row, int which) { const f32x4 a = *(const f32x4*)(ssq + (size_t)row * 16 + which * 8), b = *(const f32x4*)(ssq + (size_t)row * 16 + which * 8 + 4);
    const float s = ((a[0] + a[1]) + (a[2] + a[3])) + ((b[0] + b[1]) + (b[2] + b[3])); return __builtin_amdgcn_rsqf(s * (1.f / 512.f) + EPS); }
struct EpiQ {
    static constexpr bool PERM = true;
    bf16_t* Q; const float* ssq; const f32x2* rope; float scale;
    DI void operator()(AccRef acc, const Unit& u, int wr, int wc, int fr, int fq) const {
        const int rowb = u.pm * 256 + wr * 64 + fr;
#pragma unroll
        for (int ai = 0; ai < 2; ++ai)
#pragma unroll
            for (int m = 0; m < 4; ++m) { const int row = rowb + ai * 128 + m * 16; const float rs = row_rstd(ssq, row, 0) * scale;
#pragma unroll
                for (int bj = 0; bj < 2; ++bj) { const int c32 = 256 * u.pn + 128 * bj + 32 * wc; f32x4 v0 = acc[ai][bj][m][0] * rs, v1 = acc[ai][bj][m][1] * rs;
                    if (((c32 >> 6) % 3) == 2 && row < ML) rope8(v0, v1, row, (c32 >> 5) & 1, fq, fq * 16 + fr, rope);
                    *(u32x4*)(Q + (size_t)row * 1536 + c32 + 8 * fq) = pk8(v0, v1); } }
    }
};
struct EpiKV {
    static constexpr bool PERM = true;
    bf16_t* KN; bf16_t* VT; const float* ssq;
    DI void operator()(AccRef acc, const Unit& u, int wr, int wc, int fr, int fq) const {
        const int pn = u.pn, rowb = u.pm * 256 + wr * 64 + fr;
#pragma unroll
        for (int ai = 0; ai < 2; ++ai)
#pragma unroll
            for (int m = 0; m < 4; ++m) { const int row = rowb + ai * 128 + m * 16; const float rs = row_rstd(ssq, row, 1); int b, key; row_bk(row, b, key);
#pragma unroll
                for (int bj = 0; bj < 2; ++bj) {
                    if (pn < 4) { *(u32x4*)(KN + (size_t)row * 1024 + 256 * pn + 128 * bj + 32 * wc + 8 * fq) = pk8(acc[ai][bj][m][0] * rs, acc[ai][bj][m][1] * rs); }
                    else { const int h = 2 * (pn - 4) + bj;
#pragma unroll
                        for (int n = 0; n < 2; ++n) { bf16_t* dst = VT + ((size_t)((b * 8 + h) * 128 + 32 * wc + 8 * fq + 4 * n)) * KEYS + key;
#pragma unroll
                            for (int j = 0; j < 4; ++j) dst[(size_t)j * KEYS] = f2bf(acc[ai][bj][m][n][j] * rs); } } } }
    }
};
struct EpiY {
    static constexpr bool PERM = true;
    bf16_t* YT; bf16_t* YTc; int tok_base;
    DI void operator()(AccRef acc, const Unit& u, int wr, int wc, int fr, int fq) const {
        const int g = u.pm;
#pragma unroll
        for (int ai = 0; ai < 2; ++ai)
#pragma unroll
            for (int m = 0; m < 4; ++m) { const int d = 64 * wr + 16 * m + fr;
#pragma unroll
                for (int bj = 0; bj < 2; ++bj) { const int tok = tok_base + 256 * u.pn + 128 * bj + 32 * wc + 8 * fq; const u32x4 w = pk8(acc[ai][bj][m][0], acc[ai][bj][m][1]);
                    if (tok < ML) { const int b = tok >> 12, l = tok & 4095; bf16_t* rowp = YT + ((size_t)((b * 4 + g) * 128 + d)) * 4096;
                        if (l < 2048) {
                            if (ai == 0) *(u32x4*)(rowp + l) = w;
                            else if (l != 0) *(u32x4*)(rowp + 2048 + l) = w;
                            else { bf16_t* q = rowp + 2048; q[1] = (bf16_t)(w.x >> 16); q[2] = (bf16_t)w.y; q[3] = (bf16_t)(w.y >> 16); q[4] = (bf16_t)w.z; q[5] = (bf16_t)(w.z >> 16); q[6] = (bf16_t)w.w; q[7] = (bf16_t)(w.w >> 16); }
                        } else if (l == 2048 && ai == 0) rowp[2048] = (bf16_t)w.x;
                    } else { const int tc = tok - ML, b = tc >> 8, l = tc & 255; *(u32x4*)(YTc + ((size_t)((b * 4 + g) * 128 + d)) * 512 + ai * 256 + l) = w; } } }
    }
};
struct SchedY {
    int G, c, i0, start;
    DI void init(int G_, int c_, int start_) { G = G_; c = c_; start = start_; i0 = (start_ > c_) ? (start_ - c_ + G_ - 1) / G_ : 0; }
    DI bool next(int i, Unit& u) const { const int L = (i0 + i) * G + c - start; if (L >= 144) return false; const int bt = L >> 2; u.pm = L & 3; u.pn = (bt / 9) * 16 + (bt % 9); u.kob = 256 * u.pm; return true; }
};
struct EpiF {
    static constexpr bool PERM = true;
    bf16_t* CAT; int ctx;
    DI void operator()(AccRef acc, const Unit& u, int wr, int wc, int fr, int fq) const {
        const int b = u.pn >> 1;
#pragma unroll
        for (int ai = 0; ai < 2; ++ai)
#pragma unroll
            for (int m = 0; m < 4; ++m) { const int lp = u.pm * 256 + 128 * ai + 64 * wr + 16 * m + fr; const int row = ctx ? (ML + b * 256 + lp) : (b * 4096 + lp);
#pragma unroll
                for (int bj = 0; bj < 2; ++bj) { const int g = 2 * (u.pn & 1) + bj;
                    *(u32x4*)(CAT + (size_t)row * D + 1536 + g * 128 + 32 * wc + 8 * fq) = pk8(acc[ai][bj][m][0], acc[ai][bj][m][1]); } }
    }
};
struct EpiRes {
    static constexpr bool PERM = false;
    const float* xl; const float* xc; const bf16_t* xb; bf16_t* out; const float* gate;
    DI void operator()(AccRef acc, const Unit& u, int wr, int wc, int fr, int fq) const {
        const int row0 = u.pm * 256; const int midx = row0 < ML ? (row0 >> 12) : 4;
        const float* src = row0 < ML ? xl : (xc - (size_t)ML * D);
        const float* gp = gate + (size_t)midx * 12288;
        const int col0 = u.pn * 256 + wc * 32 + 4 * fq;
        f32x4 gv[2][2];
#pragma unroll
        for (int bj = 0; bj < 2; ++bj)
#pragma unroll
            for (int n = 0; n < 2; ++n) gv[bj][n] = *(const f32x4*)(gp + col0 + bj * 128 + n * 16);
        if (xb) {
#pragma unroll
            for (int ai = 0; ai < 2; ++ai)
#pragma unroll
                for (int m = 0; m < 4; ++m) { const size_t off = (size_t)(row0 + wr * 64 + fr + ai * 128 + m * 16) * D + col0;
#pragma unroll
                    for (int bj = 0; bj < 2; ++bj)
#pragma unroll
                        for (int n = 0; n < 2; ++n) { const size_t o2 = off + bj * 128 + n * 16;
                            const f32x4 r = bf4(*(const u32x2*)(xb + o2)) + gv[bj][n] * acc[ai][bj][m][n];
                            u32x2 w; w.x = pk2(r[0], r[1]); w.y = pk2(r[2], r[3]); *(u32x2*)(out + o2) = w; }
                    asm volatile("" ::: "memory"); }
        } else {
#pragma unroll
            for (int ai = 0; ai < 2; ++ai)
#pragma unroll
                for (int m = 0; m < 4; ++m) { const size_t off = (size_t)(row0 + wr * 64 + fr + ai * 128 + m * 16) * D + col0;
#pragma unroll
                    for (int bj = 0; bj < 2; ++bj)
#pragma unroll
                        for (int n = 0; n < 2; ++n) { const size_t o2 = off + bj * 128 + n * 16;
                            const f32x4 r = *(const f32x4*)(src + o2) + gv[bj][n] * acc[ai][bj][m][n];
                            u32x2 w; w.x = pk2(r[0], r[1]); w.y = pk2(r[2], r[3]); *(u32x2*)(out + o2) = w; }
                    asm volatile("" ::: "memory"); }
        }
    }
};
DI float dpp_ror1(float v) { return __builtin_bit_cast(float, __builtin_amdgcn_update_dpp(0, __builtin_bit_cast(int, v), 0x121, 0xf, 0xf, false)); }
DI float dpp_ror15(float v) { return __builtin_bit_cast(float, __builtin_amdgcn_update_dpp(0, __builtin_bit_cast(int, v), 0x12f, 0xf, 0xf, false)); }
struct EpiConv {
    static constexpr bool PERM = true;
    bf16_t* ACT; const float* cw; const float* cb; int Mq;
    DI void operator()(AccRef acc, const Unit& u, int wr, int wc, int fr, int fq) const {
#pragma unroll
        for (int n = 0; n < 2; ++n) {
            const int cg_ = 128 * u.pn + 32 * wc + 8 * fq + 4 * n;
#pragma unroll
            for (int ai = 0; ai < 2; ++ai) {
                const int tok0 = 252 * u.pm - 1 + 126 * wr + 64 * ai;
                f32x4 o[4];
#pragma unroll
                for (int bj = 0; bj < 2; ++bj) {
                    f32x4 w[2][4];
#pragma unroll
                    for (int t = 0; t < 3; ++t) w[bj][t] = *(const f32x4*)(cw + (size_t)t * 2 * DFF + bj * DFF + cg_);
                    w[bj][3] = *(const f32x4*)(cb + bj * DFF + cg_);
#pragma unroll
                    for (int m = 0; m < 4; ++m) {
                        const int tok = tok0 + 16 * m + fr; const int msk = tok < ML ? 4095 : 255;
                        const bool hu = (tok & msk) != 0, hd = ((tok + 1) & msk) != 0;
                        f32x4 r = acc[ai][bj][m][n] * w[bj][1] + w[bj][3];
#pragma unroll
                        for (int j = 0; j < 4; ++j) {
                            const float su = ((m > 0 || ai == 1) && fr == 15) ? (m > 0 ? acc[ai][bj][(m + 3) & 3][n][j] : acc[0][bj][3][n][j]) : acc[ai][bj][m][n][j];
                            const float sd = ((m < 3 || ai == 0) && fr == 0) ? (m < 3 ? acc[ai][bj][(m + 1) & 3][n][j] : acc[1][bj][0][n][j]) : acc[ai][bj][m][n][j];
                            const float uu = dpp_ror1(su), dd = dpp_ror15(sd);
                            r[j] += hu ? uu * w[bj][0][j] : 0.f; r[j] += hd ? dd * w[bj][2][j] : 0.f; }
                        if (bj == 0) {
#pragma unroll
                            for (int j = 0; j < 4; ++j) o[m][j] = r[j] * __builtin_amdgcn_rcpf(1.f + __builtin_amdgcn_exp2f(-LOG2E * r[j]));
                        } else o[m] = o[m] * r;
                    }
                }
#pragma unroll
                for (int m = 0; m < 4; ++m) { const int li = 64 * ai + 16 * m + fr, tok = tok0 + 16 * m + fr;
                    if (li >= 1 && li <= 126 && tok < Mq) { u32x2 v; v.x = pk2(o[m][0], o[m][1]); v.y = pk2(o[m][2], o[m][3]);
                        *(u32x2*)(ACT + (size_t)tok * DFF + cg_) = v; } }
            }
        }
    }
};

struct Frame {
    LAS unsigned char* lds; unsigned char* ldsg; int tid, lane, wave, G, vcu;
    const Params& P; unsigned char* ws;
    DI const float* inp(int i) const { return as_global(P.in[i]); }
    DI float* outp() const { return as_global(P.out); }
    DI int nrep(int d) const { int n = 1 + d; asm volatile("" : "+s"(n)); return n; }
    DI void refresh() { int t = threadIdx.x; asm volatile("" : "+v"(t)); tid = t; lane = t & 63; wave = __builtin_amdgcn_readfirstlane(t >> 6);
        long z = 0; asm volatile("" : "+s"(z)); ws = P.ws + z;
        int g = gridDim.x, bx = blockIdx.x; asm volatile("" : "+s"(g), "+s"(bx)); G = g; vcu = (g % 8 == 0) ? (bx % 8) * (g / 8) + bx / 8 : bx; }
};

DI void p_mod(const Frame& F) {
    LAS float* sv = (LAS float*)F.lds; LAS float* red = sv + 5 * 2048;
    const float* c = F.inp(1); const float* cc = F.inp(3);
    for (int i = F.tid; i < 5 * 2048; i += NT) { const int r = i >> 11, k = i & 2047; const float v = r < 4 ? c[r * 2048 + k] : cc[k]; sv[i] = v / (1.f + __expf(-v)); }
    __syncthreads();
    float* mod = (float*)(F.ws + WS_MOD);
    for (int tile = F.vcu; tile < 768; tile += F.G) {
        const int l = tile / 384, colb = (tile % 384) * 32, cl = F.tid & 31, kg = F.tid >> 5;
        const float* w = F.inp(4) + (size_t)l * 2048 * 12288 + colb + cl;
        float a0 = 0.f, a1 = 0.f, a2 = 0.f, a3 = 0.f, a4 = 0.f;
#pragma unroll 32
        for (int k = kg * 128; k < kg * 128 + 128; ++k) { const float wv = __builtin_nontemporal_load(w + (size_t)k * 12288); a0 += sv[k] * wv; a1 += sv[2048 + k] * wv; a2 += sv[4096 + k] * wv; a3 += sv[6144 + k] * wv; a4 += sv[8192 + k] * wv; }
        LAS float* rp = red + (kg * 32 + cl) * 5; rp[0] = a0; rp[1] = a1; rp[2] = a2; rp[3] = a3; rp[4] = a4;
        __syncthreads();
        if (F.tid < 160) { const int r = F.tid >> 5; float s = 0.f;
#pragma unroll
            for (int q = 0; q < 16; ++q) s += red[(q * 32 + cl) * 5 + r];
            mod[(size_t)(l * 5 + r) * 12288 + colb + cl] = s + F.inp(5)[l * 12288 + colb + cl]; }
        __syncthreads();
    }
}
DI void p_tables(const Frame& F) {
    const int gt = F.vcu * NT + F.tid, gn = F.G * NT;
    LAS f32x2* t4096 = (LAS f32x2*)F.lds;
    __syncthreads();
    for (int i = F.tid; i < 4096; i += NT) { f32x2 v; v.x = cospif((float)i / 2048.f); v.y = sinpif((float)i / 2048.f); t4096[i] = v; }
    __syncthreads();
    f32x2* rope = (f32x2*)(F.ws + WS_ROPE);
    for (int i = gt; i < 1024; i += gn) { const int pos = i >> 4, k = i & 15; const float fr = powf(10000.f, -(float)k / 16.f); const float a = (float)pos * fr; f32x2 v; v.x = cosf(a); v.y = sinf(a); rope[i] = v; }
    if (gt < 32) ((unsigned*)(F.ws + WS_CTR))[gt] = 0u;
    if (F.tid == 0) *(float**)(F.ws + WS_CTR + 128) = F.outp();
    bf16_t* dc = (bf16_t*)F.outp() + DO_DFTC;
    for (int i = gt; i < 256 * 512; i += gn) { const int lp = i >> 9, cc = i & 511, part = cc >> 8, l = cc & 255; const f32x2 t = t4096[((lp * l) & 255) * 16];
        dc[i] = f2bf((part ? -t.y : t.x) * (1.f / 16.f)); }
    bf16_t* wc = (bf16_t*)(F.ws + WS_WC); const float* wf = F.inp(14);
    for (int i = gt; i < 2 * 4 * 2 * 128 * 128; i += gn) {
        const int d = i & 127, cch = (i >> 7) & 127, part = (i >> 14) & 1, g = (i >> 15) & 3, l = i >> 17;
        const float* wp = wf + ((size_t)(l * 4 + g) * 128) * 128 + d; float sacc = 0.f;
        for (int c2 = 0; c2 < 128; ++c2) { const f32x2 t = t4096[((cch * c2) & 127) * 32]; sacc += (part ? t.y : t.x) * wp[(size_t)c2 * 128]; }
        sacc *= 0.08838834764831845f;
        bf16_t* row = wc + ((size_t)l * 1024 + (g * 2 + part) * 128 + d) * 256;
        row[cch] = f2bf(sacc); row[128 + cch] = f2bf(part ? -sacc : sacc);
    }
    bf16_t* dft = (bf16_t*)F.outp() + DO_DFT;
    for (int ch = gt; ch < 4096 * 512; ch += gn) { const int lp = ch >> 9, k0 = (ch & 511) * 8; f32x4 a, b;
#pragma unroll
        for (int j = 0; j < 8; ++j) { const int k = k0 + j; const f32x2 t = t4096[(lp * (k & 2047) + (k == 2048 ? lp * 2048 : 0)) & 4095];
            const float v = (k <= 2048 ? t.x : -t.y) * ((k == 0 || k == 2048) ? (1.f / 128.f) : (1.f / 64.f));
            if (j < 4) a[j] = v; else b[j - 4] = v; }
        *(u32x4*)(dft + (size_t)lp * 4096 + k0) = pk8(a, b); }
    __syncthreads();
}
struct CvDesc { const float* src; const float* kscale; bf16_t* dst; int K, Nsrc, Ndst, mapid, ntiles; };
DI int cv_map(int mapid, int n) {
    if (mapid == 1) return n < 1024 ? n : (n < 3072 ? n + 64 : (n < 3136 ? n - 2048 : -1));
    if (mapid == 2) { const int which = n >> 10, h = (n >> 7) & 7, j = n & 127; return h * 256 + which * 128 + j; }
    if (mapid == 3) { const int pn = n >> 8, bj = (n >> 7) & 1, q = n & 127; return bj * DFF + pn * 128 + q; }
    return n;
}
DI CvDesc cv_desc(const Frame& F, int m) {
    const int l = m / 6, j = m % 6; CvDesc d; d.kscale = nullptr; d.mapid = 0;
    if (j == 0) { d.src = F.inp(8) + (size_t)l * D * INC; d.K = D; d.Nsrc = INC; d.dst = (bf16_t*)(F.ws + WS_WIN) + (size_t)l * UC * D; d.Ndst = UC; d.mapid = 1; }
    else if (j == 1) { d.src = F.inp(10) + (size_t)l * 512 * 1536; d.K = 512; d.Nsrc = 1536; d.dst = (bf16_t*)(F.ws + WS_WUQ) + (size_t)l * 1536 * 512; d.Ndst = 1536; d.kscale = F.inp(9) + l * 512; }
    else if (j == 2) { d.src = F.inp(12) + (size_t)l * 512 * 2048; d.K = 512; d.Nsrc = 2048; d.dst = (bf16_t*)(F.ws + WS_WUKV) + (size_t)l * 2048 * 512; d.Ndst = 2048; d.kscale = F.inp(11) + l * 512; d.mapid = 2; }
    else if (j == 3) { d.src = F.inp(15) + (size_t)l * D * D; d.K = D; d.Nsrc = D; d.dst = (bf16_t*)(F.ws + WS_WOUT) + (size_t)l * D * D; d.Ndst = D; }
    else if (j == 4) { d.src = F.inp(16) + (size_t)l * D * 2 * DFF; d.K = D; d.Nsrc = 2 * DFF; d.dst = (bf16_t*)(F.ws + WS_WUP) + (size_t)l * 2 * DFF * D; d.Ndst = 2 * DFF; d.mapid = 3; }
    else { d.src = F.inp(19) + (size_t)l * DFF * D; d.K = DFF; d.Nsrc = D; d.dst = (bf16_t*)(F.ws + WS_WDN) + (size_t)l * D * DFF; d.Ndst = D; }
    d.ntiles = (d.Ndst / 128) * (d.K / 64); return d;
}
struct CvTile { const float* src; const float* kscale; bf16_t* dst; int K, Nsrc, sc0, sc1, n0, k0; bool ok; };
DI CvTile cv_tile(const Frame& F, int t) {
    CvTile r; r.ok = false;
    constexpr int NTN[6] = {26, 12, 16, 16, 88, 16}, NT_[6] = {26 * 32, 12 * 8, 16 * 8, 16 * 32, 88 * 32, 16 * 88};
    constexpr int PER_LAYER = NT_[0] + NT_[1] + NT_[2] + NT_[3] + NT_[4] + NT_[5];
    if (t >= 2 * PER_LAYER) return r;
    const int l = t >= PER_LAYER ? 1 : 0; t -= l * PER_LAYER;
    int j = 0, nt = 0, kt = 0;
#pragma unroll
    for (int q = 0; q < 6; ++q) { if (t >= 0 && t < NT_[q]) { j = q; nt = t % NTN[q]; kt = t / NTN[q]; } t -= NT_[q]; }
    const CvDesc d = cv_desc(F, l * 6 + j);
    r.n0 = nt * 128; r.k0 = kt * 64; r.src = d.src; r.kscale = d.kscale; r.dst = d.dst; r.K = d.K; r.Nsrc = d.Nsrc;
    r.sc0 = cv_map(d.mapid, r.n0); r.sc1 = cv_map(d.mapid, r.n0 + 64); r.ok = true; return r;
}
DI void cv_load(const Frame& F, const CvTile& t, f32x4 (&r)[4]) {
#pragma unroll
    for (int h = 0; h < 2; ++h) { const int sc = h ? t.sc1 : t.sc0;
#pragma unroll
        for (int p = 0; p < 2; ++p) { const int kk = p * 32 + (F.tid >> 4);
            f32x4 v = {0.f, 0.f, 0.f, 0.f};
            if (sc >= 0) { v = __builtin_nontemporal_load((const f32x4*)(t.src + (size_t)(t.k0 + kk) * t.Nsrc + sc + (F.tid & 15) * 4)); if (t.kscale) v *= t.kscale[t.k0 + kk]; }
            r[h * 2 + p] = v; } }
}
DI void p_convert(const Frame& F) {
    LAS float* ts = (LAS float*)F.lds;
    int t = F.vcu; CvTile cur = cv_tile(F, t), nx1 = cv_tile(F, t + F.G); f32x4 r0[4], r1[4]; int buf = 0;
    if (cur.ok) cv_load(F, cur, r0);
    if (nx1.ok) cv_load(F, nx1, r1);
    while (cur.ok) {
        LAS float* tb = ts + buf * (2 * 64 * 65);
#pragma unroll
        for (int h = 0; h < 2; ++h)
#pragma unroll
            for (int p = 0; p < 2; ++p) { const int kk = p * 32 + (F.tid >> 4); LAS float* q = tb + h * (64 * 65) + kk * 65 + (F.tid & 15) * 4;
                q[0] = r0[h * 2 + p][0]; q[1] = r0[h * 2 + p][1]; q[2] = r0[h * 2 + p][2]; q[3] = r0[h * 2 + p][3]; }
        __syncthreads();
#pragma unroll
        for (int i = 0; i < 4; ++i) r0[i] = r1[i];
        const CvTile nx2 = cv_tile(F, t + 2 * F.G);
        if (nx2.ok) cv_load(F, nx2, r1);
#pragma unroll
        for (int h = 0; h < 2; ++h) { const int n = F.tid >> 3, kc = F.tid & 7; const LAS float* q = tb + h * (64 * 65) + n; f32x4 a, b;
#pragma unroll
            for (int j = 0; j < 4; ++j) { a[j] = q[(kc * 8 + j) * 65]; b[j] = q[(kc * 8 + 4 + j) * 65]; }
            *(u32x4*)(cur.dst + (size_t)(cur.n0 + h * 64 + n) * cur.K + cur.k0 + kc * 8) = pk8(a, b); }
        buf ^= 1; t += F.G; cur = nx1; nx1 = nx2;
    }
    __syncthreads();
}

DI void norm_phase(const Frame& F, const float* xl, const float* xc, const bf16_t* xb, int M, const float* g, const float* modl, int sh_off, int sc_off, bf16_t* H, float* outf) {
    const int gw = F.vcu * 8 + F.wave, nw = F.G * 8;
    for (int row = gw; row < M; row += nw) {
        f32x4 v[8]; float ss = 0.f;
        if (xb) {
#pragma unroll
            for (int i = 0; i < 4; ++i) { const u32x4 w = *(const u32x4*)(xb + (size_t)row * D + i * 512 + F.lane * 8); v[2 * i] = bf4((u32x2){w.x, w.y}); v[2 * i + 1] = bf4((u32x2){w.z, w.w}); ss += sq4(v[2 * i]) + sq4(v[2 * i + 1]); }
        } else { const float* xr = row < ML ? xl + (size_t)row * D : xc + (size_t)(row - ML) * D;
#pragma unroll
            for (int i = 0; i < 4; ++i) { v[2 * i] = *(const f32x4*)(xr + i * 512 + F.lane * 8); v[2 * i + 1] = *(const f32x4*)(xr + i * 512 + F.lane * 8 + 4); ss += sq4(v[2 * i]) + sq4(v[2 * i + 1]); } }
#pragma unroll
        for (int o = 32; o >= 1; o >>= 1) ss += shx(ss, o, F.lane);
        const float rs = __builtin_amdgcn_rsqf(ss * (1.f / 2048.f) + EPS);
        const int midx = row < ML ? (row >> 12) : 4;
#pragma unroll
        for (int i = 0; i < 4; ++i) { const int col = i * 512 + F.lane * 8;
            const f32x4 g0 = *(const f32x4*)(g + col), g1 = *(const f32x4*)(g + col + 4);
            if (outf) { *(f32x4*)(outf + (size_t)row * D + col) = v[2 * i] * rs * g0; *(f32x4*)(outf + (size_t)row * D + col + 4) = v[2 * i + 1] * rs * g1; }
            else { const float* mp = modl + (size_t)midx * 12288 + col;
                const f32x4 s0 = *(const f32x4*)(mp + sc_off), s1 = *(const f32x4*)(mp + sc_off + 4), h0 = *(const f32x4*)(mp + sh_off), h1 = *(const f32x4*)(mp + sh_off + 4);
                *(u32x4*)(H + (size_t)row * D + col) = pk8(v[2 * i] * rs * g0 * (1.f + s0) + h0, v[2 * i + 1] * rs * g1 * (1.f + s1) + h1); } }
    }
}

struct AttnItem {
    const bf16_t* q; const bf16_t* kn; const bf16_t* kr; const bf16_t* vt; bf16_t* o;
    int ldq, ldk, ldo, lat_row0, ctx_row0, t0, ntl, nctx, mode, r0, hn;
};
template <int DQ>
DI void attn_item(const Frame& F, const AttnItem& it, const LAS float* rpb_lds) {
    constexpr int KP = DQ + 8, VP = 72, KS = DQ / 16;
    constexpr int KBYTES = 64 * KP * 2, VBYTES = 128 * VP * 2;
    LAS unsigned char* base = F.lds;
    int tid = threadIdx.x; asm volatile("" : "+v"(tid));
    const int lane = tid & 63, w = __builtin_amdgcn_readfirstlane(tid >> 6), qq = lane & 31, hh = lane >> 5;
    const bool grpB = w >= 4;
    const int ntile = it.ntl + it.nctx;
    u32x4 rk[2], rr, rv[2];
    auto gload = [&](int ti) {
        int rowb, vcol;
        if (ti < it.ntl) { const int kt = it.t0 + ti; rowb = it.lat_row0 + kt * 64; vcol = kt * 64; } else { const int j = ti - it.ntl; rowb = it.ctx_row0 + j * 64; vcol = SEQ + j * 64; }
#pragma unroll
        for (int i = 0; i < 2; ++i) { const int id = tid + i * NT; rk[i] = *(const u32x4*)(it.kn + (size_t)(rowb + (id >> 4)) * it.ldk + (id & 15) * 8);
            rv[i] = *(const u32x4*)(it.vt + (size_t)(id >> 3) * KEYS + vcol + (id & 7) * 8); }
        if (DQ == 192) rr = *(const u32x4*)(it.kr + (size_t)(rowb + (tid >> 3)) * UC + (tid & 7) * 8);
    };
    auto lstore = [&](int ti) {
        LAS unsigned char* kb = base + (ti & 1) * KBYTES; LAS unsigned char* vb = base + 2 * KBYTES + (ti % 3) * VBYTES;
#pragma unroll
        for (int i = 0; i < 2; ++i) { const int id = tid + i * NT; *(LAS u32x4*)(kb + ((id >> 4) * KP + (id & 15) * 8) * 2) = rk[i];
            *(LAS u32x4*)(vb + ((id >> 3) * VP + (id & 7) * 8) * 2) = rv[i]; }
        if (DQ == 192) *(LAS u32x4*)(kb + ((tid >> 3) * KP + 128 + (tid & 7) * 8) * 2) = rr;
    };
    bf16x8 qf[KS];
    { const bf16_t* qp = it.q + (size_t)(32 * w + qq) * it.ldq + 8 * hh;
#pragma unroll
        for (int ks = 0; ks < KS; ++ks) qf[ks] = *(const bf16x8*)(qp + 16 * ks); }
    f32x16 o[4];
#pragma unroll
    for (int db = 0; db < 4; ++db)
#pragma unroll
        for (int i = 0; i < 16; ++i) o[db][i] = 0.f;
    f32x16 s[2];
    float mrun = -INFINITY, lrun = 0.f;
    const int r = it.r0 + (w >> 1), wq = 32 * (w & 1) + qq;
    const int rs = min(max(r - 4, 0), 56), cs = min(max(wq - 8, 0), 48);
    auto active = [&](int ti) { const int krow = it.t0 + ti; return !(it.mode == 1 && ti < it.ntl && (krow < rs || krow > rs + 7)); };
    auto qk = [&](int ti) {
        if (!active(ti)) return;
        const int krow_l = (qq & 3) + 4 * ((qq >> 3) & 1) + 8 * ((qq >> 2) & 1) + 16 * (qq >> 4);
        LAS unsigned char* kb = base + (ti & 1) * KBYTES + (krow_l * KP + 8 * hh) * 2;
#pragma unroll
        for (int blk = 0; blk < 2; ++blk)
#pragma unroll
            for (int i = 0; i < 16; ++i) s[blk][i] = 0.f;
        bf16x8 kf[3][2];
#pragma unroll
        for (int p = 0; p < 2; ++p)
#pragma unroll
            for (int blk = 0; blk < 2; ++blk) kf[p][blk] = *(const LAS bf16x8*)(kb + (32 * blk * KP + 16 * p) * 2);
#pragma unroll
        for (int ks = 0; ks < KS; ++ks) {
            if (ks + 2 < KS) {
#pragma unroll
                for (int blk = 0; blk < 2; ++blk) kf[(ks + 2) % 3][blk] = *(const LAS bf16x8*)(kb + (32 * blk * KP + 16 * (ks + 2)) * 2); }
            __builtin_amdgcn_sched_barrier(0);
#pragma unroll
            for (int blk = 0; blk < 2; ++blk) s[blk] = __builtin_amdgcn_mfma_f32_32x32x16_bf16(kf[ks % 3][blk], qf[ks], s[blk], 0, 0, 0);
            __builtin_amdgcn_sched_barrier(0);
        }
    };
    auto smpv = [&](int ti) {
        if (!active(ti)) return;
        LAS unsigned char* vb = base + 2 * KBYTES + (ti % 3) * VBYTES;
        if (it.mode == 1 && ti < it.ntl) {
            const int krow = it.t0 + ti;
            const LAS float* bp = rpb_lds + it.hn * 465 + (krow - r + 7) * 31 - wq + 15;
#pragma unroll
            for (int blk = 0; blk < 2; ++blk)
#pragma unroll
                for (int i = 0; i < 16; ++i) { const int kc = 32 * blk + (i & 3) + 4 * ((i >> 2) & 1) + 8 * hh + 16 * (i >> 3); const bool ok = kc >= cs && kc < cs + 16;
                    const int kcc = ok ? kc : cs; s[blk][i] = ok ? s[blk][i] + bp[kcc] : -INFINITY; }
        }
        float mx = s[0][0];
#pragma unroll
        for (int blk = 0; blk < 2; ++blk)
#pragma unroll
            for (int i = 0; i < 16; ++i) mx = fmaxf(mx, s[blk][i]);
        mx = fmaxf(mx, shx(mx, 32, lane));
        const float mnew = fmaxf(mrun, mx), alpha = __builtin_amdgcn_exp2f(mrun - mnew);
        mrun = mnew;
        float ps = 0.f;
#pragma unroll
        for (int blk = 0; blk < 2; ++blk)
#pragma unroll
            for (int i = 0; i < 16; ++i) { const float p = __builtin_amdgcn_exp2f(s[blk][i] - mnew); s[blk][i] = p; ps += p; }
        lrun = lrun * alpha + ps;
        if (__builtin_amdgcn_ballot_w64(alpha != 1.f) != 0ull) {
#pragma unroll
            for (int db = 0; db < 4; ++db)
#pragma unroll
                for (int i = 0; i < 16; ++i) o[db][i] *= alpha;
        }
        LAS unsigned char* vq = vb + (qq * VP + 8 * hh) * 2;
        auto vload = [&](int step, int db) { return *(const LAS bf16x8*)(vq + (32 * db * VP + 16 * step) * 2); };
        bf16x8 vf[2][4];
#pragma unroll
        for (int db = 0; db < 4; ++db) vf[0][db] = vload(0, db);
#pragma unroll
        for (int st = 0; st < 4; ++st) {
            if (st + 1 < 4) {
#pragma unroll
                for (int db = 0; db < 4; ++db) vf[(st + 1) & 1][db] = vload(st + 1, db); }
            __builtin_amdgcn_sched_barrier(0);
            const int blk = st >> 1, s2 = st & 1;
            u32x4 pw; pw.x = pk2(s[blk][8 * s2], s[blk][8 * s2 + 1]); pw.y = pk2(s[blk][8 * s2 + 2], s[blk][8 * s2 + 3]);
            pw.z = pk2(s[blk][8 * s2 + 4], s[blk][8 * s2 + 5]); pw.w = pk2(s[blk][8 * s2 + 6], s[blk][8 * s2 + 7]);
            const bf16x8 pf = __builtin_bit_cast(bf16x8, pw);
#pragma unroll
            for (int db = 0; db < 4; ++db) o[db] = __builtin_amdgcn_mfma_f32_32x32x16_bf16(vf[st & 1][db], pf, o[db], 0, 0, 0);
            __builtin_amdgcn_sched_barrier(0);
        }
    };

    __syncthreads();
    gload(0); lstore(0);
    if (ntile > 1) gload(1);
    __syncthreads();
    for (int ti = 0; ti < ntile; ++ti) {
        qk(ti);
        if (grpB) { if (ti + 1 < ntile) lstore(ti + 1); if (ti + 2 < ntile) gload(ti + 2); __syncthreads(); }
        smpv(ti);
        if (!grpB) { if (ti + 1 < ntile) lstore(ti + 1); if (ti + 2 < ntile) gload(ti + 2); __syncthreads(); }
    }
    const float lt = lrun + shx(lrun, 32, lane), inv = 1.f / lt;
    bf16_t* op = it.o + (size_t)(32 * w + qq) * it.ldo + 4 * hh;
#pragma unroll
    for (int db = 0; db < 4; ++db)
#pragma unroll
        for (int ig = 0; ig < 4; ++ig) { u32x2 v; v.x = pk2(o[db][4 * ig] * inv, o[db][4 * ig + 1] * inv); v.y = pk2(o[db][4 * ig + 2] * inv, o[db][4 * ig + 3] * inv);
            *(u32x2*)(op + 32 * db + 8 * ig) = v; }
}

#ifndef MLAREP
#define MLAREP 1
#endif
DI void mixer_attention(const Frame& F, int layer, int cidx) {
    const int nitems = (layer == 0 ? 816 : 768) + 512 * (MLAREP - 1);
    bf16_t* U = (bf16_t*)(F.ws + WS_U); bf16_t* Q = (bf16_t*)(F.ws + WS_Q); bf16_t* KN = (bf16_t*)(F.ws + WS_KN);
    bf16_t* VT = (bf16_t*)(F.ws + WS_VT); bf16_t* VNT = (bf16_t*)(F.ws + WS_VNT); bf16_t* CAT = (bf16_t*)(F.ws + WS_CAT);
    unsigned* ctr = (unsigned*)(F.ws + WS_CTR) + cidx;
    LAS float* rpb = (LAS float*)(F.lds + 112 * 1024);
    volatile LAS int* slot = (volatile LAS int*)(F.lds + 112 * 1024 + 8192);
    __syncthreads();
    for (int i = F.tid; i < 4 * 465; i += NT) rpb[i] = F.inp(13)[layer * 4 * 465 + i] * LOG2E;
    for (int step = 0;; ++step) {
        int idx;
        if (step < 2) idx = F.vcu + 256 * step;
        else {
            __syncthreads();
            if (F.tid == 0) *slot = (int)atomicAdd(ctr, 1u);
            __syncthreads();
            idx = 512 + *slot;
        }
        if (idx >= nitems) break;
        AttnItem it; it.kr = nullptr; it.mode = 0; it.r0 = 0; it.hn = 0; it.nctx = 4;
        if (idx < 512 || (idx >= 768 && idx < 800)) {
            int b, h, row0;
            if (idx < 512) { b = idx >> 7; h = (idx >> 4) & 7; row0 = b * 4096 + (idx & 15) * 256; it.t0 = 0; it.ntl = 64; }
            else { const int j = idx - 768; b = j >> 3; h = j & 7; row0 = ML + b * 256; it.t0 = 0; it.ntl = 0; }
            it.q = Q + (size_t)row0 * 1536 + h * 192; it.ldq = 1536;
            it.kn = KN + h * 128; it.ldk = 1024; it.kr = U + U_KR;
            it.vt = VT + (size_t)(b * 8 + h) * 128 * KEYS;
            it.o = CAT + (size_t)row0 * D + h * 128; it.ldo = D;
            it.lat_row0 = b * 4096; it.ctx_row0 = ML + b * 256;
            attn_item<192>(F, it, rpb);
        } else {
            int b, hn, row0;
            if (idx < 768) { const int j = idx - 512; b = j >> 6; hn = (j >> 4) & 3; const int R = j & 15; row0 = b * 4096 + R * 256;
                const int rlo = max(4 * R - 4, 0), rhi = min(max(4 * R - 1, 0), 56) + 7; it.t0 = rlo; it.ntl = rhi - rlo + 1; it.mode = 1; it.r0 = 4 * R; it.hn = hn; }
            else { const int j = idx - 800; b = j >> 2; hn = j & 3; row0 = ML + b * 256; it.t0 = 0; it.ntl = 0; }
            it.q = U + (size_t)row0 * UC + U_QN + hn * 128; it.ldq = UC;
            it.kn = U + U_KN + hn * 128; it.ldk = UC;
            it.vt = VNT + (size_t)(b * 4 + hn) * 128 * KEYS;
            it.o = CAT + (size_t)row0 * D + 1024 + hn * 128; it.ldo = D;
            it.lat_row0 = b * 4096; it.ctx_row0 = ML + b * 256;
            attn_item<128>(F, it, rpb);
        }
    }
}


#define XB_TMO      128
#define XB_XCNT(j)  (256  + 64 * (j))
#define XB_XSUB(j)  (1280 + 64 * (j))
#define XB_XGEN(j)  (2304 + 64 * (j))
#define XB_TOP      3328
#define XB_TOPGEN   3392
#define XCD_BAR_WORDS 3456
#define XB_SPIN_CAP (1u << 18)
__device__ __forceinline__ unsigned xb_ld(unsigned* p)              { return __hip_atomic_load(p, __ATOMIC_RELAXED, __HIP_MEMORY_SCOPE_AGENT); }
__device__ __forceinline__ unsigned xb_add(unsigned* p, unsigned v) { return __hip_atomic_fetch_add(p, v, __ATOMIC_RELAXED, __HIP_MEMORY_SCOPE_AGENT); }
__device__ __forceinline__ unsigned xb_xcc_id() { return (unsigned)__builtin_amdgcn_s_getreg((3 << 11) | 20) & 0xFu; }
#define XB_SPIN(cond, bar) do { unsigned _sp = 0; while (cond) { __builtin_amdgcn_s_sleep(1); \
    if ((++_sp & 255u) == 0u) { if (xb_ld(&(bar)[XB_TMO])) break; if (_sp > XB_SPIN_CAP) { atomicAdd(&(bar)[XB_TMO], 1u); break; } } } } while (0)
struct XcdBarrier { unsigned* bar; unsigned x; volatile LAS unsigned* st; };
__device__ __forceinline__ XcdBarrier xcd_barrier_post(unsigned* bar, volatile LAS unsigned* st) {
    XcdBarrier b; b.bar = bar; b.x = xb_xcc_id(); b.st = st;
    if (threadIdx.x == 0) (void)xb_add(&bar[XB_XCNT(b.x)], 1u);
    return b;
}
__device__ __forceinline__ void xcd_barrier_complete(unsigned* bar, unsigned x, unsigned& nloc, unsigned& nx) {
    const unsigned G = gridDim.x * gridDim.y * gridDim.z;
    unsigned sum, cnt, mine, sp = 0u;
    for (;;) {
        sum = 0u; cnt = 0u; mine = 0u;
#pragma unroll
        for (unsigned j = 0; j < 16; ++j) { const unsigned c = xb_ld(&bar[XB_XCNT(j)]); sum += c; cnt += (c > 0u) ? 1u : 0u; mine = (j == x) ? c : mine; }
        if (sum == G) break;
        __builtin_amdgcn_s_sleep(1);
        if ((++sp & 255u) == 0u) { if (xb_ld(&bar[XB_TMO])) break; if (sp > XB_SPIN_CAP) { atomicAdd(&bar[XB_TMO], 1u); break; } }
    }
    nloc = mine > 0u ? mine : 1u; nx = cnt > 0u ? cnt : 1u;
}
__device__ __forceinline__ void xcd_barrier(const XcdBarrier& b) {
    asm volatile("s_waitcnt vmcnt(0)" ::: "memory");
    __syncthreads();
    if (threadIdx.x == 0) {
        unsigned* bar = b.bar;
        __builtin_amdgcn_s_waitcnt(0);
        unsigned nloc = b.st[0], nx = b.st[1];
        if (nloc == 0u) { xcd_barrier_complete(bar, b.x, nloc, nx); b.st[0] = nloc; b.st[1] = nx; }
        const unsigned old = xb_add(&bar[XB_XSUB(b.x)], 1u);
        const unsigned gen = old / nloc;
        if (old + 1u == (gen + 1u) * nloc) {
            __builtin_amdgcn_fence(__ATOMIC_RELEASE, "agent");
            asm volatile("s_waitcnt vmcnt(0)" ::: "memory");
            const unsigned og = xb_add(&bar[XB_TOP], 1u);
            const unsigned tg = og / nx;
            if (og + 1u == (tg + 1u) * nx) xb_add(&bar[XB_TOPGEN], 1u);
            else XB_SPIN(xb_ld(&bar[XB_TOPGEN]) == tg, bar);
            __builtin_amdgcn_fence(__ATOMIC_ACQUIRE, "agent");
            xb_add(&bar[XB_XGEN(b.x)], 1u);
            asm volatile("s_waitcnt vmcnt(0)" ::: "memory");
        } else {
            XB_SPIN(xb_ld(&bar[XB_XGEN(b.x)]) == gen, bar);
            __builtin_amdgcn_fence(__ATOMIC_ACQUIRE, "agent");
            asm volatile("s_waitcnt vmcnt(0)" ::: "memory");
        }
    }
    __syncthreads();
}

#ifndef PHMASK
#define PHMASK 0x7ff
#endif
#define PH(k) (((PHMASK) >> (k)) & 1)
#ifndef DUPMASK
#define DUPMASK 0x000
#endif
#define REP(k) for (int rep_ = 0, nrep_ = F.nrep((DUPMASK >> (k)) & 1); rep_ < nrep_; ++rep_)
#define Hbuf ((bf16_t*)(F.ws + WS_H))
#define H (Hbuf + D)
#define X ((bf16_t*)(F.ws + WS_X))
#define U ((bf16_t*)(F.ws + WS_U))
#define SSQ ((float*)(F.ws + WS_SSQ))
#define CAT ((bf16_t*)(F.ws + WS_CAT))
#define mod ((const float*)(F.ws + WS_MOD))
#define rope ((const f32x2*)(F.ws + WS_ROPE))
#define GSYNC() do { F.refresh(); { XcdBarrier xb_{(unsigned*)(F.ws + WS_BAR), xb_xcc_id(), (volatile LAS unsigned*)(F.lds + 135 * 1024)}; xcd_barrier(xb_); } F.refresh(); } while (0)
DI void layer_body(Frame& F, const int l) {
        const int Mq = l == 0 ? MT : ML;
#define modl (mod + (size_t)l * 5 * 12288)
#define xbl (l == 0 ? (const bf16_t*)nullptr : (const bf16_t*)X)
        REP(1) {
        if (PH(1)) norm_phase(F, F.inp(0), F.inp(2), xbl, MT, F.inp(6) + l * D, modl, 0, 2048, H, nullptr);
        GSYNC(); }
        REP(2) {
        { pg8::Gemm g{H, (const bf16_t*)(F.ws + WS_WIN) + (size_t)l * UC * D, D, D, D, 0};
          pg8::Sched S; S.init(MT / 256, UC / 256, F.G, F.vcu, 0);
          EpiU E{U, SSQ, (bf16_t*)(F.ws + WS_VNT), rope, 0.08838834764831845f * LOG2E, (bf16_t*)F.outp() + DO_FF};
          if (PH(2)) pg8::gemm_phase(F.lds, g, S, E); }
        GSYNC(); }
        REP(3) {
        { int start = 0;
          { pg8::Gemm g{U + U_CQ, (const bf16_t*)(F.ws + WS_WUQ) + (size_t)l * 1536 * 512, UC, 512, 512, 0};
            pg8::Sched S; S.init(Mq / 256, 6, F.G, F.vcu, start); start += (Mq / 256) * 6;
            EpiQ E{(bf16_t*)(F.ws + WS_Q), SSQ, rope, 0.07216878364870323f * LOG2E};
            if (PH(3)) pg8::gemm_phase(F.lds, g, S, E); }
          { pg8::Gemm g{U + U_CKV, (const bf16_t*)(F.ws + WS_WUKV) + (size_t)l * 2048 * 512, UC, 512, 512, 0};
            pg8::Sched S; S.init(MT / 256, 8, F.G, F.vcu, start); start += (MT / 256) * 8;
            EpiKV E{(bf16_t*)(F.ws + WS_KN), (bf16_t*)(F.ws + WS_VT), SSQ};
            if (PH(4)) pg8::gemm_phase(F.lds, g, S, E); }
          { pg8::Gemm g{(const bf16_t*)(F.ws + WS_WC) + (size_t)l * 1024 * 256, (const bf16_t*)F.outp() + DO_FF, 256, 1024, 256, 0};
            SchedY S; S.init(F.G, F.vcu, start); start += 144;
            EpiY E{(bf16_t*)(F.ws + WS_YT), (bf16_t*)(F.ws + WS_YTC), 0};
            if (PH(5)) pg8::gemm_phase(F.lds, g, S, E); }
          if (l == 0) { pg8::Gemm g{(const bf16_t*)(F.ws + WS_WC) + (size_t)l * 1024 * 256, (const bf16_t*)F.outp() + DO_FF + (size_t)ML * 1024, 256, 1024, 256, 0};
            pg8::Sched S; S.init(4, MC / 256, F.G, F.vcu, start); S.kobm = 256;
            EpiY E{(bf16_t*)(F.ws + WS_YT), (bf16_t*)(F.ws + WS_YTC), ML};
            if (PH(5)) pg8::gemm_phase(F.lds, g, S, E); } }
        GSYNC(); }
        REP(7) {
        if (F.vcu < 128 || (l == 0 && F.vcu < 136)) {
            const bool cx = F.vcu >= 128; const int ld = cx ? 512 : 4096;
            long zo = 0; asm volatile("" : "+s"(zo)); const bf16_t* dftp = (const bf16_t*)F.P.out + zo;
            pg8::Gemm g{dftp + (cx ? DO_DFTC : DO_DFT), (const bf16_t*)(F.ws + (cx ? WS_YTC : WS_YT)), ld, ld, ld, 0};
            pg8::OneUnit S; S.u.pm = cx ? 0 : (F.vcu & 15); S.u.pn = cx ? (F.vcu - 128) : (F.vcu >> 4); S.u.kob = 0; S.has = true;
            EpiF E{CAT, cx ? 1 : 0}; if (PH(6)) pg8::gemm_phase(F.lds, g, S, E); }
        if (PH(7)) mixer_attention(F, l, l + 2 * rep_);
        GSYNC(); }
        REP(8) {
        { pg8::Gemm g{CAT, (const bf16_t*)(F.ws + WS_WOUT) + (size_t)l * D * D, D, D, D, 0};
          pg8::Sched S; S.init(Mq / 256, 8, F.G, F.vcu, 0);
          EpiRes E{F.inp(0), F.inp(2), xbl, X, modl + 4096};
          if (PH(8)) pg8::gemm_phase(F.lds, g, S, E); }
        GSYNC(); }
        REP(4) {
        if (PH(1)) norm_phase(F, nullptr, nullptr, X, Mq, F.inp(7) + l * D, modl, 6144, 8192, H, nullptr);
        GSYNC(); }
        REP(10) {
        { pg8::Gemm g{Hbuf, (const bf16_t*)(F.ws + WS_WUP) + (size_t)l * 2 * DFF * D, D, D, D, 1};
          pg8::Sched S; S.init((Mq + 251) / 252, 44, F.G, F.vcu, 0);
          EpiConv E{(bf16_t*)(F.ws + WS_ACT), F.inp(17) + (size_t)l * 3 * 2 * DFF, F.inp(18) + (size_t)l * 2 * DFF, Mq};
          if (PH(10)) pg8::gemm_phase(F.lds, g, S, E); }
        GSYNC(); }
        { pg8::Gemm g{(const bf16_t*)(F.ws + WS_ACT), (const bf16_t*)(F.ws + WS_WDN) + (size_t)l * D * DFF, DFF, DFF, DFF, 0};
          pg8::Sched S; S.init(Mq / 256, 8, F.G, F.vcu, 0);
          EpiRes E{nullptr, nullptr, X, X, modl + 10240};
          if (PH(9)) pg8::gemm_phase(F.lds, g, S, E); }
        GSYNC();

}

__global__ void __launch_bounds__(NT) fwd_megakernel(Params p) {
    extern __shared__ __attribute__((aligned(16))) unsigned char lds_raw[];
    cg::grid_group grid = cg::this_grid();
    const int tid_ = threadIdx.x, G_ = gridDim.x, bx_ = blockIdx.x;
    Frame F{(LAS unsigned char*)lds_raw, lds_raw, tid_, tid_ & 63, __builtin_amdgcn_readfirstlane(tid_ >> 6), G_, (G_ % 8 == 0) ? (bx_ % 8) * (G_ / 8) + bx_ / 8 : bx_, p, p.ws};
    volatile LAS unsigned* xst = (volatile LAS unsigned*)(F.lds + 135 * 1024);
    if (F.tid == 0) { xst[0] = 0u; xst[1] = 0u; }
    __syncthreads();
    (void)xcd_barrier_post((unsigned*)(p.ws + WS_BAR), xst);
    REP(0) { if (PH(0)) { if (F.vcu & 1) { p_tables(F); p_mod(F); } else { p_mod(F); p_tables(F); }
    p_convert(F); }
    grid.sync(); F.refresh(); }

    for (int l = 0; l < 2; ++l) layer_body(F, l);
    if (PH(1)) norm_phase(F, nullptr, nullptr, X, ML, F.inp(20), nullptr, 0, 0, nullptr, F.outp());
}
#undef Hbuf
#undef H
#undef X
#undef U
#undef SSQ
#undef CAT
#undef mod
#undef rope
#undef modl
#undef xbl


extern "C" void kernel_launch(void* const* d_in, const int* in_sizes, int n_in, void* d_out, int out_size, void* d_ws, size_t ws_size, hipStream_t stream) {
    static int grid_blocks = 0;
    if (!grid_blocks) {
        int dev = 0, cus = 0, per_cu = 0;
        hipGetDevice(&dev);
        hipDeviceGetAttribute(&cus, hipDeviceAttributeMultiprocessorCount, dev);
        hipFuncSetAttribute((const void*)fwd_megakernel, hipFuncAttributeMaxDynamicSharedMemorySize, LDS_BYTES);
        hipOccupancyMaxActiveBlocksPerMultiprocessor(&per_cu, (const void*)fwd_megakernel, NT, LDS_BYTES);
        if (per_cu < 1) { fprintf(stderr, "occupancy query says %d blocks/CU\n", per_cu); per_cu = 1; }
        grid_blocks = cus;
        if (ws_size < WS_END) fprintf(stderr, "workspace too small: %zu < %zu\n", ws_size, (size_t)WS_END);
    }
    Params p{};
    for (int i = 0; i < 21; ++i) p.in[i] = (const float*)d_in[i];
    p.out = (float*)d_out; p.ws = (unsigned char*)d_ws;
    hipMemsetAsync((unsigned char*)d_ws + WS_BAR, 0, 16384, stream);
    void* args[] = {&p};
    hipError_t e = hipLaunchCooperativeKernel((const void*)fwd_megakernel, dim3(grid_blocks), dim3(NT), args, LDS_BYTES, stream);
    if (e != hipSuccess) fprintf(stderr, "cooperative launch failed: %s (grid %d)\n", hipGetErrorString(e), grid_blocks);
}
```

```cpp
#include <hip/hip_runtime.h>
#include <hip/hip_cooperative_groups.h>
#include <cstdio>
namespace cg = cooperative_groups;

#define LAS __attribute__((address_space(3)))
#define GAS __attribute__((address_space(1)))
template <class T> __device__ __forceinline__ T* as_global(T* p) { return p; }
#define DI __device__ __forceinline__
typedef unsigned short bf16_t;
typedef short bf16x8 __attribute__((ext_vector_type(8)));
typedef short s16x4 __attribute__((ext_vector_type(4)));
typedef float f32x4 __attribute__((ext_vector_type(4)));
typedef float f32x2 __attribute__((ext_vector_type(2)));
typedef float f32x16 __attribute__((ext_vector_type(16)));
typedef unsigned u32x4 __attribute__((ext_vector_type(4)));
typedef unsigned u32x2 __attribute__((ext_vector_type(2)));
typedef __bf16 bfv2 __attribute__((ext_vector_type(2)));

constexpr int D = 2048, NB = 4, SEQ = 4096, CTXL = 256, ML = NB * SEQ, MC = NB * CTXL, MT = ML + MC;
constexpr int INC = 3136, UC = 3328;
constexpr int U_CQ = 0, U_CKV = 512, U_QN = 1024, U_KN = 1536, U_VN = 2048, U_F = 2560, U_KR = 3072;
constexpr int DFF = 5632, KEYS = SEQ + CTXL;
constexpr size_t DO_DFT = 0, DO_DFTC = (size_t)4096 * 4096, DO_FF = DO_DFTC + 256 * 512;
static_assert((DO_FF + (size_t)(ML + MC) * 1024) * 2 <= (size_t)ML * 2048 * 4, "d_out scratch");
constexpr float EPS = 1e-6f, LOG2E = 1.4426950408889634f;
constexpr int NT = 512;
constexpr int LDS_BYTES = 136 * 1024;

constexpr size_t al(size_t x) { return (x + 255) & ~(size_t)255; }
constexpr size_t WS_WIN = 0;
constexpr size_t WS_WUQ = WS_WIN + al((size_t)2 * UC * D * 2);
constexpr size_t WS_WUKV = WS_WUQ + al((size_t)2 * 1536 * 512 * 2);
constexpr size_t WS_WOUT = WS_WUKV + al((size_t)2 * 4096 * 512 * 2);
constexpr size_t WS_WUP = WS_WOUT + al((size_t)2 * D * D * 2);
constexpr size_t WS_WDN = WS_WUP + al((size_t)2 * 2 * DFF * D * 2);
constexpr size_t WS_WC = WS_WDN + al((size_t)2 * D * DFF * 2);
constexpr size_t WS_DFTC = WS_WC + al((size_t)2 * 1024 * 1024 * 2);
constexpr size_t WS_TRIG = WS_DFTC + al((size_t)256 * 512 * 2);
constexpr size_t WS_ROPE = WS_TRIG + al(4096 * 8);
constexpr size_t WS_MOD = WS_ROPE + al(64 * 16 * 8);
constexpr size_t WS_CTR = WS_MOD + al((size_t)2 * 5 * 12288 * 4);
constexpr size_t WS_BAR = WS_CTR + 256;
constexpr size_t WS_X = WS_BAR + 16384;
constexpr size_t WS_H = WS_X + al((size_t)MT * D * 4);
constexpr size_t H_ROWS = 1 + MT + 256;
constexpr size_t WS_CAT = WS_H + al(H_ROWS * D * 2);
constexpr size_t WS_YTC = WS_CAT + al((size_t)MT * D * 2);
constexpr size_t WS_U = WS_YTC + al((size_t)2048 * 512 * 2);
constexpr size_t WS_SSQ = WS_U + al((size_t)MT * UC * 2);
constexpr size_t WS_Q = WS_SSQ + al((size_t)MT * 16 * 4);
constexpr size_t WS_KN = WS_Q + al((size_t)MT * 1536 * 2);
constexpr size_t WS_VT = WS_KN + al((size_t)MT * 1024 * 2);
constexpr size_t WS_VNT = WS_VT + al((size_t)32 * 128 * KEYS * 2);
constexpr size_t WS_YT = WS_VNT + al((size_t)16 * 128 * KEYS * 2);
constexpr size_t WS_END = WS_YT + al((size_t)2048 * 8192 * 2);
constexpr size_t WS_ACT = WS_U;
static_assert(WS_ACT + (size_t)MT * DFF * 2 <= WS_END, "ACT alias");
static_assert((size_t)4096 * 8192 * 2 <= H_ROWS * D * 2, "DFT alias");
static_assert(WS_END <= (size_t)805306368, "workspace");

struct Params { const float* in[21]; float* out; unsigned char* ws; };

DI unsigned pk2(float a, float b) { f32x2 v = {a, b}; bfv2 r = __builtin_convertvector(v, bfv2); return __builtin_bit_cast(unsigned, r); }
DI bf16_t f2bf(float a) { return (bf16_t)(pk2(a, 0.f) & 0xffffu); }
DI float shx(float v, int m, int lane) { return __builtin_bit_cast(float, __builtin_amdgcn_ds_bpermute((lane ^ m) << 2, __builtin_bit_cast(int, v))); }
DI f32x4 bf4(u32x2 w) { f32x4 r; r[0] = __builtin_bit_cast(float, w.x << 16); r[1] = __builtin_bit_cast(float, w.x & 0xffff0000u); r[2] = __builtin_bit_cast(float, w.y << 16); r[3] = __builtin_bit_cast(float, w.y & 0xffff0000u); return r; }
DI float sq4(f32x4 v) { return (v[0] * v[0] + v[1] * v[1]) + (v[2] * v[2] + v[3] * v[3]); }
DI u32x4 pk8(f32x4 a, f32x4 b) { u32x4 w; w.x = pk2(a[0], a[1]); w.y = pk2(a[2], a[3]); w.z = pk2(b[0], b[1]); w.w = pk2(b[2], b[3]); return w; }

namespace pg8 {
constexpr int BM = 256, BK = 64, HALF = 128, HTB = HALF * BK * 2, STAGE_BYTES = 8 * HTB;
DI int lds_byte(int r, int c) { const int st = (r >> 4) * 2 + (c >> 5), rr = r & 15, cc = c & 31, ob = rr * 64 + cc * 2; return st * 1024 + (ob ^ (((ob >> 9) & 1) << 5)); }
DI void stage_rc(int b, int& R, int& C) { const int st = b / 1024, sb = b % 1024, swz = sb ^ (((sb >> 9) & 1) << 5); R = (st >> 1) * 16 + swz / 64; C = (st & 1) * 32 + (swz % 64) / 2; }
DI int perm32(int rho) { const int n = rho >> 4, i = rho & 15; return 8 * (i >> 2) + 4 * n + (i & 3); }
struct Unit { int pm, pn, kob; };
struct Gemm { const bf16_t* A; const bf16_t* Bt; int lda, ldb, K; int conv; };

struct Sched {
    int nM, nN, cnt, G, c, i0, start, kobm = 0;
    DI void init(int nM_, int nN_, int G_, int c_, int start_) { nM = nM_; nN = nN_; cnt = nM * nN; G = G_; c = c_; start = start_;
        i0 = (start_ > c_) ? (start_ - c_ + G_ - 1) / G_ : 0; }
    DI bool next(int i, Unit& u) const {
        const long L = (long)(i0 + i) * G + c - start; if (L >= cnt) return false;
        const int w = (int)L, nig = 8 * nN, gid = w / nig, fm = gid * 8, gsz = (nM - fm) < 8 ? (nM - fm) : 8;
        u.pm = fm + ((w % nig) % gsz); u.pn = (w % nig) / gsz; u.kob = kobm * u.pm; return true;
    }
};
struct OneUnit { Unit u; bool has; DI bool next(int i, Unit& o) const { o = u; return has && i == 0; } };

template <class Epi, class SchedT>
DI void gemm_phase(LAS unsigned char* lds, const Gemm g, const SchedT& S, const Epi& E) {
    int tid = threadIdx.x; asm volatile("" : "+v"(tid));
    const int wid = __builtin_amdgcn_readfirstlane(tid >> 6), lane = tid & 63, wr = wid >> 2, wc = wid & 3, fr = lane & 15, fq = lane >> 4;
    const int K = g.K, nt = K / BK;
    unsigned voffA[2], voffB[2];
    auto mk_voff = [&]() { int t2 = threadIdx.x; asm volatile("" : "+v"(t2));
#pragma unroll
        for (int i = 0; i < 2; ++i) { int R, C; stage_rc(t2 * 16 + i * 8192, R, C); const int Rb = Epi::PERM ? ((R & ~31) + perm32(R & 31)) : R;
            const int Ra = g.conv ? ((R >> 6) * 126 + (R & 63)) : R;
            voffA[i] = (unsigned)(Ra * g.lda + C) * 2u; voffB[i] = (unsigned)(Rb * g.ldb + C) * 2u; } };
    mk_voff();
    const size_t kstep = (size_t)(BK * 2);
    const size_t hstepA = (size_t)(g.conv ? 64 : HALF) * g.lda * 2, hstepB = (size_t)HALF * g.ldb * 2;
    const size_t tstepA = g.conv ? (size_t)252 * g.lda * 2 : 2 * hstepA, tstepB = 2 * hstepB;
    const unsigned ldsw = (unsigned)wid * 1024u;
    const int aoff = lds_byte(wr * 64 + fr, fq * 8), boff = lds_byte(wc * 32 + fr, fq * 8);
#define PG8_SA(b, h) (((b) * 2 + (h)) * HTB)
#define PG8_SB(b, h) ((4 + (b) * 2 + (h)) * HTB)
#define PG8_STAGE(bufoff, gbase, voff) do { _Pragma("unroll") for (int _i = 0; _i < 2; ++_i) \
        __builtin_amdgcn_global_load_lds((const unsigned*)((const char*)(gbase) + (voff)[_i]), (LAS unsigned*)(lds + (bufoff) + ldsw + _i * 8192), 16, 0, 0); } while (0)
#define PG8_LDA(dst, b, h) do { _Pragma("unroll") for (int m = 0; m < 4; ++m) _Pragma("unroll") for (int k = 0; k < 2; ++k) dst[m][k] = *(const LAS bf16x8*)(lds + PG8_SA(b, h) + aoff + m * 2048 + k * 1024); } while (0)
#define PG8_LDB(dst, b, h) do { _Pragma("unroll") for (int n = 0; n < 2; ++n) _Pragma("unroll") for (int k = 0; k < 2; ++k) dst[n][k] = *(const LAS bf16x8*)(lds + PG8_SB(b, h) + boff + n * 2048 + k * 1024); } while (0)
#define PG8_MMA(ai, bj, At, Bt) do { __builtin_amdgcn_s_setprio(1); _Pragma("unroll") for (int m = 0; m < 4; ++m) _Pragma("unroll") for (int n = 0; n < 2; ++n) _Pragma("unroll") for (int k = 0; k < 2; ++k) \
        acc[ai][bj][m][n] = __builtin_amdgcn_mfma_f32_16x16x32_bf16(Bt[n][k], At[m][k], acc[ai][bj][m][n], 0, 0, 0); __builtin_amdgcn_s_setprio(0); } while (0)
#define PG8_WAIT_V(n) asm volatile("s_waitcnt vmcnt(" #n ")" ::: "memory")
#define PG8_WAIT_L(n) asm volatile("s_waitcnt lgkmcnt(" #n ")" ::: "memory")
#define PG8_BAR __builtin_amdgcn_s_barrier()
#define PG8_SCHED __builtin_amdgcn_sched_barrier(0)
    Unit cur, nxt; int ui = 0;
    if (!S.next(0, cur)) return;
    f32x4 acc[2][2][4][2];
#pragma unroll
    for (int a = 0; a < 2; ++a)
#pragma unroll
        for (int b = 0; b < 2; ++b)
#pragma unroll
            for (int m = 0; m < 4; ++m)
#pragma unroll
                for (int n = 0; n < 2; ++n) acc[a][b][m][n] = (f32x4){0.f, 0.f, 0.f, 0.f};
    bf16x8 At[4][2], B0[2][2], B1[2][2];
    const char* cA = (const char*)g.A + (size_t)cur.pm * tstepA; const char* cB = (const char*)g.Bt + (size_t)cur.pn * tstepB + (size_t)cur.kob * 2;
    PG8_STAGE(PG8_SB(0, 0), cB, voffB); PG8_STAGE(PG8_SA(0, 0), cA, voffA); PG8_STAGE(PG8_SB(0, 1), cB + hstepB, voffB); PG8_STAGE(PG8_SA(0, 1), cA + hstepA, voffA);
    if (wr == 1) PG8_BAR;
    PG8_WAIT_V(4); PG8_BAR;
    PG8_STAGE(PG8_SB(1, 0), cB + kstep, voffB); PG8_STAGE(PG8_SA(1, 0), cA + kstep, voffA); PG8_STAGE(PG8_SB(1, 1), cB + hstepB + kstep, voffB);
    PG8_WAIT_V(6); PG8_BAR;
    for (;;) {
        const bool has_next = S.next(ui + 1, nxt);
        const char* nA = has_next ? (const char*)g.A + (size_t)nxt.pm * tstepA : cA; const char* nB = has_next ? (const char*)g.Bt + (size_t)nxt.pn * tstepB + (size_t)nxt.kob * 2 : cB;
        for (int t = 0; t < nt; t += 2) {
            const bool last = (t == nt - 2);
            const char* a1 = cA + (size_t)(t + 1) * kstep;
            const char* a2 = last ? nA : cA + (size_t)(t + 2) * kstep; const char* b2 = last ? nB : cB + (size_t)(t + 2) * kstep;
            const char* a3 = a2 + kstep; const char* b3 = b2 + kstep;
            PG8_LDB(B0, 0, 0); PG8_SCHED; PG8_LDA(At, 0, 0); PG8_STAGE(PG8_SA(1, 1), a1 + hstepA, voffA);
            PG8_WAIT_L(8); PG8_BAR; PG8_WAIT_L(0); PG8_MMA(0, 0, At, B0); PG8_BAR; PG8_SCHED;
            PG8_LDB(B1, 0, 1); PG8_STAGE(PG8_SB(0, 0), b2, voffB);
            PG8_BAR; PG8_WAIT_L(0); PG8_MMA(0, 1, At, B1); PG8_BAR;
            PG8_LDA(At, 0, 1); PG8_STAGE(PG8_SA(0, 0), a2, voffA);
            PG8_BAR; PG8_WAIT_L(0); PG8_MMA(1, 0, At, B0); PG8_BAR; PG8_SCHED;
            PG8_STAGE(PG8_SB(0, 1), b2 + hstepB, voffB);
            PG8_WAIT_V(6); PG8_BAR; PG8_MMA(1, 1, At, B1); PG8_BAR;
            PG8_LDB(B0, 1, 0); PG8_SCHED; PG8_LDA(At, 1, 0); PG8_STAGE(PG8_SA(0, 1), a2 + hstepA, voffA);
            PG8_WAIT_L(8); PG8_BAR; PG8_WAIT_L(0); PG8_MMA(0, 0, At, B0); PG8_BAR; PG8_SCHED;
            PG8_LDB(B1, 1, 1); PG8_STAGE(PG8_SB(1, 0), b3, voffB);
            PG8_BAR; PG8_WAIT_L(0); PG8_MMA(0, 1, At, B1); PG8_BAR;
            PG8_LDA(At, 1, 1); PG8_STAGE(PG8_SA(1, 0), a3, voffA);
            PG8_BAR; PG8_WAIT_L(0); PG8_MMA(1, 0, At, B0); PG8_BAR; PG8_SCHED;
            PG8_STAGE(PG8_SB(1, 1), b3 + hstepB, voffB);
            PG8_WAIT_V(6); PG8_BAR; PG8_MMA(1, 1, At, B1); PG8_BAR;
        }
        { int fr2 = fr, fq2 = fq, wr2 = wr, wc2 = wc; asm volatile("" : "+v"(fr2), "+v"(fq2), "+s"(wr2), "+s"(wc2));
          E(acc, cur, wr2, wc2, fr2, fq2); }
        if (has_next) mk_voff();
        if (!has_next) break;
#pragma unroll
        for (int a = 0; a < 2; ++a)
#pragma unroll
            for (int b = 0; b < 2; ++b)
#pragma unroll
                for (int m = 0; m < 4; ++m)
#pragma unroll
                    for (int n = 0; n < 2; ++n) acc[a][b][m][n] = (f32x4){0.f, 0.f, 0.f, 0.f};
        cur = nxt; cA = nA; cB = nB; ++ui;
    }
    PG8_WAIT_V(0);
    if (wr == 0) PG8_BAR;
    PG8_BAR;
#undef PG8_SA
#undef PG8_SB
#undef PG8_STAGE
#undef PG8_LDA
#undef PG8_LDB
#undef PG8_MMA
#undef PG8_WAIT_V
#undef PG8_WAIT_L
#undef PG8_BAR
#undef PG8_SCHED
}
}
using pg8::Unit;
typedef const f32x4 (&AccRef)[2][2][4][2];

DI void row_bk(int row, int& b, int& key) { if (row < ML) { b = row >> 12; key = row & 4095; } else { const int rc = row - ML; b = rc >> 8; key = SEQ + (rc & 255); } }
DI void rope8(f32x4& v0, f32x4& v1, int row, int axis, int fq, int lane, const f32x2* rope) {
    const int l = row & 4095, pos = axis ? (l & 63) : (l >> 6);
    const f32x2* t = rope + pos * 16 + 8 * (fq & 1);
    const float sgn = (fq < 2) ? -1.f : 1.f;
#pragma unroll
    for (int j = 0; j < 4; ++j) {
        const float p0 = shx(v0[j], 32, lane), p1 = shx(v1[j], 32, lane);
        const f32x2 c0 = t[j], c1 = t[4 + j];
        v0[j] = v0[j] * c0.x + sgn * p0 * c0.y; v1[j] = v1[j] * c1.x + sgn * p1 * c1.y;
    }
}

struct EpiU {
    static constexpr bool PERM = true;
    bf16_t* U; float* ssq; bf16_t* VnT; const f32x2* rope; float qscale; bf16_t* FF;
    DI void operator()(AccRef acc, const Unit& u, int wr, int wc, int fr, int fq) const {
        const int pn = u.pn, rowb = u.pm * 256 + wr * 64 + fr;
        if (pn == 10 || pn == 11) {
#pragma unroll
            for (int ai = 0; ai < 2; ++ai)
#pragma unroll
                for (int m = 0; m < 4; ++m) { const int row = rowb + ai * 128 + m * 16; const int mrow = row < ML ? ((row & ~4095) | ((4096 - (row & 4095)) & 4095)) : row;
#pragma unroll
                    for (int bj = 0; bj < 2; ++bj) { const int c = 256 * (2 * (pn - 10) + bj) + 32 * wc + 8 * fq; const u32x4 w = pk8(acc[ai][bj][m][0], acc[ai][bj][m][1]);
                        *(u32x4*)(FF + (size_t)row * 1024 + c) = w;
                        *(u32x4*)(FF + (size_t)mrow * 1024 + 128 + c) = (row < ML) ? w : (u32x4){0u, 0u, 0u, 0u}; } }
            return;
        }
        if (pn == 8 || pn == 9) {
#pragma unroll
            for (int ai = 0; ai < 2; ++ai)
#pragma unroll
                for (int m = 0; m < 4; ++m) { int b, key; row_bk(rowb + ai * 128 + m * 16, b, key);
#pragma unroll
                    for (int bj = 0; bj < 2; ++bj) { const int hn = 2 * (pn - 8) + bj;
#pragma unroll
                        for (int n = 0; n < 2; ++n) { bf16_t* dst = VnT + ((size_t)((b * 4 + hn) * 128 + 32 * wc + 8 * fq + 4 * n)) * KEYS + key;
#pragma unroll
                            for (int j = 0; j < 4; ++j) dst[(size_t)j * KEYS] = f2bf(acc[ai][bj][m][n][j]); } } }
            return;
        }
        const float sc = (pn == 4 || pn == 5) ? qscale : 1.f;
#pragma unroll
        for (int ai = 0; ai < 2; ++ai)
#pragma unroll
            for (int m = 0; m < 4; ++m) { const int row = rowb + ai * 128 + m * 16; float ss = 0.f;
#pragma unroll
                for (int bj = 0; bj < 2; ++bj) { f32x4 v0 = acc[ai][bj][m][0] * sc, v1 = acc[ai][bj][m][1] * sc;
                    if (pn == 12 && bj == 0 && wc < 2 && row < ML) rope8(v0, v1, row, wc & 1, fq, fq * 16 + fr, rope);
                    ss += sq4(v0) + sq4(v1);
                    *(u32x4*)(U + (size_t)row * UC + 256 * pn + 128 * bj + 32 * wc + 8 * fq) = pk8(v0, v1); }
                if (pn < 4) { ss += shx(ss, 16, fq * 16 + fr); ss += shx(ss, 32, fq * 16 + fr); if (fq == 0) ssq[(size_t)row * 16 + pn * 4 + wc] = ss; } }
    }
};
DI float row_rstd(const float* ssq, int row, int which) { const f32x4 a = *(const f32x4*)(ssq + (size_t)row * 16 + which * 8), b = *(const f32x4*)(ssq + (size_t)row * 16 + which * 8 + 4);
    const float s = ((a[0] + a[1]) + (a[2] + a[3])) + ((b[0] + b[1]) + (b[2] + b[3])); return __builtin_amdgcn_rsqf(s * (1.f / 512.f) + EPS); }
struct EpiQ {
    static constexpr bool PERM = true;
    bf16_t* Q; const float* ssq; const f32x2* rope; float scale;
    DI void operator()(AccRef acc, const Unit& u, int wr, int wc, int fr, int fq) const {
        const int rowb = u.pm * 256 + wr * 64 + fr;
#pragma unroll
        for (int ai = 0; ai < 2; ++ai)
#pragma unroll
            for (int m = 0; m < 4; ++m) { const int row = rowb + ai * 128 + m * 16; const float rs = row_rstd(ssq, row, 0) * scale;
#pragma unroll
                for (int bj = 0; bj < 2; ++bj) { const int c32 = 256 * u.pn + 128 * bj + 32 * wc; f32x4 v0 = acc[ai][bj][m][0] * rs, v1 = acc[ai][bj][m][1] * rs;
                    if (((c32 >> 6) % 3) == 2 && row < ML) rope8(v0, v1, row, (c32 >> 5) & 1, fq, fq * 16 + fr, rope);
                    *(u32x4*)(Q + (size_t)row * 1536 + c32 + 8 * fq) = pk8(v0, v1); } }
    }
};
struct EpiKV {
    static constexpr bool PERM = true;
    bf16_t* KN; bf16_t* VT; const float* ssq;
    DI void operator()(AccRef acc, const Unit& u, int wr, int wc, int fr, int fq) const {
        const int pn = u.pn, rowb = u.pm * 256 + wr * 64 + fr;
#pragma unroll
        for (int ai = 0; ai < 2; ++ai)
#pragma unroll
            for (int m = 0; m < 4; ++m) { const int row = rowb + ai * 128 + m * 16; const float rs = row_rstd(ssq, row, 1); int b, key; row_bk(row, b, key);
#pragma unroll
                for (int bj = 0; bj < 2; ++bj) {
                    if (pn < 4) { *(u32x4*)(KN + (size_t)row * 1024 + 256 * pn + 128 * bj + 32 * wc + 8 * fq) = pk8(acc[ai][bj][m][0] * rs, acc[ai][bj][m][1] * rs); }
                    else { const int h = 2 * (pn - 4) + bj;
#pragma unroll
                        for (int n = 0; n < 2; ++n) { bf16_t* dst = VT + ((size_t)((b * 8 + h) * 128 + 32 * wc + 8 * fq + 4 * n)) * KEYS + key;
#pragma unroll
                            for (int j = 0; j < 4; ++j) dst[(size_t)j * KEYS] = f2bf(acc[ai][bj][m][n][j] * rs); } } } }
    }
};
struct EpiY {
    static constexpr bool PERM = true;
    bf16_t* YT; bf16_t* YTc; int tok_base;
    DI void operator()(AccRef acc, const Unit& u, int wr, int wc, int fr, int fq) const {
        const int g = u.pm;
#pragma unroll
        for (int ai = 0; ai < 2; ++ai)
#pragma unroll
            for (int m = 0; m < 4; ++m) { const int d = 64 * wr + 16 * m + fr;
#pragma unroll
                for (int bj = 0; bj < 2; ++bj) { const int tok = tok_base + 256 * u.pn + 128 * bj + 32 * wc + 8 * fq; const u32x4 w = pk8(acc[ai][bj][m][0], acc[ai][bj][m][1]);
                    if (tok < ML) { const int b = tok >> 12, l = tok & 4095; bf16_t* rowp = YT + ((size_t)((b * 4 + g) * 128 + d)) * 4096;
                        if (l < 2048) {
                            if (ai == 0) *(u32x4*)(rowp + l) = w;
                            else if (l != 0) *(u32x4*)(rowp + 2048 + l) = w;
                            else { bf16_t* q = rowp + 2048; q[1] = (bf16_t)(w.x >> 16); q[2] = (bf16_t)w.y; q[3] = (bf16_t)(w.y >> 16); q[4] = (bf16_t)w.z; q[5] = (bf16_t)(w.z >> 16); q[6] = (bf16_t)w.w; q[7] = (bf16_t)(w.w >> 16); }
                        } else if (l == 2048 && ai == 0) rowp[2048] = (bf16_t)w.x;
                    } else { const int tc = tok - ML, b = tc >> 8, l = tc & 255; *(u32x4*)(YTc + ((size_t)((b * 4 + g) * 128 + d)) * 512 + ai * 256 + l) = w; } } }
    }
};
struct SchedY {
    int G, c, i0, start;
    DI void init(int G_, int c_, int start_) { G = G_; c = c_; start = start_; i0 = (start_ > c_) ? (start_ - c_ + G_ - 1) / G_ : 0; }
    DI bool next(int i, Unit& u) const { const int L = (i0 + i) * G + c - start; if (L >= 144) return false; const int bt = L >> 2; u.pm = L & 3; u.pn = (bt / 9) * 16 + (bt % 9); u.kob = 256 * u.pm; return true; }
};
struct EpiF {
    static constexpr bool PERM = true;
    bf16_t* CAT; int ctx;
    DI void operator()(AccRef acc, const Unit& u, int wr, int wc, int fr, int fq) const {
        const int b = u.pn >> 1;
#pragma unroll
        for (int ai = 0; ai < 2; ++ai)
#pragma unroll
            for (int m = 0; m < 4; ++m) { const int lp = u.pm * 256 + 128 * ai + 64 * wr + 16 * m + fr; const int row = ctx ? (ML + b * 256 + lp) : (b * 4096 + lp);
#pragma unroll
                for (int bj = 0; bj < 2; ++bj) { const int g = 2 * (u.pn & 1) + bj;
                    *(u32x4*)(CAT + (size_t)row * D + 1536 + g * 128 + 32 * wc + 8 * fq) = pk8(acc[ai][bj][m][0], acc[ai][bj][m][1]); } }
    }
};
struct EpiRes {
    static constexpr bool PERM = false;
    const float* xl; const float* xc; const bf16_t* xb; bf16_t* out; const float* gate;
    DI void operator()(AccRef acc, const Unit& u, int wr, int wc, int fr, int fq) const {
        const int row0 = u.pm * 256; const int midx = row0 < ML ? (row0 >> 12) : 4;
        const float* src = row0 < ML ? xl : (xc - (size_t)ML * D);
        const float* gp = gate + (size_t)midx * 12288;
        const int col0 = u.pn * 256 + wc * 32 + 4 * fq;
        f32x4 gv[2][2];
#pragma unroll
        for (int bj = 0; bj < 2; ++bj)
#pragma unroll
            for (int n = 0; n < 2; ++n) gv[bj][n] = *(const f32x4*)(gp + col0 + bj * 128 + n * 16);
        if (xb) {
#pragma unroll
            for (int ai = 0; ai < 2; ++ai)
#pragma unroll
                for (int m = 0; m < 4; ++m) { const size_t off = (size_t)(row0 + wr * 64 + fr + ai * 128 + m * 16) * D + col0;
#pragma unroll
                    for (int bj = 0; bj < 2; ++bj)
#pragma unroll
                        for (int n = 0; n < 2; ++n) { const size_t o2 = off + bj * 128 + n * 16;
                            const f32x4 r = bf4(*(const u32x2*)(xb + o2)) + gv[bj][n] * acc[ai][bj][m][n];
                            u32x2 w; w.x = pk2(r[0], r[1]); w.y = pk2(r[2], r[3]); *(u32x2*)(out + o2) = w; }
                    asm volatile("" ::: "memory"); }
        } else {
#pragma unroll
            for (int ai = 0; ai < 2; ++ai)
#pragma unroll
                for (int m = 0; m < 4; ++m) { const size_t off = (size_t)(row0 + wr * 64 + fr + ai * 128 + m * 16) * D + col0;
#pragma unroll
                    for (int bj = 0; bj < 2; ++bj)
#pragma unroll
                        for (int n = 0; n < 2; ++n) { const size_t o2 = off + bj * 128 + n * 16;
                            const f32x4 r = *(const f32x4*)(src + o2) + gv[bj][n] * acc[ai][bj][m][n];
                            u32x2 w; w.x = pk2(r[0], r[1]); w.y = pk2(r[2], r[3]); *(u32x2*)(out + o2) = w; }
                    asm volatile("" ::: "memory"); }
        }
    }
};
DI float dpp_ror1(float v) { return __builtin_bit_cast(float, __builtin_amdgcn_update_dpp(0, __builtin_bit_cast(int, v), 0x121, 0xf, 0xf, false)); }
DI float dpp_ror15(float v) { return __builtin_bit_cast(float, __builtin_amdgcn_update_dpp(0, __builtin_bit_cast(int, v), 0x12f, 0xf, 0xf, false)); }
struct EpiConv {
    static constexpr bool PERM = true;
    bf16_t* ACT; const float* cw; const float* cb; int Mq;
    DI void operator()(AccRef acc, const Unit& u, int wr, int wc, int fr, int fq) const {
#pragma unroll
        for (int n = 0; n < 2; ++n) {
            const int cg_ = 128 * u.pn + 32 * wc + 8 * fq + 4 * n;
#pragma unroll
            for (int ai = 0; ai < 2; ++ai) {
                const int tok0 = 252 * u.pm - 1 + 126 * wr + 64 * ai;
                f32x4 o[4];
#pragma unroll
                for (int bj = 0; bj < 2; ++bj) {
                    f32x4 w[2][4];
#pragma unroll
                    for (int t = 0; t < 3; ++t) w[bj][t] = *(const f32x4*)(cw + (size_t)t * 2 * DFF + bj * DFF + cg_);
                    w[bj][3] = *(const f32x4*)(cb + bj * DFF + cg_);
#pragma unroll
                    for (int m = 0; m < 4; ++m) {
                        const int tok = tok0 + 16 * m + fr; const int msk = tok < ML ? 4095 : 255;
                        const bool hu = (tok & msk) != 0, hd = ((tok + 1) & msk) != 0;
                        f32x4 r = acc[ai][bj][m][n] * w[bj][1] + w[bj][3];
#pragma unroll
                        for (int j = 0; j < 4; ++j) {
                            const float su = ((m > 0 || ai == 1) && fr == 15) ? (m > 0 ? acc[ai][bj][(m + 3) & 3][n][j] : acc[0][bj][3][n][j]) : acc[ai][bj][m][n][j];
                            const float sd = ((m < 3 || ai == 0) && fr == 0) ? (m < 3 ? acc[ai][bj][(m + 1) & 3][n][j] : acc[1][bj][0][n][j]) : acc[ai][bj][m][n][j];
                            const float uu = dpp_ror1(su), dd = dpp_ror15(sd);
                            r[j] += hu ? uu * w[bj][0][j] : 0.f; r[j] += hd ? dd * w[bj][2][j] : 0.f; }
                        if (bj == 0) {
#pragma unroll
                            for (int j = 0; j < 4; ++j) o[m][j] = r[j] * __builtin_amdgcn_rcpf(1.f + __builtin_amdgcn_exp2f(-LOG2E * r[j]));
                        } else o[m] = o[m] * r;
                    }
                }
#pragma unroll
                for (int m = 0; m < 4; ++m) { const int li = 64 * ai + 16 * m + fr, tok = tok0 + 16 * m + fr;
                    if (li >= 1 && li <= 126 && tok < Mq) { u32x2 v; v.x = pk2(o[m][0], o[m][1]); v.y = pk2(o[m][2], o[m][3]);
                        *(u32x2*)(ACT + (size_t)tok * DFF + cg_) = v; } }
            }
        }
    }
};

struct Frame {
    LAS unsigned char* lds; unsigned char* ldsg; int tid, lane, wave, G, vcu;
    const Params& P; unsigned char* ws;
    DI const float* inp(int i) const { return as_global(P.in[i]); }
    DI float* outp() const { return as_global(P.out); }
    DI int nrep(int d) const { int n = 1 + d; asm volatile("" : "+s"(n)); return n; }
    DI void refresh() { int t = threadIdx.x; asm volatile("" : "+v"(t)); tid = t; lane = t & 63; wave = __builtin_amdgcn_readfirstlane(t >> 6);
        long z = 0; asm volatile("" : "+s"(z)); ws = P.ws + z;
        int g = gridDim.x, bx = blockIdx.x; asm volatile("" : "+s"(g), "+s"(bx)); G = g; vcu = (g % 8 == 0) ? (bx % 8) * (g / 8) + bx / 8 : bx; }
};

DI void p_mod(const Frame& F) {
    LAS float* sv = (LAS float*)F.lds; LAS float* red = sv + 5 * 2048;
    const float* c = F.inp(1); const float* cc = F.inp(3);
    for (int i = F.tid; i < 5 * 2048; i += NT) { const int r = i >> 11, k = i & 2047; const float v = r < 4 ? c[r * 2048 + k] : cc[k]; sv[i] = v / (1.f + __expf(-v)); }
    __syncthreads();
    float* mod = (float*)(F.ws + WS_MOD);
    for (int tile = F.vcu; tile < 768; tile += F.G) {
        const int l = tile / 384, colb = (tile % 384) * 32, cl = F.tid & 31, kg = F.tid >> 5;
        const float* w = F.inp(4) + (size_t)l * 2048 * 12288 + colb + cl;
        float a0 = 0.f, a1 = 0.f, a2 = 0.f, a3 = 0.f, a4 = 0.f;
#pragma unroll 32
        for (int k = kg * 128; k < kg * 128 + 128; ++k) { const float wv = __builtin_nontemporal_load(w + (size_t)k * 12288); a0 += sv[k] * wv; a1 += sv[2048 + k] * wv; a2 += sv[4096 + k] * wv; a3 += sv[6144 + k] * wv; a4 += sv[8192 + k] * wv; }
        LAS float* rp = red + (kg * 32 + cl) * 5; rp[0] = a0; rp[1] = a1; rp[2] = a2; rp[3] = a3; rp[4] = a4;
        __syncthreads();
        if (F.tid < 160) { const int r = F.tid >> 5; float s = 0.f;
#pragma unroll
            for (int q = 0; q < 16; ++q) s += red[(q * 32 + cl) * 5 + r];
            mod[(size_t)(l * 5 + r) * 12288 + colb + cl] = s + F.inp(5)[l * 12288 + colb + cl]; }
        __syncthreads();
    }
}
DI void p_tables(const Frame& F) {
    const int gt = F.vcu * NT + F.tid, gn = F.G * NT;
    LAS f32x2* t4096 = (LAS f32x2*)F.lds;
    __syncthreads();
    for (int i = F.tid; i < 4096; i += NT) { f32x2 v; v.x = cospif((float)i / 2048.f); v.y = sinpif((float)i / 2048.f); t4096[i] = v; }
    __syncthreads();
    f32x2* rope = (f32x2*)(F.ws + WS_ROPE);
    for (int i = gt; i < 1024; i += gn) { const int pos = i >> 4, k = i & 15; const float fr = powf(10000.f, -(float)k / 16.f); const float a = (float)pos * fr; f32x2 v; v.x = cosf(a); v.y = sinf(a); rope[i] = v; }
    if (gt < 32) ((unsigned*)(F.ws + WS_CTR))[gt] = 0u;
    if (F.tid == 0) *(float**)(F.ws + WS_CTR + 128) = F.outp();
    bf16_t* dc = (bf16_t*)F.outp() + DO_DFTC;
    for (int i = gt; i < 256 * 512; i += gn) { const int lp = i >> 9, cc = i & 511, part = cc >> 8, l = cc & 255; const f32x2 t = t4096[((lp * l) & 255) * 16];
        dc[i] = f2bf((part ? -t.y : t.x) * (1.f / 16.f)); }
    bf16_t* wc = (bf16_t*)(F.ws + WS_WC); const float* wf = F.inp(14);
    for (int i = gt; i < 2 * 4 * 2 * 128 * 128; i += gn) {
        const int d = i & 127, cch = (i >> 7) & 127, part = (i >> 14) & 1, g = (i >> 15) & 3, l = i >> 17;
        const float* wp = wf + ((size_t)(l * 4 + g) * 128) * 128 + d; float sacc = 0.f;
        for (int c2 = 0; c2 < 128; ++c2) { const f32x2 t = t4096[((cch * c2) & 127) * 32]; sacc += (part ? t.y : t.x) * wp[(size_t)c2 * 128]; }
        sacc *= 0.08838834764831845f;
        bf16_t* row = wc + ((size_t)l * 1024 + (g * 2 + part) * 128 + d) * 256;
        row[cch] = f2bf(sacc); row[128 + cch] = f2bf(part ? -sacc : sacc);
    }
    bf16_t* dft = (bf16_t*)F.outp() + DO_DFT;
    for (int ch = gt; ch < 4096 * 512; ch += gn) { const int lp = ch >> 9, k0 = (ch & 511) * 8; f32x4 a, b;
#pragma unroll
        for (int j = 0; j < 8; ++j) { const int k = k0 + j; const f32x2 t = t4096[(lp * (k & 2047) + (k == 2048 ? lp * 2048 : 0)) & 4095];
            const float v = (k <= 2048 ? t.x : -t.y) * ((k == 0 || k == 2048) ? (1.f / 128.f) : (1.f / 64.f));
            if (j < 4) a[j] = v; else b[j - 4] = v; }
        *(u32x4*)(dft + (size_t)lp * 4096 + k0) = pk8(a, b); }
    __syncthreads();
}
struct CvDesc { const float* src; const float* kscale; bf16_t* dst; int K, Nsrc, Ndst, mapid, ntiles; };
DI int cv_map(int mapid, int n) {
    if (mapid == 1) return n < 1024 ? n : (n < 3072 ? n + 64 : (n < 3136 ? n - 2048 : -1));
    if (mapid == 2) { const int which = n >> 10, h = (n >> 7) & 7, j = n & 127; return h * 256 + which * 128 + j; }
    if (mapid == 3) { const int pn = n >> 8, bj = (n >> 7) & 1, q = n & 127; return bj * DFF + pn * 128 + q; }
    return n;
}
DI CvDesc cv_desc(const Frame& F, int m) {
    const int l = m / 6, j = m % 6; CvDesc d; d.kscale = nullptr; d.mapid = 0;
    if (j == 0) { d.src = F.inp(8) + (size_t)l * D * INC; d.K = D; d.Nsrc = INC; d.dst = (bf16_t*)(F.ws + WS_WIN) + (size_t)l * UC * D; d.Ndst = UC; d.mapid = 1; }
    else if (j == 1) { d.src = F.inp(10) + (size_t)l * 512 * 1536; d.K = 512; d.Nsrc = 1536; d.dst = (bf16_t*)(F.ws + WS_WUQ) + (size_t)l * 1536 * 512; d.Ndst = 1536; d.kscale = F.inp(9) + l * 512; }
    else if (j == 2) { d.src = F.inp(12) + (size_t)l * 512 * 2048; d.K = 512; d.Nsrc = 2048; d.dst = (bf16_t*)(F.ws + WS_WUKV) + (size_t)l * 2048 * 512; d.Ndst = 2048; d.kscale = F.inp(11) + l * 512; d.mapid = 2; }
    else if (j == 3) { d.src = F.inp(15) + (size_t)l * D * D; d.K = D; d.Nsrc = D; d.dst = (bf16_t*)(F.ws + WS_WOUT) + (size_t)l * D * D; d.Ndst = D; }
    else if (j == 4) { d.src = F.inp(16) + (size_t)l * D * 2 * DFF; d.K = D; d.Nsrc = 2 * DFF; d.dst = (bf16_t*)(F.ws + WS_WUP) + (size_t)l * 2 * DFF * D; d.Ndst = 2 * DFF; d.mapid = 3; }
    else { d.src = F.inp(19) + (size_t)l * DFF * D; d.K = DFF; d.Nsrc = D; d.dst = (bf16_t*)(F.ws + WS_WDN) + (size_t)l * D * DFF; d.Ndst = D; }
    d.ntiles = (d.Ndst / 128) * (d.K / 64); return d;
}
struct CvTile { const float* src; const float* kscale; bf16_t* dst; int K, Nsrc, sc0, sc1, n0, k0; bool ok; };
DI CvTile cv_tile(const Frame& F, int t) {
    CvTile r; r.ok = false;
    constexpr int NTN[6] = {26, 12, 16, 16, 88, 16}, NT_[6] = {26 * 32, 12 * 8, 16 * 8, 16 * 32, 88 * 32, 16 * 88};
    constexpr int PER_LAYER = NT_[0] + NT_[1] + NT_[2] + NT_[3] + NT_[4] + NT_[5];
    if (t >= 2 * PER_LAYER) return r;
    const int l = t >= PER_LAYER ? 1 : 0; t -= l * PER_LAYER;
    int j = 0, nt = 0, kt = 0;
#pragma unroll
    for (int q = 0; q < 6; ++q) { if (t >= 0 && t < NT_[q]) { j = q; nt = t % NTN[q]; kt = t / NTN[q]; } t -= NT_[q]; }
    const CvDesc d = cv_desc(F, l * 6 + j);
    r.n0 = nt * 128; r.k0 = kt * 64; r.src = d.src; r.kscale = d.kscale; r.dst = d.dst; r.K = d.K; r.Nsrc = d.Nsrc;
    r.sc0 = cv_map(d.mapid, r.n0); r.sc1 = cv_map(d.mapid, r.n0 + 64); r.ok = true; return r;
}
DI void cv_load(const Frame& F, const CvTile& t, f32x4 (&r)[4]) {
#pragma unroll
    for (int h = 0; h < 2; ++h) { const int sc = h ? t.sc1 : t.sc0;
#pragma unroll
        for (int p = 0; p < 2; ++p) { const int kk = p * 32 + (F.tid >> 4);
            f32x4 v = {0.f, 0.f, 0.f, 0.f};
            if (sc >= 0) { v = __builtin_nontemporal_load((const f32x4*)(t.src + (size_t)(t.k0 + kk) * t.Nsrc + sc + (F.tid & 15) * 4)); if (t.kscale) v *= t.kscale[t.k0 + kk]; }
            r[h * 2 + p] = v; } }
}
DI void p_convert(const Frame& F) {
    LAS float* ts = (LAS float*)F.lds;
    int t = F.vcu; CvTile cur = cv_tile(F, t), nx1 = cv_tile(F, t + F.G); f32x4 r0[4], r1[4]; int buf = 0;
    if (cur.ok) cv_load(F, cur, r0);
    if (nx1.ok) cv_load(F, nx1, r1);
    while (cur.ok) {
        LAS float* tb = ts + buf * (2 * 64 * 65);
#pragma unroll
        for (int h = 0; h < 2; ++h)
#pragma unroll
            for (int p = 0; p < 2; ++p) { const int kk = p * 32 + (F.tid >> 4); LAS float* q = tb + h * (64 * 65) + kk * 65 + (F.tid & 15) * 4;
                q[0] = r0[h * 2 + p][0]; q[1] = r0[h * 2 + p][1]; q[2] = r0[h * 2 + p][2]; q[3] = r0[h * 2 + p][3]; }
        __syncthreads();
#pragma unroll
        for (int i = 0; i < 4; ++i) r0[i] = r1[i];
        const CvTile nx2 = cv_tile(F, t + 2 * F.G);
        if (nx2.ok) cv_load(F, nx2, r1);
#pragma unroll
        for (int h = 0; h < 2; ++h) { const int n = F.tid >> 3, kc = F.tid & 7; const LAS float* q = tb + h * (64 * 65) + n; f32x4 a, b;
#pragma unroll
            for (int j = 0; j < 4; ++j) { a[j] = q[(kc * 8 + j) * 65]; b[j] = q[(kc * 8 + 4 + j) * 65]; }
            *(u32x4*)(cur.dst + (size_t)(cur.n0 + h * 64 + n) * cur.K + cur.k0 + kc * 8) = pk8(a, b); }
        buf ^= 1; t += F.G; cur = nx1; nx1 = nx2;
    }
    __syncthreads();
}

DI void norm_phase(const Frame& F, const float* xl, const float* xc, const bf16_t* xb, int M, const float* g, const float* modl, int sh_off, int sc_off, bf16_t* H, float* outf) {
    const int gw = F.vcu * 8 + F.wave, nw = F.G * 8;
    const int row_lo = (int)(((long)gw * M) / nw), row_hi = (int)(((long)(gw + 1) * M) / nw);
    f32x4 gs[8], shv[8]; int cur = -1;
    for (int row = row_lo; row < row_hi; ++row) {
        const int midx = row < ML ? (row >> 12) : 4;
        if (midx != cur) { cur = midx;
#pragma unroll
            for (int i = 0; i < 4; ++i) { const int col = i * 512 + F.lane * 8;
                gs[2 * i] = *(const f32x4*)(g + col); gs[2 * i + 1] = *(const f32x4*)(g + col + 4);
                if (!outf) { const float* mp = modl + (size_t)midx * 12288 + col;
                    gs[2 * i] = gs[2 * i] * (1.f + *(const f32x4*)(mp + sc_off)); gs[2 * i + 1] = gs[2 * i + 1] * (1.f + *(const f32x4*)(mp + sc_off + 4));
                    shv[2 * i] = *(const f32x4*)(mp + sh_off); shv[2 * i + 1] = *(const f32x4*)(mp + sh_off + 4); } } }
        f32x4 v[8]; float ss = 0.f;
        if (xb) {
#pragma unroll
            for (int i = 0; i < 4; ++i) { const u32x4 w = *(const u32x4*)(xb + (size_t)row * D + i * 512 + F.lane * 8); v[2 * i] = bf4((u32x2){w.x, w.y}); v[2 * i + 1] = bf4((u32x2){w.z, w.w}); ss += sq4(v[2 * i]) + sq4(v[2 * i + 1]); }
        } else { const float* xr = row < ML ? xl + (size_t)row * D : xc + (size_t)(row - ML) * D;
#pragma unroll
            for (int i = 0; i < 4; ++i) { v[2 * i] = *(const f32x4*)(xr + i * 512 + F.lane * 8); v[2 * i + 1] = *(const f32x4*)(xr + i * 512 + F.lane * 8 + 4); ss += sq4(v[2 * i]) + sq4(v[2 * i + 1]); } }
#pragma unroll
        for (int o = 32; o >= 1; o >>= 1) ss += shx(ss, o, F.lane);
        const float rs = __builtin_amdgcn_rsqf(ss * (1.f / 2048.f) + EPS);
#pragma unroll
        for (int i = 0; i < 4; ++i) { const int col = i * 512 + F.lane * 8;
            if (outf) { *(f32x4*)(outf + (size_t)row * D + col) = v[2 * i] * rs * gs[2 * i]; *(f32x4*)(outf + (size_t)row * D + col + 4) = v[2 * i + 1] * rs * gs[2 * i + 1]; }
            else *(u32x4*)(H + (size_t)row * D + col) = pk8(v[2 * i] * rs * gs[2 * i] + shv[2 * i], v[2 * i + 1] * rs * gs[2 * i + 1] + shv[2 * i + 1]); }
    }
}

struct AttnItem {
    const bf16_t* q; const bf16_t* kn; const bf16_t* kr; const bf16_t* vt; bf16_t* o;
    int ldq, ldk, ldo, lat_row0, ctx_row0, t0, ntl, nctx, mode, r0, hn;
};
template <int DQ>
DI void attn_item(const Frame& F, const AttnItem& it, const LAS float* rpb_lds) {
    constexpr int KP = DQ + 8, VP = 72, KS = DQ / 16;
    constexpr int KBYTES = 64 * KP * 2, VBYTES = 128 * VP * 2;
    LAS unsigned char* base = F.lds;
    int tid = threadIdx.x; asm volatile("" : "+v"(tid));
    const int lane = tid & 63, w = __builtin_amdgcn_readfirstlane(tid >> 6), qq = lane & 31, hh = lane >> 5;
    const bool grpB = w >= 4;
    const int ntile = it.ntl + it.nctx;
    u32x4 rk[2], rr, rv[2];
    auto gload = [&](int ti) {
        int rowb, vcol;
        if (ti < it.ntl) { const int kt = it.t0 + ti; rowb = it.lat_row0 + kt * 64; vcol = kt * 64; } else { const int j = ti - it.ntl; rowb = it.ctx_row0 + j * 64; vcol = SEQ + j * 64; }
#pragma unroll
        for (int i = 0; i < 2; ++i) { const int id = tid + i * NT; rk[i] = *(const u32x4*)(it.kn + (size_t)(rowb + (id >> 4)) * it.ldk + (id & 15) * 8);
            rv[i] = *(const u32x4*)(it.vt + (size_t)(id >> 3) * KEYS + vcol + (id & 7) * 8); }
        if (DQ == 192) rr = *(const u32x4*)(it.kr + (size_t)(rowb + (tid >> 3)) * UC + (tid & 7) * 8);
    };
    auto lstore = [&](int ti) {
        LAS unsigned char* kb = base + (ti & 1) * KBYTES; LAS unsigned char* vb = base + 2 * KBYTES + (ti % 3) * VBYTES;
#pragma unroll
        for (int i = 0; i < 2; ++i) { const int id = tid + i * NT; *(LAS u32x4*)(kb + ((id >> 4) * KP + (id & 15) * 8) * 2) = rk[i];
            *(LAS u32x4*)(vb + ((id >> 3) * VP + (id & 7) * 8) * 2) = rv[i]; }
        if (DQ == 192) *(LAS u32x4*)(kb + ((tid >> 3) * KP + 128 + (tid & 7) * 8) * 2) = rr;
    };
    bf16x8 qf[KS];
    { const bf16_t* qp = it.q + (size_t)(32 * w + qq) * it.ldq + 8 * hh;
#pragma unroll
        for (int ks = 0; ks < KS; ++ks) qf[ks] = *(const bf16x8*)(qp + 16 * ks); }
    f32x16 o[4];
#pragma unroll
    for (int db = 0; db < 4; ++db)
#pragma unroll
        for (int i = 0; i < 16; ++i) o[db][i] = 0.f;
    f32x16 s[2];
    float mrun = -INFINITY, lrun = 0.f;
    const int r = it.r0 + (w >> 1), wq = 32 * (w & 1) + qq;
    const int rs = min(max(r - 4, 0), 56), cs = min(max(wq - 8, 0), 48);
    auto active = [&](int ti) { const int krow = it.t0 + ti; return !(it.mode == 1 && ti < it.ntl && (krow < rs || krow > rs + 7)); };
    auto qk = [&](int ti) {
        if (!active(ti)) return;
        const int krow_l = (qq & 3) + 4 * ((qq >> 3) & 1) + 8 * ((qq >> 2) & 1) + 16 * (qq >> 4);
        LAS unsigned char* kb = base + (ti & 1) * KBYTES + (krow_l * KP + 8 * hh) * 2;
#pragma unroll
        for (int blk = 0; blk < 2; ++blk)
#pragma unroll
            for (int i = 0; i < 16; ++i) s[blk][i] = 0.f;
        bf16x8 kf[3][2];
#pragma unroll
        for (int p = 0; p < 2; ++p)
#pragma unroll
            for (int blk = 0; blk < 2; ++blk) kf[p][blk] = *(const LAS bf16x8*)(kb + (32 * blk * KP + 16 * p) * 2);
#pragma unroll
        for (int ks = 0; ks < KS; ++ks) {
            if (ks + 2 < KS) {
#pragma unroll
                for (int blk = 0; blk < 2; ++blk) kf[(ks + 2) % 3][blk] = *(const LAS bf16x8*)(kb + (32 * blk * KP + 16 * (ks + 2)) * 2); }
            __builtin_amdgcn_sched_barrier(0);
#pragma unroll
            for (int blk = 0; blk < 2; ++blk) s[blk] = __builtin_amdgcn_mfma_f32_32x32x16_bf16(kf[ks % 3][blk], qf[ks], s[blk], 0, 0, 0);
            __builtin_amdgcn_sched_barrier(0);
        }
    };
    auto smpv = [&](int ti) {
        if (!active(ti)) return;
        LAS unsigned char* vb = base + 2 * KBYTES + (ti % 3) * VBYTES;
        if (it.mode == 1 && ti < it.ntl) {
            const int krow = it.t0 + ti;
            const LAS float* bp = rpb_lds + it.hn * 465 + (krow - r + 7) * 31 - wq + 15;
#pragma unroll
            for (int blk = 0; blk < 2; ++blk)
#pragma unroll
                for (int i = 0; i < 16; ++i) { const int kc = 32 * blk + (i & 3) + 4 * ((i >> 2) & 1) + 8 * hh + 16 * (i >> 3); const bool ok = kc >= cs && kc < cs + 16;
                    const int kcc = ok ? kc : cs; s[blk][i] = ok ? s[blk][i] + bp[kcc] : -INFINITY; }
        }
        float mx = s[0][0];
#pragma unroll
        for (int blk = 0; blk < 2; ++blk)
#pragma unroll
            for (int i = 0; i < 16; ++i) mx = fmaxf(mx, s[blk][i]);
        mx = fmaxf(mx, shx(mx, 32, lane));
        const float mnew = fmaxf(mrun, mx), alpha = __builtin_amdgcn_exp2f(mrun - mnew);
        mrun = mnew;
        float ps = 0.f;
#pragma unroll
        for (int blk = 0; blk < 2; ++blk)
#pragma unroll
            for (int i = 0; i < 16; ++i) { const float p = __builtin_amdgcn_exp2f(s[blk][i] - mnew); s[blk][i] = p; ps += p; }
        lrun = lrun * alpha + ps;
        if (__builtin_amdgcn_ballot_w64(alpha != 1.f) != 0ull) {
#pragma unroll
            for (int db = 0; db < 4; ++db)
#pragma unroll
                for (int i = 0; i < 16; ++i) o[db][i] *= alpha;
        }
        LAS unsigned char* vq = vb + (qq * VP + 8 * hh) * 2;
        auto vload = [&](int step, int db) { return *(const LAS bf16x8*)(vq + (32 * db * VP + 16 * step) * 2); };
        bf16x8 vf[2][4];
#pragma unroll
        for (int db = 0; db < 4; ++db) vf[0][db] = vload(0, db);
#pragma unroll
        for (int st = 0; st < 4; ++st) {
            if (st + 1 < 4) {
#pragma unroll
                for (int db = 0; db < 4; ++db) vf[(st + 1) & 1][db] = vload(st + 1, db); }
            __builtin_amdgcn_sched_barrier(0);
            const int blk = st >> 1, s2 = st & 1;
            u32x4 pw; pw.x = pk2(s[blk][8 * s2], s[blk][8 * s2 + 1]); pw.y = pk2(s[blk][8 * s2 + 2], s[blk][8 * s2 + 3]);
            pw.z = pk2(s[blk][8 * s2 + 4], s[blk][8 * s2 + 5]); pw.w = pk2(s[blk][8 * s2 + 6], s[blk][8 * s2 + 7]);
            const bf16x8 pf = __builtin_bit_cast(bf16x8, pw);
#pragma unroll
            for (int db = 0; db < 4; ++db) o[db] = __builtin_amdgcn_mfma_f32_32x32x16_bf16(vf[st & 1][db], pf, o[db], 0, 0, 0);
            __builtin_amdgcn_sched_barrier(0);
        }
    };

    __syncthreads();
    gload(0); lstore(0);
    if (ntile > 1) gload(1);
    __syncthreads();
    for (int ti = 0; ti < ntile; ++ti) {
        qk(ti);
        if (grpB) { if (ti + 1 < ntile) lstore(ti + 1); if (ti + 2 < ntile) gload(ti + 2); __syncthreads(); }
        smpv(ti);
        if (!grpB) { if (ti + 1 < ntile) lstore(ti + 1); if (ti + 2 < ntile) gload(ti + 2); __syncthreads(); }
    }
    const float lt = lrun + shx(lrun, 32, lane), inv = 1.f / lt;
    bf16_t* op = it.o + (size_t)(32 * w + qq) * it.ldo + 4 * hh;
#pragma unroll
    for (int db = 0; db < 4; ++db)
#pragma unroll
        for (int ig = 0; ig < 4; ++ig) { u32x2 v; v.x = pk2(o[db][4 * ig] * inv, o[db][4 * ig + 1] * inv); v.y = pk2(o[db][4 * ig + 2] * inv, o[db][4 * ig + 3] * inv);
            *(u32x2*)(op + 32 * db + 8 * ig) = v; }
}

#ifndef MLAREP
#define MLAREP 1
#endif
DI void mixer_attention(const Frame& F, int layer, int cidx) {
    const int nitems = (layer == 0 ? 816 : 768) + 512 * (MLAREP - 1);
    bf16_t* U = (bf16_t*)(F.ws + WS_U); bf16_t* Q = (bf16_t*)(F.ws + WS_Q); bf16_t* KN = (bf16_t*)(F.ws + WS_KN);
    bf16_t* VT = (bf16_t*)(F.ws + WS_VT); bf16_t* VNT = (bf16_t*)(F.ws + WS_VNT); bf16_t* CAT = (bf16_t*)(F.ws + WS_CAT);
    unsigned* ctr = (unsigned*)(F.ws + WS_CTR) + cidx;
    LAS float* rpb = (LAS float*)(F.lds + 112 * 1024);
    volatile LAS int* slot = (volatile LAS int*)(F.lds + 112 * 1024 + 8192);
    __syncthreads();
    for (int i = F.tid; i < 4 * 465; i += NT) rpb[i] = F.inp(13)[layer * 4 * 465 + i] * LOG2E;
    for (int step = 0;; ++step) {
        int idx;
        if (step < 2) idx = F.vcu + 256 * step;
        else {
            __syncthreads();
            if (F.tid == 0) *slot = (int)atomicAdd(ctr, 1u);
            __syncthreads();
            idx = 512 + *slot;
        }
        if (idx >= nitems) break;
        AttnItem it; it.kr = nullptr; it.mode = 0; it.r0 = 0; it.hn = 0; it.nctx = 4;
        if (idx < 512 || (idx >= 768 && idx < 800)) {
            int b, h, row0;
            if (idx < 512) { b = idx >> 7; h = (idx >> 4) & 7; row0 = b * 4096 + (idx & 15) * 256; it.t0 = 0; it.ntl = 64; }
            else { const int j = idx - 768; b = j >> 3; h = j & 7; row0 = ML + b * 256; it.t0 = 0; it.ntl = 0; }
            it.q = Q + (size_t)row0 * 1536 + h * 192; it.ldq = 1536;
            it.kn = KN + h * 128; it.ldk = 1024; it.kr = U + U_KR;
            it.vt = VT + (size_t)(b * 8 + h) * 128 * KEYS;
            it.o = CAT + (size_t)row0 * D + h * 128; it.ldo = D;
            it.lat_row0 = b * 4096; it.ctx_row0 = ML + b * 256;
            attn_item<192>(F, it, rpb);
        } else {
            int b, hn, row0;
            if (idx < 768) { const int j = idx - 512; b = j >> 6; hn = (j >> 4) & 3; const int R = j & 15; row0 = b * 4096 + R * 256;
                const int rlo = max(4 * R - 4, 0), rhi = min(max(4 * R - 1, 0), 56) + 7; it.t0 = rlo; it.ntl = rhi - rlo + 1; it.mode = 1; it.r0 = 4 * R; it.hn = hn; }
            else { const int j = idx - 800; b = j >> 2; hn = j & 3; row0 = ML + b * 256; it.t0 = 0; it.ntl = 0; }
            it.q = U + (size_t)row0 * UC + U_QN + hn * 128; it.ldq = UC;
            it.kn = U + U_KN + hn * 128; it.ldk = UC;
            it.vt = VNT + (size_t)(b * 4 + hn) * 128 * KEYS;
            it.o = CAT + (size_t)row0 * D + 1024 + hn * 128; it.ldo = D;
            it.lat_row0 = b * 4096; it.ctx_row0 = ML + b * 256;
            attn_item<128>(F, it, rpb);
        }
    }
}


#define XB_TMO      128
#define XB_XCNT(j)  (256  + 64 * (j))
#define XB_XSUB(j)  (1280 + 64 * (j))
#define XB_XGEN(j)  (2304 + 64 * (j))
#define XB_TOP      3328
#define XB_TOPGEN   3392
#define XCD_BAR_WORDS 3456
#define XB_SPIN_CAP (1u << 18)
__device__ __forceinline__ unsigned xb_ld(unsigned* p)              { return __hip_atomic_load(p, __ATOMIC_RELAXED, __HIP_MEMORY_SCOPE_AGENT); }
__device__ __forceinline__ unsigned xb_add(unsigned* p, unsigned v) { return __hip_atomic_fetch_add(p, v, __ATOMIC_RELAXED, __HIP_MEMORY_SCOPE_AGENT); }
__device__ __forceinline__ unsigned xb_xcc_id() { return (unsigned)__builtin_amdgcn_s_getreg((3 << 11) | 20) & 0xFu; }
#define XB_SPIN(cond, bar) do { unsigned _sp = 0; while (cond) { __builtin_amdgcn_s_sleep(1); \
    if ((++_sp & 255u) == 0u) { if (xb_ld(&(bar)[XB_TMO])) break; if (_sp > XB_SPIN_CAP) { atomicAdd(&(bar)[XB_TMO], 1u); break; } } } } while (0)
struct XcdBarrier { unsigned* bar; unsigned x; volatile LAS unsigned* st; };
__device__ __forceinline__ XcdBarrier xcd_barrier_post(unsigned* bar, volatile LAS unsigned* st) {
    XcdBarrier b; b.bar = bar; b.x = xb_xcc_id(); b.st = st;
    if (threadIdx.x == 0) (void)xb_add(&bar[XB_XCNT(b.x)], 1u);
    return b;
}
__device__ __forceinline__ void xcd_barrier_complete(unsigned* bar, unsigned x, unsigned& nloc, unsigned& nx) {
    const unsigned G = gridDim.x * gridDim.y * gridDim.z;
    unsigned sum, cnt, mine, sp = 0u;
    for (;;) {
        sum = 0u; cnt = 0u; mine = 0u;
#pragma unroll
        for (unsigned j = 0; j < 16; ++j) { const unsigned c = xb_ld(&bar[XB_XCNT(j)]); sum += c; cnt += (c > 0u) ? 1u : 0u; mine = (j == x) ? c : mine; }
        if (sum == G) break;
        __builtin_amdgcn_s_sleep(1);
        if ((++sp & 255u) == 0u) { if (xb_ld(&bar[XB_TMO])) break; if (sp > XB_SPIN_CAP) { atomicAdd(&bar[XB_TMO], 1u); break; } }
    }
    nloc = mine > 0u ? mine : 1u; nx = cnt > 0u ? cnt : 1u;
}
__device__ __forceinline__ void xcd_barrier(const XcdBarrier& b) {
    asm volatile("s_waitcnt vmcnt(0)" ::: "memory");
    __syncthreads();
    if (threadIdx.x == 0) {
        unsigned* bar = b.bar;
        __builtin_amdgcn_s_waitcnt(0);
        unsigned nloc = b.st[0], nx = b.st[1];
        if (nloc == 0u) { xcd_barrier_complete(bar, b.x, nloc, nx); b.st[0] = nloc; b.st[1] = nx; }
        const unsigned old = xb_add(&bar[XB_XSUB(b.x)], 1u);
        const unsigned gen = old / nloc;
        if (old + 1u == (gen + 1u) * nloc) {
            __builtin_amdgcn_fence(__ATOMIC_RELEASE, "agent");
            asm volatile("s_waitcnt vmcnt(0)" ::: "memory");
            const unsigned og = xb_add(&bar[XB_TOP], 1u);
            const unsigned tg = og / nx;
            if (og + 1u == (tg + 1u) * nx) xb_add(&bar[XB_TOPGEN], 1u);
            else XB_SPIN(xb_ld(&bar[XB_TOPGEN]) == tg, bar);
            __builtin_amdgcn_fence(__ATOMIC_ACQUIRE, "agent");
            xb_add(&bar[XB_XGEN(b.x)], 1u);
            asm volatile("s_waitcnt vmcnt(0)" ::: "memory");
        } else {
            XB_SPIN(xb_ld(&bar[XB_XGEN(b.x)]) == gen, bar);
            __builtin_amdgcn_fence(__ATOMIC_ACQUIRE, "agent");
            asm volatile("s_waitcnt vmcnt(0)" ::: "memory");
        }
    }
    __syncthreads();
}

#ifndef PHMASK
#define PHMASK 0x7ff
#endif
#define PH(k) (((PHMASK) >> (k)) & 1)
#ifndef DUPMASK
#define DUPMASK 0x000
#endif
#define REP(k) for (int rep_ = 0, nrep_ = F.nrep((DUPMASK >> (k)) & 1); rep_ < nrep_; ++rep_)
#define Hbuf ((bf16_t*)(F.ws + WS_H))
#define H (Hbuf + D)
#define X ((bf16_t*)(F.ws + WS_X))
#define U ((bf16_t*)(F.ws + WS_U))
#define SSQ ((float*)(F.ws + WS_SSQ))
#define CAT ((bf16_t*)(F.ws + WS_CAT))
#define mod ((const float*)(F.ws + WS_MOD))
#define rope ((const f32x2*)(F.ws + WS_ROPE))
#define GSYNC() do { F.refresh(); { XcdBarrier xb_{(unsigned*)(F.ws + WS_BAR), xb_xcc_id(), (volatile LAS unsigned*)(F.lds + 135 * 1024)}; xcd_barrier(xb_); } F.refresh(); } while (0)
DI void layer_body(Frame& F, const int l) {
        const int Mq = l == 0 ? MT : ML;
#define modl (mod + (size_t)l * 5 * 12288)
#define xbl (l == 0 ? (const bf16_t*)nullptr : (const bf16_t*)X)
        REP(1) {
        if (PH(1)) norm_phase(F, F.inp(0), F.inp(2), xbl, MT, F.inp(6) + l * D, modl, 0, 2048, H, nullptr);
        GSYNC(); }
        REP(2) {
        { pg8::Gemm g{H, (const bf16_t*)(F.ws + WS_WIN) + (size_t)l * UC * D, D, D, D, 0};
          pg8::Sched S; S.init(MT / 256, UC / 256, F.G, F.vcu, 0);
          EpiU E{U, SSQ, (bf16_t*)(F.ws + WS_VNT), rope, 0.08838834764831845f * LOG2E, (bf16_t*)F.outp() + DO_FF};
          if (PH(2)) pg8::gemm_phase(F.lds, g, S, E); }
        GSYNC(); }
        REP(3) {
        { int start = 0;
          { pg8::Gemm g{U + U_CQ, (const bf16_t*)(F.ws + WS_WUQ) + (size_t)l * 1536 * 512, UC, 512, 512, 0};
            pg8::Sched S; S.init(Mq / 256, 6, F.G, F.vcu, start); start += (Mq / 256) * 6;
            EpiQ E{(bf16_t*)(F.ws + WS_Q), SSQ, rope, 0.07216878364870323f * LOG2E};
            if (PH(3)) pg8::gemm_phase(F.lds, g, S, E); }
          { pg8::Gemm g{U + U_CKV, (const bf16_t*)(F.ws + WS_WUKV) + (size_t)l * 2048 * 512, UC, 512, 512, 0};
            pg8::Sched S; S.init(MT / 256, 8, F.G, F.vcu, start); start += (MT / 256) * 8;
            EpiKV E{(bf16_t*)(F.ws + WS_KN), (bf16_t*)(F.ws + WS_VT), SSQ};
            if (PH(4)) pg8::gemm_phase(F.lds, g, S, E); }
          { pg8::Gemm g{(const bf16_t*)(F.ws + WS_WC) + (size_t)l * 1024 * 256, (const bf16_t*)F.outp() + DO_FF, 256, 1024, 256, 0};
            SchedY S; S.init(F.G, F.vcu, start); start += 144;
            EpiY E{(bf16_t*)(F.ws + WS_YT), (bf16_t*)(F.ws + WS_YTC), 0};
            if (PH(5)) pg8::gemm_phase(F.lds, g, S, E); }
          if (l == 0) { pg8::Gemm g{(const bf16_t*)(F.ws + WS_WC) + (size_t)l * 1024 * 256, (const bf16_t*)F.outp() + DO_FF + (size_t)ML * 1024, 256, 1024, 256, 0};
            pg8::Sched S; S.init(4, MC / 256, F.G, F.vcu, start); S.kobm = 256;
            EpiY E{(bf16_t*)(F.ws + WS_YT), (bf16_t*)(F.ws + WS_YTC), ML};
            if (PH(5)) pg8::gemm_phase(F.lds, g, S, E); } }
        GSYNC(); }
        REP(7) {
        if (F.vcu < 128 || (l == 0 && F.vcu < 136)) {
            const bool cx = F.vcu >= 128; const int ld = cx ? 512 : 4096;
            long zo = 0; asm volatile("" : "+s"(zo)); const bf16_t* dftp = (const bf16_t*)F.P.out + zo;
            pg8::Gemm g{dftp + (cx ? DO_DFTC : DO_DFT), (const bf16_t*)(F.ws + (cx ? WS_YTC : WS_YT)), ld, ld, ld, 0};
            pg8::OneUnit S; S.u.pm = cx ? 0 : (F.vcu & 15); S.u.pn = cx ? (F.vcu - 128) : (F.vcu >> 4); S.u.kob = 0; S.has = true;
            EpiF E{CAT, cx ? 1 : 0}; if (PH(6)) pg8::gemm_phase(F.lds, g, S, E); }
        if (PH(7)) mixer_attention(F, l, l + 2 * rep_);
        GSYNC(); }
        REP(8) {
        { pg8::Gemm g{CAT, (const bf16_t*)(F.ws + WS_WOUT) + (size_t)l * D * D, D, D, D, 0};
          pg8::Sched S; S.init(Mq / 256, 8, F.G, F.vcu, 0);
          EpiRes E{F.inp(0), F.inp(2), xbl, X, modl + 4096};
          if (PH(8)) pg8::gemm_phase(F.lds, g, S, E); }
        GSYNC(); }
        REP(4) {
        if (PH(1)) norm_phase(F, nullptr, nullptr, X, Mq, F.inp(7) + l * D, modl, 6144, 8192, H, nullptr);
        GSYNC(); }
        REP(10) {
        { pg8::Gemm g{Hbuf, (const bf16_t*)(F.ws + WS_WUP) + (size_t)l * 2 * DFF * D, D, D, D, 1};
          pg8::Sched S; S.init((Mq + 251) / 252, 44, F.G, F.vcu, 0);
          EpiConv E{(bf16_t*)(F.ws + WS_ACT), F.inp(17) + (size_t)l * 3 * 2 * DFF, F.inp(18) + (size_t)l * 2 * DFF, Mq};
          if (PH(10)) pg8::gemm_phase(F.lds, g, S, E); }
        GSYNC(); }
        { pg8::Gemm g{(const bf16_t*)(F.ws + WS_ACT), (const bf16_t*)(F.ws + WS_WDN) + (size_t)l * D * DFF, DFF, DFF, DFF, 0};
          pg8::Sched S; S.init(Mq / 256, 8, F.G, F.vcu, 0);
          EpiRes E{nullptr, nullptr, X, X, modl + 10240};
          if (PH(9)) pg8::gemm_phase(F.lds, g, S, E); }
        GSYNC();

}

__global__ void __launch_bounds__(NT) fwd_megakernel(Params p) {
    extern __shared__ __attribute__((aligned(16))) unsigned char lds_raw[];
    cg::grid_group grid = cg::this_grid();
    const int tid_ = threadIdx.x, G_ = gridDim.x, bx_ = blockIdx.x;
    Frame F{(LAS unsigned char*)lds_raw, lds_raw, tid_, tid_ & 63, __builtin_amdgcn_readfirstlane(tid_ >> 6), G_, (G_ % 8 == 0) ? (bx_ % 8) * (G_ / 8) + bx_ / 8 : bx_, p, p.ws};
    volatile LAS unsigned* xst = (volatile LAS unsigned*)(F.lds + 135 * 1024);
    if (F.tid == 0) { xst[0] = 0u; xst[1] = 0u; }
    __syncthreads();
    (void)xcd_barrier_post((unsigned*)(p.ws + WS_BAR), xst);
    REP(0) { if (PH(0)) { if (F.vcu & 1) { p_tables(F); p_mod(F); } else { p_mod(F); p_tables(F); }
    p_convert(F); }
    grid.sync(); F.refresh(); }

    for (int l = 0; l < 2; ++l) layer_body(F, l);
    if (PH(1)) norm_phase(F, nullptr, nullptr, X, ML, F.inp(20), nullptr, 0, 0, nullptr, F.outp());
}
#undef Hbuf
#undef H
#undef X
#undef U
#undef SSQ
#undef CAT
#undef mod
#undef rope
#undef modl
#undef xbl


extern "C" void kernel_launch(void* const* d_in, const int* in_sizes, int n_in, void* d_out, int out_size, void* d_ws, size_t ws_size, hipStream_t stream) {
    static int grid_blocks = 0;
    if (!grid_blocks) {
        int dev = 0, cus = 0, per_cu = 0;
        hipGetDevice(&dev);
        hipDeviceGetAttribute(&cus, hipDeviceAttributeMultiprocessorCount, dev);
        hipFuncSetAttribute((const void*)fwd_megakernel, hipFuncAttributeMaxDynamicSharedMemorySize, LDS_BYTES);
        hipOccupancyMaxActiveBlocksPerMultiprocessor(&per_cu, (const void*)fwd_megakernel, NT, LDS_BYTES);
        if (per_cu < 1) { fprintf(stderr, "occupancy query says %d blocks/CU\n", per_cu); per_cu = 1; }
        grid_blocks = cus;
        if (ws_size < WS_END) fprintf(stderr, "workspace too small: %zu < %zu\n", ws_size, (size_t)WS_END);
    }
    Params p{};
    for (int i = 0; i < 21; ++i) p.in[i] = (const float*)d_in[i];
    p.out = (float*)d_out; p.ws = (unsigned char*)d_ws;
    hipMemsetAsync((unsigned char*)d_ws + WS_BAR, 0, 16384, stream);
    void* args[] = {&p};
    hipError_t e = hipLaunchCooperativeKernel((const void*)fwd_megakernel, dim3(grid_blocks), dim3(NT), args, LDS_BYTES, stream);
    if (e != hipSuccess) fprintf(stderr, "cooperative launch failed: %s (grid %d)\n", hipGetErrorString(e), grid_blocks);
}
```

```cpp
#include <hip/hip_runtime.h>
#include <hip/hip_cooperative_groups.h>
#include <cstdio>
namespace cg = cooperative_groups;

#define LAS __attribute__((address_space(3)))
#define GAS __attribute__((address_space(1)))
template <class T> __device__ __forceinline__ T* as_global(T* p) { return p; }
#define DI __device__ __forceinline__
typedef unsigned short bf16_t;
typedef short bf16x8 __attribute__((ext_vector_type(8)));
typedef short s16x4 __attribute__((ext_vector_type(4)));
typedef float f32x4 __attribute__((ext_vector_type(4)));
typedef float f32x2 __attribute__((ext_vector_type(2)));
typedef float f32x16 __attribute__((ext_vector_type(16)));
typedef unsigned u32x4 __attribute__((ext_vector_type(4)));
typedef unsigned u32x2 __attribute__((ext_vector_type(2)));
typedef __bf16 bfv2 __attribute__((ext_vector_type(2)));

constexpr int D = 2048, NB = 4, SEQ = 4096, CTXL = 256, ML = NB * SEQ, MC = NB * CTXL, MT = ML + MC;
constexpr int INC = 3136, UC = 3328;
constexpr int U_CQ = 0, U_CKV = 512, U_QN = 1024, U_KN = 1536, U_VN = 2048, U_F = 2560, U_KR = 3072;
constexpr int DFF = 5632, KEYS = SEQ + CTXL;
constexpr size_t DO_DFT = 0, DO_DFTC = (size_t)4096 * 4096, DO_FF = DO_DFTC + 256 * 512;
static_assert((DO_FF + (size_t)(ML + MC) * 1024) * 2 <= (size_t)ML * 2048 * 4, "d_out scratch");
constexpr float EPS = 1e-6f, LOG2E = 1.4426950408889634f;
constexpr int NT = 512;
constexpr int LDS_BYTES = 136 * 1024;

constexpr size_t al(size_t x) { return (x + 255) & ~(size_t)255; }
constexpr size_t WS_WIN = 0;
constexpr size_t WS_WUQ = WS_WIN + al((size_t)2 * UC * D * 2);
constexpr size_t WS_WUKV = WS_WUQ + al((size_t)2 * 1536 * 512 * 2);
constexpr size_t WS_WOUT = WS_WUKV + al((size_t)2 * 4096 * 512 * 2);
constexpr size_t WS_WUP = WS_WOUT + al((size_t)2 * D * D * 2);
constexpr size_t WS_WDN = WS_WUP + al((size_t)2 * 2 * DFF * D * 2);
constexpr size_t WS_WC = WS_WDN + al((size_t)2 * D * DFF * 2);
constexpr size_t WS_DFTC = WS_WC + al((size_t)2 * 1024 * 1024 * 2);
constexpr size_t WS_TRIG = WS_DFTC + al((size_t)256 * 512 * 2);
constexpr size_t WS_ROPE = WS_TRIG + al(4096 * 8);
constexpr size_t WS_MOD = WS_ROPE + al(64 * 16 * 8);
constexpr size_t WS_CTR = WS_MOD + al((size_t)2 * 5 * 12288 * 4);
constexpr size_t WS_BAR = WS_CTR + 256;
constexpr size_t WS_X = WS_BAR + 16384;
constexpr size_t WS_H = WS_X + al((size_t)MT * D * 4);
constexpr size_t H_ROWS = 1 + MT + 256;
constexpr size_t WS_CAT = WS_H + al(H_ROWS * D * 2);
constexpr size_t WS_YTC = WS_CAT + al((size_t)MT * D * 2);
constexpr size_t WS_U = WS_YTC + al((size_t)2048 * 512 * 2);
constexpr size_t WS_SSQ = WS_U + al((size_t)MT * UC * 2);
constexpr size_t WS_Q = WS_SSQ + al((size_t)MT * 16 * 4);
constexpr size_t WS_KN = WS_Q + al((size_t)MT * 1536 * 2);
constexpr size_t WS_VT = WS_KN + al((size_t)MT * 1024 * 2);
constexpr size_t WS_VNT = WS_VT + al((size_t)32 * 128 * KEYS * 2);
constexpr size_t WS_YT = WS_VNT + al((size_t)16 * 128 * KEYS * 2);
constexpr size_t WS_END = WS_YT + al((size_t)2048 * 8192 * 2);
constexpr size_t WS_ACT = WS_U;
static_assert(WS_ACT + (size_t)MT * DFF * 2 <= WS_END, "ACT alias");
static_assert((size_t)4096 * 8192 * 2 <= H_ROWS * D * 2, "DFT alias");
static_assert(WS_END <= (size_t)805306368, "workspace");

struct Params { const float* in[21]; float* out; unsigned char* ws; };

DI unsigned pk2(float a, float b) { f32x2 v = {a, b}; bfv2 r = __builtin_convertvector(v, bfv2); return __builtin_bit_cast(unsigned, r); }
DI bf16_t f2bf(float a) { return (bf16_t)(pk2(a, 0.f) & 0xffffu); }
DI float shx(float v, int m, int lane) { return __builtin_bit_cast(float, __builtin_amdgcn_ds_bpermute((lane ^ m) << 2, __builtin_bit_cast(int, v))); }
DI f32x4 bf4(u32x2 w) { f32x4 r; r[0] = __builtin_bit_cast(float, w.x << 16); r[1] = __builtin_bit_cast(float, w.x & 0xffff0000u); r[2] = __builtin_bit_cast(float, w.y << 16); r[3] = __builtin_bit_cast(float, w.y & 0xffff0000u); return r; }
DI float sq4(f32x4 v) { return (v[0] * v[0] + v[1] * v[1]) + (v[2] * v[2] + v[3] * v[3]); }
DI u32x4 pk8(f32x4 a, f32x4 b) { u32x4 w; w.x = pk2(a[0], a[1]); w.y = pk2(a[2], a[3]); w.z = pk2(b[0], b[1]); w.w = pk2(b[2], b[3]); return w; }

namespace pg8 {
constexpr int BM = 256, BK = 64, HALF = 128, HTB = HALF * BK * 2, STAGE_BYTES = 8 * HTB;
DI int lds_byte(int r, int c) { const int st = (r >> 4) * 2 + (c >> 5), rr = r & 15, cc = c & 31, ob = rr * 64 + cc * 2; return st * 1024 + (ob ^ (((ob >> 9) & 1) << 5)); }
DI void stage_rc(int b, int& R, int& C) { const int st = b / 1024, sb = b % 1024, swz = sb ^ (((sb >> 9) & 1) << 5); R = (st >> 1) * 16 + swz / 64; C = (st & 1) * 32 + (swz % 64) / 2; }
DI int perm32(int rho) { const int n = rho >> 4, i = rho & 15; return 8 * (i >> 2) + 4 * n + (i & 3); }
struct Unit { int pm, pn, kob; };
struct Gemm { const bf16_t* A; const bf16_t* Bt; int lda, ldb, K; int conv; };

struct Sched {
    int nM, nN, cnt, G, c, i0, start, kobm = 0;
    DI void init(int nM_, int nN_, int G_, int c_, int start_) { nM = nM_; nN = nN_; cnt = nM * nN; G = G_; c = c_; start = start_;
        i0 = (start_ > c_) ? (start_ - c_ + G_ - 1) / G_ : 0; }
    DI bool next(int i, Unit& u) const {
        const long L = (long)(i0 + i) * G + c - start; if (L >= cnt) return false;
        const int w = (int)L, nig = 8 * nN, gid = w / nig, fm = gid * 8, gsz = (nM - fm) < 8 ? (nM - fm) : 8;
        u.pm = fm + ((w % nig) % gsz); u.pn = (w % nig) / gsz; u.kob = kobm * u.pm; return true;
    }
};
struct OneUnit { Unit u; bool has; DI bool next(int i, Unit& o) const { o = u; return has && i == 0; } };

template <class Epi, class SchedT>
DI void gemm_phase(LAS unsigned char* lds, const Gemm g, const SchedT& S, const Epi& E) {
    int tid = threadIdx.x; asm volatile("" : "+v"(tid));
    const int wid = __builtin_amdgcn_readfirstlane(tid >> 6), lane = tid & 63, wr = wid >> 2, wc = wid & 3, fr = lane & 15, fq = lane >> 4;
    const int K = g.K, nt = K / BK;
    unsigned voffA[2], voffB[2];
    auto mk_voff = [&]() { int t2 = threadIdx.x; asm volatile("" : "+v"(t2));
#pragma unroll
        for (int i = 0; i < 2; ++i) { int R, C; stage_rc(t2 * 16 + i * 8192, R, C); const int Rb = Epi::PERM ? ((R & ~31) + perm32(R & 31)) : R;
            const int Ra = g.conv ? ((R >> 6) * 126 + (R & 63)) : R;
            voffA[i] = (unsigned)(Ra * g.lda + C) * 2u; voffB[i] = (unsigned)(Rb * g.ldb + C) * 2u; } };
    mk_voff();
    const size_t kstep = (size_t)(BK * 2);
    const size_t hstepA = (size_t)(g.conv ? 64 : HALF) * g.lda * 2, hstepB = (size_t)HALF * g.ldb * 2;
    const size_t tstepA = g.conv ? (size_t)252 * g.lda * 2 : 2 * hstepA, tstepB = 2 * hstepB;
    const unsigned ldsw = (unsigned)wid * 1024u;
    const int aoff = lds_byte(wr * 64 + fr, fq * 8), boff = lds_byte(wc * 32 + fr, fq * 8);
#define PG8_SA(b, h) (((b) * 2 + (h)) * HTB)
#define PG8_SB(b, h) ((4 + (b) * 2 + (h)) * HTB)
#define PG8_STAGE(bufoff, gbase, voff) do { _Pragma("unroll") for (int _i = 0; _i < 2; ++_i) \
        __builtin_amdgcn_global_load_lds((const unsigned*)((const char*)(gbase) + (voff)[_i]), (LAS unsigned*)(lds + (bufoff) + ldsw + _i * 8192), 16, 0, 0); } while (0)
#define PG8_LDA(dst, b, h) do { _Pragma("unroll") for (int m = 0; m < 4; ++m) _Pragma("unroll") for (int k = 0; k < 2; ++k) dst[m][k] = *(const LAS bf16x8*)(lds + PG8_SA(b, h) + aoff + m * 2048 + k * 1024); } while (0)
#define PG8_LDB(dst, b, h) do { _Pragma("unroll") for (int n = 0; n < 2; ++n) _Pragma("unroll") for (int k = 0; k < 2; ++k) dst[n][k] = *(const LAS bf16x8*)(lds + PG8_SB(b, h) + boff + n * 2048 + k * 1024); } while (0)
#define PG8_MMA(ai, bj, At, Bt) do { __builtin_amdgcn_s_setprio(1); _Pragma("unroll") for (int m = 0; m < 4; ++m) _Pragma("unroll") for (int n = 0; n < 2; ++n) _Pragma("unroll") for (int k = 0; k < 2; ++k) \
        acc[ai][bj][m][n] = __builtin_amdgcn_mfma_f32_16x16x32_bf16(Bt[n][k], At[m][k], acc[ai][bj][m][n], 0, 0, 0); __builtin_amdgcn_s_setprio(0); } while (0)
#define PG8_WAIT_V(n) asm volatile("s_waitcnt vmcnt(" #n ")" ::: "memory")
#define PG8_WAIT_L(n) asm volatile("s_waitcnt lgkmcnt(" #n ")" ::: "memory")
#define PG8_BAR __builtin_amdgcn_s_barrier()
#define PG8_SCHED __builtin_amdgcn_sched_barrier(0)
    Unit cur, nxt; int ui = 0;
    if (!S.next(0, cur)) return;
    f32x4 acc[2][2][4][2];
#pragma unroll
    for (int a = 0; a < 2; ++a)
#pragma unroll
        for (int b = 0; b < 2; ++b)
#pragma unroll
            for (int m = 0; m < 4; ++m)
#pragma unroll
                for (int n = 0; n < 2; ++n) acc[a][b][m][n] = (f32x4){0.f, 0.f, 0.f, 0.f};
    bf16x8 At[4][2], B0[2][2], B1[2][2];
    const char* cA = (const char*)g.A + (size_t)cur.pm * tstepA; const char* cB = (const char*)g.Bt + (size_t)cur.pn * tstepB + (size_t)cur.kob * 2;
    PG8_STAGE(PG8_SB(0, 0), cB, voffB); PG8_STAGE(PG8_SA(0, 0), cA, voffA); PG8_STAGE(PG8_SB(0, 1), cB + hstepB, voffB); PG8_STAGE(PG8_SA(0, 1), cA + hstepA, voffA);
    if (wr == 1) PG8_BAR;
    PG8_WAIT_V(4); PG8_BAR;
    PG8_STAGE(PG8_SB(1, 0), cB + kstep, voffB); PG8_STAGE(PG8_SA(1, 0), cA + kstep, voffA); PG8_STAGE(PG8_SB(1, 1), cB + hstepB + kstep, voffB);
    PG8_WAIT_V(6); PG8_BAR;
    for (;;) {
        const bool has_next = S.next(ui + 1, nxt);
        const char* nA = has_next ? (const char*)g.A + (size_t)nxt.pm * tstepA : cA; const char* nB = has_next ? (const char*)g.Bt + (size_t)nxt.pn * tstepB + (size_t)nxt.kob * 2 : cB;
        for (int t = 0; t < nt; t += 2) {
            const bool last = (t == nt - 2);
            const char* a1 = cA + (size_t)(t + 1) * kstep;
            const char* a2 = last ? nA : cA + (size_t)(t + 2) * kstep; const char* b2 = last ? nB : cB + (size_t)(t + 2) * kstep;
            const char* a3 = a2 + kstep; const char* b3 = b2 + kstep;
            PG8_LDB(B0, 0, 0); PG8_SCHED; PG8_LDA(At, 0, 0); PG8_STAGE(PG8_SA(1, 1), a1 + hstepA, voffA);
            PG8_WAIT_L(8); PG8_BAR; PG8_WAIT_L(0); PG8_MMA(0, 0, At, B0); PG8_BAR; PG8_SCHED;
            PG8_LDB(B1, 0, 1); PG8_STAGE(PG8_SB(0, 0), b2, voffB);
            PG8_BAR; PG8_WAIT_L(0); PG8_MMA(0, 1, At, B1); PG8_BAR;
            PG8_LDA(At, 0, 1); PG8_STAGE(PG8_SA(0, 0), a2, voffA);
            PG8_BAR; PG8_WAIT_L(0); PG8_MMA(1, 0, At, B0); PG8_BAR; PG8_SCHED;
            PG8_STAGE(PG8_SB(0, 1), b2 + hstepB, voffB);
            PG8_WAIT_V(6); PG8_BAR; PG8_MMA(1, 1, At, B1); PG8_BAR;
            PG8_LDB(B0, 1, 0); PG8_SCHED; PG8_LDA(At, 1, 0); PG8_STAGE(PG8_SA(0, 1), a2 + hstepA, voffA);
            PG8_WAIT_L(8); PG8_BAR; PG8_WAIT_L(0); PG8_MMA(0, 0, At, B0); PG8_BAR; PG8_SCHED;
            PG8_LDB(B1, 1, 1); PG8_STAGE(PG8_SB(1, 0), b3, voffB);
            PG8_BAR; PG8_WAIT_L(0); PG8_MMA(0, 1, At, B1); PG8_BAR;
            PG8_LDA(At, 1, 1); PG8_STAGE(PG8_SA(1, 0), a3, voffA);
            PG8_BAR; PG8_WAIT_L(0); PG8_MMA(1, 0, At, B0); PG8_BAR; PG8_SCHED;
            PG8_STAGE(PG8_SB(1, 1), b3 + hstepB, voffB);
            PG8_WAIT_V(6); PG8_BAR; PG8_MMA(1, 1, At, B1); PG8_BAR;
        }
        { int fr2 = fr, fq2 = fq, wr2 = wr, wc2 = wc; asm volatile("" : "+v"(fr2), "+v"(fq2), "+s"(wr2), "+s"(wc2));
          E(acc, cur, wr2, wc2, fr2, fq2); }
        if (has_next) mk_voff();
        if (!has_next) break;
#pragma unroll
        for (int a = 0; a < 2; ++a)
#pragma unroll
            for (int b = 0; b < 2; ++b)
#pragma unroll
                for (int m = 0; m < 4; ++m)
#pragma unroll
                    for (int n = 0; n < 2; ++n) acc[a][b][m][n] = (f32x4){0.f, 0.f, 0.f, 0.f};
        cur = nxt; cA = nA; cB = nB; ++ui;
    }
    PG8_WAIT_V(0);
    if (wr == 0) PG8_BAR;
    PG8_BAR;
#undef PG8_SA
#undef PG8_SB
#undef PG8_STAGE
#undef PG8_LDA
#undef PG8_LDB
#undef PG8_MMA
#undef PG8_WAIT_V
#undef PG8_WAIT_L
#undef PG8_BAR
#undef PG8_SCHED
}
}
using pg8::Unit;
typedef const f32x4 (&AccRef)[2][2][4][2];

DI void row_bk(int row, int& b, int& key) { if (row < ML) { b = row >> 12; key = row & 4095; } else { const int rc = row - ML; b = rc >> 8; key = SEQ + (rc & 255); } }
DI void rope8(f32x4& v0, f32x4& v1, int row, int axis, int fq, int lane, const f32x2* rope) {
    const int l = row & 4095, pos = axis ? (l & 63) : (l >> 6);
    const f32x2* t = rope + pos * 16 + 8 * (fq & 1);
    const float sgn = (fq < 2) ? -1.f : 1.f;
#pragma unroll
    for (int j = 0; j < 4; ++j) {
        const float p0 = shx(v0[j], 32, lane), p1 = shx(v1[j], 32, lane);
        const f32x2 c0 = t[j], c1 = t[4 + j];
        v0[j] = v0[j] * c0.x + sgn * p0 * c0.y; v1[j] = v1[j] * c1.x + sgn * p1 * c1.y;
    }
}

struct EpiU {
    static constexpr bool PERM = true;
    bf16_t* U; float* ssq; bf16_t* VnT; const f32x2* rope; float qscale; bf16_t* FF;
    DI void operator()(AccRef acc, const Unit& u, int wr, int wc, int fr, int fq) const {
        const int pn = u.pn, rowb = u.pm * 256 + wr * 64 + fr;
        if (pn == 10 || pn == 11) {
#pragma unroll
            for (int ai = 0; ai < 2; ++ai)
#pragma unroll
                for (int m = 0; m < 4; ++m) { const int row = rowb + ai * 128 + m * 16; const int mrow = row < ML ? ((row & ~4095) | ((4096 - (row & 4095)) & 4095)) : row;
#pragma unroll
                    for (int bj = 0; bj < 2; ++bj) { const int c = 256 * (2 * (pn - 10) + bj) + 32 * wc + 8 * fq; const u32x4 w = pk8(acc[ai][bj][m][0], acc[ai][bj][m][1]);
                        *(u32x4*)(FF + (size_t)row * 1024 + c) = w;
                        *(u32x4*)(FF + (size_t)mrow * 1024 + 128 + c) = (row < ML) ? w : (u32x4){0u, 0u, 0u, 0u}; } }
            return;
        }
        if (pn == 8 || pn == 9) {
#pragma unroll
            for (int ai = 0; ai < 2; ++ai)
#pragma unroll
                for (int m = 0; m < 4; ++m) { int b, key; row_bk(rowb + ai * 128 + m * 16, b, key);
#pragma unroll
                    for (int bj = 0; bj < 2; ++bj) { const int hn = 2 * (pn - 8) + bj;
#pragma unroll
                        for (int n = 0; n < 2; ++n) { bf16_t* dst = VnT + ((size_t)((b * 4 + hn) * 128 + 32 * wc + 8 * fq + 4 * n)) * KEYS + key;
#pragma unroll
                            for (int j = 0; j < 4; ++j) dst[(size_t)j * KEYS] = f2bf(acc[ai][bj][m][n][j]); } } }
            return;
        }
        const float sc = (pn == 4 || pn == 5) ? qscale : 1.f;
#pragma unroll
        for (int ai = 0; ai < 2; ++ai)
#pragma unroll
            for (int m = 0; m < 4; ++m) { const int row = rowb + ai * 128 + m * 16; float ss = 0.f;
#pragma unroll
                for (int bj = 0; bj < 2; ++bj) { f32x4 v0 = acc[ai][bj][m][0] * sc, v1 = acc[ai][bj][m][1] * sc;
                    if (pn == 12 && bj == 0 && wc < 2 && row < ML) rope8(v0, v1, row, wc & 1, fq, fq * 16 + fr, rope);
                    ss += sq4(v0) + sq4(v1);
                    *(u32x4*)(U + (size_t)row * UC + 256 * pn + 128 * bj + 32 * wc + 8 * fq) = pk8(v0, v1); }
                if (pn < 4) { ss += shx(ss, 16, fq * 16 + fr); ss += shx(ss, 32, fq * 16 + fr); if (fq == 0) ssq[(size_t)row * 16 + pn * 4 + wc] = ss; } }
    }
};
DI float row_rstd(const float* ssq, int row, int which) { const f32x4 a = *(const f32x4*)(ssq + (size_t)row * 16 + which * 8), b = *(const f32x4*)(ssq + (size_t)row * 16 + which * 8 + 4);
    const float s = ((a[0] + a[1]) + (a[2] + a[3])) + ((b[0] + b[1]) + (b[2] + b[3])); return __builtin_amdgcn_rsqf(s * (1.f / 512.f) + EPS); }
struct EpiQ {
    static constexpr bool PERM = true;
    bf16_t* Q; const float* ssq; const f32x2* rope; float scale;
    DI void operator()(AccRef acc, const Unit& u, int wr, int wc, int fr, int fq) const {
        const int rowb = u.pm * 256 + wr * 64 + fr;
#pragma unroll
        for (int ai = 0; ai < 2; ++ai)
#pragma unroll
            for (int m = 0; m < 4; ++m) { const int row = rowb + ai * 128 + m * 16; const float rs = row_rstd(ssq, row, 0) * scale;
#pragma unroll
                for (int bj = 0; bj < 2; ++bj) { const int c32 = 256 * u.pn + 128 * bj + 32 * wc; f32x4 v0 = acc[ai][bj][m][0] * rs, v1 = acc[ai][bj][m][1] * rs;
                    if (((c32 >> 6) % 3) == 2 && row < ML) rope8(v0, v1, row, (c32 >> 5) & 1, fq, fq * 16 + fr, rope);
                    *(u32x4*)(Q + (size_t)row * 1536 + c32 + 8 * fq) = pk8(v0, v1); } }
    }
};
struct EpiKV {
    static constexpr bool PERM = true;
    bf16_t* KN; bf16_t* VT; const float* ssq;
    DI void operator()(AccRef acc, const Unit& u, int wr, int wc, int fr, int fq) const {
        const int pn = u.pn, rowb = u.pm * 256 + wr * 64 + fr;
#pragma unroll
        for (int ai = 0; ai < 2; ++ai)
#pragma unroll
            for (int m = 0; m < 4; ++m) { const int row = rowb + ai * 128 + m * 16; const float rs = row_rstd(ssq, row, 1); int b, key; row_bk(row, b, key);
#pragma unroll
                for (int bj = 0; bj < 2; ++bj) {
                    if (pn < 4) { *(u32x4*)(KN + (size_t)row * 1024 + 256 * pn + 128 * bj + 32 * wc + 8 * fq) = pk8(acc[ai][bj][m][0] * rs, acc[ai][bj][m][1] * rs); }
                    else { const int h = 2 * (pn - 4) + bj;
#pragma unroll
                        for (int n = 0; n < 2; ++n) { bf16_t* dst = VT + ((size_t)((b * 8 + h) * 128 + 32 * wc + 8 * fq + 4 * n)) * KEYS + key;
#pragma unroll
                            for (int j = 0; j < 4; ++j) dst[(size_t)j * KEYS] = f2bf(acc[ai][bj][m][n][j] * rs); } } } }
    }
};
struct EpiY {
    static constexpr bool PERM = true;
    bf16_t* YT; bf16_t* YTc; int tok_base;
    DI void operator()(AccRef acc, const Unit& u, int wr, int wc, int fr, int fq) const {
        const int g = u.pm;
#pragma unroll
        for (int ai = 0; ai < 2; ++ai)
#pragma unroll
            for (int m = 0; m < 4; ++m) { const int d = 64 * wr + 16 * m + fr;
#pragma unroll
                for (int bj = 0; bj < 2; ++bj) { const int tok = tok_base + 256 * u.pn + 128 * bj + 32 * wc + 8 * fq; const u32x4 w = pk8(acc[ai][bj][m][0], acc[ai][bj][m][1]);
                    if (tok < ML) { const int b = tok >> 12, l = tok & 4095; bf16_t* rowp = YT + ((size_t)((b * 4 + g) * 128 + d)) * 4096;
                        if (l < 2048) {
                            if (ai == 0) *(u32x4*)(rowp + l) = w;
                            else if (l != 0) *(u32x4*)(rowp + 2048 + l) = w;
                            else { bf16_t* q = rowp + 2048; q[1] = (bf16_t)(w.x >> 16); q[2] = (bf16_t)w.y; q[3] = (bf16_t)(w.y >> 16); q[4] = (bf16_t)w.z; q[5] = (bf16_t)(w.z >> 16); q[6] = (bf16_t)w.w; q[7] = (bf16_t)(w.w >> 16); }
                        } else if (l == 2048 && ai == 0) rowp[2048] = (bf16_t)w.x;
                    } else { const int tc = tok - ML, b = tc >> 8, l = tc & 255; *(u32x4*)(YTc + ((size_t)((b * 4 + g) * 128 + d)) * 512 + ai * 256 + l) = w; } } }
    }
};
struct SchedY {
    int G, c, i0, start;
    DI void init(int G_, int c_, int start_) { G = G_; c = c_; start = start_; i0 = (start_ > c_) ? (start_ - c_ + G_ - 1) / G_ : 0; }
    DI bool next(int i, Unit& u) const { const int L = (i0 + i) * G + c - start; if (L >= 144) return false; const int bt = L >> 2; u.pm = L & 3; u.pn = (bt / 9) * 16 + (bt % 9); u.kob = 256 * u.pm; return true; }
};
struct EpiF {
    static constexpr bool PERM = true;
    bf16_t* CAT; int ctx;
    DI void operator()(AccRef acc, const Unit& u, int wr, int wc, int fr, int fq) const {
        const int b = u.pn >> 1;
#pragma unroll
        for (int ai = 0; ai < 2; ++ai)
#pragma unroll
            for (int m = 0; m < 4; ++m) { const int lp = u.pm * 256 + 128 * ai + 64 * wr + 16 * m + fr; const int row = ctx ? (ML + b * 256 + lp) : (b * 4096 + lp);
#pragma unroll
                for (int bj = 0; bj < 2; ++bj) { const int g = 2 * (u.pn & 1) + bj;
                    *(u32x4*)(CAT + (size_t)row * D + 1536 + g * 128 + 32 * wc + 8 * fq) = pk8(acc[ai][bj][m][0], acc[ai][bj][m][1]); } }
    }
};
struct EpiRes {
    static constexpr bool PERM = false;
    const float* xl; const float* xc; const bf16_t* xb; bf16_t* out; const float* gate;
    DI void operator()(AccRef acc, const Unit& u, int wr, int wc, int fr, int fq) const {
        const int row0 = u.pm * 256; const int midx = row0 < ML ? (row0 >> 12) : 4;
        const float* src = row0 < ML ? xl : (xc - (size_t)ML * D);
        const float* gp = gate + (size_t)midx * 12288;
        const int col0 = u.pn * 256 + wc * 32 + 4 * fq;
        f32x4 gv[2][2];
#pragma unroll
        for (int bj = 0; bj < 2; ++bj)
#pragma unroll
            for (int n = 0; n < 2; ++n) gv[bj][n] = *(const f32x4*)(gp + col0 + bj * 128 + n * 16);
        if (xb) {
#pragma unroll
            for (int ai = 0; ai < 2; ++ai)
#pragma unroll
                for (int m = 0; m < 4; ++m) { const size_t off = (size_t)(row0 + wr * 64 + fr + ai * 128 + m * 16) * D + col0;
#pragma unroll
                    for (int bj = 0; bj < 2; ++bj)
#pragma unroll
                        for (int n = 0; n < 2; ++n) { const size_t o2 = off + bj * 128 + n * 16;
                            const f32x4 r = bf4(*(const u32x2*)(xb + o2)) + gv[bj][n] * acc[ai][bj][m][n];
                            u32x2 w; w.x = pk2(r[0], r[1]); w.y = pk2(r[2], r[3]); *(u32x2*)(out + o2) = w; }
                    asm volatile("" ::: "memory"); }
        } else {
#pragma unroll
            for (int ai = 0; ai < 2; ++ai)
#pragma unroll
                for (int m = 0; m < 4; ++m) { const size_t off = (size_t)(row0 + wr * 64 + fr + ai * 128 + m * 16) * D + col0;
#pragma unroll
                    for (int bj = 0; bj < 2; ++bj)
#pragma unroll
                        for (int n = 0; n < 2; ++n) { const size_t o2 = off + bj * 128 + n * 16;
                            const f32x4 r = *(const f32x4*)(src + o2) + gv[bj][n] * acc[ai][bj][m][n];
                            u32x2 w; w.x = pk2(r[0], r[1]); w.y = pk2(r[2], r[3]); *(u32x2*)(out + o2) = w; }
                    asm volatile("" ::: "memory"); }
        }
    }
};
DI float dpp_ror1(float v) { return __builtin_bit_cast(float, __builtin_amdgcn_update_dpp(0, __builtin_bit_cast(int, v), 0x121, 0xf, 0xf, false)); }
DI float dpp_ror15(float v) { return __builtin_bit_cast(float, __builtin_amdgcn_update_dpp(0, __builtin_bit_cast(int, v), 0x12f, 0xf, 0xf, false)); }
struct EpiConv {
    static constexpr bool PERM = true;
    bf16_t* ACT; const float* cw; const float* cb; int Mq;
    DI void operator()(AccRef acc, const Unit& u, int wr, int wc, int fr, int fq) const {
#pragma unroll
        for (int n = 0; n < 2; ++n) {
            const int cg_ = 128 * u.pn + 32 * wc + 8 * fq + 4 * n;
#pragma unroll
            for (int ai = 0; ai < 2; ++ai) {
                const int tok0 = 252 * u.pm - 1 + 126 * wr + 64 * ai;
                f32x4 o[4];
#pragma unroll
                for (int bj = 0; bj < 2; ++bj) {
                    f32x4 w[2][4];
#pragma unroll
                    for (int t = 0; t < 3; ++t) w[bj][t] = *(const f32x4*)(cw + (size_t)t * 2 * DFF + bj * DFF + cg_);
                    w[bj][3] = *(const f32x4*)(cb + bj * DFF + cg_);
#pragma unroll
                    for (int m = 0; m < 4; ++m) {
                        const int tok = tok0 + 16 * m + fr; const int msk = tok < ML ? 4095 : 255;
                        const bool hu = (tok & msk) != 0, hd = ((tok + 1) & msk) != 0;
                        f32x4 r = acc[ai][bj][m][n] * w[bj][1] + w[bj][3];
                        f32x4 w0m, w2m;
#pragma unroll
                        for (int j = 0; j < 4; ++j) { w0m[j] = hu ? w[bj][0][j] : 0.f; w2m[j] = hd ? w[bj][2][j] : 0.f; }
#pragma unroll
                        for (int j = 0; j < 4; ++j) {
                            const float su = ((m > 0 || ai == 1) && fr == 15) ? (m > 0 ? acc[ai][bj][(m + 3) & 3][n][j] : acc[0][bj][3][n][j]) : acc[ai][bj][m][n][j];
                            const float sd = ((m < 3 || ai == 0) && fr == 0) ? (m < 3 ? acc[ai][bj][(m + 1) & 3][n][j] : acc[1][bj][0][n][j]) : acc[ai][bj][m][n][j];
                            float rj = r[j];
                            asm("s_nop 1\n\tv_fmac_f32_dpp %0, %1, %2 row_ror:1 row_mask:0xf bank_mask:0xf" : "+v"(rj) : "v"(su), "v"(w0m[j]));
                            asm("s_nop 1\n\tv_fmac_f32_dpp %0, %1, %2 row_ror:15 row_mask:0xf bank_mask:0xf" : "+v"(rj) : "v"(sd), "v"(w2m[j]));
                            r[j] = rj; }
                        if (bj == 0) {
#pragma unroll
                            for (int j = 0; j < 4; ++j) o[m][j] = r[j] * __builtin_amdgcn_rcpf(1.f + __builtin_amdgcn_exp2f(-LOG2E * r[j]));
                        } else o[m] = o[m] * r;
                    }
                }
#pragma unroll
                for (int m = 0; m < 4; ++m) { const int li = 64 * ai + 16 * m + fr, tok = tok0 + 16 * m + fr;
                    if (li >= 1 && li <= 126 && tok < Mq) { u32x2 v; v.x = pk2(o[m][0], o[m][1]); v.y = pk2(o[m][2], o[m][3]);
                        *(u32x2*)(ACT + (size_t)tok * DFF + cg_) = v; } }
            }
        }
    }
};

struct Frame {
    LAS unsigned char* lds; unsigned char* ldsg; int tid, lane, wave, G, vcu;
    const Params& P; unsigned char* ws;
    DI const float* inp(int i) const { return as_global(P.in[i]); }
    DI float* outp() const { return as_global(P.out); }
    DI int nrep(int d) const { int n = 1 + d; asm volatile("" : "+s"(n)); return n; }
    DI void refresh() { int t = threadIdx.x; asm volatile("" : "+v"(t)); tid = t; lane = t & 63; wave = __builtin_amdgcn_readfirstlane(t >> 6);
        long z = 0; asm volatile("" : "+s"(z)); ws = P.ws + z;
        int g = gridDim.x, bx = blockIdx.x; asm volatile("" : "+s"(g), "+s"(bx)); G = g; vcu = (g % 8 == 0) ? (bx % 8) * (g / 8) + bx / 8 : bx; }
};

DI void p_mod(const Frame& F) {
    LAS float* sv = (LAS float*)F.lds; LAS float* red = sv + 5 * 2048;
    const float* c = F.inp(1); const float* cc = F.inp(3);
    for (int i = F.tid; i < 5 * 2048; i += NT) { const int r = i >> 11, k = i & 2047; const float v = r < 4 ? c[r * 2048 + k] : cc[k]; sv[i] = v / (1.f + __expf(-v)); }
    __syncthreads();
    float* mod = (float*)(F.ws + WS_MOD);
    for (int tile = F.vcu; tile < 768; tile += F.G) {
        const int l = tile / 384, colb = (tile % 384) * 32, cl = F.tid & 31, kg = F.tid >> 5;
        const float* w = F.inp(4) + (size_t)l * 2048 * 12288 + colb + cl;
        float a0 = 0.f, a1 = 0.f, a2 = 0.f, a3 = 0.f, a4 = 0.f;
#pragma unroll 32
        for (int k = kg * 128; k < kg * 128 + 128; ++k) { const float wv = __builtin_nontemporal_load(w + (size_t)k * 12288); a0 += sv[k] * wv; a1 += sv[2048 + k] * wv; a2 += sv[4096 + k] * wv; a3 += sv[6144 + k] * wv; a4 += sv[8192 + k] * wv; }
        LAS float* rp = red + (kg * 32 + cl) * 5; rp[0] = a0; rp[1] = a1; rp[2] = a2; rp[3] = a3; rp[4] = a4;
        __syncthreads();
        if (F.tid < 160) { const int r = F.tid >> 5; float s = 0.f;
#pragma unroll
            for (int q = 0; q < 16; ++q) s += red[(q * 32 + cl) * 5 + r];
            mod[(size_t)(l * 5 + r) * 12288 + colb + cl] = s + F.inp(5)[l * 12288 + colb + cl]; }
        __syncthreads();
    }
}
DI void p_tables(const Frame& F) {
    const int gt = F.vcu * NT + F.tid, gn = F.G * NT;
    LAS f32x2* t4096 = (LAS f32x2*)F.lds;
    __syncthreads();
    for (int i = F.tid; i < 4096; i += NT) { f32x2 v; v.x = cospif((float)i / 2048.f); v.y = sinpif((float)i / 2048.f); t4096[i] = v; }
    __syncthreads();
    f32x2* rope = (f32x2*)(F.ws + WS_ROPE);
    for (int i = gt; i < 1024; i += gn) { const int pos = i >> 4, k = i & 15; const float fr = powf(10000.f, -(float)k / 16.f); const float a = (float)pos * fr; f32x2 v; v.x = cosf(a); v.y = sinf(a); rope[i] = v; }
    if (gt < 32) ((unsigned*)(F.ws + WS_CTR))[gt] = 0u;
    if (F.tid == 0) *(float**)(F.ws + WS_CTR + 128) = F.outp();
    bf16_t* dc = (bf16_t*)F.outp() + DO_DFTC;
    for (int i = gt; i < 256 * 512; i += gn) { const int lp = i >> 9, cc = i & 511, part = cc >> 8, l = cc & 255; const f32x2 t = t4096[((lp * l) & 255) * 16];
        dc[i] = f2bf((part ? -t.y : t.x) * (1.f / 16.f)); }
    bf16_t* wc = (bf16_t*)(F.ws + WS_WC); const float* wf = F.inp(14);
    for (int i = gt; i < 2 * 4 * 2 * 128 * 128; i += gn) {
        const int d = i & 127, cch = (i >> 7) & 127, part = (i >> 14) & 1, g = (i >> 15) & 3, l = i >> 17;
        const float* wp = wf + ((size_t)(l * 4 + g) * 128) * 128 + d; float sacc = 0.f;
        for (int c2 = 0; c2 < 128; ++c2) { const f32x2 t = t4096[((cch * c2) & 127) * 32]; sacc += (part ? t.y : t.x) * wp[(size_t)c2 * 128]; }
        sacc *= 0.08838834764831845f;
        bf16_t* row = wc + ((size_t)l * 1024 + (g * 2 + part) * 128 + d) * 256;
        row[cch] = f2bf(sacc); row[128 + cch] = f2bf(part ? -sacc : sacc);
    }
    bf16_t* dft = (bf16_t*)F.outp() + DO_DFT;
    for (int ch = gt; ch < 4096 * 512; ch += gn) { const int lp = ch >> 9, k0 = (ch & 511) * 8; f32x4 a, b;
#pragma unroll
        for (int j = 0; j < 8; ++j) { const int k = k0 + j; const f32x2 t = t4096[(lp * (k & 2047) + (k == 2048 ? lp * 2048 : 0)) & 4095];
            const float v = (k <= 2048 ? t.x : -t.y) * ((k == 0 || k == 2048) ? (1.f / 128.f) : (1.f / 64.f));
            if (j < 4) a[j] = v; else b[j - 4] = v; }
        *(u32x4*)(dft + (size_t)lp * 4096 + k0) = pk8(a, b); }
    __syncthreads();
}
struct CvDesc { const float* src; const float* kscale; bf16_t* dst; int K, Nsrc, Ndst, mapid, ntiles; };
DI int cv_map(int mapid, int n) {
    if (mapid == 1) return n < 1024 ? n : (n < 3072 ? n + 64 : (n < 3136 ? n - 2048 : -1));
    if (mapid == 2) { const int which = n >> 10, h = (n >> 7) & 7, j = n & 127; return h * 256 + which * 128 + j; }
    if (mapid == 3) { const int pn = n >> 8, bj = (n >> 7) & 1, q = n & 127; return bj * DFF + pn * 128 + q; }
    return n;
}
DI CvDesc cv_desc(const Frame& F, int m) {
    const int l = m / 6, j = m % 6; CvDesc d; d.kscale = nullptr; d.mapid = 0;
    if (j == 0) { d.src = F.inp(8) + (size_t)l * D * INC; d.K = D; d.Nsrc = INC; d.dst = (bf16_t*)(F.ws + WS_WIN) + (size_t)l * UC * D; d.Ndst = UC; d.mapid = 1; }
    else if (j == 1) { d.src = F.inp(10) + (size_t)l * 512 * 1536; d.K = 512; d.Nsrc = 1536; d.dst = (bf16_t*)(F.ws + WS_WUQ) + (size_t)l * 1536 * 512; d.Ndst = 1536; d.kscale = F.inp(9) + l * 512; }
    else if (j == 2) { d.src = F.inp(12) + (size_t)l * 512 * 2048; d.K = 512; d.Nsrc = 2048; d.dst = (bf16_t*)(F.ws + WS_WUKV) + (size_t)l * 2048 * 512; d.Ndst = 2048; d.kscale = F.inp(11) + l * 512; d.mapid = 2; }
    else if (j == 3) { d.src = F.inp(15) + (size_t)l * D * D; d.K = D; d.Nsrc = D; d.dst = (bf16_t*)(F.ws + WS_WOUT) + (size_t)l * D * D; d.Ndst = D; }
    else if (j == 4) { d.src = F.inp(16) + (size_t)l * D * 2 * DFF; d.K = D; d.Nsrc = 2 * DFF; d.dst = (bf16_t*)(F.ws + WS_WUP) + (size_t)l * 2 * DFF * D; d.Ndst = 2 * DFF; d.mapid = 3; }
    else { d.src = F.inp(19) + (size_t)l * DFF * D; d.K = DFF; d.Nsrc = D; d.dst = (bf16_t*)(F.ws + WS_WDN) + (size_t)l * D * DFF; d.Ndst = D; }
    d.ntiles = (d.Ndst / 128) * (d.K / 64); return d;
}
struct CvTile { const float* src; const float* kscale; bf16_t* dst; int K, Nsrc, sc0, sc1, n0, k0; bool ok; };
DI CvTile cv_tile(const Frame& F, int t) {
    CvTile r; r.ok = false;
    constexpr int NTN[6] = {26, 12, 16, 16, 88, 16}, NT_[6] = {26 * 32, 12 * 8, 16 * 8, 16 * 32, 88 * 32, 16 * 88};
    constexpr int PER_LAYER = NT_[0] + NT_[1] + NT_[2] + NT_[3] + NT_[4] + NT_[5];
    if (t >= 2 * PER_LAYER) return r;
    const int l = t >= PER_LAYER ? 1 : 0; t -= l * PER_LAYER;
    int j = 0, nt = 0, kt = 0;
#pragma unroll
    for (int q = 0; q < 6; ++q) { if (t >= 0 && t < NT_[q]) { j = q; nt = t % NTN[q]; kt = t / NTN[q]; } t -= NT_[q]; }
    const CvDesc d = cv_desc(F, l * 6 + j);
    r.n0 = nt * 128; r.k0 = kt * 64; r.src = d.src; r.kscale = d.kscale; r.dst = d.dst; r.K = d.K; r.Nsrc = d.Nsrc;
    r.sc0 = cv_map(d.mapid, r.n0); r.sc1 = cv_map(d.mapid, r.n0 + 64); r.ok = true; return r;
}
DI void cv_load(const Frame& F, const CvTile& t, f32x4 (&r)[4]) {
#pragma unroll
    for (int h = 0; h < 2; ++h) { const int sc = h ? t.sc1 : t.sc0;
#pragma unroll
        for (int p = 0; p < 2; ++p) { const int kk = p * 32 + (F.tid >> 4);
            f32x4 v = {0.f, 0.f, 0.f, 0.f};
            if (sc >= 0) { v = __builtin_nontemporal_load((const f32x4*)(t.src + (size_t)(t.k0 + kk) * t.Nsrc + sc + (F.tid & 15) * 4)); if (t.kscale) v *= t.kscale[t.k0 + kk]; }
            r[h * 2 + p] = v; } }
}
DI void p_convert(const Frame& F) {
    LAS float* ts = (LAS float*)F.lds;
    int t = F.vcu; CvTile cur = cv_tile(F, t), nx1 = cv_tile(F, t + F.G); f32x4 r0[4], r1[4]; int buf = 0;
    if (cur.ok) cv_load(F, cur, r0);
    if (nx1.ok) cv_load(F, nx1, r1);
    while (cur.ok) {
        LAS float* tb = ts + buf * (2 * 64 * 65);
#pragma unroll
        for (int h = 0; h < 2; ++h)
#pragma unroll
            for (int p = 0; p < 2; ++p) { const int kk = p * 32 + (F.tid >> 4); LAS float* q = tb + h * (64 * 65) + kk * 65 + (F.tid & 15) * 4;
                q[0] = r0[h * 2 + p][0]; q[1] = r0[h * 2 + p][1]; q[2] = r0[h * 2 + p][2]; q[3] = r0[h * 2 + p][3]; }
        __syncthreads();
#pragma unroll
        for (int i = 0; i < 4; ++i) r0[i] = r1[i];
        const CvTile nx2 = cv_tile(F, t + 2 * F.G);
        if (nx2.ok) cv_load(F, nx2, r1);
#pragma unroll
        for (int h = 0; h < 2; ++h) { const int n = F.tid >> 3, kc = F.tid & 7; const LAS float* q = tb + h * (64 * 65) + n; f32x4 a, b;
#pragma unroll
            for (int j = 0; j < 4; ++j) { a[j] = q[(kc * 8 + j) * 65]; b[j] = q[(kc * 8 + 4 + j) * 65]; }
            *(u32x4*)(cur.dst + (size_t)(cur.n0 + h * 64 + n) * cur.K + cur.k0 + kc * 8) = pk8(a, b); }
        buf ^= 1; t += F.G; cur = nx1; nx1 = nx2;
    }
    __syncthreads();
}

DI void norm_phase(const Frame& F, const float* xl, const float* xc, const bf16_t* xb, int M, const float* g, const float* modl, int sh_off, int sc_off, bf16_t* H, float* outf) {
    const int gw = F.vcu * 8 + F.wave, nw = F.G * 8;
    const int row_lo = (int)(((long)gw * M) / nw), row_hi = (int)(((long)(gw + 1) * M) / nw);
    f32x4 gs[8], shv[8]; int cur = -1;
    for (int row = row_lo; row < row_hi; ++row) {
        const int midx = row < ML ? (row >> 12) : 4;
        if (midx != cur) { cur = midx;
#pragma unroll
            for (int i = 0; i < 4; ++i) { const int col = i * 512 + F.lane * 8;
                gs[2 * i] = *(const f32x4*)(g + col); gs[2 * i + 1] = *(const f32x4*)(g + col + 4);
                if (!outf) { const float* mp = modl + (size_t)midx * 12288 + col;
                    gs[2 * i] = gs[2 * i] * (1.f + *(const f32x4*)(mp + sc_off)); gs[2 * i + 1] = gs[2 * i + 1] * (1.f + *(const f32x4*)(mp + sc_off + 4));
                    shv[2 * i] = *(const f32x4*)(mp + sh_off); shv[2 * i + 1] = *(const f32x4*)(mp + sh_off + 4); } } }
        f32x4 v[8]; float ss = 0.f;
        if (xb) {
#pragma unroll
            for (int i = 0; i < 4; ++i) { const u32x4 w = *(const u32x4*)(xb + (size_t)row * D + i * 512 + F.lane * 8); v[2 * i] = bf4((u32x2){w.x, w.y}); v[2 * i + 1] = bf4((u32x2){w.z, w.w}); ss += sq4(v[2 * i]) + sq4(v[2 * i + 1]); }
        } else { const float* xr = row < ML ? xl + (size_t)row * D : xc + (size_t)(row - ML) * D;
#pragma unroll
            for (int i = 0; i < 4; ++i) { v[2 * i] = *(const f32x4*)(xr + i * 512 + F.lane * 8); v[2 * i + 1] = *(const f32x4*)(xr + i * 512 + F.lane * 8 + 4); ss += sq4(v[2 * i]) + sq4(v[2 * i + 1]); } }
#pragma unroll
        for (int o = 32; o >= 1; o >>= 1) ss += shx(ss, o, F.lane);
        const float rs = __builtin_amdgcn_rsqf(ss * (1.f / 2048.f) + EPS);
#pragma unroll
        for (int i = 0; i < 4; ++i) { const int col = i * 512 + F.lane * 8;
            if (outf) { *(f32x4*)(outf + (size_t)row * D + col) = v[2 * i] * rs * gs[2 * i]; *(f32x4*)(outf + (size_t)row * D + col + 4) = v[2 * i + 1] * rs * gs[2 * i + 1]; }
            else *(u32x4*)(H + (size_t)row * D + col) = pk8(v[2 * i] * rs * gs[2 * i] + shv[2 * i], v[2 * i + 1] * rs * gs[2 * i + 1] + shv[2 * i + 1]); }
    }
}

struct AttnItem {
    const bf16_t* q; const bf16_t* kn; const bf16_t* kr; const bf16_t* vt; bf16_t* o;
    int ldq, ldk, ldo, lat_row0, ctx_row0, t0, ntl, nctx, mode, r0, hn;
};
template <int DQ>
DI void attn_item(const Frame& F, const AttnItem& it, const LAS float* rpb_lds) {
    constexpr int KP = DQ + 8, VP = 72, KS = DQ / 16;
    constexpr int KBYTES = 64 * KP * 2, VBYTES = 128 * VP * 2;
    LAS unsigned char* base = F.lds;
    int tid = threadIdx.x; asm volatile("" : "+v"(tid));
    const int lane = tid & 63, w = __builtin_amdgcn_readfirstlane(tid >> 6), qq = lane & 31, hh = lane >> 5;
    const bool grpB = w >= 4;
    const int ntile = it.ntl + it.nctx;
    u32x4 rk[2], rr, rv[2];
    auto gload = [&](int ti) {
        int rowb, vcol;
        if (ti < it.ntl) { const int kt = it.t0 + ti; rowb = it.lat_row0 + kt * 64; vcol = kt * 64; } else { const int j = ti - it.ntl; rowb = it.ctx_row0 + j * 64; vcol = SEQ + j * 64; }
#pragma unroll
        for (int i = 0; i < 2; ++i) { const int id = tid + i * NT; rk[i] = *(const u32x4*)(it.kn + (size_t)(rowb + (id >> 4)) * it.ldk + (id & 15) * 8);
            rv[i] = *(const u32x4*)(it.vt + (size_t)(id >> 3) * KEYS + vcol + (id & 7) * 8); }
        if (DQ == 192) rr = *(const u32x4*)(it.kr + (size_t)(rowb + (tid >> 3)) * UC + (tid & 7) * 8);
    };
    auto lstore = [&](int ti) {
        LAS unsigned char* kb = base + (ti & 1) * KBYTES; LAS unsigned char* vb = base + 2 * KBYTES + (ti % 3) * VBYTES;
#pragma unroll
        for (int i = 0; i < 2; ++i) { const int id = tid + i * NT; *(LAS u32x4*)(kb + ((id >> 4) * KP + (id & 15) * 8) * 2) = rk[i];
            *(LAS u32x4*)(vb + ((id >> 3) * VP + (id & 7) * 8) * 2) = rv[i]; }
        if (DQ == 192) *(LAS u32x4*)(kb + ((tid >> 3) * KP + 128 + (tid & 7) * 8) * 2) = rr;
    };
    bf16x8 qf[KS];
    { const bf16_t* qp = it.q + (size_t)(32 * w + qq) * it.ldq + 8 * hh;
#pragma unroll
        for (int ks = 0; ks < KS; ++ks) qf[ks] = *(const bf16x8*)(qp + 16 * ks); }
    f32x16 o[4];
#pragma unroll
    for (int db = 0; db < 4; ++db)
#pragma unroll
        for (int i = 0; i < 16; ++i) o[db][i] = 0.f;
    f32x16 s[2];
    float mrun = -INFINITY, lrun = 0.f;
    const int r = it.r0 + (w >> 1), wq = 32 * (w & 1) + qq;
    const int rs = min(max(r - 4, 0), 56), cs = min(max(wq - 8, 0), 48);
    auto active = [&](int ti) { const int krow = it.t0 + ti; return !(it.mode == 1 && ti < it.ntl && (krow < rs || krow > rs + 7)); };
    auto qk = [&](int ti) {
        if (!active(ti)) return;
        const int krow_l = (qq & 3) + 4 * ((qq >> 3) & 1) + 8 * ((qq >> 2) & 1) + 16 * (qq >> 4);
        LAS unsigned char* kb = base + (ti & 1) * KBYTES + (krow_l * KP + 8 * hh) * 2;
#pragma unroll
        for (int blk = 0; blk < 2; ++blk)
#pragma unroll
            for (int i = 0; i < 16; ++i) s[blk][i] = 0.f;
        bf16x8 kf[3][2];
#pragma unroll
        for (int p = 0; p < 2; ++p)
#pragma unroll
            for (int blk = 0; blk < 2; ++blk) kf[p][blk] = *(const LAS bf16x8*)(kb + (32 * blk * KP + 16 * p) * 2);
#pragma unroll
        for (int ks = 0; ks < KS; ++ks) {
            if (ks + 2 < KS) {
#pragma unroll
                for (int blk = 0; blk < 2; ++blk) kf[(ks + 2) % 3][blk] = *(const LAS bf16x8*)(kb + (32 * blk * KP + 16 * (ks + 2)) * 2); }
            __builtin_amdgcn_sched_barrier(0);
#pragma unroll
            for (int blk = 0; blk < 2; ++blk) s[blk] = __builtin_amdgcn_mfma_f32_32x32x16_bf16(kf[ks % 3][blk], qf[ks], s[blk], 0, 0, 0);
            __builtin_amdgcn_sched_barrier(0);
        }
    };
    auto smpv = [&](int ti) {
        if (!active(ti)) return;
        LAS unsigned char* vb = base + 2 * KBYTES + (ti % 3) * VBYTES;
        if (it.mode == 1 && ti < it.ntl) {
            const int krow = it.t0 + ti;
            const LAS float* bp = rpb_lds + it.hn * 465 + (krow - r + 7) * 31 - wq + 15;
#pragma unroll
            for (int blk = 0; blk < 2; ++blk)
#pragma unroll
                for (int i = 0; i < 16; ++i) { const int kc = 32 * blk + (i & 3) + 4 * ((i >> 2) & 1) + 8 * hh + 16 * (i >> 3); const bool ok = kc >= cs && kc < cs + 16;
                    const int kcc = ok ? kc : cs; s[blk][i] = ok ? s[blk][i] + bp[kcc] : -INFINITY; }
        }
        float mx = s[0][0];
#pragma unroll
        for (int blk = 0; blk < 2; ++blk)
#pragma unroll
            for (int i = 0; i < 16; ++i) mx = fmaxf(mx, s[blk][i]);
        mx = fmaxf(mx, shx(mx, 32, lane));
        const float mnew = fmaxf(mrun, mx), alpha = __builtin_amdgcn_exp2f(mrun - mnew);
        mrun = mnew;
        float ps = 0.f;
#pragma unroll
        for (int blk = 0; blk < 2; ++blk)
#pragma unroll
            for (int i = 0; i < 16; ++i) { const float p = __builtin_amdgcn_exp2f(s[blk][i] - mnew); s[blk][i] = p; ps += p; }
        lrun = lrun * alpha + ps;
        if (__builtin_amdgcn_ballot_w64(alpha != 1.f) != 0ull) {
#pragma unroll
            for (int db = 0; db < 4; ++db)
#pragma unroll
                for (int i = 0; i < 16; ++i) o[db][i] *= alpha;
        }
        LAS unsigned char* vq = vb + (qq * VP + 8 * hh) * 2;
        auto vload = [&](int step, int db) { return *(const LAS bf16x8*)(vq + (32 * db * VP + 16 * step) * 2); };
        bf16x8 vf[2][4];
#pragma unroll
        for (int db = 0; db < 4; ++db) vf[0][db] = vload(0, db);
#pragma unroll
        for (int st = 0; st < 4; ++st) {
            if (st + 1 < 4) {
#pragma unroll
                for (int db = 0; db < 4; ++db) vf[(st + 1) & 1][db] = vload(st + 1, db); }
            __builtin_amdgcn_sched_barrier(0);
            const int blk = st >> 1, s2 = st & 1;
            u32x4 pw; pw.x = pk2(s[blk][8 * s2], s[blk][8 * s2 + 1]); pw.y = pk2(s[blk][8 * s2 + 2], s[blk][8 * s2 + 3]);
            pw.z = pk2(s[blk][8 * s2 + 4], s[blk][8 * s2 + 5]); pw.w = pk2(s[blk][8 * s2 + 6], s[blk][8 * s2 + 7]);
            const bf16x8 pf = __builtin_bit_cast(bf16x8, pw);
#pragma unroll
            for (int db = 0; db < 4; ++db) o[db] = __builtin_amdgcn_mfma_f32_32x32x16_bf16(vf[st & 1][db], pf, o[db], 0, 0, 0);
            __builtin_amdgcn_sched_barrier(0);
        }
    };

    __syncthreads();
    gload(0); lstore(0);
    if (ntile > 1) gload(1);
    __syncthreads();
    for (int ti = 0; ti < ntile; ++ti) {
        qk(ti);
        if (grpB) { if (ti + 1 < ntile) lstore(ti + 1); if (ti + 2 < ntile) gload(ti + 2); __syncthreads(); }
        smpv(ti);
        if (!grpB) { if (ti + 1 < ntile) lstore(ti + 1); if (ti + 2 < ntile) gload(ti + 2); __syncthreads(); }
    }
    const float lt = lrun + shx(lrun, 32, lane), inv = 1.f / lt;
    bf16_t* op = it.o + (size_t)(32 * w + qq) * it.ldo + 4 * hh;
#pragma unroll
    for (int db = 0; db < 4; ++db)
#pragma unroll
        for (int ig = 0; ig < 4; ++ig) { u32x2 v; v.x = pk2(o[db][4 * ig] * inv, o[db][4 * ig + 1] * inv); v.y = pk2(o[db][4 * ig + 2] * inv, o[db][4 * ig + 3] * inv);
            *(u32x2*)(op + 32 * db + 8 * ig) = v; }
}

#ifndef MLAREP
#define MLAREP 1
#endif
DI void mixer_attention(const Frame& F, int layer, int cidx) {
    const int nitems = (layer == 0 ? 816 : 768) + 512 * (MLAREP - 1);
    bf16_t* U = (bf16_t*)(F.ws + WS_U); bf16_t* Q = (bf16_t*)(F.ws + WS_Q); bf16_t* KN = (bf16_t*)(F.ws + WS_KN);
    bf16_t* VT = (bf16_t*)(F.ws + WS_VT); bf16_t* VNT = (bf16_t*)(F.ws + WS_VNT); bf16_t* CAT = (bf16_t*)(F.ws + WS_CAT);
    unsigned* ctr = (unsigned*)(F.ws + WS_CTR) + cidx;
    LAS float* rpb = (LAS float*)(F.lds + 112 * 1024);
    volatile LAS int* slot = (volatile LAS int*)(F.lds + 112 * 1024 + 8192);
    __syncthreads();
    for (int i = F.tid; i < 4 * 465; i += NT) rpb[i] = F.inp(13)[layer * 4 * 465 + i] * LOG2E;
    for (int step = 0;; ++step) {
        int idx;
        if (step < 2) idx = F.vcu + 256 * step;
        else {
            __syncthreads();
            if (F.tid == 0) *slot = (int)atomicAdd(ctr, 1u);
            __syncthreads();
            idx = 512 + *slot;
        }
        if (idx >= nitems) break;
        AttnItem it; it.kr = nullptr; it.mode = 0; it.r0 = 0; it.hn = 0; it.nctx = 4;
        if (idx < 512 || (idx >= 768 && idx < 800)) {
            int b, h, row0;
            if (idx < 512) { b = idx >> 7; h = (idx >> 4) & 7; row0 = b * 4096 + (idx & 15) * 256; it.t0 = 0; it.ntl = 64; }
            else { const int j = idx - 768; b = j >> 3; h = j & 7; row0 = ML + b * 256; it.t0 = 0; it.ntl = 0; }
            it.q = Q + (size_t)row0 * 1536 + h * 192; it.ldq = 1536;
            it.kn = KN + h * 128; it.ldk = 1024; it.kr = U + U_KR;
            it.vt = VT + (size_t)(b * 8 + h) * 128 * KEYS;
            it.o = CAT + (size_t)row0 * D + h * 128; it.ldo = D;
            it.lat_row0 = b * 4096; it.ctx_row0 = ML + b * 256;
            attn_item<192>(F, it, rpb);
        } else {
            int b, hn, row0;
            if (idx < 768) { const int j = idx - 512; b = j >> 6; hn = (j >> 4) & 3; const int R = j & 15; row0 = b * 4096 + R * 256;
                const int rlo = max(4 * R - 4, 0), rhi = min(max(4 * R - 1, 0), 56) + 7; it.t0 = rlo; it.ntl = rhi - rlo + 1; it.mode = 1; it.r0 = 4 * R; it.hn = hn; }
            else { const int j = idx - 800; b = j >> 2; hn = j & 3; row0 = ML + b * 256; it.t0 = 0; it.ntl = 0; }
            it.q = U + (size_t)row0 * UC + U_QN + hn * 128; it.ldq = UC;
            it.kn = U + U_KN + hn * 128; it.ldk = UC;
            it.vt = VNT + (size_t)(b * 4 + hn) * 128 * KEYS;
            it.o = CAT + (size_t)row0 * D + 1024 + hn * 128; it.ldo = D;
            it.lat_row0 = b * 4096; it.ctx_row0 = ML + b * 256;
            attn_item<128>(F, it, rpb);
        }
    }
}


#define XB_TMO      128
#define XB_XCNT(j)  (256  + 64 * (j))
#define XB_XSUB(j)  (1280 + 64 * (j))
#define XB_XGEN(j)  (2304 + 64 * (j))
#define XB_TOP      3328
#define XB_TOPGEN   3392
#define XCD_BAR_WORDS 3456
#define XB_SPIN_CAP (1u << 18)
__device__ __forceinline__ unsigned xb_ld(unsigned* p)              { return __hip_atomic_load(p, __ATOMIC_RELAXED, __HIP_MEMORY_SCOPE_AGENT); }
__device__ __forceinline__ unsigned xb_add(unsigned* p, unsigned v) { return __hip_atomic_fetch_add(p, v, __ATOMIC_RELAXED, __HIP_MEMORY_SCOPE_AGENT); }
__device__ __forceinline__ unsigned xb_xcc_id() { return (unsigned)__builtin_amdgcn_s_getreg((3 << 11) | 20) & 0xFu; }
#define XB_SPIN(cond, bar) do { unsigned _sp = 0; while (cond) { __builtin_amdgcn_s_sleep(1); \
    if ((++_sp & 255u) == 0u) { if (xb_ld(&(bar)[XB_TMO])) break; if (_sp > XB_SPIN_CAP) { atomicAdd(&(bar)[XB_TMO], 1u); break; } } } } while (0)
struct XcdBarrier { unsigned* bar; unsigned x; volatile LAS unsigned* st; };
__device__ __forceinline__ XcdBarrier xcd_barrier_post(unsigned* bar, volatile LAS unsigned* st) {
    XcdBarrier b; b.bar = bar; b.x = xb_xcc_id(); b.st = st;
    if (threadIdx.x == 0) (void)xb_add(&bar[XB_XCNT(b.x)], 1u);
    return b;
}
__device__ __forceinline__ void xcd_barrier_complete(unsigned* bar, unsigned x, unsigned& nloc, unsigned& nx) {
    const unsigned G = gridDim.x * gridDim.y * gridDim.z;
    unsigned sum, cnt, mine, sp = 0u;
    for (;;) {
        sum = 0u; cnt = 0u; mine = 0u;
#pragma unroll
        for (unsigned j = 0; j < 16; ++j) { const unsigned c = xb_ld(&bar[XB_XCNT(j)]); sum += c; cnt += (c > 0u) ? 1u : 0u; mine = (j == x) ? c : mine; }
        if (sum == G) break;
        __builtin_amdgcn_s_sleep(1);
        if ((++sp & 255u) == 0u) { if (xb_ld(&bar[XB_TMO])) break; if (sp > XB_SPIN_CAP) { atomicAdd(&bar[XB_TMO], 1u); break; } }
    }
    nloc = mine > 0u ? mine : 1u; nx = cnt > 0u ? cnt : 1u;
}
__device__ __forceinline__ void xcd_barrier(const XcdBarrier& b) {
    asm volatile("s_waitcnt vmcnt(0)" ::: "memory");
    __syncthreads();
    if (threadIdx.x == 0) {
        unsigned* bar = b.bar;
        __builtin_amdgcn_s_waitcnt(0);
        unsigned nloc = b.st[0], nx = b.st[1];
        if (nloc == 0u) { xcd_barrier_complete(bar, b.x, nloc, nx); b.st[0] = nloc; b.st[1] = nx; }
        const unsigned old = xb_add(&bar[XB_XSUB(b.x)], 1u);
        const unsigned gen = old / nloc;
        if (old + 1u == (gen + 1u) * nloc) {
            __builtin_amdgcn_fence(__ATOMIC_RELEASE, "agent");
            asm volatile("s_waitcnt vmcnt(0)" ::: "memory");
            const unsigned og = xb_add(&bar[XB_TOP], 1u);
            const unsigned tg = og / nx;
            if (og + 1u == (tg + 1u) * nx) xb_add(&bar[XB_TOPGEN], 1u);
            else XB_SPIN(xb_ld(&bar[XB_TOPGEN]) == tg, bar);
            __builtin_amdgcn_fence(__ATOMIC_ACQUIRE, "agent");
            xb_add(&bar[XB_XGEN(b.x)], 1u);
            asm volatile("s_waitcnt vmcnt(0)" ::: "memory");
        } else {
            XB_SPIN(xb_ld(&bar[XB_XGEN(b.x)]) == gen, bar);
            __builtin_amdgcn_fence(__ATOMIC_ACQUIRE, "agent");
            asm volatile("s_waitcnt vmcnt(0)" ::: "memory");
        }
    }
    __syncthreads();
}

#ifndef PHMASK
#define PHMASK 0x7ff
#endif
#define PH(k) (((PHMASK) >> (k)) & 1)
#ifndef DUPMASK
#define DUPMASK 0x000
#endif
#define REP(k) for (int rep_ = 0, nrep_ = F.nrep((DUPMASK >> (k)) & 1); rep_ < nrep_; ++rep_)
#define Hbuf ((bf16_t*)(F.ws + WS_H))
#define H (Hbuf + D)
#define X ((bf16_t*)(F.ws + WS_X))
#define U ((bf16_t*)(F.ws + WS_U))
#define SSQ ((float*)(F.ws + WS_SSQ))
#define CAT ((bf16_t*)(F.ws + WS_CAT))
#define mod ((const float*)(F.ws + WS_MOD))
#define rope ((const f32x2*)(F.ws + WS_ROPE))
#define GSYNC() do { F.refresh(); { XcdBarrier xb_{(unsigned*)(F.ws + WS_BAR), xb_xcc_id(), (volatile LAS unsigned*)(F.lds + 135 * 1024)}; xcd_barrier(xb_); } F.refresh(); } while (0)
DI void layer_body(Frame& F, const int l) {
        const int Mq = l == 0 ? MT : ML;
#define modl (mod + (size_t)l * 5 * 12288)
#define xbl (l == 0 ? (const bf16_t*)nullptr : (const bf16_t*)X)
        REP(1) {
        if (PH(1)) norm_phase(F, F.inp(0), F.inp(2), xbl, MT, F.inp(6) + l * D, modl, 0, 2048, H, nullptr);
        GSYNC(); }
        REP(2) {
        { pg8::Gemm g{H, (const bf16_t*)(F.ws + WS_WIN) + (size_t)l * UC * D, D, D, D, 0};
          pg8::Sched S; S.init(MT / 256, UC / 256, F.G, F.vcu, 0);
          EpiU E{U, SSQ, (bf16_t*)(F.ws + WS_VNT), rope, 0.08838834764831845f * LOG2E, (bf16_t*)F.outp() + DO_FF};
          if (PH(2)) pg8::gemm_phase(F.lds, g, S, E); }
        GSYNC(); }
        REP(3) {
        { int start = 0;
          { pg8::Gemm g{U + U_CQ, (const bf16_t*)(F.ws + WS_WUQ) + (size_t)l * 1536 * 512, UC, 512, 512, 0};
            pg8::Sched S; S.init(Mq / 256, 6, F.G, F.vcu, start); start += (Mq / 256) * 6;
            EpiQ E{(bf16_t*)(F.ws + WS_Q), SSQ, rope, 0.07216878364870323f * LOG2E};
            if (PH(3)) pg8::gemm_phase(F.lds, g, S, E); }
          { pg8::Gemm g{U + U_CKV, (const bf16_t*)(F.ws + WS_WUKV) + (size_t)l * 2048 * 512, UC, 512, 512, 0};
            pg8::Sched S; S.init(MT / 256, 8, F.G, F.vcu, start); start += (MT / 256) * 8;
            EpiKV E{(bf16_t*)(F.ws + WS_KN), (bf16_t*)(F.ws + WS_VT), SSQ};
            if (PH(4)) pg8::gemm_phase(F.lds, g, S, E); }
          { pg8::Gemm g{(const bf16_t*)(F.ws + WS_WC) + (size_t)l * 1024 * 256, (const bf16_t*)F.outp() + DO_FF, 256, 1024, 256, 0};
            SchedY S; S.init(F.G, F.vcu, start); start += 144;
            EpiY E{(bf16_t*)(F.ws + WS_YT), (bf16_t*)(F.ws + WS_YTC), 0};
            if (PH(5)) pg8::gemm_phase(F.lds, g, S, E); }
          if (l == 0) { pg8::Gemm g{(const bf16_t*)(F.ws + WS_WC) + (size_t)l * 1024 * 256, (const bf16_t*)F.outp() + DO_FF + (size_t)ML * 1024, 256, 1024, 256, 0};
            pg8::Sched S; S.init(4, MC / 256, F.G, F.vcu, start); S.kobm = 256;
            EpiY E{(bf16_t*)(F.ws + WS_YT), (bf16_t*)(F.ws + WS_YTC), ML};
            if (PH(5)) pg8::gemm_phase(F.lds, g, S, E); } }
        GSYNC(); }
        REP(7) {
        if (F.vcu < 128 || (l == 0 && F.vcu < 136)) {
            const bool cx = F.vcu >= 128; const int ld = cx ? 512 : 4096;
            long zo = 0; asm volatile("" : "+s"(zo)); const bf16_t* dftp = (const bf16_t*)F.P.out + zo;
            pg8::Gemm g{dftp + (cx ? DO_DFTC : DO_DFT), (const bf16_t*)(F.ws + (cx ? WS_YTC : WS_YT)), ld, ld, ld, 0};
            pg8::OneUnit S; S.u.pm = cx ? 0 : (F.vcu & 15); S.u.pn = cx ? (F.vcu - 128) : (F.vcu >> 4); S.u.kob = 0; S.has = true;
            EpiF E{CAT, cx ? 1 : 0}; if (PH(6)) pg8::gemm_phase(F.lds, g, S, E); }
        if (PH(7)) mixer_attention(F, l, l + 2 * rep_);
        GSYNC(); }
        REP(8) {
        { pg8::Gemm g{CAT, (const bf16_t*)(F.ws + WS_WOUT) + (size_t)l * D * D, D, D, D, 0};
          pg8::Sched S; S.init(Mq / 256, 8, F.G, F.vcu, 0);
          EpiRes E{F.inp(0), F.inp(2), xbl, X, modl + 4096};
          if (PH(8)) pg8::gemm_phase(F.lds, g, S, E); }
        GSYNC(); }
        REP(4) {
        if (PH(1)) norm_phase(F, nullptr, nullptr, X, Mq, F.inp(7) + l * D, modl, 6144, 8192, H, nullptr);
        GSYNC(); }
        REP(10) {
        { pg8::Gemm g{Hbuf, (const bf16_t*)(F.ws + WS_WUP) + (size_t)l * 2 * DFF * D, D, D, D, 1};
          pg8::Sched S; S.init((Mq + 251) / 252, 44, F.G, F.vcu, 0);
          EpiConv E{(bf16_t*)(F.ws + WS_ACT), F.inp(17) + (size_t)l * 3 * 2 * DFF, F.inp(18) + (size_t)l * 2 * DFF, Mq};
          if (PH(10)) pg8::gemm_phase(F.lds, g, S, E); }
        GSYNC(); }
        { pg8::Gemm g{(const bf16_t*)(F.ws + WS_ACT), (const bf16_t*)(F.ws + WS_WDN) + (size_t)l * D * DFF, DFF, DFF, DFF, 0};
          pg8::Sched S; S.init(Mq / 256, 8, F.G, F.vcu, 0);
          EpiRes E{nullptr, nullptr, X, X, modl + 10240};
          if (PH(9)) pg8::gemm_phase(F.lds, g, S, E); }
        GSYNC();

}

__global__ void __launch_bounds__(NT) fwd_megakernel(Params p) {
    extern __shared__ __attribute__((aligned(16))) unsigned char lds_raw[];
    cg::grid_group grid = cg::this_grid();
    const int tid_ = threadIdx.x, G_ = gridDim.x, bx_ = blockIdx.x;
    Frame F{(LAS unsigned char*)lds_raw, lds_raw, tid_, tid_ & 63, __builtin_amdgcn_readfirstlane(tid_ >> 6), G_, (G_ % 8 == 0) ? (bx_ % 8) * (G_ / 8) + bx_ / 8 : bx_, p, p.ws};
    volatile LAS unsigned* xst = (volatile LAS unsigned*)(F.lds + 135 * 1024);
    if (F.tid == 0) { xst[0] = 0u; xst[1] = 0u; }
    __syncthreads();
    (void)xcd_barrier_post((unsigned*)(p.ws + WS_BAR), xst);
    REP(0) { if (PH(0)) { if (F.vcu & 1) { p_tables(F); p_mod(F); } else { p_mod(F); p_tables(F); }
    p_convert(F); }
    grid.sync(); F.refresh(); }

    for (int l = 0; l < 2; ++l) layer_body(F, l);
    if (PH(1)) norm_phase(F, nullptr, nullptr, X, ML, F.inp(20), nullptr, 0, 0, nullptr, F.outp());
}
#undef Hbuf
#undef H
#undef X
#undef U
#undef SSQ
#undef CAT
#undef mod
#undef rope
#undef modl
#undef xbl


extern "C" void kernel_launch(void* const* d_in, const int* in_sizes, int n_in, void* d_out, int out_size, void* d_ws, size_t ws_size, hipStream_t stream) {
    static int grid_blocks = 0;
    if (!grid_blocks) {
        int dev = 0, cus = 0, per_cu = 0;
        hipGetDevice(&dev);
        hipDeviceGetAttribute(&cus, hipDeviceAttributeMultiprocessorCount, dev);
        hipFuncSetAttribute((const void*)fwd_megakernel, hipFuncAttributeMaxDynamicSharedMemorySize, LDS_BYTES);
        hipOccupancyMaxActiveBlocksPerMultiprocessor(&per_cu, (const void*)fwd_megakernel, NT, LDS_BYTES);
        if (per_cu < 1) { fprintf(stderr, "occupancy query says %d blocks/CU\n", per_cu); per_cu = 1; }
        grid_blocks = cus;
        if (ws_size < WS_END) fprintf(stderr, "workspace too small: %zu < %zu\n", ws_size, (size_t)WS_END);
    }
    Params p{};
    for (int i = 0; i < 21; ++i) p.in[i] = (const float*)d_in[i];
    p.out = (float*)d_out; p.ws = (unsigned char*)d_ws;
    hipMemsetAsync((unsigned char*)d_ws + WS_BAR, 0, 16384, stream);
    void* args[] = {&p};
    hipError_t e = hipLaunchCooperativeKernel((const void*)fwd_megakernel, dim3(grid_blocks), dim3(NT), args, LDS_BYTES, stream);
    if (e != hipSuccess) fprintf(stderr, "cooperative launch failed: %s (grid %d)\n", hipGetErrorString(e), grid_blocks);
}
```

```cpp
#include <hip/hip_runtime.h>
#include <hip/hip_cooperative_groups.h>
#include <cstdio>
namespace cg = cooperative_groups;

#define LAS __attribute__((address_space(3)))
#define GAS __attribute__((address_space(1)))
template <class T> __device__ __forceinline__ T* as_global(T* p) { return p; }
#define DI __device__ __forceinline__
typedef unsigned short bf16_t;
typedef short bf16x8 __attribute__((ext_vector_type(8)));
typedef short s16x4 __attribute__((ext_vector_type(4)));
typedef float f32x4 __attribute__((ext_vector_type(4)));
typedef float f32x2 __attribute__((ext_vector_type(2)));
typedef float f32x16 __attribute__((ext_vector_type(16)));
typedef unsigned u32x4 __attribute__((ext_vector_type(4)));
typedef unsigned u32x2 __attribute__((ext_vector_type(2)));
typedef __bf16 bfv2 __attribute__((ext_vector_type(2)));

constexpr int D = 2048, NB = 4, SEQ = 4096, CTXL = 256, ML = NB * SEQ, MC = NB * CTXL, MT = ML + MC;
constexpr int INC = 3136, UC = 3328;
constexpr int U_CQ = 0, U_CKV = 512, U_QN = 1024, U_KN = 1536, U_VN = 2048, U_F = 2560, U_KR = 3072;
constexpr int DFF = 5632, KEYS = SEQ + CTXL;
constexpr size_t DO_DFT = 0, DO_DFTC = (size_t)4096 * 4096, DO_FF = DO_DFTC + 256 * 512;
static_assert((DO_FF + (size_t)(ML + MC) * 1024) * 2 <= (size_t)ML * 2048 * 4, "d_out scratch");
constexpr float EPS = 1e-6f, LOG2E = 1.4426950408889634f;
constexpr int NT = 512;
constexpr int LDS_BYTES = 136 * 1024;

constexpr size_t al(size_t x) { return (x + 255) & ~(size_t)255; }
constexpr size_t WS_WIN = 0;
constexpr size_t WS_WUQ = WS_WIN + al((size_t)2 * UC * D * 2);
constexpr size_t WS_WUKV = WS_WUQ + al((size_t)2 * 1536 * 512 * 2);
constexpr size_t WS_WOUT = WS_WUKV + al((size_t)2 * 4096 * 512 * 2);
constexpr size_t WS_WUP = WS_WOUT + al((size_t)2 * D * D * 2);
constexpr size_t WS_WDN = WS_WUP + al((size_t)2 * 2 * DFF * D * 2);
constexpr size_t WS_WC = WS_WDN + al((size_t)2 * D * DFF * 2);
constexpr size_t WS_DFTC = WS_WC + al((size_t)2 * 1024 * 1024 * 2);
constexpr size_t WS_TRIG = WS_DFTC + al((size_t)256 * 512 * 2);
constexpr size_t WS_ROPE = WS_TRIG + al(4096 * 8);
constexpr size_t WS_MOD = WS_ROPE + al(64 * 16 * 8);
constexpr size_t WS_CTR = WS_MOD + al((size_t)2 * 5 * 12288 * 4);
constexpr size_t WS_BAR = WS_CTR + 256;
constexpr size_t WS_X = WS_BAR + 16384;
constexpr size_t WS_H = WS_X + al((size_t)MT * D * 4);
constexpr size_t H_ROWS = 1 + MT + 256;
constexpr size_t WS_CAT = WS_H + al(H_ROWS * D * 2);
constexpr size_t WS_YTC = WS_CAT + al((size_t)MT * D * 2);
constexpr size_t WS_U = WS_YTC + al((size_t)2048 * 512 * 2);
constexpr size_t WS_SSQ = WS_U + al((size_t)MT * UC * 2);
constexpr size_t WS_Q = WS_SSQ + al((size_t)MT * 16 * 4);
constexpr size_t WS_KN = WS_Q + al((size_t)MT * 1536 * 2);
constexpr size_t WS_VT = WS_KN + al((size_t)MT * 1024 * 2);
constexpr size_t WS_VNT = WS_VT + al((size_t)32 * 128 * KEYS * 2);
constexpr size_t WS_YT = WS_VNT + al((size_t)16 * 128 * KEYS * 2);
constexpr size_t WS_END = WS_YT + al((size_t)2048 * 8192 * 2);
constexpr size_t WS_ACT = WS_U;
static_assert(WS_ACT + (size_t)MT * DFF * 2 <= WS_END, "ACT alias");
static_assert((size_t)4096 * 8192 * 2 <= H_ROWS * D * 2, "DFT alias");
static_assert(WS_END <= (size_t)805306368, "workspace");

struct Params { const float* in[21]; float* out; unsigned char* ws; };

DI unsigned pk2(float a, float b) { f32x2 v = {a, b}; bfv2 r = __builtin_convertvector(v, bfv2); return __builtin_bit_cast(unsigned, r); }
DI bf16_t f2bf(float a) { return (bf16_t)(pk2(a, 0.f) & 0xffffu); }
DI float shx(float v, int m, int lane) { return __builtin_bit_cast(float, __builtin_amdgcn_ds_bpermute((lane ^ m) << 2, __builtin_bit_cast(int, v))); }
DI f32x4 bf4(u32x2 w) { f32x4 r; r[0] = __builtin_bit_cast(float, w.x << 16); r[1] = __builtin_bit_cast(float, w.x & 0xffff0000u); r[2] = __builtin_bit_cast(float, w.y << 16); r[3] = __builtin_bit_cast(float, w.y & 0xffff0000u); return r; }
DI float sq4(f32x4 v) { return (v[0] * v[0] + v[1] * v[1]) + (v[2] * v[2] + v[3] * v[3]); }
DI u32x4 pk8(f32x4 a, f32x4 b) { u32x4 w; w.x = pk2(a[0], a[1]); w.y = pk2(a[2], a[3]); w.z = pk2(b[0], b[1]); w.w = pk2(b[2], b[3]); return w; }

namespace pg8 {
constexpr int BM = 256, BK = 64, HALF = 128, HTB = HALF * BK * 2, STAGE_BYTES = 8 * HTB;
DI int lds_byte(int r, int c) { const int st = (r >> 4) * 2 + (c >> 5), rr = r & 15, cc = c & 31, ob = rr * 64 + cc * 2; return st * 1024 + (ob ^ (((ob >> 9) & 1) << 5)); }
DI void stage_rc(int b, int& R, int& C) { const int st = b / 1024, sb = b % 1024, swz = sb ^ (((sb >> 9) & 1) << 5); R = (st >> 1) * 16 + swz / 64; C = (st & 1) * 32 + (swz % 64) / 2; }
DI int perm32(int rho) { const int n = rho >> 4, i = rho & 15; return 8 * (i >> 2) + 4 * n + (i & 3); }
struct Unit { int pm, pn, kob; };
struct Gemm { const bf16_t* A; const bf16_t* Bt; int lda, ldb, K; int conv; };

struct Sched {
    int nM, nN, cnt, G, c, i0, start, kobm = 0;
    DI void init(int nM_, int nN_, int G_, int c_, int start_) { nM = nM_; nN = nN_; cnt = nM * nN; G = G_; c = c_; start = start_;
        i0 = (start_ > c_) ? (start_ - c_ + G_ - 1) / G_ : 0; }
    DI bool next(int i, Unit& u) const {
        const long L = (long)(i0 + i) * G + c - start; if (L >= cnt) return false;
        const int w = (int)L, nig = 8 * nN, gid = w / nig, fm = gid * 8, gsz = (nM - fm) < 8 ? (nM - fm) : 8;
        u.pm = fm + ((w % nig) % gsz); u.pn = (w % nig) / gsz; u.kob = kobm * u.pm; return true;
    }
};
struct OneUnit { Unit u; bool has; DI bool next(int i, Unit& o) const { o = u; return has && i == 0; } };

template <class Epi, class SchedT>
DI void gemm_phase(LAS unsigned char* lds, const Gemm g, const SchedT& S, const Epi& E) {
    int tid = threadIdx.x; asm volatile("" : "+v"(tid));
    const int wid = __builtin_amdgcn_readfirstlane(tid >> 6), lane = tid & 63, wr = wid >> 2, wc = wid & 3, fr = lane & 15, fq = lane >> 4;
    const int K = g.K, nt = K / BK;
    unsigned voffA[2], voffB[2];
    auto mk_voff = [&]() { int t2 = threadIdx.x; asm volatile("" : "+v"(t2));
#pragma unroll
        for (int i = 0; i < 2; ++i) { int R, C; stage_rc(t2 * 16 + i * 8192, R, C); const int Rb = Epi::PERM ? ((R & ~31) + perm32(R & 31)) : R;
            const int Ra = g.conv ? ((R >> 6) * 126 + (R & 63)) : R;
            voffA[i] = (unsigned)(Ra * g.lda + C) * 2u; voffB[i] = (unsigned)(Rb * g.ldb + C) * 2u; } };
    mk_voff();
    const size_t kstep = (size_t)(BK * 2);
    const size_t hstepA = (size_t)(g.conv ? 64 : HALF) * g.lda * 2, hstepB = (size_t)HALF * g.ldb * 2;
    const size_t tstepA = g.conv ? (size_t)252 * g.lda * 2 : 2 * hstepA, tstepB = 2 * hstepB;
    const unsigned ldsw = (unsigned)wid * 1024u;
    const int aoff = lds_byte(wr * 64 + fr, fq * 8), boff = lds_byte(wc * 32 + fr, fq * 8);
#define PG8_SA(b, h) (((b) * 2 + (h)) * HTB)
#define PG8_SB(b, h) ((4 + (b) * 2 + (h)) * HTB)
#define PG8_STAGE(bufoff, gbase, voff) do { _Pragma("unroll") for (int _i = 0; _i < 2; ++_i) \
        __builtin_amdgcn_global_load_lds((const unsigned*)((const char*)(gbase) + (voff)[_i]), (LAS unsigned*)(lds + (bufoff) + ldsw + _i * 8192), 16, 0, 0); } while (0)
#define PG8_LDA(dst, b, h) do { _Pragma("unroll") for (int m = 0; m < 4; ++m) _Pragma("unroll") for (int k = 0; k < 2; ++k) dst[m][k] = *(const LAS bf16x8*)(lds + PG8_SA(b, h) + aoff + m * 2048 + k * 1024); } while (0)
#define PG8_LDB(dst, b, h) do { _Pragma("unroll") for (int n = 0; n < 2; ++n) _Pragma("unroll") for (int k = 0; k < 2; ++k) dst[n][k] = *(const LAS bf16x8*)(lds + PG8_SB(b, h) + boff + n * 2048 + k * 1024); } while (0)
#define PG8_MMA(ai, bj, At, Bt) do { __builtin_amdgcn_s_setprio(1); _Pragma("unroll") for (int m = 0; m < 4; ++m) _Pragma("unroll") for (int n = 0; n < 2; ++n) _Pragma("unroll") for (int k = 0; k < 2; ++k) \
        acc[ai][bj][m][n] = __builtin_amdgcn_mfma_f32_16x16x32_bf16(Bt[n][k], At[m][k], acc[ai][bj][m][n], 0, 0, 0); __builtin_amdgcn_s_setprio(0); } while (0)
#define PG8_WAIT_V(n) asm volatile("s_waitcnt vmcnt(" #n ")" ::: "memory")
#define PG8_WAIT_L(n) asm volatile("s_waitcnt lgkmcnt(" #n ")" ::: "memory")
#define PG8_BAR __builtin_amdgcn_s_barrier()
#define PG8_SCHED __builtin_amdgcn_sched_barrier(0)
    Unit cur, nxt; int ui = 0;
    if (!S.next(0, cur)) return;
    f32x4 acc[2][2][4][2];
#pragma unroll
    for (int a = 0; a < 2; ++a)
#pragma unroll
        for (int b = 0; b < 2; ++b)
#pragma unroll
            for (int m = 0; m < 4; ++m)
#pragma unroll
                for (int n = 0; n < 2; ++n) acc[a][b][m][n] = (f32x4){0.f, 0.f, 0.f, 0.f};
    bf16x8 At[4][2], B0[2][2], B1[2][2];
    const char* cA = (const char*)g.A + (size_t)cur.pm * tstepA; const char* cB = (const char*)g.Bt + (size_t)cur.pn * tstepB + (size_t)cur.kob * 2;
    PG8_STAGE(PG8_SB(0, 0), cB, voffB); PG8_STAGE(PG8_SA(0, 0), cA, voffA); PG8_STAGE(PG8_SB(0, 1), cB + hstepB, voffB); PG8_STAGE(PG8_SA(0, 1), cA + hstepA, voffA);
    if (wr == 1) PG8_BAR;
    PG8_WAIT_V(4); PG8_BAR;
    PG8_STAGE(PG8_SB(1, 0), cB + kstep, voffB); PG8_STAGE(PG8_SA(1, 0), cA + kstep, voffA); PG8_STAGE(PG8_SB(1, 1), cB + hstepB + kstep, voffB);
    PG8_WAIT_V(6); PG8_BAR;
    for (;;) {
        const bool has_next = S.next(ui + 1, nxt);
        const char* nA = has_next ? (const char*)g.A + (size_t)nxt.pm * tstepA : cA; const char* nB = has_next ? (const char*)g.Bt + (size_t)nxt.pn * tstepB + (size_t)nxt.kob * 2 : cB;
        for (int t = 0; t < nt; t += 2) {
            const bool last = (t == nt - 2);
            const char* a1 = cA + (size_t)(t + 1) * kstep;
            const char* a2 = last ? nA : cA + (size_t)(t + 2) * kstep; const char* b2 = last ? nB : cB + (size_t)(t + 2) * kstep;
            const char* a3 = a2 + kstep; const char* b3 = b2 + kstep;
            PG8_LDB(B0, 0, 0); PG8_SCHED; PG8_LDA(At, 0, 0); PG8_STAGE(PG8_SA(1, 1), a1 + hstepA, voffA);
            PG8_WAIT_L(8); PG8_BAR; PG8_WAIT_L(0); PG8_MMA(0, 0, At, B0); PG8_BAR; PG8_SCHED;
            PG8_LDB(B1, 0, 1); PG8_STAGE(PG8_SB(0, 0), b2, voffB);
            PG8_BAR; PG8_WAIT_L(0); PG8_MMA(0, 1, At, B1); PG8_BAR;
            PG8_LDA(At, 0, 1); PG8_STAGE(PG8_SA(0, 0), a2, voffA);
            PG8_BAR; PG8_WAIT_L(0); PG8_MMA(1, 0, At, B0); PG8_BAR; PG8_SCHED;
            PG8_STAGE(PG8_SB(0, 1), b2 + hstepB, voffB);
            PG8_WAIT_V(6); PG8_BAR; PG8_MMA(1, 1, At, B1); PG8_BAR;
            PG8_LDB(B0, 1, 0); PG8_SCHED; PG8_LDA(At, 1, 0); PG8_STAGE(PG8_SA(0, 1), a2 + hstepA, voffA);
            PG8_WAIT_L(8); PG8_BAR; PG8_WAIT_L(0); PG8_MMA(0, 0, At, B0); PG8_BAR; PG8_SCHED;
            PG8_LDB(B1, 1, 1); PG8_STAGE(PG8_SB(1, 0), b3, voffB);
            PG8_BAR; PG8_WAIT_L(0); PG8_MMA(0, 1, At, B1); PG8_BAR;
            PG8_LDA(At, 1, 1); PG8_STAGE(PG8_SA(1, 0), a3, voffA);
            PG8_BAR; PG8_WAIT_L(0); PG8_MMA(1, 0, At, B0); PG8_BAR; PG8_SCHED;
            PG8_STAGE(PG8_SB(1, 1), b3 + hstepB, voffB);
            PG8_WAIT_V(6); PG8_BAR; PG8_MMA(1, 1, At, B1); PG8_BAR;
        }
        { int fr2 = fr, fq2 = fq, wr2 = wr, wc2 = wc; asm volatile("" : "+v"(fr2), "+v"(fq2), "+s"(wr2), "+s"(wc2));
          E(acc, cur, wr2, wc2, fr2, fq2); }
        if (has_next) mk_voff();
        if (!has_next) break;
#pragma unroll
        for (int a = 0; a < 2; ++a)
#pragma unroll
            for (int b = 0; b < 2; ++b)
#pragma unroll
                for (int m = 0; m < 4; ++m)
#pragma unroll
                    for (int n = 0; n < 2; ++n) acc[a][b][m][n] = (f32x4){0.f, 0.f, 0.f, 0.f};
        cur = nxt; cA = nA; cB = nB; ++ui;
    }
    PG8_WAIT_V(0);
    if (wr == 0) PG8_BAR;
    PG8_BAR;
#undef PG8_SA
#undef PG8_SB
#undef PG8_STAGE
#undef PG8_LDA
#undef PG8_LDB
#undef PG8_MMA
#undef PG8_WAIT_V
#undef PG8_WAIT_L
#undef PG8_BAR
#undef PG8_SCHED
}
}
using pg8::Unit;
typedef const f32x4 (&AccRef)[2][2][4][2];

DI void row_bk(int row, int& b, int& key) { if (row < ML) { b = row >> 12; key = row & 4095; } else { const int rc = row - ML; b = rc >> 8; key = SEQ + (rc & 255); } }
DI void rope8(f32x4& v0, f32x4& v1, int row, int axis, int fq, int lane, const f32x2* rope) {
    const int l = row & 4095, pos = axis ? (l & 63) : (l >> 6);
    const f32x2* t = rope + pos * 16 + 8 * (fq & 1);
    const float sgn = (fq < 2) ? -1.f : 1.f;
#pragma unroll
    for (int j = 0; j < 4; ++j) {
        const float p0 = shx(v0[j], 32, lane), p1 = shx(v1[j], 32, lane);
        const f32x2 c0 = t[j], c1 = t[4 + j];
        v0[j] = v0[j] * c0.x + sgn * p0 * c0.y; v1[j] = v1[j] * c1.x + sgn * p1 * c1.y;
    }
}

struct EpiU {
    static constexpr bool PERM = true;
    bf16_t* U; float* ssq; bf16_t* VnT; const f32x2* rope; float qscale; bf16_t* FF;
    DI void operator()(AccRef acc, const Unit& u, int wr, int wc, int fr, int fq) const {
        const int pn = u.pn, rowb = u.pm * 256 + wr * 64 + fr;
        if (pn == 10 || pn == 11) {
#pragma unroll
            for (int ai = 0; ai < 2; ++ai)
#pragma unroll
                for (int m = 0; m < 4; ++m) { const int row = rowb + ai * 128 + m * 16; const int mrow = row < ML ? ((row & ~4095) | ((4096 - (row & 4095)) & 4095)) : row;
#pragma unroll
                    for (int bj = 0; bj < 2; ++bj) { const int c = 256 * (2 * (pn - 10) + bj) + 32 * wc + 8 * fq; const u32x4 w = pk8(acc[ai][bj][m][0], acc[ai][bj][m][1]);
                        *(u32x4*)(FF + (size_t)row * 1024 + c) = w;
                        *(u32x4*)(FF + (size_t)mrow * 1024 + 128 + c) = (row < ML) ? w : (u32x4){0u, 0u, 0u, 0u}; } }
            return;
        }
        if (pn == 8 || pn == 9) {
#pragma unroll
            for (int ai = 0; ai < 2; ++ai)
#pragma unroll
                for (int m = 0; m < 4; ++m) { int b, key; row_bk(rowb + ai * 128 + m * 16, b, key);
#pragma unroll
                    for (int bj = 0; bj < 2; ++bj) { const int hn = 2 * (pn - 8) + bj;
#pragma unroll
                        for (int n = 0; n < 2; ++n) { bf16_t* dst = VnT + ((size_t)((b * 4 + hn) * 128 + 32 * wc + 8 * fq + 4 * n)) * KEYS + key;
#pragma unroll
                            for (int j = 0; j < 4; ++j) dst[(size_t)j * KEYS] = f2bf(acc[ai][bj][m][n][j]); } } }
            return;
        }
        const float sc = (pn == 4 || pn == 5) ? qscale : 1.f;
#pragma unroll
        for (int ai = 0; ai < 2; ++ai)
#pragma unroll
            for (int m = 0; m < 4; ++m) { const int row = rowb + ai * 128 + m * 16; float ss = 0.f;
#pragma unroll
                for (int bj = 0; bj < 2; ++bj) { f32x4 v0 = acc[ai][bj][m][0] * sc, v1 = acc[ai][bj][m][1] * sc;
                    if (pn == 12 && bj == 0 && wc < 2 && row < ML) rope8(v0, v1, row, wc & 1, fq, fq * 16 + fr, rope);
                    ss += sq4(v0) + sq4(v1);
                    *(u32x4*)(U + (size_t)row * UC + 256 * pn + 128 * bj + 32 * wc + 8 * fq) = pk8(v0, v1); }
                if (pn < 4) { ss += shx(ss, 16, fq * 16 + fr); ss += shx(ss, 32, fq * 16 + fr); if (fq == 0) ssq[(size_t)row * 16 + pn * 4 + wc] = ss; } }
    }
};
DI float row_rstd(const float* ssq, int row, int which) { const f32x4 a = *(const f32x4*)(ssq + (size_t)row * 16 + which * 8), b = *(const f32x4*)(ssq + (size_t)row * 16 + which * 8 + 4);
    const float s = ((a[0] + a[1]) + (a[2] + a[3])) + ((b[0] + b[1]) + (b[2] + b[3])); return __builtin_amdgcn_rsqf(s * (1.f / 512.f) + EPS); }
struct EpiQ {
    static constexpr bool PERM = true;
    bf16_t* Q; const float* ssq; const f32x2* rope; float scale;
    DI void operator()(AccRef acc, const Unit& u, int wr, int wc, int fr, int fq) const {
        const int rowb = u.pm * 256 + wr * 64 + fr;
#pragma unroll
        for (int ai = 0; ai < 2; ++ai)
#pragma unroll
            for (int m = 0; m < 4; ++m) { const int row = rowb + ai * 128 + m * 16; const float rs = row_rstd(ssq, row, 0) * scale;
#pragma unroll
                for (int bj = 0; bj < 2; ++bj) { const int c32 = 256 * u.pn + 128 * bj + 32 * wc; f32x4 v0 = acc[ai][bj][m][0] * rs, v1 = acc[ai][bj][m][1] * rs;
                    if (((c32 >> 6) % 3) == 2 && row < ML) rope8(v0, v1, row, (c32 >> 5) & 1, fq, fq * 16 + fr, rope);
                    *(u32x4*)(Q + (size_t)row * 1536 + c32 + 8 * fq) = pk8(v0, v1); } }
    }
};
struct EpiKV {
    static constexpr bool PERM = true;
    bf16_t* KN; bf16_t* VT; const float* ssq;
    DI void operator()(AccRef acc, const Unit& u, int wr, int wc, int fr, int fq) const {
        const int pn = u.pn, rowb = u.pm * 256 + wr * 64 + fr;
#pragma unroll
        for (int ai = 0; ai < 2; ++ai)
#pragma unroll
            for (int m = 0; m < 4; ++m) { const int row = rowb + ai * 128 + m * 16; const float rs = row_rstd(ssq, row, 1); int b, key; row_bk(row, b, key);
#pragma unroll
                for (int bj = 0; bj < 2; ++bj) {
                    if (pn < 4) { *(u32x4*)(KN + (size_t)row * 1024 + 256 * pn + 128 * bj + 32 * wc + 8 * fq) = pk8(acc[ai][bj][m][0] * rs, acc[ai][bj][m][1] * rs); }
                    else { const int h = 2 * (pn - 4) + bj;
#pragma unroll
                        for (int n = 0; n < 2; ++n) { bf16_t* dst = VT + ((size_t)((b * 8 + h) * 128 + 32 * wc + 8 * fq + 4 * n)) * KEYS + key;
#pragma unroll
                            for (int j = 0; j < 4; ++j) dst[(size_t)j * KEYS] = f2bf(acc[ai][bj][m][n][j] * rs); } } } }
    }
};
struct EpiY {
    static constexpr bool PERM = true;
    bf16_t* YT; bf16_t* YTc; int tok_base;
    DI void operator()(AccRef acc, const Unit& u, int wr, int wc, int fr, int fq) const {
        const int g = u.pm;
#pragma unroll
        for (int ai = 0; ai < 2; ++ai)
#pragma unroll
            for (int m = 0; m < 4; ++m) { const int d = 64 * wr + 16 * m + fr;
#pragma unroll
                for (int bj = 0; bj < 2; ++bj) { const int tok = tok_base + 256 * u.pn + 128 * bj + 32 * wc + 8 * fq; const u32x4 w = pk8(acc[ai][bj][m][0], acc[ai][bj][m][1]);
                    if (tok < ML) { const int b = tok >> 12, l = tok & 4095; bf16_t* rowp = YT + ((size_t)((b * 4 + g) * 128 + d)) * 4096;
                        if (l < 2048) {
                            if (ai == 0) *(u32x4*)(rowp + l) = w;
                            else if (l != 0) *(u32x4*)(rowp + 2048 + l) = w;
                            else { bf16_t* q = rowp + 2048; q[1] = (bf16_t)(w.x >> 16); q[2] = (bf16_t)w.y; q[3] = (bf16_t)(w.y >> 16); q[4] = (bf16_t)w.z; q[5] = (bf16_t)(w.z >> 16); q[6] = (bf16_t)w.w; q[7] = (bf16_t)(w.w >> 16); }
                        } else if (l == 2048 && ai == 0) rowp[2048] = (bf16_t)w.x;
                    } else { const int tc = tok - ML, b = tc >> 8, l = tc & 255; *(u32x4*)(YTc + ((size_t)((b * 4 + g) * 128 + d)) * 512 + ai * 256 + l) = w; } } }
    }
};
struct SchedY {
    int G, c, i0, start;
    DI void init(int G_, int c_, int start_) { G = G_; c = c_; start = start_; i0 = (start_ > c_) ? (start_ - c_ + G_ - 1) / G_ : 0; }
    DI bool next(int i, Unit& u) const { const int L = (i0 + i) * G + c - start; if (L >= 144) return false; const int bt = L >> 2; u.pm = L & 3; u.pn = (bt / 9) * 16 + (bt % 9); u.kob = 256 * u.pm; return true; }
};
struct EpiF {
    static constexpr bool PERM = true;
    bf16_t* CAT; int ctx;
    DI void operator()(AccRef acc, const Unit& u, int wr, int wc, int fr, int fq) const {
        const int b = u.pn >> 1;
#pragma unroll
        for (int ai = 0; ai < 2; ++ai)
#pragma unroll
            for (int m = 0; m < 4; ++m) { const int lp = u.pm * 256 + 128 * ai + 64 * wr + 16 * m + fr; const int row = ctx ? (ML + b * 256 + lp) : (b * 4096 + lp);
#pragma unroll
                for (int bj = 0; bj < 2; ++bj) { const int g = 2 * (u.pn & 1) + bj;
                    *(u32x4*)(CAT + (size_t)row * D + 1536 + g * 128 + 32 * wc + 8 * fq) = pk8(acc[ai][bj][m][0], acc[ai][bj][m][1]); } }
    }
};
struct EpiRes {
    static constexpr bool PERM = false;
    const float* xl; const float* xc; const bf16_t* xb; bf16_t* out; const float* gate;
    DI void operator()(AccRef acc, const Unit& u, int wr, int wc, int fr, int fq) const {
        const int row0 = u.pm * 256; const int midx = row0 < ML ? (row0 >> 12) : 4;
        const float* src = row0 < ML ? xl : (xc - (size_t)ML * D);
        const float* gp = gate + (size_t)midx * 12288;
        const int col0 = u.pn * 256 + wc * 32 + 4 * fq;
        f32x4 gv[2][2];
#pragma unroll
        for (int bj = 0; bj < 2; ++bj)
#pragma unroll
            for (int n = 0; n < 2; ++n) gv[bj][n] = *(const f32x4*)(gp + col0 + bj * 128 + n * 16);
        if (xb) {
#pragma unroll
            for (int ai = 0; ai < 2; ++ai)
#pragma unroll
                for (int m = 0; m < 4; ++m) { const size_t off = (size_t)(row0 + wr * 64 + fr + ai * 128 + m * 16) * D + col0;
#pragma unroll
                    for (int bj = 0; bj < 2; ++bj)
#pragma unroll
                        for (int n = 0; n < 2; ++n) { const size_t o2 = off + bj * 128 + n * 16;
                            const f32x4 r = bf4(*(const u32x2*)(xb + o2)) + gv[bj][n] * acc[ai][bj][m][n];
                            u32x2 w; w.x = pk2(r[0], r[1]); w.y = pk2(r[2], r[3]); *(u32x2*)(out + o2) = w; }
                    asm volatile("" ::: "memory"); }
        } else {
#pragma unroll
            for (int ai = 0; ai < 2; ++ai)
#pragma unroll
                for (int m = 0; m < 4; ++m) { const size_t off = (size_t)(row0 + wr * 64 + fr + ai * 128 + m * 16) * D + col0;
#pragma unroll
                    for (int bj = 0; bj < 2; ++bj)
#pragma unroll
                        for (int n = 0; n < 2; ++n) { const size_t o2 = off + bj * 128 + n * 16;
                            const f32x4 r = *(const f32x4*)(src + o2) + gv[bj][n] * acc[ai][bj][m][n];
                            u32x2 w; w.x = pk2(r[0], r[1]); w.y = pk2(r[2], r[3]); *(u32x2*)(out + o2) = w; }
                    asm volatile("" ::: "memory"); }
        }
    }
};
DI float dpp_ror1(float v) { return __builtin_bit_cast(float, __builtin_amdgcn_update_dpp(0, __builtin_bit_cast(int, v), 0x121, 0xf, 0xf, false)); }
DI float dpp_ror15(float v) { return __builtin_bit_cast(float, __builtin_amdgcn_update_dpp(0, __builtin_bit_cast(int, v), 0x12f, 0xf, 0xf, false)); }
struct EpiConv {
    static constexpr bool PERM = true;
    bf16_t* ACT; const float* cw; const float* cb; int Mq;
    DI void operator()(AccRef acc, const Unit& u, int wr, int wc, int fr, int fq) const {
#pragma unroll
        for (int n = 0; n < 2; ++n) {
            const int cg_ = 128 * u.pn + 32 * wc + 8 * fq + 4 * n;
            f32x4 o[2][4];
#pragma unroll
            for (int bj = 0; bj < 2; ++bj) {
                const f32x4 w0 = *(const f32x4*)(cw + bj * DFF + cg_), w1 = *(const f32x4*)(cw + (size_t)2 * DFF + bj * DFF + cg_),
                            w2 = *(const f32x4*)(cw + (size_t)4 * DFF + bj * DFF + cg_), wb = *(const f32x4*)(cb + bj * DFF + cg_);
#pragma unroll
                for (int ai = 0; ai < 2; ++ai) {
                    const int tok0 = 252 * u.pm - 1 + 126 * wr + 64 * ai;
#pragma unroll
                    for (int m = 0; m < 4; ++m) {
                        const int tok = tok0 + 16 * m + fr; const int msk = tok < ML ? 4095 : 255;
                        const bool hu = (tok & msk) != 0, hd = ((tok + 1) & msk) != 0;
                        f32x4 r = acc[ai][bj][m][n] * w1 + wb;
                        f32x4 w0m, w2m;
#pragma unroll
                        for (int j = 0; j < 4; ++j) { w0m[j] = hu ? w0[j] : 0.f; w2m[j] = hd ? w2[j] : 0.f; }
#pragma unroll
                        for (int j = 0; j < 4; ++j) {
                            const float su = ((m > 0 || ai == 1) && fr == 15) ? (m > 0 ? acc[ai][bj][(m + 3) & 3][n][j] : acc[0][bj][3][n][j]) : acc[ai][bj][m][n][j];
                            const float sd = ((m < 3 || ai == 0) && fr == 0) ? (m < 3 ? acc[ai][bj][(m + 1) & 3][n][j] : acc[1][bj][0][n][j]) : acc[ai][bj][m][n][j];
                            float rj = r[j];
                            asm("s_nop 1\n\tv_fmac_f32_dpp %0, %1, %2 row_ror:1 row_mask:0xf bank_mask:0xf" : "+v"(rj) : "v"(su), "v"(w0m[j]));
                            asm("s_nop 1\n\tv_fmac_f32_dpp %0, %1, %2 row_ror:15 row_mask:0xf bank_mask:0xf" : "+v"(rj) : "v"(sd), "v"(w2m[j]));
                            r[j] = rj; }
                        if (bj == 0) {
#pragma unroll
                            for (int j = 0; j < 4; ++j) o[ai][m][j] = r[j] * __builtin_amdgcn_rcpf(1.f + __builtin_amdgcn_exp2f(-LOG2E * r[j]));
                        } else o[ai][m] = o[ai][m] * r;
                    }
                }
            }
#pragma unroll
            for (int ai = 0; ai < 2; ++ai) {
                const int tok0 = 252 * u.pm - 1 + 126 * wr + 64 * ai;
#pragma unroll
                for (int m = 0; m < 4; ++m) { const int li = 64 * ai + 16 * m + fr, tok = tok0 + 16 * m + fr;
                    if (li >= 1 && li <= 126 && tok < Mq) { u32x2 v; v.x = pk2(o[ai][m][0], o[ai][m][1]); v.y = pk2(o[ai][m][2], o[ai][m][3]);
                        *(u32x2*)(ACT + (size_t)tok * DFF + cg_) = v; } }
            }
        }
    }
};

struct Frame {
    LAS unsigned char* lds; unsigned char* ldsg; int tid, lane, wave, G, vcu;
    const Params& P; unsigned char* ws;
    DI const float* inp(int i) const { return as_global(P.in[i]); }
    DI float* outp() const { return as_global(P.out); }
    DI int nrep(int d) const { int n = 1 + d; asm volatile("" : "+s"(n)); return n; }
    DI void refresh() { int t = threadIdx.x; asm volatile("" : "+v"(t)); tid = t; lane = t & 63; wave = __builtin_amdgcn_readfirstlane(t >> 6);
        long z = 0; asm volatile("" : "+s"(z)); ws = P.ws + z;
        int g = gridDim.x, bx = blockIdx.x; asm volatile("" : "+s"(g), "+s"(bx)); G = g; vcu = (g % 8 == 0) ? (bx % 8) * (g / 8) + bx / 8 : bx; }
};

DI void p_mod(const Frame& F) {
    LAS float* sv = (LAS float*)F.lds; LAS float* red = sv + 5 * 2048;
    const float* c = F.inp(1); const float* cc = F.inp(3);
    for (int i = F.tid; i < 5 * 2048; i += NT) { const int r = i >> 11, k = i & 2047; const float v = r < 4 ? c[r * 2048 + k] : cc[k]; sv[i] = v / (1.f + __expf(-v)); }
    __syncthreads();
    float* mod = (float*)(F.ws + WS_MOD);
    for (int tile = F.vcu; tile < 768; tile += F.G) {
        const int l = tile / 384, colb = (tile % 384) * 32, cl = F.tid & 31, kg = F.tid >> 5;
        const float* w = F.inp(4) + (size_t)l * 2048 * 12288 + colb + cl;
        float a0 = 0.f, a1 = 0.f, a2 = 0.f, a3 = 0.f, a4 = 0.f;
#pragma unroll 32
        for (int k = kg * 128; k < kg * 128 + 128; ++k) { const float wv = __builtin_nontemporal_load(w + (size_t)k * 12288); a0 += sv[k] * wv; a1 += sv[2048 + k] * wv; a2 += sv[4096 + k] * wv; a3 += sv[6144 + k] * wv; a4 += sv[8192 + k] * wv; }
        LAS float* rp = red + (kg * 32 + cl) * 5; rp[0] = a0; rp[1] = a1; rp[2] = a2; rp[3] = a3; rp[4] = a4;
        __syncthreads();
        if (F.tid < 160) { const int r = F.tid >> 5; float s = 0.f;
#pragma unroll
            for (int q = 0; q < 16; ++q) s += red[(q * 32 + cl) * 5 + r];
            mod[(size_t)(l * 5 + r) * 12288 + colb + cl] = s + F.inp(5)[l * 12288 + colb + cl]; }
        __syncthreads();
    }
}
DI void p_tables(const Frame& F) {
    const int gt = F.vcu * NT + F.tid, gn = F.G * NT;
    LAS f32x2* t4096 = (LAS f32x2*)F.lds;
    __syncthreads();
    for (int i = F.tid; i < 4096; i += NT) { f32x2 v; v.x = cospif((float)i / 2048.f); v.y = sinpif((float)i / 2048.f); t4096[i] = v; }
    __syncthreads();
    f32x2* rope = (f32x2*)(F.ws + WS_ROPE);
    for (int i = gt; i < 1024; i += gn) { const int pos = i >> 4, k = i & 15; const float fr = powf(10000.f, -(float)k / 16.f); const float a = (float)pos * fr; f32x2 v; v.x = cosf(a); v.y = sinf(a); rope[i] = v; }
    if (gt < 32) ((unsigned*)(F.ws + WS_CTR))[gt] = 0u;
    if (F.tid == 0) *(float**)(F.ws + WS_CTR + 128) = F.outp();
    bf16_t* dc = (bf16_t*)F.outp() + DO_DFTC;
    for (int i = gt; i < 256 * 512; i += gn) { const int lp = i >> 9, cc = i & 511, part = cc >> 8, l = cc & 255; const f32x2 t = t4096[((lp * l) & 255) * 16];
        dc[i] = f2bf((part ? -t.y : t.x) * (1.f / 16.f)); }
    bf16_t* wc = (bf16_t*)(F.ws + WS_WC); const float* wf = F.inp(14);
    for (int i = gt; i < 2 * 4 * 2 * 128 * 128; i += gn) {
        const int d = i & 127, cch = (i >> 7) & 127, part = (i >> 14) & 1, g = (i >> 15) & 3, l = i >> 17;
        const float* wp = wf + ((size_t)(l * 4 + g) * 128) * 128 + d; float sacc = 0.f;
        for (int c2 = 0; c2 < 128; ++c2) { const f32x2 t = t4096[((cch * c2) & 127) * 32]; sacc += (part ? t.y : t.x) * wp[(size_t)c2 * 128]; }
        sacc *= 0.08838834764831845f;
        bf16_t* row = wc + ((size_t)l * 1024 + (g * 2 + part) * 128 + d) * 256;
        row[cch] = f2bf(sacc); row[128 + cch] = f2bf(part ? -sacc : sacc);
    }
    bf16_t* dft = (bf16_t*)F.outp() + DO_DFT;
    for (int ch = gt; ch < 4096 * 512; ch += gn) { const int lp = ch >> 9, k0 = (ch & 511) * 8; f32x4 a, b;
#pragma unroll
        for (int j = 0; j < 8; ++j) { const int k = k0 + j; const f32x2 t = t4096[(lp * (k & 2047) + (k == 2048 ? lp * 2048 : 0)) & 4095];
            const float v = (k <= 2048 ? t.x : -t.y) * ((k == 0 || k == 2048) ? (1.f / 128.f) : (1.f / 64.f));
            if (j < 4) a[j] = v; else b[j - 4] = v; }
        *(u32x4*)(dft + (size_t)lp * 4096 + k0) = pk8(a, b); }
    __syncthreads();
}
struct CvDesc { const float* src; const float* kscale; bf16_t* dst; int K, Nsrc, Ndst, mapid, ntiles; };
DI int cv_map(int mapid, int n) {
    if (mapid == 1) return n < 1024 ? n : (n < 3072 ? n + 64 : (n < 3136 ? n - 2048 : -1));
    if (mapid == 2) { const int which = n >> 10, h = (n >> 7) & 7, j = n & 127; return h * 256 + which * 128 + j; }
    if (mapid == 3) { const int pn = n >> 8, bj = (n >> 7) & 1, q = n & 127; return bj * DFF + pn * 128 + q; }
    return n;
}
DI CvDesc cv_desc(const Frame& F, int m) {
    const int l = m / 6, j = m % 6; CvDesc d; d.kscale = nullptr; d.mapid = 0;
    if (j == 0) { d.src = F.inp(8) + (size_t)l * D * INC; d.K = D; d.Nsrc = INC; d.dst = (bf16_t*)(F.ws + WS_WIN) + (size_t)l * UC * D; d.Ndst = UC; d.mapid = 1; }
    else if (j == 1) { d.src = F.inp(10) + (size_t)l * 512 * 1536; d.K = 512; d.Nsrc = 1536; d.dst = (bf16_t*)(F.ws + WS_WUQ) + (size_t)l * 1536 * 512; d.Ndst = 1536; d.kscale = F.inp(9) + l * 512; }
    else if (j == 2) { d.src = F.inp(12) + (size_t)l * 512 * 2048; d.K = 512; d.Nsrc = 2048; d.dst = (bf16_t*)(F.ws + WS_WUKV) + (size_t)l * 2048 * 512; d.Ndst = 2048; d.kscale = F.inp(11) + l * 512; d.mapid = 2; }
    else if (j == 3) { d.src = F.inp(15) + (size_t)l * D * D; d.K = D; d.Nsrc = D; d.dst = (bf16_t*)(F.ws + WS_WOUT) + (size_t)l * D * D; d.Ndst = D; }
    else if (j == 4) { d.src = F.inp(16) + (size_t)l * D * 2 * DFF; d.K = D; d.Nsrc = 2 * DFF; d.dst = (bf16_t*)(F.ws + WS_WUP) + (size_t)l * 2 * DFF * D; d.Ndst = 2 * DFF; d.mapid = 3; }
    else { d.src = F.inp(19) + (size_t)l * DFF * D; d.K = DFF; d.Nsrc = D; d.dst = (bf16_t*)(F.ws + WS_WDN) + (size_t)l * D * DFF; d.Ndst = D; }
    d.ntiles = (d.Ndst / 128) * (d.K / 64); return d;
}
struct CvTile { const float* src; const float* kscale; bf16_t* dst; int K, Nsrc, sc0, sc1, n0, k0; bool ok; };
DI CvTile cv_tile(const Frame& F, int t) {
    CvTile r; r.ok = false;
    constexpr int NTN[6] = {26, 12, 16, 16, 88, 16}, NT_[6] = {26 * 32, 12 * 8, 16 * 8, 16 * 32, 88 * 32, 16 * 88};
    constexpr int PER_LAYER = NT_[0] + NT_[1] + NT_[2] + NT_[3] + NT_[4] + NT_[5];
    if (t >= 2 * PER_LAYER) return r;
    const int l = t >= PER_LAYER ? 1 : 0; t -= l * PER_LAYER;
    int j = 0, nt = 0, kt = 0;
#pragma unroll
    for (int q = 0; q < 6; ++q) { if (t >= 0 && t < NT_[q]) { j = q; nt = t % NTN[q]; kt = t / NTN[q]; } t -= NT_[q]; }
    const CvDesc d = cv_desc(F, l * 6 + j);
    r.n0 = nt * 128; r.k0 = kt * 64; r.src = d.src; r.kscale = d.kscale; r.dst = d.dst; r.K = d.K; r.Nsrc = d.Nsrc;
    r.sc0 = cv_map(d.mapid, r.n0); r.sc1 = cv_map(d.mapid, r.n0 + 64); r.ok = true; return r;
}
DI void cv_load(const Frame& F, const CvTile& t, f32x4 (&r)[4]) {
#pragma unroll
    for (int h = 0; h < 2; ++h) { const int sc = h ? t.sc1 : t.sc0;
#pragma unroll
        for (int p = 0; p < 2; ++p) { const int kk = p * 32 + (F.tid >> 4);
            f32x4 v = {0.f, 0.f, 0.f, 0.f};
            if (sc >= 0) { v = __builtin_nontemporal_load((const f32x4*)(t.src + (size_t)(t.k0 + kk) * t.Nsrc + sc + (F.tid & 15) * 4)); if (t.kscale) v *= t.kscale[t.k0 + kk]; }
            r[h * 2 + p] = v; } }
}
DI void p_convert(const Frame& F) {
    LAS float* ts = (LAS float*)F.lds;
    int t = F.vcu; CvTile cur = cv_tile(F, t), nx1 = cv_tile(F, t + F.G); f32x4 r0[4], r1[4]; int buf = 0;
    if (cur.ok) cv_load(F, cur, r0);
    if (nx1.ok) cv_load(F, nx1, r1);
    while (cur.ok) {
        LAS float* tb = ts + buf * (2 * 64 * 65);
#pragma unroll
        for (int h = 0; h < 2; ++h)
#pragma unroll
            for (int p = 0; p < 2; ++p) { const int kk = p * 32 + (F.tid >> 4); LAS float* q = tb + h * (64 * 65) + kk * 65 + (F.tid & 15) * 4;
                q[0] = r0[h * 2 + p][0]; q[1] = r0[h * 2 + p][1]; q[2] = r0[h * 2 + p][2]; q[3] = r0[h * 2 + p][3]; }
        __syncthreads();
#pragma unroll
        for (int i = 0; i < 4; ++i) r0[i] = r1[i];
        const CvTile nx2 = cv_tile(F, t + 2 * F.G);
        if (nx2.ok) cv_load(F, nx2, r1);
#pragma unroll
        for (int h = 0; h < 2; ++h) { const int n = F.tid >> 3, kc = F.tid & 7; const LAS float* q = tb + h * (64 * 65) + n; f32x4 a, b;
#pragma unroll
            for (int j = 0; j < 4; ++j) { a[j] = q[(kc * 8 + j) * 65]; b[j] = q[(kc * 8 + 4 + j) * 65]; }
            *(u32x4*)(cur.dst + (size_t)(cur.n0 + h * 64 + n) * cur.K + cur.k0 + kc * 8) = pk8(a, b); }
        buf ^= 1; t += F.G; cur = nx1; nx1 = nx2;
    }
    __syncthreads();
}

DI void norm_phase(const Frame& F, const float* xl, const float* xc, const bf16_t* xb, int M, const float* g, const float* modl, int sh_off, int sc_off, bf16_t* H, float* outf) {
    const int gw = F.vcu * 8 + F.wave, nw = F.G * 8;
    const int row_lo = (int)(((long)gw * M) / nw), row_hi = (int)(((long)(gw + 1) * M) / nw);
    f32x4 gs[8], shv[8]; int cur = -1;
    for (int row = row_lo; row < row_hi; ++row) {
        const int midx = row < ML ? (row >> 12) : 4;
        if (midx != cur) { cur = midx;
#pragma unroll
            for (int i = 0; i < 4; ++i) { const int col = i * 512 + F.lane * 8;
                gs[2 * i] = *(const f32x4*)(g + col); gs[2 * i + 1] = *(const f32x4*)(g + col + 4);
                if (!outf) { const float* mp = modl + (size_t)midx * 12288 + col;
                    gs[2 * i] = gs[2 * i] * (1.f + *(const f32x4*)(mp + sc_off)); gs[2 * i + 1] = gs[2 * i + 1] * (1.f + *(const f32x4*)(mp + sc_off + 4));
                    shv[2 * i] = *(const f32x4*)(mp + sh_off); shv[2 * i + 1] = *(const f32x4*)(mp + sh_off + 4); } } }
        f32x4 v[8]; float ss = 0.f;
        if (xb) {
#pragma unroll
            for (int i = 0; i < 4; ++i) { const u32x4 w = *(const u32x4*)(xb + (size_t)row * D + i * 512 + F.lane * 8); v[2 * i] = bf4((u32x2){w.x, w.y}); v[2 * i + 1] = bf4((u32x2){w.z, w.w}); ss += sq4(v[2 * i]) + sq4(v[2 * i + 1]); }
        } else { const float* xr = row < ML ? xl + (size_t)row * D : xc + (size_t)(row - ML) * D;
#pragma unroll
            for (int i = 0; i < 4; ++i) { v[2 * i] = *(const f32x4*)(xr + i * 512 + F.lane * 8); v[2 * i + 1] = *(const f32x4*)(xr + i * 512 + F.lane * 8 + 4); ss += sq4(v[2 * i]) + sq4(v[2 * i + 1]); } }
#pragma unroll
        for (int o = 32; o >= 1; o >>= 1) ss += shx(ss, o, F.lane);
        const float rs = __builtin_amdgcn_rsqf(ss * (1.f / 2048.f) + EPS);
#pragma unroll
        for (int i = 0; i < 4; ++i) { const int col = i * 512 + F.lane * 8;
            if (outf) { *(f32x4*)(outf + (size_t)row * D + col) = v[2 * i] * rs * gs[2 * i]; *(f32x4*)(outf + (size_t)row * D + col + 4) = v[2 * i + 1] * rs * gs[2 * i + 1]; }
            else *(u32x4*)(H + (size_t)row * D + col) = pk8(v[2 * i] * rs * gs[2 * i] + shv[2 * i], v[2 * i + 1] * rs * gs[2 * i + 1] + shv[2 * i + 1]); }
    }
}

struct AttnItem {
    const bf16_t* q; const bf16_t* kn; const bf16_t* kr; const bf16_t* vt; bf16_t* o;
    int ldq, ldk, ldo, lat_row0, ctx_row0, t0, ntl, nctx, mode, r0, hn;
};
template <int DQ>
DI void attn_item(const Frame& F, const AttnItem& it, const LAS float* rpb_lds) {
    constexpr int KP = DQ + 8, VP = 72, KS = DQ / 16;
    constexpr int KBYTES = 64 * KP * 2, VBYTES = 128 * VP * 2;
    LAS unsigned char* base = F.lds;
    int tid = threadIdx.x; asm volatile("" : "+v"(tid));
    const int lane = tid & 63, w = __builtin_amdgcn_readfirstlane(tid >> 6), qq = lane & 31, hh = lane >> 5;
    const bool grpB = w >= 4;
    const int ntile = it.ntl + it.nctx;
    u32x4 rk[2], rr, rv[2];
    auto gload = [&](int ti) {
        int rowb, vcol;
        if (ti < it.ntl) { const int kt = it.t0 + ti; rowb = it.lat_row0 + kt * 64; vcol = kt * 64; } else { const int j = ti - it.ntl; rowb = it.ctx_row0 + j * 64; vcol = SEQ + j * 64; }
#pragma unroll
        for (int i = 0; i < 2; ++i) { const int id = tid + i * NT; rk[i] = *(const u32x4*)(it.kn + (size_t)(rowb + (id >> 4)) * it.ldk + (id & 15) * 8);
            rv[i] = *(const u32x4*)(it.vt + (size_t)(id >> 3) * KEYS + vcol + (id & 7) * 8); }
        if (DQ == 192) rr = *(const u32x4*)(it.kr + (size_t)(rowb + (tid >> 3)) * UC + (tid & 7) * 8);
    };
    auto lstore = [&](int ti) {
        LAS unsigned char* kb = base + (ti & 1) * KBYTES; LAS unsigned char* vb = base + 2 * KBYTES + (ti % 3) * VBYTES;
#pragma unroll
        for (int i = 0; i < 2; ++i) { const int id = tid + i * NT; *(LAS u32x4*)(kb + ((id >> 4) * KP + (id & 15) * 8) * 2) = rk[i];
            *(LAS u32x4*)(vb + ((id >> 3) * VP + (id & 7) * 8) * 2) = rv[i]; }
        if (DQ == 192) *(LAS u32x4*)(kb + ((tid >> 3) * KP + 128 + (tid & 7) * 8) * 2) = rr;
    };
    bf16x8 qf[KS];
    { const bf16_t* qp = it.q + (size_t)(32 * w + qq) * it.ldq + 8 * hh;
#pragma unroll
        for (int ks = 0; ks < KS; ++ks) qf[ks] = *(const bf16x8*)(qp + 16 * ks); }
    f32x16 o[4];
#pragma unroll
    for (int db = 0; db < 4; ++db)
#pragma unroll
        for (int i = 0; i < 16; ++i) o[db][i] = 0.f;
    f32x16 s[2];
    float mrun = -INFINITY, lrun = 0.f;
    const int r = it.r0 + (w >> 1), wq = 32 * (w & 1) + qq;
    const int rs = min(max(r - 4, 0), 56), cs = min(max(wq - 8, 0), 48);
    auto active = [&](int ti) { const int krow = it.t0 + ti; return !(it.mode == 1 && ti < it.ntl && (krow < rs || krow > rs + 7)); };
    auto qk = [&](int ti) {
        if (!active(ti)) return;
        const int krow_l = (qq & 3) + 4 * ((qq >> 3) & 1) + 8 * ((qq >> 2) & 1) + 16 * (qq >> 4);
        LAS unsigned char* kb = base + (ti & 1) * KBYTES + (krow_l * KP + 8 * hh) * 2;
#pragma unroll
        for (int blk = 0; blk < 2; ++blk)
#pragma unroll
            for (int i = 0; i < 16; ++i) s[blk][i] = 0.f;
        bf16x8 kf[3][2];
#pragma unroll
        for (int p = 0; p < 2; ++p)
#pragma unroll
            for (int blk = 0; blk < 2; ++blk) kf[p][blk] = *(const LAS bf16x8*)(kb + (32 * blk * KP + 16 * p) * 2);
#pragma unroll
        for (int ks = 0; ks < KS; ++ks) {
            if (ks + 2 < KS) {
#pragma unroll
                for (int blk = 0; blk < 2; ++blk) kf[(ks + 2) % 3][blk] = *(const LAS bf16x8*)(kb + (32 * blk * KP + 16 * (ks + 2)) * 2); }
            __builtin_amdgcn_sched_barrier(0);
#pragma unroll
            for (int blk = 0; blk < 2; ++blk) s[blk] = __builtin_amdgcn_mfma_f32_32x32x16_bf16(kf[ks % 3][blk], qf[ks], s[blk], 0, 0, 0);
            __builtin_amdgcn_sched_barrier(0);
        }
    };
    auto smpv = [&](int ti) {
        if (!active(ti)) return;
        LAS unsigned char* vb = base + 2 * KBYTES + (ti % 3) * VBYTES;
        if (it.mode == 1 && ti < it.ntl) {
            const int krow = it.t0 + ti;
            const LAS float* bp = rpb_lds + it.hn * 465 + (krow - r + 7) * 31 - wq + 15;
#pragma unroll
            for (int blk = 0; blk < 2; ++blk)
#pragma unroll
                for (int i = 0; i < 16; ++i) { const int kc = 32 * blk + (i & 3) + 4 * ((i >> 2) & 1) + 8 * hh + 16 * (i >> 3); const bool ok = kc >= cs && kc < cs + 16;
                    const int kcc = ok ? kc : cs; s[blk][i] = ok ? s[blk][i] + bp[kcc] : -INFINITY; }
        }
        float mx = s[0][0];
#pragma unroll
        for (int blk = 0; blk < 2; ++blk)
#pragma unroll
            for (int i = 0; i < 16; ++i) mx = fmaxf(mx, s[blk][i]);
        mx = fmaxf(mx, shx(mx, 32, lane));
        const float mnew = fmaxf(mrun, mx), alpha = __builtin_amdgcn_exp2f(mrun - mnew);
        mrun = mnew;
        float ps = 0.f;
#pragma unroll
        for (int blk = 0; blk < 2; ++blk)
#pragma unroll
            for (int i = 0; i < 16; ++i) { const float p = __builtin_amdgcn_exp2f(s[blk][i] - mnew); s[blk][i] = p; ps += p; }
        lrun = lrun * alpha + ps;
        if (__builtin_amdgcn_ballot_w64(alpha != 1.f) != 0ull) {
#pragma unroll
            for (int db = 0; db < 4; ++db)
#pragma unroll
                for (int i = 0; i < 16; ++i) o[db][i] *= alpha;
        }
        LAS unsigned char* vq = vb + (qq * VP + 8 * hh) * 2;
        auto vload = [&](int step, int db) { return *(const LAS bf16x8*)(vq + (32 * db * VP + 16 * step) * 2); };
        bf16x8 vf[2][4];
#pragma unroll
        for (int db = 0; db < 4; ++db) vf[0][db] = vload(0, db);
#pragma unroll
        for (int st = 0; st < 4; ++st) {
            if (st + 1 < 4) {
#pragma unroll
                for (int db = 0; db < 4; ++db) vf[(st + 1) & 1][db] = vload(st + 1, db); }
            __builtin_amdgcn_sched_barrier(0);
            const int blk = st >> 1, s2 = st & 1;
            u32x4 pw; pw.x = pk2(s[blk][8 * s2], s[blk][8 * s2 + 1]); pw.y = pk2(s[blk][8 * s2 + 2], s[blk][8 * s2 + 3]);
            pw.z = pk2(s[blk][8 * s2 + 4], s[blk][8 * s2 + 5]); pw.w = pk2(s[blk][8 * s2 + 6], s[blk][8 * s2 + 7]);
            const bf16x8 pf = __builtin_bit_cast(bf16x8, pw);
#pragma unroll
            for (int db = 0; db < 4; ++db) o[db] = __builtin_amdgcn_mfma_f32_32x32x16_bf16(vf[st & 1][db], pf, o[db], 0, 0, 0);
            __builtin_amdgcn_sched_barrier(0);
        }
    };

    __syncthreads();
    gload(0); lstore(0);
    if (ntile > 1) gload(1);
    __syncthreads();
    for (int ti = 0; ti < ntile; ++ti) {
        qk(ti);
        if (grpB) { if (ti + 1 < ntile) lstore(ti + 1); if (ti + 2 < ntile) gload(ti + 2); __syncthreads(); }
        smpv(ti);
        if (!grpB) { if (ti + 1 < ntile) lstore(ti + 1); if (ti + 2 < ntile) gload(ti + 2); __syncthreads(); }
    }
    const float lt = lrun + shx(lrun, 32, lane), inv = 1.f / lt;
    bf16_t* op = it.o + (size_t)(32 * w + qq) * it.ldo + 4 * hh;
#pragma unroll
    for (int db = 0; db < 4; ++db)
#pragma unroll
        for (int ig = 0; ig < 4; ++ig) { u32x2 v; v.x = pk2(o[db][4 * ig] * inv, o[db][4 * ig + 1] * inv); v.y = pk2(o[db][4 * ig + 2] * inv, o[db][4 * ig + 3] * inv);
            *(u32x2*)(op + 32 * db + 8 * ig) = v; }
}

#ifndef MLAREP
#define MLAREP 1
#endif
DI void mixer_attention(const Frame& F, int layer, int cidx) {
    const int nitems = (layer == 0 ? 816 : 768) + 512 * (MLAREP - 1);
    bf16_t* U = (bf16_t*)(F.ws + WS_U); bf16_t* Q = (bf16_t*)(F.ws + WS_Q); bf16_t* KN = (bf16_t*)(F.ws + WS_KN);
    bf16_t* VT = (bf16_t*)(F.ws + WS_VT); bf16_t* VNT = (bf16_t*)(F.ws + WS_VNT); bf16_t* CAT = (bf16_t*)(F.ws + WS_CAT);
    unsigned* ctr = (unsigned*)(F.ws + WS_CTR) + cidx;
    LAS float* rpb = (LAS float*)(F.lds + 112 * 1024);
    volatile LAS int* slot = (volatile LAS int*)(F.lds + 112 * 1024 + 8192);
    __syncthreads();
    for (int i = F.tid; i < 4 * 465; i += NT) rpb[i] = F.inp(13)[layer * 4 * 465 + i] * LOG2E;
    for (int step = 0;; ++step) {
        int idx;
        if (step < 2) idx = F.vcu + 256 * step;
        else {
            __syncthreads();
            if (F.tid == 0) *slot = (int)atomicAdd(ctr, 1u);
            __syncthreads();
            idx = 512 + *slot;
        }
        if (idx >= nitems) break;
        AttnItem it; it.kr = nullptr; it.mode = 0; it.r0 = 0; it.hn = 0; it.nctx = 4;
        if (idx < 512 || (idx >= 768 && idx < 800)) {
            int b, h, row0;
            if (idx < 512) { b = idx >> 7; h = (idx >> 4) & 7; row0 = b * 4096 + (idx & 15) * 256; it.t0 = 0; it.ntl = 64; }
            else { const int j = idx - 768; b = j >> 3; h = j & 7; row0 = ML + b * 256; it.t0 = 0; it.ntl = 0; }
            it.q = Q + (size_t)row0 * 1536 + h * 192; it.ldq = 1536;
            it.kn = KN + h * 128; it.ldk = 1024; it.kr = U + U_KR;
            it.vt = VT + (size_t)(b * 8 + h) * 128 * KEYS;
            it.o = CAT + (size_t)row0 * D + h * 128; it.ldo = D;
            it.lat_row0 = b * 4096; it.ctx_row0 = ML + b * 256;
            attn_item<192>(F, it, rpb);
        } else {
            int b, hn, row0;
            if (idx < 768) { const int j = idx - 512; b = j >> 6; hn = (j >> 4) & 3; const int R = j & 15; row0 = b * 4096 + R * 256;
                const int rlo = max(4 * R - 4, 0), rhi = min(max(4 * R - 1, 0), 56) + 7; it.t0 = rlo; it.ntl = rhi - rlo + 1; it.mode = 1; it.r0 = 4 * R; it.hn = hn; }
            else { const int j = idx - 800; b = j >> 2; hn = j & 3; row0 = ML + b * 256; it.t0 = 0; it.ntl = 0; }
            it.q = U + (size_t)row0 * UC + U_QN + hn * 128; it.ldq = UC;
            it.kn = U + U_KN + hn * 128; it.ldk = UC;
            it.vt = VNT + (size_t)(b * 4 + hn) * 128 * KEYS;
            it.o = CAT + (size_t)row0 * D + 1024 + hn * 128; it.ldo = D;
            it.lat_row0 = b * 4096; it.ctx_row0 = ML + b * 256;
            attn_item<128>(F, it, rpb);
        }
    }
}


#define XB_TMO      128
#define XB_XCNT(j)  (256  + 64 * (j))
#define XB_XSUB(j)  (1280 + 64 * (j))
#define XB_XGEN(j)  (2304 + 64 * (j))
#define XB_TOP      3328
#define XB_TOPGEN   3392
#define XCD_BAR_WORDS 3456
#define XB_SPIN_CAP (1u << 18)
__device__ __forceinline__ unsigned xb_ld(unsigned* p)              { return __hip_atomic_load(p, __ATOMIC_RELAXED, __HIP_MEMORY_SCOPE_AGENT); }
__device__ __forceinline__ unsigned xb_add(unsigned* p, unsigned v) { return __hip_atomic_fetch_add(p, v, __ATOMIC_RELAXED, __HIP_MEMORY_SCOPE_AGENT); }
__device__ __forceinline__ unsigned xb_xcc_id() { return (unsigned)__builtin_amdgcn_s_getreg((3 << 11) | 20) & 0xFu; }
#define XB_SPIN(cond, bar) do { unsigned _sp = 0; while (cond) { __builtin_amdgcn_s_sleep(1); \
    if ((++_sp & 255u) == 0u) { if (xb_ld(&(bar)[XB_TMO])) break; if (_sp > XB_SPIN_CAP) { atomicAdd(&(bar)[XB_TMO], 1u); break; } } } } while (0)
struct XcdBarrier { unsigned* bar; unsigned x; volatile LAS unsigned* st; };
__device__ __forceinline__ XcdBarrier xcd_barrier_post(unsigned* bar, volatile LAS unsigned* st) {
    XcdBarrier b; b.bar = bar; b.x = xb_xcc_id(); b.st = st;
    if (threadIdx.x == 0) (void)xb_add(&bar[XB_XCNT(b.x)], 1u);
    return b;
}
__device__ __forceinline__ void xcd_barrier_complete(unsigned* bar, unsigned x, unsigned& nloc, unsigned& nx) {
    const unsigned G = gridDim.x * gridDim.y * gridDim.z;
    unsigned sum, cnt, mine, sp = 0u;
    for (;;) {
        sum = 0u; cnt = 0u; mine = 0u;
#pragma unroll
        for (unsigned j = 0; j < 16; ++j) { const unsigned c = xb_ld(&bar[XB_XCNT(j)]); sum += c; cnt += (c > 0u) ? 1u : 0u; mine = (j == x) ? c : mine; }
        if (sum == G) break;
        __builtin_amdgcn_s_sleep(1);
        if ((++sp & 255u) == 0u) { if (xb_ld(&bar[XB_TMO])) break; if (sp > XB_SPIN_CAP) { atomicAdd(&bar[XB_TMO], 1u); break; } }
    }
    nloc = mine > 0u ? mine : 1u; nx = cnt > 0u ? cnt : 1u;
}
__device__ __forceinline__ void xcd_barrier(const XcdBarrier& b) {
    asm volatile("s_waitcnt vmcnt(0)" ::: "memory");
    __syncthreads();
    if (threadIdx.x == 0) {
        unsigned* bar = b.bar;
        __builtin_amdgcn_s_waitcnt(0);
        unsigned nloc = b.st[0], nx = b.st[1];
        if (nloc == 0u) { xcd_barrier_complete(bar, b.x, nloc, nx); b.st[0] = nloc; b.st[1] = nx; }
        const unsigned old = xb_add(&bar[XB_XSUB(b.x)], 1u);
        const unsigned gen = old / nloc;
        if (old + 1u == (gen + 1u) * nloc) {
            __builtin_amdgcn_fence(__ATOMIC_RELEASE, "agent");
            asm volatile("s_waitcnt vmcnt(0)" ::: "memory");
            const unsigned og = xb_add(&bar[XB_TOP], 1u);
            const unsigned tg = og / nx;
            if (og + 1u == (tg + 1u) * nx) xb_add(&bar[XB_TOPGEN], 1u);
            else XB_SPIN(xb_ld(&bar[XB_TOPGEN]) == tg, bar);
            __builtin_amdgcn_fence(__ATOMIC_ACQUIRE, "agent");
            xb_add(&bar[XB_XGEN(b.x)], 1u);
            asm volatile("s_waitcnt vmcnt(0)" ::: "memory");
        } else {
            XB_SPIN(xb_ld(&bar[XB_XGEN(b.x)]) == gen, bar);
            __builtin_amdgcn_fence(__ATOMIC_ACQUIRE, "agent");
            asm volatile("s_waitcnt vmcnt(0)" ::: "memory");
        }
    }
    __syncthreads();
}

#ifndef PHMASK
#define PHMASK 0x7ff
#endif
#define PH(k) (((PHMASK) >> (k)) & 1)
#ifndef DUPMASK
#define DUPMASK 0x000
#endif
#define REP(k) for (int rep_ = 0, nrep_ = F.nrep((DUPMASK >> (k)) & 1); rep_ < nrep_; ++rep_)
#define Hbuf ((bf16_t*)(F.ws + WS_H))
#define H (Hbuf + D)
#define X ((bf16_t*)(F.ws + WS_X))
#define U ((bf16_t*)(F.ws + WS_U))
#define SSQ ((float*)(F.ws + WS_SSQ))
#define CAT ((bf16_t*)(F.ws + WS_CAT))
#define mod ((const float*)(F.ws + WS_MOD))
#define rope ((const f32x2*)(F.ws + WS_ROPE))
#define GSYNC() do { F.refresh(); { XcdBarrier xb_{(unsigned*)(F.ws + WS_BAR), xb_xcc_id(), (volatile LAS unsigned*)(F.lds + 135 * 1024)}; xcd_barrier(xb_); } F.refresh(); } while (0)
DI void layer_body(Frame& F, const int l) {
        const int Mq = l == 0 ? MT : ML;
#define modl (mod + (size_t)l * 5 * 12288)
#define xbl (l == 0 ? (const bf16_t*)nullptr : (const bf16_t*)X)
        REP(1) {
        if (PH(1)) norm_phase(F, F.inp(0), F.inp(2), xbl, MT, F.inp(6) + l * D, modl, 0, 2048, H, nullptr);
        GSYNC(); }
        REP(2) {
        { pg8::Gemm g{H, (const bf16_t*)(F.ws + WS_WIN) + (size_t)l * UC * D, D, D, D, 0};
          pg8::Sched S; S.init(MT / 256, UC / 256, F.G, F.vcu, 0);
          EpiU E{U, SSQ, (bf16_t*)(F.ws + WS_VNT), rope, 0.08838834764831845f * LOG2E, (bf16_t*)F.outp() + DO_FF};
          if (PH(2)) pg8::gemm_phase(F.lds, g, S, E); }
        GSYNC(); }
        REP(3) {
        { int start = 0;
          { pg8::Gemm g{U + U_CQ, (const bf16_t*)(F.ws + WS_WUQ) + (size_t)l * 1536 * 512, UC, 512, 512, 0};
            pg8::Sched S; S.init(Mq / 256, 6, F.G, F.vcu, start); start += (Mq / 256) * 6;
            EpiQ E{(bf16_t*)(F.ws + WS_Q), SSQ, rope, 0.07216878364870323f * LOG2E};
            if (PH(3)) pg8::gemm_phase(F.lds, g, S, E); }
          { pg8::Gemm g{U + U_CKV, (const bf16_t*)(F.ws + WS_WUKV) + (size_t)l * 2048 * 512, UC, 512, 512, 0};
            pg8::Sched S; S.init(MT / 256, 8, F.G, F.vcu, start); start += (MT / 256) * 8;
            EpiKV E{(bf16_t*)(F.ws + WS_KN), (bf16_t*)(F.ws + WS_VT), SSQ};
            if (PH(4)) pg8::gemm_phase(F.lds, g, S, E); }
          { pg8::Gemm g{(const bf16_t*)(F.ws + WS_WC) + (size_t)l * 1024 * 256, (const bf16_t*)F.outp() + DO_FF, 256, 1024, 256, 0};
            SchedY S; S.init(F.G, F.vcu, start); start += 144;
            EpiY E{(bf16_t*)(F.ws + WS_YT), (bf16_t*)(F.ws + WS_YTC), 0};
            if (PH(5)) pg8::gemm_phase(F.lds, g, S, E); }
          if (l == 0) { pg8::Gemm g{(const bf16_t*)(F.ws + WS_WC) + (size_t)l * 1024 * 256, (const bf16_t*)F.outp() + DO_FF + (size_t)ML * 1024, 256, 1024, 256, 0};
            pg8::Sched S; S.init(4, MC / 256, F.G, F.vcu, start); S.kobm = 256;
            EpiY E{(bf16_t*)(F.ws + WS_YT), (bf16_t*)(F.ws + WS_YTC), ML};
            if (PH(5)) pg8::gemm_phase(F.lds, g, S, E); } }
        GSYNC(); }
        REP(7) {
        if (F.vcu < 128 || (l == 0 && F.vcu < 136)) {
            const bool cx = F.vcu >= 128; const int ld = cx ? 512 : 4096;
            long zo = 0; asm volatile("" : "+s"(zo)); const bf16_t* dftp = (const bf16_t*)F.P.out + zo;
            pg8::Gemm g{dftp + (cx ? DO_DFTC : DO_DFT), (const bf16_t*)(F.ws + (cx ? WS_YTC : WS_YT)), ld, ld, ld, 0};
            pg8::OneUnit S; S.u.pm = cx ? 0 : (F.vcu & 15); S.u.pn = cx ? (F.vcu - 128) : (F.vcu >> 4); S.u.kob = 0; S.has = true;
            EpiF E{CAT, cx ? 1 : 0}; if (PH(6)) pg8::gemm_phase(F.lds, g, S, E); }
        if (PH(7)) mixer_attention(F, l, l + 2 * rep_);
        GSYNC(); }
        REP(8) {
        { pg8::Gemm g{CAT, (const bf16_t*)(F.ws + WS_WOUT) + (size_t)l * D * D, D, D, D, 0};
          pg8::Sched S; S.init(Mq / 256, 8, F.G, F.vcu, 0);
          EpiRes E{F.inp(0), F.inp(2), xbl, X, modl + 4096};
          if (PH(8)) pg8::gemm_phase(F.lds, g, S, E); }
        GSYNC(); }
        REP(4) {
        if (PH(1)) norm_phase(F, nullptr, nullptr, X, Mq, F.inp(7) + l * D, modl, 6144, 8192, H, nullptr);
        GSYNC(); }
        REP(10) {
        { pg8::Gemm g{Hbuf, (const bf16_t*)(F.ws + WS_WUP) + (size_t)l * 2 * DFF * D, D, D, D, 1};
          pg8::Sched S; S.init((Mq + 251) / 252, 44, F.G, F.vcu, 0);
          EpiConv E{(bf16_t*)(F.ws + WS_ACT), F.inp(17) + (size_t)l * 3 * 2 * DFF, F.inp(18) + (size_t)l * 2 * DFF, Mq};
          if (PH(10)) pg8::gemm_phase(F.lds, g, S, E); }
        GSYNC(); }
        { pg8::Gemm g{(const bf16_t*)(F.ws + WS_ACT), (const bf16_t*)(F.ws + WS_WDN) + (size_t)l * D * DFF, DFF, DFF, DFF, 0};
          pg8::Sched S; S.init(Mq / 256, 8, F.G, F.vcu, 0);
          EpiRes E{nullptr, nullptr, X, X, modl + 10240};
          if (PH(9)) pg8::gemm_phase(F.lds, g, S, E); }
        GSYNC();

}

__global__ void __launch_bounds__(NT) fwd_megakernel(Params p) {
    extern __shared__ __attribute__((aligned(16))) unsigned char lds_raw[];
    cg::grid_group grid = cg::this_grid();
    const int tid_ = threadIdx.x, G_ = gridDim.x, bx_ = blockIdx.x;
    Frame F{(LAS unsigned char*)lds_raw, lds_raw, tid_, tid_ & 63, __builtin_amdgcn_readfirstlane(tid_ >> 6), G_, (G_ % 8 == 0) ? (bx_ % 8) * (G_ / 8) + bx_ / 8 : bx_, p, p.ws};
    volatile LAS unsigned* xst = (volatile LAS unsigned*)(F.lds + 135 * 1024);
    if (F.tid == 0) { xst[0] = 0u; xst[1] = 0u; }
    __syncthreads();
    (void)xcd_barrier_post((unsigned*)(p.ws + WS_BAR), xst);
    REP(0) { if (PH(0)) { if (F.vcu & 1) { p_tables(F); p_mod(F); } else { p_mod(F); p_tables(F); }
    p_convert(F); }
    grid.sync(); F.refresh(); }

    for (int l = 0; l < 2; ++l) layer_body(F, l);
    if (PH(1)) norm_phase(F, nullptr, nullptr, X, ML, F.inp(20), nullptr, 0, 0, nullptr, F.outp());
}
#undef Hbuf
#undef H
#undef X
#undef U
#undef SSQ
#undef CAT
#undef mod
#undef rope
#undef modl
#undef xbl


extern "C" void kernel_launch(void* const* d_in, const int* in_sizes, int n_in, void* d_out, int out_size, void* d_ws, size_t ws_size, hipStream_t stream) {
    static int grid_blocks = 0;
    if (!grid_blocks) {
        int dev = 0, cus = 0, per_cu = 0;
        hipGetDevice(&dev);
        hipDeviceGetAttribute(&cus, hipDeviceAttributeMultiprocessorCount, dev);
        hipFuncSetAttribute((const void*)fwd_megakernel, hipFuncAttributeMaxDynamicSharedMemorySize, LDS_BYTES);
        hipOccupancyMaxActiveBlocksPerMultiprocessor(&per_cu, (const void*)fwd_megakernel, NT, LDS_BYTES);
        if (per_cu < 1) { fprintf(stderr, "occupancy query says %d blocks/CU\n", per_cu); per_cu = 1; }
        grid_blocks = cus;
        if (ws_size < WS_END) fprintf(stderr, "workspace too small: %zu < %zu\n", ws_size, (size_t)WS_END);
    }
    Params p{};
    for (int i = 0; i < 21; ++i) p.in[i] = (const float*)d_in[i];
    p.out = (float*)d_out; p.ws = (unsigned char*)d_ws;
    hipMemsetAsync((unsigned char*)d_ws + WS_BAR, 0, 16384, stream);
    void* args[] = {&p};
    hipError_t e = hipLaunchCooperativeKernel((const void*)fwd_megakernel, dim3(grid_blocks), dim3(NT), args, LDS_BYTES, stream);
    if (e != hipSuccess) fprintf(stderr, "cooperative launch failed: %s (grid %d)\n", hipGetErrorString(e), grid_blocks);
}
```

```cpp
#include <hip/hip_runtime.h>
#include <hip/hip_cooperative_groups.h>
#include <cstdio>
namespace cg = cooperative_groups;

#define LAS __attribute__((address_space(3)))
#define GAS __attribute__((address_space(1)))
template <class T> __device__ __forceinline__ T* as_global(T* p) { return p; }
#define DI __device__ __forceinline__
typedef unsigned short bf16_t;
typedef short bf16x8 __attribute__((ext_vector_type(8)));
typedef short s16x4 __attribute__((ext_vector_type(4)));
typedef float f32x4 __attribute__((ext_vector_type(4)));
typedef float f32x2 __attribute__((ext_vector_type(2)));
typedef float f32x16 __attribute__((ext_vector_type(16)));
typedef unsigned u32x4 __attribute__((ext_vector_type(4)));
typedef unsigned u32x2 __attribute__((ext_vector_type(2)));
typedef __bf16 bfv2 __attribute__((ext_vector_type(2)));

constexpr int D = 2048, NB = 4, SEQ = 4096, CTXL = 256, ML = NB * SEQ, MC = NB * CTXL, MT = ML + MC;
constexpr int INC = 3136, UC = 3328;
constexpr int U_CQ = 0, U_CKV = 512, U_QN = 1024, U_KN = 1536, U_VN = 2048, U_F = 2560, U_KR = 3072;
constexpr int DFF = 5632, KEYS = SEQ + CTXL;
constexpr size_t DO_DFT = 0, DO_DFTC = (size_t)4096 * 4096, DO_FF = DO_DFTC + 256 * 512;
static_assert((DO_FF + (size_t)(ML + MC) * 1024) * 2 <= (size_t)ML * 2048 * 4, "d_out scratch");
constexpr float EPS = 1e-6f, LOG2E = 1.4426950408889634f;
constexpr int NT = 512;
constexpr int LDS_BYTES = 136 * 1024;

constexpr size_t al(size_t x) { return (x + 255) & ~(size_t)255; }
constexpr size_t WS_WIN = 0;
constexpr size_t WS_WUQ = WS_WIN + al((size_t)2 * UC * D * 2);
constexpr size_t WS_WUKV = WS_WUQ + al((size_t)2 * 1536 * 512 * 2);
constexpr size_t WS_WOUT = WS_WUKV + al((size_t)2 * 4096 * 512 * 2);
constexpr size_t WS_WUP = WS_WOUT + al((size_t)2 * D * D * 2);
constexpr size_t WS_WDN = WS_WUP + al((size_t)2 * 2 * DFF * D * 2);
constexpr size_t WS_WC = WS_WDN + al((size_t)2 * D * DFF * 2);
constexpr size_t WS_DFTC = WS_WC + al((size_t)2 * 1024 * 1024 * 2);
constexpr size_t WS_TRIG = WS_DFTC + al((size_t)256 * 512 * 2);
constexpr size_t WS_ROPE = WS_TRIG + al(4096 * 8);
constexpr size_t WS_MOD = WS_ROPE + al(64 * 16 * 8);
constexpr size_t WS_CTR = WS_MOD + al((size_t)2 * 5 * 12288 * 4);
constexpr size_t WS_BAR = WS_CTR + 256;
constexpr size_t WS_X = WS_BAR + 16384;
constexpr size_t WS_H = WS_X + al((size_t)MT * D * 4);
constexpr size_t H_ROWS = 1 + MT + 256;
constexpr size_t WS_CAT = WS_H + al(H_ROWS * D * 2);
constexpr size_t WS_YTC = WS_CAT + al((size_t)MT * D * 2);
constexpr size_t WS_U = WS_YTC + al((size_t)2048 * 512 * 2);
constexpr size_t WS_SSQ = WS_U + al((size_t)MT * UC * 2);
constexpr size_t WS_Q = WS_SSQ + al((size_t)MT * 16 * 4);
constexpr size_t WS_KN = WS_Q + al((size_t)MT * 1536 * 2);
constexpr size_t WS_VT = WS_KN + al((size_t)MT * 1024 * 2);
constexpr size_t WS_VNT = WS_VT + al((size_t)32 * 128 * KEYS * 2);
constexpr size_t WS_YT = WS_VNT + al((size_t)16 * 128 * KEYS * 2);
constexpr size_t WS_END = WS_YT + al((size_t)2048 * 8192 * 2);
constexpr size_t WS_ACT = WS_U;
static_assert(WS_ACT + (size_t)MT * DFF * 2 <= WS_END, "ACT alias");
static_assert((size_t)4096 * 8192 * 2 <= H_ROWS * D * 2, "DFT alias");
static_assert(WS_END <= (size_t)805306368, "workspace");

struct Params { const float* in[21]; float* out; unsigned char* ws; };

DI unsigned pk2(float a, float b) { f32x2 v = {a, b}; bfv2 r = __builtin_convertvector(v, bfv2); return __builtin_bit_cast(unsigned, r); }
DI bf16_t f2bf(float a) { return (bf16_t)(pk2(a, 0.f) & 0xffffu); }
DI float shx(float v, int m, int lane) { return __builtin_bit_cast(float, __builtin_amdgcn_ds_bpermute((lane ^ m) << 2, __builtin_bit_cast(int, v))); }
DI f32x4 bf4(u32x2 w) { f32x4 r; r[0] = __builtin_bit_cast(float, w.x << 16); r[1] = __builtin_bit_cast(float, w.x & 0xffff0000u); r[2] = __builtin_bit_cast(float, w.y << 16); r[3] = __builtin_bit_cast(float, w.y & 0xffff0000u); return r; }
DI float sq4(f32x4 v) { return (v[0] * v[0] + v[1] * v[1]) + (v[2] * v[2] + v[3] * v[3]); }
DI u32x4 pk8(f32x4 a, f32x4 b) { u32x4 w; w.x = pk2(a[0], a[1]); w.y = pk2(a[2], a[3]); w.z = pk2(b[0], b[1]); w.w = pk2(b[2], b[3]); return w; }

namespace pg8 {
constexpr int BM = 256, BK = 64, HALF = 128, HTB = HALF * BK * 2, STAGE_BYTES = 8 * HTB;
DI int lds_byte(int r, int c) { const int st = (r >> 4) * 2 + (c >> 5), rr = r & 15, cc = c & 31, ob = rr * 64 + cc * 2; return st * 1024 + (ob ^ (((ob >> 9) & 1) << 5)); }
DI void stage_rc(int b, int& R, int& C) { const int st = b / 1024, sb = b % 1024, swz = sb ^ (((sb >> 9) & 1) << 5); R = (st >> 1) * 16 + swz / 64; C = (st & 1) * 32 + (swz % 64) / 2; }
DI int perm32(int rho) { const int n = rho >> 4, i = rho & 15; return 8 * (i >> 2) + 4 * n + (i & 3); }
struct Unit { int pm, pn, kob; };
struct Gemm { const bf16_t* A; const bf16_t* Bt; int lda, ldb, K; int conv; };

struct Sched {
    int nM, nN, cnt, G, c, i0, start, kobm = 0;
    DI void init(int nM_, int nN_, int G_, int c_, int start_) { nM = nM_; nN = nN_; cnt = nM * nN; G = G_; c = c_; start = start_;
        i0 = (start_ > c_) ? (start_ - c_ + G_ - 1) / G_ : 0; }
    DI bool next(int i, Unit& u) const {
        const long L = (long)(i0 + i) * G + c - start; if (L >= cnt) return false;
        const int w = (int)L, nig = 8 * nN, gid = w / nig, fm = gid * 8, gsz = (nM - fm) < 8 ? (nM - fm) : 8;
        u.pm = fm + ((w % nig) % gsz); u.pn = (w % nig) / gsz; u.kob = kobm * u.pm; return true;
    }
};
struct OneUnit { Unit u; bool has; DI bool next(int i, Unit& o) const { o = u; return has && i == 0; } };

template <class Epi, class SchedT>
DI void gemm_phase(LAS unsigned char* lds, const Gemm g, const SchedT& S, const Epi& E) {
    int tid = threadIdx.x; asm volatile("" : "+v"(tid));
    const int wid = __builtin_amdgcn_readfirstlane(tid >> 6), lane = tid & 63, wr = wid >> 2, wc = wid & 3, fr = lane & 15, fq = lane >> 4;
    const int K = g.K, nt = K / BK;
    unsigned voffA[2], voffB[2];
    auto mk_voff = [&]() { int t2 = threadIdx.x; asm volatile("" : "+v"(t2));
#pragma unroll
        for (int i = 0; i < 2; ++i) { int R, C; stage_rc(t2 * 16 + i * 8192, R, C); const int Rb = Epi::PERM ? ((R & ~31) + perm32(R & 31)) : R;
            const int Ra = g.conv ? ((R >> 6) * 126 + (R & 63)) : R;
            voffA[i] = (unsigned)(Ra * g.lda + C) * 2u; voffB[i] = (unsigned)(Rb * g.ldb + C) * 2u; } };
    mk_voff();
    const size_t kstep = (size_t)(BK * 2);
    const size_t hstepA = (size_t)(g.conv ? 64 : HALF) * g.lda * 2, hstepB = (size_t)HALF * g.ldb * 2;
    const size_t tstepA = g.conv ? (size_t)252 * g.lda * 2 : 2 * hstepA, tstepB = 2 * hstepB;
    const unsigned ldsw = (unsigned)wid * 1024u;
    const int aoff = lds_byte(wr * 64 + fr, fq * 8), boff = lds_byte(wc * 32 + fr, fq * 8);
#define PG8_SA(b, h) (((b) * 2 + (h)) * HTB)
#define PG8_SB(b, h) ((4 + (b) * 2 + (h)) * HTB)
#define PG8_STAGE(bufoff, gbase, voff) do { _Pragma("unroll") for (int _i = 0; _i < 2; ++_i) \
        __builtin_amdgcn_global_load_lds((const unsigned*)((const char*)(gbase) + (voff)[_i]), (LAS unsigned*)(lds + (bufoff) + ldsw + _i * 8192), 16, 0, 0); } while (0)
#define PG8_LDA(dst, b, h) do { _Pragma("unroll") for (int m = 0; m < 4; ++m) _Pragma("unroll") for (int k = 0; k < 2; ++k) dst[m][k] = *(const LAS bf16x8*)(lds + PG8_SA(b, h) + aoff + m * 2048 + k * 1024); } while (0)
#define PG8_LDB(dst, b, h) do { _Pragma("unroll") for (int n = 0; n < 2; ++n) _Pragma("unroll") for (int k = 0; k < 2; ++k) dst[n][k] = *(const LAS bf16x8*)(lds + PG8_SB(b, h) + boff + n * 2048 + k * 1024); } while (0)
#define PG8_MMA(ai, bj, At, Bt) do { __builtin_amdgcn_s_setprio(1); _Pragma("unroll") for (int m = 0; m < 4; ++m) _Pragma("unroll") for (int n = 0; n < 2; ++n) _Pragma("unroll") for (int k = 0; k < 2; ++k) \
        acc[ai][bj][m][n] = __builtin_amdgcn_mfma_f32_16x16x32_bf16(Bt[n][k], At[m][k], acc[ai][bj][m][n], 0, 0, 0); __builtin_amdgcn_s_setprio(0); } while (0)
#define PG8_WAIT_V(n) asm volatile("s_waitcnt vmcnt(" #n ")" ::: "memory")
#define PG8_WAIT_L(n) asm volatile("s_waitcnt lgkmcnt(" #n ")" ::: "memory")
#define PG8_BAR __builtin_amdgcn_s_barrier()
#define PG8_SCHED __builtin_amdgcn_sched_barrier(0)
    Unit cur, nxt; int ui = 0;
    if (!S.next(0, cur)) return;
    f32x4 acc[2][2][4][2];
#pragma unroll
    for (int a = 0; a < 2; ++a)
#pragma unroll
        for (int b = 0; b < 2; ++b)
#pragma unroll
            for (int m = 0; m < 4; ++m)
#pragma unroll
                for (int n = 0; n < 2; ++n) acc[a][b][m][n] = (f32x4){0.f, 0.f, 0.f, 0.f};
    bf16x8 At[4][2], B0[2][2], B1[2][2];
    const char* cA = (const char*)g.A + (size_t)cur.pm * tstepA; const char* cB = (const char*)g.Bt + (size_t)cur.pn * tstepB + (size_t)cur.kob * 2;
    PG8_STAGE(PG8_SB(0, 0), cB, voffB); PG8_STAGE(PG8_SA(0, 0), cA, voffA); PG8_STAGE(PG8_SB(0, 1), cB + hstepB, voffB); PG8_STAGE(PG8_SA(0, 1), cA + hstepA, voffA);
    if (wr == 1) PG8_BAR;
    PG8_WAIT_V(4); PG8_BAR;
    PG8_STAGE(PG8_SB(1, 0), cB + kstep, voffB); PG8_STAGE(PG8_SA(1, 0), cA + kstep, voffA); PG8_STAGE(PG8_SB(1, 1), cB + hstepB + kstep, voffB);
    PG8_WAIT_V(6); PG8_BAR;
    for (;;) {
        const bool has_next = S.next(ui + 1, nxt);
        const char* nA = has_next ? (const char*)g.A + (size_t)nxt.pm * tstepA : cA; const char* nB = has_next ? (const char*)g.Bt + (size_t)nxt.pn * tstepB + (size_t)nxt.kob * 2 : cB;
        for (int t = 0; t < nt; t += 2) {
            const bool last = (t == nt - 2);
            const char* a1 = cA + (size_t)(t + 1) * kstep;
            const char* a2 = last ? nA : cA + (size_t)(t + 2) * kstep; const char* b2 = last ? nB : cB + (size_t)(t + 2) * kstep;
            const char* a3 = a2 + kstep; const char* b3 = b2 + kstep;
            PG8_LDB(B0, 0, 0); PG8_SCHED; PG8_LDA(At, 0, 0); PG8_STAGE(PG8_SA(1, 1), a1 + hstepA, voffA);
            PG8_WAIT_L(8); PG8_BAR; PG8_WAIT_L(0); PG8_MMA(0, 0, At, B0); PG8_BAR; PG8_SCHED;
            PG8_LDB(B1, 0, 1); PG8_STAGE(PG8_SB(0, 0), b2, voffB);
            PG8_BAR; PG8_WAIT_L(0); PG8_MMA(0, 1, At, B1); PG8_BAR;
            PG8_LDA(At, 0, 1); PG8_STAGE(PG8_SA(0, 0), a2, voffA);
            PG8_BAR; PG8_WAIT_L(0); PG8_MMA(1, 0, At, B0); PG8_BAR; PG8_SCHED;
            PG8_STAGE(PG8_SB(0, 1), b2 + hstepB, voffB);
            PG8_WAIT_V(6); PG8_BAR; PG8_MMA(1, 1, At, B1); PG8_BAR;
            PG8_LDB(B0, 1, 0); PG8_SCHED; PG8_LDA(At, 1, 0); PG8_STAGE(PG8_SA(0, 1), a2 + hstepA, voffA);
            PG8_WAIT_L(8); PG8_BAR; PG8_WAIT_L(0); PG8_MMA(0, 0, At, B0); PG8_BAR; PG8_SCHED;
            PG8_LDB(B1, 1, 1); PG8_STAGE(PG8_SB(1, 0), b3, voffB);
            PG8_BAR; PG8_WAIT_L(0); PG8_MMA(0, 1, At, B1); PG8_BAR;
            PG8_LDA(At, 1, 1); PG8_STAGE(PG8_SA(1, 0), a3, voffA);
            PG8_BAR; PG8_WAIT_L(0); PG8_MMA(1, 0, At, B0); PG8_BAR; PG8_SCHED;
            PG8_STAGE(PG8_SB(1, 1), b3 + hstepB, voffB);
            PG8_WAIT_V(6); PG8_BAR; PG8_MMA(1, 1, At, B1); PG8_BAR;
        }
        { int fr2 = fr, fq2 = fq, wr2 = wr, wc2 = wc; asm volatile("" : "+v"(fr2), "+v"(fq2), "+s"(wr2), "+s"(wc2));
          E(acc, cur, wr2, wc2, fr2, fq2); }
        if (has_next) mk_voff();
        if (!has_next) break;
#pragma unroll
        for (int a = 0; a < 2; ++a)
#pragma unroll
            for (int b = 0; b < 2; ++b)
#pragma unroll
                for (int m = 0; m < 4; ++m)
#pragma unroll
                    for (int n = 0; n < 2; ++n) acc[a][b][m][n] = (f32x4){0.f, 0.f, 0.f, 0.f};
        cur = nxt; cA = nA; cB = nB; ++ui;
    }
    PG8_WAIT_V(0);
    if (wr == 0) PG8_BAR;
    PG8_BAR;
#undef PG8_SA
#undef PG8_SB
#undef PG8_STAGE
#undef PG8_LDA
#undef PG8_LDB
#undef PG8_MMA
#undef PG8_WAIT_V
#undef PG8_WAIT_L
#undef PG8_BAR
#undef PG8_SCHED
}
}
using pg8::Unit;
typedef const f32x4 (&AccRef)[2][2][4][2];

DI void row_bk(int row, int& b, int& key) { if (row < ML) { b = row >> 12; key = row & 4095; } else { const int rc = row - ML; b = rc >> 8; key = SEQ + (rc & 255); } }
DI void rope8(f32x4& v0, f32x4& v1, int row, int axis, int fq, int lane, const f32x2* rope) {
    const int l = row & 4095, pos = axis ? (l & 63) : (l >> 6);
    const f32x2* t = rope + pos * 16 + 8 * (fq & 1);
    const float sgn = (fq < 2) ? -1.f : 1.f;
#pragma unroll
    for (int j = 0; j < 4; ++j) {
        const float p0 = shx(v0[j], 32, lane), p1 = shx(v1[j], 32, lane);
        const f32x2 c0 = t[j], c1 = t[4 + j];
        v0[j] = v0[j] * c0.x + sgn * p0 * c0.y; v1[j] = v1[j] * c1.x + sgn * p1 * c1.y;
    }
}

struct EpiU {
    static constexpr bool PERM = true;
    bf16_t* U; float* ssq; bf16_t* VnT; const f32x2* rope; float qscale; bf16_t* FF;
    DI void operator()(AccRef acc, const Unit& u, int wr, int wc, int fr, int fq) const {
        const int pn = u.pn, rowb = u.pm * 256 + wr * 64 + fr;
        if (pn == 10 || pn == 11) {
#pragma unroll
            for (int ai = 0; ai < 2; ++ai)
#pragma unroll
                for (int m = 0; m < 4; ++m) { const int row = rowb + ai * 128 + m * 16; const int mrow = row < ML ? ((row & ~4095) | ((4096 - (row & 4095)) & 4095)) : row;
#pragma unroll
                    for (int bj = 0; bj < 2; ++bj) { const int c = 256 * (2 * (pn - 10) + bj) + 32 * wc + 8 * fq; const u32x4 w = pk8(acc[ai][bj][m][0], acc[ai][bj][m][1]);
                        *(u32x4*)(FF + (size_t)row * 1024 + c) = w;
                        *(u32x4*)(FF + (size_t)mrow * 1024 + 128 + c) = (row < ML) ? w : (u32x4){0u, 0u, 0u, 0u}; } }
            return;
        }
        if (pn == 8 || pn == 9) {
#pragma unroll
            for (int ai = 0; ai < 2; ++ai)
#pragma unroll
                for (int m = 0; m < 4; ++m) { int b, key; row_bk(rowb + ai * 128 + m * 16, b, key);
#pragma unroll
                    for (int bj = 0; bj < 2; ++bj) { const int hn = 2 * (pn - 8) + bj;
#pragma unroll
                        for (int n = 0; n < 2; ++n) { bf16_t* dst = VnT + ((size_t)((b * 4 + hn) * 128 + 32 * wc + 8 * fq + 4 * n)) * KEYS + key;
#pragma unroll
                            for (int j = 0; j < 4; ++j) dst[(size_t)j * KEYS] = f2bf(acc[ai][bj][m][n][j]); } } }
            return;
        }
        const float sc = (pn == 4 || pn == 5) ? qscale : 1.f;
#pragma unroll
        for (int ai = 0; ai < 2; ++ai)
#pragma unroll
            for (int m = 0; m < 4; ++m) { const int row = rowb + ai * 128 + m * 16; float ss = 0.f;
#pragma unroll
                for (int bj = 0; bj < 2; ++bj) { f32x4 v0 = acc[ai][bj][m][0] * sc, v1 = acc[ai][bj][m][1] * sc;
                    if (pn == 12 && bj == 0 && wc < 2 && row < ML) rope8(v0, v1, row, wc & 1, fq, fq * 16 + fr, rope);
                    ss += sq4(v0) + sq4(v1);
                    *(u32x4*)(U + (size_t)row * UC + 256 * pn + 128 * bj + 32 * wc + 8 * fq) = pk8(v0, v1); }
                if (pn < 4) { ss += shx(ss, 16, fq * 16 + fr); ss += shx(ss, 32, fq * 16 + fr); if (fq == 0) ssq[(size_t)row * 16 + pn * 4 + wc] = ss; } }
    }
};
DI float row_rstd(const float* ssq, int row, int which) { const f32x4 a = *(const f32x4*)(ssq + (size_t)row * 16 + which * 8), b = *(const f32x4*)(ssq + (size_t)row * 16 + which * 8 + 4);
    const float s = ((a[0] + a[1]) + (a[2] + a[3])) + ((b[0] + b[1]) + (b[2] + b[3])); return __builtin_amdgcn_rsqf(s * (1.f / 512.f) + EPS); }
struct EpiQ {
    static constexpr bool PERM = true;
    bf16_t* Q; const float* ssq; const f32x2* rope; float scale;
    DI void operator()(AccRef acc, const Unit& u, int wr, int wc, int fr, int fq) const {
        const int rowb = u.pm * 256 + wr * 64 + fr;
#pragma unroll
        for (int ai = 0; ai < 2; ++ai)
#pragma unroll
            for (int m = 0; m < 4; ++m) { const int row = rowb + ai * 128 + m * 16; const float rs = row_rstd(ssq, row, 0) * scale;
#pragma unroll
                for (int bj = 0; bj < 2; ++bj) { const int c32 = 256 * u.pn + 128 * bj + 32 * wc; f32x4 v0 = acc[ai][bj][m][0] * rs, v1 = acc[ai][bj][m][1] * rs;
                    if (((c32 >> 6) % 3) == 2 && row < ML) rope8(v0, v1, row, (c32 >> 5) & 1, fq, fq * 16 + fr, rope);
                    *(u32x4*)(Q + (size_t)row * 1536 + c32 + 8 * fq) = pk8(v0, v1); } }
    }
};
struct EpiKV {
    static constexpr bool PERM = true;
    bf16_t* KN; bf16_t* VT; const float* ssq;
    DI void operator()(AccRef acc, const Unit& u, int wr, int wc, int fr, int fq) const {
        const int pn = u.pn, rowb = u.pm * 256 + wr * 64 + fr;
#pragma unroll
        for (int ai = 0; ai < 2; ++ai)
#pragma unroll
            for (int m = 0; m < 4; ++m) { const int row = rowb + ai * 128 + m * 16; const float rs = row_rstd(ssq, row, 1); int b, key; row_bk(row, b, key);
#pragma unroll
                for (int bj = 0; bj < 2; ++bj) {
                    if (pn < 4) { *(u32x4*)(KN + (size_t)row * 1024 + 256 * pn + 128 * bj + 32 * wc + 8 * fq) = pk8(acc[ai][bj][m][0] * rs, acc[ai][bj][m][1] * rs); }
                    else { const int h = 2 * (pn - 4) + bj;
#pragma unroll
                        for (int n = 0; n < 2; ++n) { bf16_t* dst = VT + ((size_t)((b * 8 + h) * 128 + 32 * wc + 8 * fq + 4 * n)) * KEYS + key;
#pragma unroll
                            for (int j = 0; j < 4; ++j) dst[(size_t)j * KEYS] = f2bf(acc[ai][bj][m][n][j] * rs); } } } }
    }
};
struct EpiY {
    static constexpr bool PERM = true;
    bf16_t* YT; bf16_t* YTc; int tok_base;
    DI void operator()(AccRef acc, const Unit& u, int wr, int wc, int fr, int fq) const {
        const int g = u.pm;
#pragma unroll
        for (int ai = 0; ai < 2; ++ai)
#pragma unroll
            for (int m = 0; m < 4; ++m) { const int d = 64 * wr + 16 * m + fr;
#pragma unroll
                for (int bj = 0; bj < 2; ++bj) { const int tok = tok_base + 256 * u.pn + 128 * bj + 32 * wc + 8 * fq; const u32x4 w = pk8(acc[ai][bj][m][0], acc[ai][bj][m][1]);
                    if (tok < ML) { const int b = tok >> 12, l = tok & 4095; bf16_t* rowp = YT + ((size_t)((b * 4 + g) * 128 + d)) * 4096;
                        if (l < 2048) {
                            if (ai == 0) *(u32x4*)(rowp + l) = w;
                            else if (l != 0) *(u32x4*)(rowp + 2048 + l) = w;
                            else { bf16_t* q = rowp + 2048; q[1] = (bf16_t)(w.x >> 16); q[2] = (bf16_t)w.y; q[3] = (bf16_t)(w.y >> 16); q[4] = (bf16_t)w.z; q[5] = (bf16_t)(w.z >> 16); q[6] = (bf16_t)w.w; q[7] = (bf16_t)(w.w >> 16); }
                        } else if (l == 2048 && ai == 0) rowp[2048] = (bf16_t)w.x;
                    } else { const int tc = tok - ML, b = tc >> 8, l = tc & 255; *(u32x4*)(YTc + ((size_t)((b * 4 + g) * 128 + d)) * 512 + ai * 256 + l) = w; } } }
    }
};
struct SchedY {
    int G, c, i0, start;
    DI void init(int G_, int c_, int start_) { G = G_; c = c_; start = start_; i0 = (start_ > c_) ? (start_ - c_ + G_ - 1) / G_ : 0; }
    DI bool next(int i, Unit& u) const { const int L = (i0 + i) * G + c - start; if (L >= 144) return false; const int bt = L >> 2; u.pm = L & 3; u.pn = (bt / 9) * 16 + (bt % 9); u.kob = 256 * u.pm; return true; }
};
struct EpiF {
    static constexpr bool PERM = true;
    bf16_t* CAT; int ctx;
    DI void operator()(AccRef acc, const Unit& u, int wr, int wc, int fr, int fq) const {
        const int b = u.pn >> 1;
#pragma unroll
        for (int ai = 0; ai < 2; ++ai)
#pragma unroll
            for (int m = 0; m < 4; ++m) { const int lp = u.pm * 256 + 128 * ai + 64 * wr + 16 * m + fr; const int row = ctx ? (ML + b * 256 + lp) : (b * 4096 + lp);
#pragma unroll
                for (int bj = 0; bj < 2; ++bj) { const int g = 2 * (u.pn & 1) + bj;
                    *(u32x4*)(CAT + (size_t)row * D + 1536 + g * 128 + 32 * wc + 8 * fq) = pk8(acc[ai][bj][m][0], acc[ai][bj][m][1]); } }
    }
};
struct EpiRes {
    static constexpr bool PERM = false;
    const float* xl; const float* xc; const bf16_t* xb; bf16_t* out; const float* gate;
    DI void operator()(AccRef acc, const Unit& u, int wr, int wc, int fr, int fq) const {
        const int row0 = u.pm * 256; const int midx = row0 < ML ? (row0 >> 12) : 4;
        const float* src = row0 < ML ? xl : (xc - (size_t)ML * D);
        const float* gp = gate + (size_t)midx * 12288;
        const int col0 = u.pn * 256 + wc * 32 + 4 * fq;
        f32x4 gv[2][2];
#pragma unroll
        for (int bj = 0; bj < 2; ++bj)
#pragma unroll
            for (int n = 0; n < 2; ++n) gv[bj][n] = *(const f32x4*)(gp + col0 + bj * 128 + n * 16);
        if (xb) {
#pragma unroll
            for (int ai = 0; ai < 2; ++ai)
#pragma unroll
                for (int m = 0; m < 4; ++m) { const size_t off = (size_t)(row0 + wr * 64 + fr + ai * 128 + m * 16) * D + col0;
#pragma unroll
                    for (int bj = 0; bj < 2; ++bj)
#pragma unroll
                        for (int n = 0; n < 2; ++n) { const size_t o2 = off + bj * 128 + n * 16;
                            const f32x4 r = bf4(*(const u32x2*)(xb + o2)) + gv[bj][n] * acc[ai][bj][m][n];
                            u32x2 w; w.x = pk2(r[0], r[1]); w.y = pk2(r[2], r[3]); *(u32x2*)(out + o2) = w; }
                    asm volatile("" ::: "memory"); }
        } else {
#pragma unroll
            for (int ai = 0; ai < 2; ++ai)
#pragma unroll
                for (int m = 0; m < 4; ++m) { const size_t off = (size_t)(row0 + wr * 64 + fr + ai * 128 + m * 16) * D + col0;
#pragma unroll
                    for (int bj = 0; bj < 2; ++bj)
#pragma unroll
                        for (int n = 0; n < 2; ++n) { const size_t o2 = off + bj * 128 + n * 16;
                            const f32x4 r = *(const f32x4*)(src + o2) + gv[bj][n] * acc[ai][bj][m][n];
                            u32x2 w; w.x = pk2(r[0], r[1]); w.y = pk2(r[2], r[3]); *(u32x2*)(out + o2) = w; }
                    asm volatile("" ::: "memory"); }
        }
    }
};
DI float dpp_ror1(float v) { return __builtin_bit_cast(float, __builtin_amdgcn_update_dpp(0, __builtin_bit_cast(int, v), 0x121, 0xf, 0xf, false)); }
DI float dpp_ror15(float v) { return __builtin_bit_cast(float, __builtin_amdgcn_update_dpp(0, __builtin_bit_cast(int, v), 0x12f, 0xf, 0xf, false)); }
struct EpiConv {
    static constexpr bool PERM = true;
    bf16_t* ACT; const float* cw; const float* cb; int Mq;
    DI void operator()(AccRef acc, const Unit& u, int wr, int wc, int fr, int fq) const {
#pragma unroll
        for (int n = 0; n < 2; ++n) {
            const int cg_ = 128 * u.pn + 32 * wc + 8 * fq + 4 * n;
            f32x4 o[2][4];
#pragma unroll
            for (int bj = 0; bj < 2; ++bj) {
                const f32x4 w0 = *(const f32x4*)(cw + bj * DFF + cg_), w1 = *(const f32x4*)(cw + (size_t)2 * DFF + bj * DFF + cg_),
                            w2 = *(const f32x4*)(cw + (size_t)4 * DFF + bj * DFF + cg_), wb = *(const f32x4*)(cb + bj * DFF + cg_);
#pragma unroll
                for (int ai = 0; ai < 2; ++ai) {
                    const int tok0 = 252 * u.pm - 1 + 126 * wr + 64 * ai;
#pragma unroll
                    for (int m = 0; m < 4; ++m) {
                        const int tok = tok0 + 16 * m + fr; const int msk = tok < ML ? 4095 : 255;
                        const bool hu = (tok & msk) != 0, hd = ((tok + 1) & msk) != 0;
                        f32x4 r = acc[ai][bj][m][n] * w1 + wb;
                        f32x4 w0m, w2m;
#pragma unroll
                        for (int j = 0; j < 4; ++j) { w0m[j] = hu ? w0[j] : 0.f; w2m[j] = hd ? w2[j] : 0.f; }
#pragma unroll
                        for (int j = 0; j < 4; ++j) {
                            const float su = ((m > 0 || ai == 1) && fr == 15) ? (m > 0 ? acc[ai][bj][(m + 3) & 3][n][j] : acc[0][bj][3][n][j]) : acc[ai][bj][m][n][j];
                            const float sd = ((m < 3 || ai == 0) && fr == 0) ? (m < 3 ? acc[ai][bj][(m + 1) & 3][n][j] : acc[1][bj][0][n][j]) : acc[ai][bj][m][n][j];
                            float rj = r[j];
                            asm("s_nop 1\n\tv_fmac_f32_dpp %0, %1, %2 row_ror:1 row_mask:0xf bank_mask:0xf" : "+v"(rj) : "v"(su), "v"(w0m[j]));
                            asm("s_nop 1\n\tv_fmac_f32_dpp %0, %1, %2 row_ror:15 row_mask:0xf bank_mask:0xf" : "+v"(rj) : "v"(sd), "v"(w2m[j]));
                            r[j] = rj; }
                        if (bj == 0) {
#pragma unroll
                            for (int j = 0; j < 4; ++j) o[ai][m][j] = r[j] * __builtin_amdgcn_rcpf(1.f + __builtin_amdgcn_exp2f(-LOG2E * r[j]));
                        } else o[ai][m] = o[ai][m] * r;
                    }
                }
            }
#pragma unroll
            for (int ai = 0; ai < 2; ++ai) {
                const int tok0 = 252 * u.pm - 1 + 126 * wr + 64 * ai;
#pragma unroll
                for (int m = 0; m < 4; ++m) { const int li = 64 * ai + 16 * m + fr, tok = tok0 + 16 * m + fr;
                    if (li >= 1 && li <= 126 && tok < Mq) { u32x2 v; v.x = pk2(o[ai][m][0], o[ai][m][1]); v.y = pk2(o[ai][m][2], o[ai][m][3]);
                        *(u32x2*)(ACT + (size_t)tok * DFF + cg_) = v; } }
            }
        }
    }
};

struct Frame {
    LAS unsigned char* lds; unsigned char* ldsg; int tid, lane, wave, G, vcu;
    const Params& P; unsigned char* ws;
    DI const float* inp(int i) const { return as_global(P.in[i]); }
    DI float* outp() const { return as_global(P.out); }
    DI int nrep(int d) const { int n = 1 + d; asm volatile("" : "+s"(n)); return n; }
    DI void refresh() { int t = threadIdx.x; asm volatile("" : "+v"(t)); tid = t; lane = t & 63; wave = __builtin_amdgcn_readfirstlane(t >> 6);
        long z = 0; asm volatile("" : "+s"(z)); ws = P.ws + z;
        int g = gridDim.x, bx = blockIdx.x; asm volatile("" : "+s"(g), "+s"(bx)); G = g; vcu = (g % 8 == 0) ? (bx % 8) * (g / 8) + bx / 8 : bx; }
};

DI void p_mod(const Frame& F) {
    LAS float* sv = (LAS float*)F.lds; LAS float* red = sv + 5 * 2048;
    const float* c = F.inp(1); const float* cc = F.inp(3);
    for (int i = F.tid; i < 5 * 2048; i += NT) { const int r = i >> 11, k = i & 2047; const float v = r < 4 ? c[r * 2048 + k] : cc[k]; sv[i] = v / (1.f + __expf(-v)); }
    __syncthreads();
    float* mod = (float*)(F.ws + WS_MOD);
    for (int tile = F.vcu; tile < 192; tile += F.G) {
        const int l = tile / 96, colb = (tile % 96) * 128, c4 = F.tid & 31, kg = F.tid >> 5;
        const float* w = F.inp(4) + (size_t)l * 2048 * 12288 + colb + c4 * 4;
        f32x4 a0 = {0.f, 0.f, 0.f, 0.f}, a1 = a0, a2 = a0, a3 = a0, a4 = a0;
#pragma unroll 16
        for (int k = kg * 128; k < kg * 128 + 128; ++k) { const f32x4 wv = __builtin_nontemporal_load((const f32x4*)(w + (size_t)k * 12288));
            a0 += sv[k] * wv; a1 += sv[2048 + k] * wv; a2 += sv[4096 + k] * wv; a3 += sv[6144 + k] * wv; a4 += sv[8192 + k] * wv; }
        LAS float* rp = red + (kg * 32 + c4) * 20;
#pragma unroll
        for (int j = 0; j < 4; ++j) { rp[j] = a0[j]; rp[4 + j] = a1[j]; rp[8 + j] = a2[j]; rp[12 + j] = a3[j]; rp[16 + j] = a4[j]; }
        __syncthreads();
        for (int o = F.tid; o < 640; o += NT) { const int r = o >> 7, col = o & 127; float sacc = 0.f;
#pragma unroll
            for (int q = 0; q < 16; ++q) sacc += red[(q * 32 + (col >> 2)) * 20 + r * 4 + (col & 3)];
            mod[(size_t)(l * 5 + r) * 12288 + colb + col] = sacc + F.inp(5)[l * 12288 + colb + col]; }
        __syncthreads();
    }
}
DI void p_tables(const Frame& F) {
    const int gt = F.vcu * NT + F.tid, gn = F.G * NT;
    LAS f32x2* t4096 = (LAS f32x2*)F.lds;
    __syncthreads();
    for (int i = F.tid; i < 4096; i += NT) { f32x2 v; v.x = cospif((float)i / 2048.f); v.y = sinpif((float)i / 2048.f); t4096[i] = v; }
    __syncthreads();
    f32x2* rope = (f32x2*)(F.ws + WS_ROPE);
    for (int i = gt; i < 1024; i += gn) { const int pos = i >> 4, k = i & 15; const float fr = powf(10000.f, -(float)k / 16.f); const float a = (float)pos * fr; f32x2 v; v.x = cosf(a); v.y = sinf(a); rope[i] = v; }
    if (gt < 32) ((unsigned*)(F.ws + WS_CTR))[gt] = 0u;
    if (F.tid == 0) *(float**)(F.ws + WS_CTR + 128) = F.outp();
    bf16_t* dc = (bf16_t*)F.outp() + DO_DFTC;
    for (int i = gt; i < 256 * 512; i += gn) { const int lp = i >> 9, cc = i & 511, part = cc >> 8, l = cc & 255; const f32x2 t = t4096[((lp * l) & 255) * 16];
        dc[i] = f2bf((part ? -t.y : t.x) * (1.f / 16.f)); }
    bf16_t* wc = (bf16_t*)(F.ws + WS_WC); const float* wf = F.inp(14);
    for (int i = gt; i < 2 * 4 * 2 * 128 * 128; i += gn) {
        const int d = i & 127, cch = (i >> 7) & 127, part = (i >> 14) & 1, g = (i >> 15) & 3, l = i >> 17;
        const float* wp = wf + ((size_t)(l * 4 + g) * 128) * 128 + d; float sacc = 0.f;
        for (int c2 = 0; c2 < 128; ++c2) { const f32x2 t = t4096[((cch * c2) & 127) * 32]; sacc += (part ? t.y : t.x) * wp[(size_t)c2 * 128]; }
        sacc *= 0.08838834764831845f;
        bf16_t* row = wc + ((size_t)l * 1024 + (g * 2 + part) * 128 + d) * 256;
        row[cch] = f2bf(sacc); row[128 + cch] = f2bf(part ? -sacc : sacc);
    }
    bf16_t* dft = (bf16_t*)F.outp() + DO_DFT;
    for (int ch = gt; ch < 4096 * 512; ch += gn) { const int lp = ch >> 9, k0 = (ch & 511) * 8; f32x4 a, b;
#pragma unroll
        for (int j = 0; j < 8; ++j) { const int k = k0 + j; const f32x2 t = t4096[(lp * (k & 2047) + (k == 2048 ? lp * 2048 : 0)) & 4095];
            const float v = (k <= 2048 ? t.x : -t.y) * ((k == 0 || k == 2048) ? (1.f / 128.f) : (1.f / 64.f));
            if (j < 4) a[j] = v; else b[j - 4] = v; }
        *(u32x4*)(dft + (size_t)lp * 4096 + k0) = pk8(a, b); }
    __syncthreads();
}
struct CvDesc { const float* src; const float* kscale; bf16_t* dst; int K, Nsrc, Ndst, mapid, ntiles; };
DI int cv_map(int mapid, int n) {
    if (mapid == 1) return n < 1024 ? n : (n < 3072 ? n + 64 : (n < 3136 ? n - 2048 : -1));
    if (mapid == 2) { const int which = n >> 10, h = (n >> 7) & 7, j = n & 127; return h * 256 + which * 128 + j; }
    if (mapid == 3) { const int pn = n >> 8, bj = (n >> 7) & 1, q = n & 127; return bj * DFF + pn * 128 + q; }
    return n;
}
DI CvDesc cv_desc(const Frame& F, int m) {
    const int l = m / 6, j = m % 6; CvDesc d; d.kscale = nullptr; d.mapid = 0;
    if (j == 0) { d.src = F.inp(8) + (size_t)l * D * INC; d.K = D; d.Nsrc = INC; d.dst = (bf16_t*)(F.ws + WS_WIN) + (size_t)l * UC * D; d.Ndst = UC; d.mapid = 1; }
    else if (j == 1) { d.src = F.inp(10) + (size_t)l * 512 * 1536; d.K = 512; d.Nsrc = 1536; d.dst = (bf16_t*)(F.ws + WS_WUQ) + (size_t)l * 1536 * 512; d.Ndst = 1536; d.kscale = F.inp(9) + l * 512; }
    else if (j == 2) { d.src = F.inp(12) + (size_t)l * 512 * 2048; d.K = 512; d.Nsrc = 2048; d.dst = (bf16_t*)(F.ws + WS_WUKV) + (size_t)l * 2048 * 512; d.Ndst = 2048; d.kscale = F.inp(11) + l * 512; d.mapid = 2; }
    else if (j == 3) { d.src = F.inp(15) + (size_t)l * D * D; d.K = D; d.Nsrc = D; d.dst = (bf16_t*)(F.ws + WS_WOUT) + (size_t)l * D * D; d.Ndst = D; }
    else if (j == 4) { d.src = F.inp(16) + (size_t)l * D * 2 * DFF; d.K = D; d.Nsrc = 2 * DFF; d.dst = (bf16_t*)(F.ws + WS_WUP) + (size_t)l * 2 * DFF * D; d.Ndst = 2 * DFF; d.mapid = 3; }
    else { d.src = F.inp(19) + (size_t)l * DFF * D; d.K = DFF; d.Nsrc = D; d.dst = (bf16_t*)(F.ws + WS_WDN) + (size_t)l * D * DFF; d.Ndst = D; }
    d.ntiles = (d.Ndst / 128) * (d.K / 64); return d;
}
struct CvTile { const float* src; const float* kscale; bf16_t* dst; int K, Nsrc, sc0, sc1, n0, k0; bool ok; };
DI CvTile cv_tile(const Frame& F, int t) {
    CvTile r; r.ok = false;
    constexpr int NTN[6] = {26, 12, 16, 16, 88, 16}, NT_[6] = {26 * 32, 12 * 8, 16 * 8, 16 * 32, 88 * 32, 16 * 88};
    constexpr int PER_LAYER = NT_[0] + NT_[1] + NT_[2] + NT_[3] + NT_[4] + NT_[5];
    if (t >= 2 * PER_LAYER) return r;
    const int l = t >= PER_LAYER ? 1 : 0; t -= l * PER_LAYER;
    int j = 0, nt = 0, kt = 0;
#pragma unroll
    for (int q = 0; q < 6; ++q) { if (t >= 0 && t < NT_[q]) { j = q; nt = t % NTN[q]; kt = t / NTN[q]; } t -= NT_[q]; }
    const CvDesc d = cv_desc(F, l * 6 + j);
    r.n0 = nt * 128; r.k0 = kt * 64; r.src = d.src; r.kscale = d.kscale; r.dst = d.dst; r.K = d.K; r.Nsrc = d.Nsrc;
    r.sc0 = cv_map(d.mapid, r.n0); r.sc1 = cv_map(d.mapid, r.n0 + 64); r.ok = true; return r;
}
DI void cv_load(const Frame& F, const CvTile& t, f32x4 (&r)[4]) {
#pragma unroll
    for (int h = 0; h < 2; ++h) { const int sc = h ? t.sc1 : t.sc0;
#pragma unroll
        for (int p = 0; p < 2; ++p) { const int kk = p * 32 + (F.tid >> 4);
            f32x4 v = {0.f, 0.f, 0.f, 0.f};
            if (sc >= 0) { v = __builtin_nontemporal_load((const f32x4*)(t.src + (size_t)(t.k0 + kk) * t.Nsrc + sc + (F.tid & 15) * 4)); if (t.kscale) v *= t.kscale[t.k0 + kk]; }
            r[h * 2 + p] = v; } }
}
DI void p_convert(const Frame& F) {
    LAS float* ts = (LAS float*)F.lds;
    int t = F.vcu; CvTile cur = cv_tile(F, t), nx1 = cv_tile(F, t + F.G); f32x4 r0[4], r1[4]; int buf = 0;
    if (cur.ok) cv_load(F, cur, r0);
    if (nx1.ok) cv_load(F, nx1, r1);
    while (cur.ok) {
        LAS float* tb = ts + buf * (2 * 64 * 65);
#pragma unroll
        for (int h = 0; h < 2; ++h)
#pragma unroll
            for (int p = 0; p < 2; ++p) { const int kk = p * 32 + (F.tid >> 4); LAS float* q = tb + h * (64 * 65) + kk * 65 + (F.tid & 15) * 4;
                q[0] = r0[h * 2 + p][0]; q[1] = r0[h * 2 + p][1]; q[2] = r0[h * 2 + p][2]; q[3] = r0[h * 2 + p][3]; }
        __syncthreads();
#pragma unroll
        for (int i = 0; i < 4; ++i) r0[i] = r1[i];
        const CvTile nx2 = cv_tile(F, t + 2 * F.G);
        if (nx2.ok) cv_load(F, nx2, r1);
#pragma unroll
        for (int h = 0; h < 2; ++h) { const int n = F.tid >> 3, kc = F.tid & 7; const LAS float* q = tb + h * (64 * 65) + n; f32x4 a, b;
#pragma unroll
            for (int j = 0; j < 4; ++j) { a[j] = q[(kc * 8 + j) * 65]; b[j] = q[(kc * 8 + 4 + j) * 65]; }
            *(u32x4*)(cur.dst + (size_t)(cur.n0 + h * 64 + n) * cur.K + cur.k0 + kc * 8) = pk8(a, b); }
        buf ^= 1; t += F.G; cur = nx1; nx1 = nx2;
    }
    __syncthreads();
}

DI void norm_phase(const Frame& F, const float* xl, const float* xc, const bf16_t* xb, int M, const float* g, const float* modl, int sh_off, int sc_off, bf16_t* H, float* outf) {
    const int gw = F.vcu * 8 + F.wave, nw = F.G * 8;
    const int row_lo = (int)(((long)gw * M) / nw), row_hi = (int)(((long)(gw + 1) * M) / nw);
    f32x4 gs[8], shv[8]; int cur = -1;
    for (int row = row_lo; row < row_hi; ++row) {
        const int midx = row < ML ? (row >> 12) : 4;
        if (midx != cur) { cur = midx;
#pragma unroll
            for (int i = 0; i < 4; ++i) { const int col = i * 512 + F.lane * 8;
                gs[2 * i] = *(const f32x4*)(g + col); gs[2 * i + 1] = *(const f32x4*)(g + col + 4);
                if (!outf) { const float* mp = modl + (size_t)midx * 12288 + col;
                    gs[2 * i] = gs[2 * i] * (1.f + *(const f32x4*)(mp + sc_off)); gs[2 * i + 1] = gs[2 * i + 1] * (1.f + *(const f32x4*)(mp + sc_off + 4));
                    shv[2 * i] = *(const f32x4*)(mp + sh_off); shv[2 * i + 1] = *(const f32x4*)(mp + sh_off + 4); } } }
        f32x4 v[8]; float ss = 0.f;
        if (xb) {
#pragma unroll
            for (int i = 0; i < 4; ++i) { const u32x4 w = *(const u32x4*)(xb + (size_t)row * D + i * 512 + F.lane * 8); v[2 * i] = bf4((u32x2){w.x, w.y}); v[2 * i + 1] = bf4((u32x2){w.z, w.w}); ss += sq4(v[2 * i]) + sq4(v[2 * i + 1]); }
        } else { const float* xr = row < ML ? xl + (size_t)row * D : xc + (size_t)(row - ML) * D;
#pragma unroll
            for (int i = 0; i < 4; ++i) { v[2 * i] = *(const f32x4*)(xr + i * 512 + F.lane * 8); v[2 * i + 1] = *(const f32x4*)(xr + i * 512 + F.lane * 8 + 4); ss += sq4(v[2 * i]) + sq4(v[2 * i + 1]); } }
#pragma unroll
        for (int o = 32; o >= 1; o >>= 1) ss += shx(ss, o, F.lane);
        const float rs = __builtin_amdgcn_rsqf(ss * (1.f / 2048.f) + EPS);
#pragma unroll
        for (int i = 0; i < 4; ++i) { const int col = i * 512 + F.lane * 8;
            if (outf) { *(f32x4*)(outf + (size_t)row * D + col) = v[2 * i] * rs * gs[2 * i]; *(f32x4*)(outf + (size_t)row * D + col + 4) = v[2 * i + 1] * rs * gs[2 * i + 1]; }
            else *(u32x4*)(H + (size_t)row * D + col) = pk8(v[2 * i] * rs * gs[2 * i] + shv[2 * i], v[2 * i + 1] * rs * gs[2 * i + 1] + shv[2 * i + 1]); }
    }
}

struct AttnItem {
    const bf16_t* q; const bf16_t* kn; const bf16_t* kr; const bf16_t* vt; bf16_t* o;
    int ldq, ldk, ldo, lat_row0, ctx_row0, t0, ntl, nctx, mode, r0, hn;
};
template <int DQ>
DI void attn_item(const Frame& F, const AttnItem& it, const LAS float* rpb_lds) {
    constexpr int KP = DQ + 8, VP = 72, KS = DQ / 16;
    constexpr int KBYTES = 64 * KP * 2, VBYTES = 128 * VP * 2;
    LAS unsigned char* base = F.lds;
    int tid = threadIdx.x; asm volatile("" : "+v"(tid));
    const int lane = tid & 63, w = __builtin_amdgcn_readfirstlane(tid >> 6), qq = lane & 31, hh = lane >> 5;
    const bool grpB = w >= 4;
    const int ntile = it.ntl + it.nctx;
    u32x4 rk[2], rr, rv[2];
    auto gload = [&](int ti) {
        int rowb, vcol;
        if (ti < it.ntl) { const int kt = it.t0 + ti; rowb = it.lat_row0 + kt * 64; vcol = kt * 64; } else { const int j = ti - it.ntl; rowb = it.ctx_row0 + j * 64; vcol = SEQ + j * 64; }
#pragma unroll
        for (int i = 0; i < 2; ++i) { const int id = tid + i * NT; rk[i] = *(const u32x4*)(it.kn + (size_t)(rowb + (id >> 4)) * it.ldk + (id & 15) * 8);
            rv[i] = *(const u32x4*)(it.vt + (size_t)(id >> 3) * KEYS + vcol + (id & 7) * 8); }
        if (DQ == 192) rr = *(const u32x4*)(it.kr + (size_t)(rowb + (tid >> 3)) * UC + (tid & 7) * 8);
    };
    auto lstore = [&](int ti) {
        LAS unsigned char* kb = base + (ti & 1) * KBYTES; LAS unsigned char* vb = base + 2 * KBYTES + (ti % 3) * VBYTES;
#pragma unroll
        for (int i = 0; i < 2; ++i) { const int id = tid + i * NT; *(LAS u32x4*)(kb + ((id >> 4) * KP + (id & 15) * 8) * 2) = rk[i];
            *(LAS u32x4*)(vb + ((id >> 3) * VP + (id & 7) * 8) * 2) = rv[i]; }
        if (DQ == 192) *(LAS u32x4*)(kb + ((tid >> 3) * KP + 128 + (tid & 7) * 8) * 2) = rr;
    };
    bf16x8 qf[KS];
    { const bf16_t* qp = it.q + (size_t)(32 * w + qq) * it.ldq + 8 * hh;
#pragma unroll
        for (int ks = 0; ks < KS; ++ks) qf[ks] = *(const bf16x8*)(qp + 16 * ks); }
    f32x16 o[4];
#pragma unroll
    for (int db = 0; db < 4; ++db)
#pragma unroll
        for (int i = 0; i < 16; ++i) o[db][i] = 0.f;
    f32x16 s[2];
    float mrun = -INFINITY, lrun = 0.f;
    const int r = it.r0 + (w >> 1), wq = 32 * (w & 1) + qq;
    const int rs = min(max(r - 4, 0), 56), cs = min(max(wq - 8, 0), 48);
    auto active = [&](int ti) { const int krow = it.t0 + ti; return !(it.mode == 1 && ti < it.ntl && (krow < rs || krow > rs + 7)); };
    auto qk = [&](int ti) {
        if (!active(ti)) return;
        const int krow_l = (qq & 3) + 4 * ((qq >> 3) & 1) + 8 * ((qq >> 2) & 1) + 16 * (qq >> 4);
        LAS unsigned char* kb = base + (ti & 1) * KBYTES + (krow_l * KP + 8 * hh) * 2;
#pragma unroll
        for (int blk = 0; blk < 2; ++blk)
#pragma unroll
            for (int i = 0; i < 16; ++i) s[blk][i] = 0.f;
        bf16x8 kf[3][2];
#pragma unroll
        for (int p = 0; p < 2; ++p)
#pragma unroll
            for (int blk = 0; blk < 2; ++blk) kf[p][blk] = *(const LAS bf16x8*)(kb + (32 * blk * KP + 16 * p) * 2);
#pragma unroll
        for (int ks = 0; ks < KS; ++ks) {
            if (ks + 2 < KS) {
#pragma unroll
                for (int blk = 0; blk < 2; ++blk) kf[(ks + 2) % 3][blk] = *(const LAS bf16x8*)(kb + (32 * blk * KP + 16 * (ks + 2)) * 2); }
            __builtin_amdgcn_sched_barrier(0);
#pragma unroll
            for (int blk = 0; blk < 2; ++blk) s[blk] = __builtin_amdgcn_mfma_f32_32x32x16_bf16(kf[ks % 3][blk], qf[ks], s[blk], 0, 0, 0);
            __builtin_amdgcn_sched_barrier(0);
        }
    };
    auto smpv = [&](int ti) {
        if (!active(ti)) return;
        LAS unsigned char* vb = base + 2 * KBYTES + (ti % 3) * VBYTES;
        if (it.mode == 1 && ti < it.ntl) {
            const int krow = it.t0 + ti;
            const LAS float* bp = rpb_lds + it.hn * 465 + (krow - r + 7) * 31 - wq + 15;
#pragma unroll
            for (int blk = 0; blk < 2; ++blk)
#pragma unroll
                for (int i = 0; i < 16; ++i) { const int kc = 32 * blk + (i & 3) + 4 * ((i >> 2) & 1) + 8 * hh + 16 * (i >> 3); const bool ok = kc >= cs && kc < cs + 16;
                    const int kcc = ok ? kc : cs; s[blk][i] = ok ? s[blk][i] + bp[kcc] : -INFINITY; }
        }
        float mx = s[0][0];
#pragma unroll
        for (int blk = 0; blk < 2; ++blk)
#pragma unroll
            for (int i = 0; i < 16; ++i) mx = fmaxf(mx, s[blk][i]);
        mx = fmaxf(mx, shx(mx, 32, lane));
        const float mnew = fmaxf(mrun, mx), alpha = __builtin_amdgcn_exp2f(mrun - mnew);
        mrun = mnew;
        float ps = 0.f;
#pragma unroll
        for (int blk = 0; blk < 2; ++blk)
#pragma unroll
            for (int i = 0; i < 16; ++i) { const float p = __builtin_amdgcn_exp2f(s[blk][i] - mnew); s[blk][i] = p; ps += p; }
        lrun = lrun * alpha + ps;
        if (__builtin_amdgcn_ballot_w64(alpha != 1.f) != 0ull) {
#pragma unroll
            for (int db = 0; db < 4; ++db)
#pragma unroll
                for (int i = 0; i < 16; ++i) o[db][i] *= alpha;
        }
        LAS unsigned char* vq = vb + (qq * VP + 8 * hh) * 2;
        auto vload = [&](int step, int db) { return *(const LAS bf16x8*)(vq + (32 * db * VP + 16 * step) * 2); };
        bf16x8 vf[2][4];
#pragma unroll
        for (int db = 0; db < 4; ++db) vf[0][db] = vload(0, db);
#pragma unroll
        for (int st = 0; st < 4; ++st) {
            if (st + 1 < 4) {
#pragma unroll
                for (int db = 0; db < 4; ++db) vf[(st + 1) & 1][db] = vload(st + 1, db); }
            __builtin_amdgcn_sched_barrier(0);
            const int blk = st >> 1, s2 = st & 1;
            u32x4 pw; pw.x = pk2(s[blk][8 * s2], s[blk][8 * s2 + 1]); pw.y = pk2(s[blk][8 * s2 + 2], s[blk][8 * s2 + 3]);
            pw.z = pk2(s[blk][8 * s2 + 4], s[blk][8 * s2 + 5]); pw.w = pk2(s[blk][8 * s2 + 6], s[blk][8 * s2 + 7]);
            const bf16x8 pf = __builtin_bit_cast(bf16x8, pw);
#pragma unroll
            for (int db = 0; db < 4; ++db) o[db] = __builtin_amdgcn_mfma_f32_32x32x16_bf16(vf[st & 1][db], pf, o[db], 0, 0, 0);
            __builtin_amdgcn_sched_barrier(0);
        }
    };

    __syncthreads();
    gload(0); lstore(0);
    if (ntile > 1) gload(1);
    __syncthreads();
    for (int ti = 0; ti < ntile; ++ti) {
        qk(ti);
        if (grpB) { if (ti + 1 < ntile) lstore(ti + 1); if (ti + 2 < ntile) gload(ti + 2); __syncthreads(); }
        smpv(ti);
        if (!grpB) { if (ti + 1 < ntile) lstore(ti + 1); if (ti + 2 < ntile) gload(ti + 2); __syncthreads(); }
    }
    const float lt = lrun + shx(lrun, 32, lane), inv = 1.f / lt;
    bf16_t* op = it.o + (size_t)(32 * w + qq) * it.ldo + 4 * hh;
#pragma unroll
    for (int db = 0; db < 4; ++db)
#pragma unroll
        for (int ig = 0; ig < 4; ++ig) { u32x2 v; v.x = pk2(o[db][4 * ig] * inv, o[db][4 * ig + 1] * inv); v.y = pk2(o[db][4 * ig + 2] * inv, o[db][4 * ig + 3] * inv);
            *(u32x2*)(op + 32 * db + 8 * ig) = v; }
}

#ifndef MLAREP
#define MLAREP 1
#endif
DI void mixer_attention(const Frame& F, int layer, int cidx) {
    const int nitems = (layer == 0 ? 816 : 768) + 512 * (MLAREP - 1);
    bf16_t* U = (bf16_t*)(F.ws + WS_U); bf16_t* Q = (bf16_t*)(F.ws + WS_Q); bf16_t* KN = (bf16_t*)(F.ws + WS_KN);
    bf16_t* VT = (bf16_t*)(F.ws + WS_VT); bf16_t* VNT = (bf16_t*)(F.ws + WS_VNT); bf16_t* CAT = (bf16_t*)(F.ws + WS_CAT);
    unsigned* ctr = (unsigned*)(F.ws + WS_CTR) + cidx;
    LAS float* rpb = (LAS float*)(F.lds + 112 * 1024);
    volatile LAS int* slot = (volatile LAS int*)(F.lds + 112 * 1024 + 8192);
    __syncthreads();
    for (int i = F.tid; i < 4 * 465; i += NT) rpb[i] = F.inp(13)[layer * 4 * 465 + i] * LOG2E;
    for (int step = 0;; ++step) {
        int idx;
        if (step < 2) idx = F.vcu + 256 * step;
        else {
            __syncthreads();
            if (F.tid == 0) *slot = (int)atomicAdd(ctr, 1u);
            __syncthreads();
            idx = 512 + *slot;
        }
        if (idx >= nitems) break;
        AttnItem it; it.kr = nullptr; it.mode = 0; it.r0 = 0; it.hn = 0; it.nctx = 4;
        if (idx < 512 || (idx >= 768 && idx < 800)) {
            int b, h, row0;
            if (idx < 512) { b = idx >> 7; h = (idx >> 4) & 7; row0 = b * 4096 + (idx & 15) * 256; it.t0 = 0; it.ntl = 64; }
            else { const int j = idx - 768; b = j >> 3; h = j & 7; row0 = ML + b * 256; it.t0 = 0; it.ntl = 0; }
            it.q = Q + (size_t)row0 * 1536 + h * 192; it.ldq = 1536;
            it.kn = KN + h * 128; it.ldk = 1024; it.kr = U + U_KR;
            it.vt = VT + (size_t)(b * 8 + h) * 128 * KEYS;
            it.o = CAT + (size_t)row0 * D + h * 128; it.ldo = D;
            it.lat_row0 = b * 4096; it.ctx_row0 = ML + b * 256;
            attn_item<192>(F, it, rpb);
        } else {
            int b, hn, row0;
            if (idx < 768) { const int j = idx - 512; b = j >> 6; hn = (j >> 4) & 3; const int R = j & 15; row0 = b * 4096 + R * 256;
                const int rlo = max(4 * R - 4, 0), rhi = min(max(4 * R - 1, 0), 56) + 7; it.t0 = rlo; it.ntl = rhi - rlo + 1; it.mode = 1; it.r0 = 4 * R; it.hn = hn; }
            else { const int j = idx - 800; b = j >> 2; hn = j & 3; row0 = ML + b * 256; it.t0 = 0; it.ntl = 0; }
            it.q = U + (size_t)row0 * UC + U_QN + hn * 128; it.ldq = UC;
            it.kn = U + U_KN + hn * 128; it.ldk = UC;
            it.vt = VNT + (size_t)(b * 4 + hn) * 128 * KEYS;
            it.o = CAT + (size_t)row0 * D + 1024 + hn * 128; it.ldo = D;
            it.lat_row0 = b * 4096; it.ctx_row0 = ML + b * 256;
            attn_item<128>(F, it, rpb);
        }
    }
}


#define XB_TMO      128
#define XB_XCNT(j)  (256  + 64 * (j))
#define XB_XSUB(j)  (1280 + 64 * (j))
#define XB_XGEN(j)  (2304 + 64 * (j))
#define XB_TOP      3328
#define XB_TOPGEN   3392
#define XCD_BAR_WORDS 3456
#define XB_SPIN_CAP (1u << 18)
__device__ __forceinline__ unsigned xb_ld(unsigned* p)              { return __hip_atomic_load(p, __ATOMIC_RELAXED, __HIP_MEMORY_SCOPE_AGENT); }
__device__ __forceinline__ unsigned xb_add(unsigned* p, unsigned v) { return __hip_atomic_fetch_add(p, v, __ATOMIC_RELAXED, __HIP_MEMORY_SCOPE_AGENT); }
__device__ __forceinline__ unsigned xb_xcc_id() { return (unsigned)__builtin_amdgcn_s_getreg((3 << 11) | 20) & 0xFu; }
#define XB_SPIN(cond, bar) do { unsigned _sp = 0; while (cond) { __builtin_amdgcn_s_sleep(1); \
    if ((++_sp & 255u) == 0u) { if (xb_ld(&(bar)[XB_TMO])) break; if (_sp > XB_SPIN_CAP) { atomicAdd(&(bar)[XB_TMO], 1u); break; } } } } while (0)
struct XcdBarrier { unsigned* bar; unsigned x; volatile LAS unsigned* st; };
__device__ __forceinline__ XcdBarrier xcd_barrier_post(unsigned* bar, volatile LAS unsigned* st) {
    XcdBarrier b; b.bar = bar; b.x = xb_xcc_id(); b.st = st;
    if (threadIdx.x == 0) (void)xb_add(&bar[XB_XCNT(b.x)], 1u);
    return b;
}
__device__ __forceinline__ void xcd_barrier_complete(unsigned* bar, unsigned x, unsigned& nloc, unsigned& nx) {
    const unsigned G = gridDim.x * gridDim.y * gridDim.z;
    unsigned sum, cnt, mine, sp = 0u;
    for (;;) {
        sum = 0u; cnt = 0u; mine = 0u;
#pragma unroll
        for (unsigned j = 0; j < 16; ++j) { const unsigned c = xb_ld(&bar[XB_XCNT(j)]); sum += c; cnt += (c > 0u) ? 1u : 0u; mine = (j == x) ? c : mine; }
        if (sum == G) break;
        __builtin_amdgcn_s_sleep(1);
        if ((++sp & 255u) == 0u) { if (xb_ld(&bar[XB_TMO])) break; if (sp > XB_SPIN_CAP) { atomicAdd(&bar[XB_TMO], 1u); break; } }
    }
    nloc = mine > 0u ? mine : 1u; nx = cnt > 0u ? cnt : 1u;
}
__device__ __forceinline__ void xcd_barrier(const XcdBarrier& b) {
    asm volatile("s_waitcnt vmcnt(0)" ::: "memory");
    __syncthreads();
    if (threadIdx.x == 0) {
        unsigned* bar = b.bar;
        __builtin_amdgcn_s_waitcnt(0);
        unsigned nloc = b.st[0], nx = b.st[1];
        if (nloc == 0u) { xcd_barrier_complete(bar, b.x, nloc, nx); b.st[0] = nloc; b.st[1] = nx; }
        const unsigned old = xb_add(&bar[XB_XSUB(b.x)], 1u);
        const unsigned gen = old / nloc;
        if (old + 1u == (gen + 1u) * nloc) {
            __builtin_amdgcn_fence(__ATOMIC_RELEASE, "agent");
            asm volatile("s_waitcnt vmcnt(0)" ::: "memory");
            const unsigned og = xb_add(&bar[XB_TOP], 1u);
            const unsigned tg = og / nx;
            if (og + 1u == (tg + 1u) * nx) xb_add(&bar[XB_TOPGEN], 1u);
            else XB_SPIN(xb_ld(&bar[XB_TOPGEN]) == tg, bar);
            __builtin_amdgcn_fence(__ATOMIC_ACQUIRE, "agent");
            xb_add(&bar[XB_XGEN(b.x)], 1u);
            asm volatile("s_waitcnt vmcnt(0)" ::: "memory");
        } else {
            XB_SPIN(xb_ld(&bar[XB_XGEN(b.x)]) == gen, bar);
            __builtin_amdgcn_fence(__ATOMIC_ACQUIRE, "agent");
            asm volatile("s_waitcnt vmcnt(0)" ::: "memory");
        }
    }
    __syncthreads();
}

#ifndef PHMASK
#define PHMASK 0x7ff
#endif
#define PH(k) (((PHMASK) >> (k)) & 1)
#ifndef DUPMASK
#define DUPMASK 0x000
#endif
#define REP(k) for (int rep_ = 0, nrep_ = F.nrep((DUPMASK >> (k)) & 1); rep_ < nrep_; ++rep_)
#define Hbuf ((bf16_t*)(F.ws + WS_H))
#define H (Hbuf + D)
#define X ((bf16_t*)(F.ws + WS_X))
#define U ((bf16_t*)(F.ws + WS_U))
#define SSQ ((float*)(F.ws + WS_SSQ))
#define CAT ((bf16_t*)(F.ws + WS_CAT))
#define mod ((const float*)(F.ws + WS_MOD))
#define rope ((const f32x2*)(F.ws + WS_ROPE))
#define GSYNC() do { F.refresh(); { XcdBarrier xb_{(unsigned*)(F.ws + WS_BAR), xb_xcc_id(), (volatile LAS unsigned*)(F.lds + 135 * 1024)}; xcd_barrier(xb_); } F.refresh(); } while (0)
DI void layer_body(Frame& F, const int l) {
        const int Mq = l == 0 ? MT : ML;
#define modl (mod + (size_t)l * 5 * 12288)
#define xbl (l == 0 ? (const bf16_t*)nullptr : (const bf16_t*)X)
        REP(1) {
        if (PH(1)) norm_phase(F, F.inp(0), F.inp(2), xbl, MT, F.inp(6) + l * D, modl, 0, 2048, H, nullptr);
        GSYNC(); }
        REP(2) {
        { pg8::Gemm g{H, (const bf16_t*)(F.ws + WS_WIN) + (size_t)l * UC * D, D, D, D, 0};
          pg8::Sched S; S.init(MT / 256, UC / 256, F.G, F.vcu, 0);
          EpiU E{U, SSQ, (bf16_t*)(F.ws + WS_VNT), rope, 0.08838834764831845f * LOG2E, (bf16_t*)F.outp() + DO_FF};
          if (PH(2)) pg8::gemm_phase(F.lds, g, S, E); }
        GSYNC(); }
        REP(3) {
        { int start = 0;
          { pg8::Gemm g{U + U_CQ, (const bf16_t*)(F.ws + WS_WUQ) + (size_t)l * 1536 * 512, UC, 512, 512, 0};
            pg8::Sched S; S.init(Mq / 256, 6, F.G, F.vcu, start); start += (Mq / 256) * 6;
            EpiQ E{(bf16_t*)(F.ws + WS_Q), SSQ, rope, 0.07216878364870323f * LOG2E};
            if (PH(3)) pg8::gemm_phase(F.lds, g, S, E); }
          { pg8::Gemm g{U + U_CKV, (const bf16_t*)(F.ws + WS_WUKV) + (size_t)l * 2048 * 512, UC, 512, 512, 0};
            pg8::Sched S; S.init(MT / 256, 8, F.G, F.vcu, start); start += (MT / 256) * 8;
            EpiKV E{(bf16_t*)(F.ws + WS_KN), (bf16_t*)(F.ws + WS_VT), SSQ};
            if (PH(4)) pg8::gemm_phase(F.lds, g, S, E); }
          { pg8::Gemm g{(const bf16_t*)(F.ws + WS_WC) + (size_t)l * 1024 * 256, (const bf16_t*)F.outp() + DO_FF, 256, 1024, 256, 0};
            SchedY S; S.init(F.G, F.vcu, start); start += 144;
            EpiY E{(bf16_t*)(F.ws + WS_YT), (bf16_t*)(F.ws + WS_YTC), 0};
            if (PH(5)) pg8::gemm_phase(F.lds, g, S, E); }
          if (l == 0) { pg8::Gemm g{(const bf16_t*)(F.ws + WS_WC) + (size_t)l * 1024 * 256, (const bf16_t*)F.outp() + DO_FF + (size_t)ML * 1024, 256, 1024, 256, 0};
            pg8::Sched S; S.init(4, MC / 256, F.G, F.vcu, start); S.kobm = 256;
            EpiY E{(bf16_t*)(F.ws + WS_YT), (bf16_t*)(F.ws + WS_YTC), ML};
            if (PH(5)) pg8::gemm_phase(F.lds, g, S, E); } }
        GSYNC(); }
        REP(7) {
        if (F.vcu < 128 || (l == 0 && F.vcu < 136)) {
            const bool cx = F.vcu >= 128; const int ld = cx ? 512 : 4096;
            long zo = 0; asm volatile("" : "+s"(zo)); const bf16_t* dftp = (const bf16_t*)F.P.out + zo;
            pg8::Gemm g{dftp + (cx ? DO_DFTC : DO_DFT), (const bf16_t*)(F.ws + (cx ? WS_YTC : WS_YT)), ld, ld, ld, 0};
            pg8::OneUnit S; S.u.pm = cx ? 0 : (F.vcu & 15); S.u.pn = cx ? (F.vcu - 128) : (F.vcu >> 4); S.u.kob = 0; S.has = true;
            EpiF E{CAT, cx ? 1 : 0}; if (PH(6)) pg8::gemm_phase(F.lds, g, S, E); }
        if (PH(7)) mixer_attention(F, l, l + 2 * rep_);
        GSYNC(); }
        REP(8) {
        { pg8::Gemm g{CAT, (const bf16_t*)(F.ws + WS_WOUT) + (size_t)l * D * D, D, D, D, 0};
          pg8::Sched S; S.init(Mq / 256, 8, F.G, F.vcu, 0);
          EpiRes E{F.inp(0), F.inp(2), xbl, X, modl + 4096};
          if (PH(8)) pg8::gemm_phase(F.lds, g, S, E); }
        GSYNC(); }
        REP(4) {
        if (PH(1)) norm_phase(F, nullptr, nullptr, X, Mq, F.inp(7) + l * D, modl, 6144, 8192, H, nullptr);
        GSYNC(); }
        REP(10) {
        { pg8::Gemm g{Hbuf, (const bf16_t*)(F.ws + WS_WUP) + (size_t)l * 2 * DFF * D, D, D, D, 1};
          pg8::Sched S; S.init((Mq + 251) / 252, 44, F.G, F.vcu, 0);
          EpiConv E{(bf16_t*)(F.ws + WS_ACT), F.inp(17) + (size_t)l * 3 * 2 * DFF, F.inp(18) + (size_t)l * 2 * DFF, Mq};
          if (PH(10)) pg8::gemm_phase(F.lds, g, S, E); }
        GSYNC(); }
        { pg8::Gemm g{(const bf16_t*)(F.ws + WS_ACT), (const bf16_t*)(F.ws + WS_WDN) + (size_t)l * D * DFF, DFF, DFF, DFF, 0};
          pg8::Sched S; S.init(Mq / 256, 8, F.G, F.vcu, 0);
          EpiRes E{nullptr, nullptr, X, X, modl + 10240};
          if (PH(9)) pg8::gemm_phase(F.lds, g, S, E); }
        GSYNC();

}

__global__ void __launch_bounds__(NT) fwd_megakernel(Params p) {
    extern __shared__ __attribute__((aligned(16))) unsigned char lds_raw[];
    cg::grid_group grid = cg::this_grid();
    const int tid_ = threadIdx.x, G_ = gridDim.x, bx_ = blockIdx.x;
    Frame F{(LAS unsigned char*)lds_raw, lds_raw, tid_, tid_ & 63, __builtin_amdgcn_readfirstlane(tid_ >> 6), G_, (G_ % 8 == 0) ? (bx_ % 8) * (G_ / 8) + bx_ / 8 : bx_, p, p.ws};
    volatile LAS unsigned* xst = (volatile LAS unsigned*)(F.lds + 135 * 1024);
    if (F.tid == 0) { xst[0] = 0u; xst[1] = 0u; }
    __syncthreads();
    (void)xcd_barrier_post((unsigned*)(p.ws + WS_BAR), xst);
    REP(0) { if (PH(0)) { if (F.vcu & 1) { p_tables(F); p_mod(F); } else { p_mod(F); p_tables(F); }
    p_convert(F); }
    grid.sync(); F.refresh(); }

    for (int l = 0; l < 2; ++l) layer_body(F, l);
    if (PH(1)) norm_phase(F, nullptr, nullptr, X, ML, F.inp(20), nullptr, 0, 0, nullptr, F.outp());
}
#undef Hbuf
#undef H
#undef X
#undef U
#undef SSQ
#undef CAT
#undef mod
#undef rope
#undef modl
#undef xbl


extern "C" void kernel_launch(void* const* d_in, const int* in_sizes, int n_in, void* d_out, int out_size, void* d_ws, size_t ws_size, hipStream_t stream) {
    static int grid_blocks = 0;
    if (!grid_blocks) {
        int dev = 0, cus = 0, per_cu = 0;
        hipGetDevice(&dev);
        hipDeviceGetAttribute(&cus, hipDeviceAttributeMultiprocessorCount, dev);
        hipFuncSetAttribute((const void*)fwd_megakernel, hipFuncAttributeMaxDynamicSharedMemorySize, LDS_BYTES);
        hipOccupancyMaxActiveBlocksPerMultiprocessor(&per_cu, (const void*)fwd_megakernel, NT, LDS_BYTES);
        if (per_cu < 1) { fprintf(stderr, "occupancy query says %d blocks/CU\n", per_cu); per_cu = 1; }
        grid_blocks = cus;
        if (ws_size < WS_END) fprintf(stderr, "workspace too small: %zu < %zu\n", ws_size, (size_t)WS_END);
    }
    Params p{};
    for (int i = 0; i < 21; ++i) p.in[i] = (const float*)d_in[i];
    p.out = (float*)d_out; p.ws = (unsigned char*)d_ws;
    hipMemsetAsync((unsigned char*)d_ws + WS_BAR, 0, 16384, stream);
    void* args[] = {&p};
    hipError_t e = hipLaunchCooperativeKernel((const void*)fwd_megakernel, dim3(grid_blocks), dim3(NT), args, LDS_BYTES, stream);
    if (e != hipSuccess) fprintf(stderr, "cooperative launch failed: %s (grid %d)\n", hipGetErrorString(e), grid_blocks);
}
```
